# Optimizing an MI355X kernel written in HIP

```python
import jax, jax.numpy as jnp
from jax import lax
import numpy as np

D_MODEL = 1024
BATCH = 4
SEQ = 4096
DEPTH = 4

N_MIXERS = 3
HEAD_DIM = 64
MIX_HEADS = 12
MIX_WIDTH = MIX_HEADS * HEAD_DIM
MEM_LEN = 256
MEM_HEADS = 4
MEM_WIDTH = MEM_HEADS * HEAD_DIM
CAT_WIDTH = MIX_WIDTH + MEM_WIDTH
KV_HEADS = 4
KV_WIDTH = KV_HEADS * HEAD_DIM
ROT_DIM = HEAD_DIM // 4
ROPE_THETA = 500000.0
CONV_WIDTH = 3
Q_RANK = 256
IDX_HEADS = 8
IDX_DIM = 64
TOPK_MAX = 256
BLOCK = 128
WINDOW = 128
N_EXPERTS = 32
TOP_K = 4
D_EXPERT = 1024
SWIGLU_LIMIT = 7.0
SWIGLU_ALPHA = 1.702
ALPHA = (2 * DEPTH) ** 0.25
BETA = (8 * DEPTH) ** -0.25
LN_EPS = 1e-5
N_A = (DEPTH + 2) // 3
N_B = (DEPTH + 1) // 3
N_C = DEPTH // 3
A_IN = 3 * MIX_WIDTH + MEM_WIDTH
B_IN = Q_RANK + 2 * KV_WIDTH + IDX_DIM + IDX_HEADS + MEM_WIDTH
C_IN = MIX_WIDTH + 2 * KV_WIDTH + MEM_WIDTH

kernel_name = 'hybrid_conv_dsa_swa_memxattn_moe_trunk'


def layer_norm(x, g, b):
    xf = x.astype(jnp.float32)
    mu = xf.mean(-1, keepdims=True)
    var = jnp.square(xf - mu).mean(-1, keepdims=True)
    return ((xf - mu) * lax.rsqrt(var + LN_EPS) * g.astype(jnp.float32) + b.astype(jnp.float32)).astype(x.dtype)


def rms_norm(x, g):
    xf = x.astype(jnp.float32)
    y = xf * lax.rsqrt(jnp.mean(jnp.square(xf), -1, keepdims=True) + LN_EPS)
    return (y * g.astype(jnp.float32)).astype(x.dtype)


def rope_tables(seq_len):
    inv = ROPE_THETA ** (-jnp.arange(0, ROT_DIM, 2, dtype=jnp.float32) / ROT_DIM)
    ang = jnp.arange(seq_len, dtype=jnp.float32)[:, None] * inv[None, :]
    return jnp.cos(ang), jnp.sin(ang)


def partial_rope(x, cos, sin):
    c = cos[None, :, None, :].astype(x.dtype)
    s = sin[None, :, None, :].astype(x.dtype)
    x1 = x[..., :ROT_DIM // 2]
    x2 = x[..., ROT_DIM // 2:ROT_DIM]
    return jnp.concatenate([x1 * c - x2 * s, x2 * c + x1 * s, x[..., ROT_DIM:]], -1)


def memory_attention(qm, mem, w_kv_mem):
    B, S, _ = qm.shape
    M = mem.shape[1]
    q = qm.reshape(B, S, MEM_HEADS, HEAD_DIM)
    k, v = jnp.split(mem @ w_kv_mem, 2, -1)
    k = k.reshape(B, M, MEM_HEADS, HEAD_DIM)
    v = v.reshape(B, M, MEM_HEADS, HEAD_DIM)
    logits = jnp.einsum('bshd,bmhd->bhsm', q, k).astype(jnp.float32) * HEAD_DIM ** -0.5
    p = jax.nn.softmax(logits, -1).astype(v.dtype)
    return jnp.einsum('bhsm,bmhd->bshd', p, v).reshape(B, S, MEM_WIDTH)


def short_conv_mixer(x, w_in, conv_w):
    S = x.shape[1]
    u, b_gate, c_gate, qm = jnp.split(x @ w_in, [MIX_WIDTH, 2 * MIX_WIDTH, 3 * MIX_WIDTH], -1)
    zp = jnp.pad(c_gate * u, ((0, 0), (CONV_WIDTH - 1, 0), (0, 0)))
    conv = conv_w[0] * zp[:, 0:S]
    for tap in range(1, CONV_WIDTH):
        conv = conv + conv_w[tap] * zp[:, tap:tap + S]
    return b_gate * conv, qm


def dsa_mixer(x, w_in, q_norm_g, w_uq, w_uq_idx, cos, sin):
    B, S, _ = x.shape
    o1 = Q_RANK
    o2 = o1 + KV_WIDTH
    o3 = o2 + KV_WIDTH
    o4 = o3 + IDX_DIM
    o5 = o4 + IDX_HEADS
    cq, k, v, k_idx, w_idx, qm = jnp.split(x @ w_in, [o1, o2, o3, o4, o5], -1)
    cq = rms_norm(cq, q_norm_g)
    q = partial_rope((cq @ w_uq).reshape(B, S, MIX_HEADS, HEAD_DIM), cos, sin)
    q_idx = partial_rope((cq @ w_uq_idx).reshape(B, S, IDX_HEADS, IDX_DIM), cos, sin)
    k = partial_rope(k.reshape(B, S, KV_HEADS, HEAD_DIM), cos, sin)
    v = v.reshape(B, S, KV_HEADS, HEAD_DIM)
    k_idx = partial_rope(k_idx[:, :, None, :], cos, sin)[:, :, 0]
    w_idx = w_idx.astype(jnp.float32) * IDX_HEADS ** -0.5
    n_sel = min(TOPK_MAX, S // 4)
    n_blk = S // BLOCK
    rep = MIX_HEADS // KV_HEADS
    key_pos = jnp.arange(S)

    def query_block(j):
        start = j * BLOCK
        qb = lax.dynamic_slice_in_dim(q, start, BLOCK, 1)
        qib = lax.dynamic_slice_in_dim(q_idx, start, BLOCK, 1)
        wb = lax.dynamic_slice_in_dim(w_idx, start, BLOCK, 1)
        q_pos = start + jnp.arange(BLOCK)
        dots = jnp.einsum('bqhd,bsd->bqhs', qib, k_idx).astype(jnp.float32) * IDX_DIM ** -0.5
        score = jnp.einsum('bqh,bqhs->bqs', wb, jax.nn.relu(dots))
        causal = key_pos[None, :] <= q_pos[:, None]
        score = jnp.where(causal[None], score, -jnp.inf)
        _, sel = lax.top_k(score, n_sel)
        valid = sel <= q_pos[None, :, None]
        kg = jax.vmap(lambda kb, ib: kb[ib])(k, sel)
        vg = jax.vmap(lambda vb, ib: vb[ib])(v, sel)
        qb = qb.reshape(B, BLOCK, KV_HEADS, rep, HEAD_DIM)
        logits = jnp.einsum('bqgrd,bqkgd->bqgrk', qb, kg).astype(jnp.float32) * HEAD_DIM ** -0.5
        logits = jnp.where(valid[:, :, None, None, :], logits, -jnp.inf)
        p = jax.nn.softmax(logits, -1).astype(vg.dtype)
        return jnp.einsum('bqgrk,bqkgd->bqgrd', p, vg).reshape(B, BLOCK, MIX_WIDTH)

    out = lax.map(query_block, jnp.arange(n_blk))
    return out.transpose(1, 0, 2, 3).reshape(B, S, MIX_WIDTH), qm


def swa_mixer(x, w_in, sinks, cos, sin):
    B, S, _ = x.shape
    q, k, v, qm = jnp.split(x @ w_in, [MIX_WIDTH, MIX_WIDTH + KV_WIDTH, MIX_WIDTH + 2 * KV_WIDTH], -1)
    q = partial_rope(q.reshape(B, S, MIX_HEADS, HEAD_DIM), cos, sin)
    k = partial_rope(k.reshape(B, S, KV_HEADS, HEAD_DIM), cos, sin)
    v = v.reshape(B, S, KV_HEADS, HEAD_DIM)
    n_blk = S // BLOCK
    rep = MIX_HEADS // KV_HEADS
    qb = q.reshape(B, n_blk, BLOCK, KV_HEADS, rep, HEAD_DIM)

    def band(t):
        tb = jnp.pad(t, ((0, 0), (BLOCK, 0), (0, 0), (0, 0))).reshape(B, n_blk + 1, BLOCK, KV_HEADS, HEAD_DIM)
        return jnp.concatenate([tb[:, :-1], tb[:, 1:]], axis=2)

    kb, vb = band(k), band(v)
    logits = jnp.einsum('bnqgrd,bnkgd->bngrqk', qb, kb).astype(jnp.float32) * HEAD_DIM ** -0.5
    i = jnp.arange(BLOCK)[:, None]
    r = jnp.arange(2 * BLOCK)[None, :]
    blk_start = (jnp.arange(n_blk) * BLOCK)[:, None, None]
    mask = (r > i) & (r <= i + WINDOW) & (blk_start + r >= BLOCK)
    logits = jnp.where(mask[None, :, None, None], logits, -jnp.inf)
    sink = sinks.astype(jnp.float32).reshape(KV_HEADS, rep)[None, None, :, :, None, None]
    m = jnp.maximum(logits.max(-1, keepdims=True), sink)
    e = jnp.exp(logits - m)
    p = e / (e.sum(-1, keepdims=True) + jnp.exp(sink - m))
    o = jnp.einsum('bngrqk,bnkgd->bnqgrd', p.astype(vb.dtype), vb)
    return o.reshape(B, S, MIX_WIDTH), qm


def moe(x, router_w, router_b, w_gate_up, b_gate_up, w_down, b_down):
    B, S, D = x.shape
    xt = x.reshape(B * S, D)
    logits = (xt @ router_w + router_b).astype(jnp.float32)
    top_val, top_idx = lax.top_k(logits, TOP_K)
    gates = jax.nn.softmax(top_val, -1)
    combine = jnp.einsum('tk,tke->te', gates, jax.nn.one_hot(top_idx, N_EXPERTS, dtype=jnp.float32)).astype(x.dtype)
    out = jnp.zeros_like(xt)
    for e in range(N_EXPERTS):
        h = xt @ w_gate_up[e] + b_gate_up[e]
        gate = jnp.minimum(h[:, :D_EXPERT], SWIGLU_LIMIT)
        up = jnp.clip(h[:, D_EXPERT:], -SWIGLU_LIMIT, SWIGLU_LIMIT)
        act = (up + 1.0) * gate * jax.nn.sigmoid(SWIGLU_ALPHA * gate)
        out = out + combine[:, e:e + 1] * (act @ w_down[e] + b_down[e])
    return out.reshape(B, S, D)


def setup_inputs(seed: int = 0) -> dict:
    key = jax.random.key(seed)
    ks = iter(jax.random.split(key, 32))

    def nrm(shape, scale):
        return jax.random.normal(next(ks), shape, jnp.float32) * scale

    return {
        'x': nrm((BATCH, SEQ, D_MODEL), 1.0),
        'mem': nrm((BATCH, MEM_LEN, D_MODEL), 1.0),
        'a_w_in': nrm((N_A, D_MODEL, A_IN), D_MODEL ** -0.5),
        'a_conv_w': nrm((N_A, CONV_WIDTH, MIX_WIDTH), CONV_WIDTH ** -0.5),
        'b_w_in': nrm((N_B, D_MODEL, B_IN), D_MODEL ** -0.5),
        'b_q_norm_g': 1.0 + nrm((N_B, Q_RANK), 0.02),
        'b_w_uq': nrm((N_B, Q_RANK, MIX_WIDTH), Q_RANK ** -0.5),
        'b_w_uq_idx': nrm((N_B, Q_RANK, IDX_HEADS * IDX_DIM), Q_RANK ** -0.5),
        'c_w_in': nrm((N_C, D_MODEL, C_IN), D_MODEL ** -0.5),
        'c_sinks': nrm((N_C, MIX_HEADS), 1.0),
        'w_out': nrm((DEPTH, CAT_WIDTH, D_MODEL), BETA * CAT_WIDTH ** -0.5),
        'w_kv_mem': nrm((DEPTH, D_MODEL, 2 * MEM_WIDTH), D_MODEL ** -0.5),
        'ln1_g': 1.0 + nrm((DEPTH, D_MODEL), 0.02),
        'ln1_b': nrm((DEPTH, D_MODEL), 0.02),
        'router_w': nrm((DEPTH, D_MODEL, N_EXPERTS), D_MODEL ** -0.5),
        'router_b': nrm((DEPTH, N_EXPERTS), 0.01),
        'w_gate_up': nrm((DEPTH, N_EXPERTS, D_MODEL, 2 * D_EXPERT), D_MODEL ** -0.5),
        'b_gate_up': nrm((DEPTH, N_EXPERTS, 2 * D_EXPERT), 0.01),
        'w_down': nrm((DEPTH, N_EXPERTS, D_EXPERT, D_MODEL), BETA * D_EXPERT ** -0.5),
        'b_down': nrm((DEPTH, N_EXPERTS, D_MODEL), 0.01),
        'ln2_g': 1.0 + nrm((DEPTH, D_MODEL), 0.02),
        'ln2_b': nrm((DEPTH, D_MODEL), 0.02),
    }


def reference(x, mem, a_w_in, a_conv_w, b_w_in, b_q_norm_g, b_w_uq, b_w_uq_idx, c_w_in, c_sinks,
              w_out, w_kv_mem, ln1_g, ln1_b, router_w, router_b, w_gate_up, b_gate_up, w_down, b_down,
              ln2_g, ln2_b):
    cos, sin = rope_tables(x.shape[1])
    for i in range(DEPTH):
        kind = i % N_MIXERS
        j = i // N_MIXERS
        if kind == 0:
            mix, qm = short_conv_mixer(x, a_w_in[j], a_conv_w[j])
        elif kind == 1:
            mix, qm = dsa_mixer(x, b_w_in[j], b_q_norm_g[j], b_w_uq[j], b_w_uq_idx[j], cos, sin)
        else:
            mix, qm = swa_mixer(x, c_w_in[j], c_sinks[j], cos, sin)
        mem_out = memory_attention(qm, mem, w_kv_mem[i])
        y = jnp.concatenate([mix, mem_out], -1) @ w_out[i]
        x = layer_norm(ALPHA * x + y, ln1_g[i], ln1_b[i])
        f = moe(x, router_w[i], router_b[i], w_gate_up[i], b_gate_up[i], w_down[i], b_down[i])
        x = layer_norm(ALPHA * x + f, ln2_g[i], ln2_b[i])
    return x
```

```cpp
#include <hip/hip_runtime.h>
#include <cstdio>
#include <cstdint>
#include <cmath>

#ifndef MK_MULTI
#define MK_MULTI 0
#endif
#ifndef MK_SPLIT
#define MK_SPLIT 0
#endif
#ifndef MK_CHECK
#define MK_CHECK 0
#endif

namespace pg8 {
#define PG8_LAS __attribute__((address_space(3)))
typedef unsigned short bf16_t;
typedef short bf16x8 __attribute__((ext_vector_type(8)));
typedef float f32x4 __attribute__((ext_vector_type(4)));
typedef unsigned u32x4 __attribute__((ext_vector_type(4)));
typedef int i32x8 __attribute__((ext_vector_type(8)));
typedef short bf16x16 __attribute__((ext_vector_type(16)));
typedef unsigned u32x2 __attribute__((ext_vector_type(2)));
constexpr int BM = 256, BK = 64, HALF = 128, HTB = HALF * BK * 2  , STAGE_BYTES = 8 * HTB, NXCD = 8, WGM = 8;

__host__ __device__ __forceinline__ int lds_byte(int r, int c) { const int st = (r >> 4) * 2 + (c >> 5), rr = r & 15, cc = c & 31, ob = rr * 64 + cc * 2; return st * 1024 + (ob ^ (((ob >> 9) & 1) << 5)); }
__host__ __device__ __forceinline__ void stage_rc(int b, int& R, int& C) { const int st = b / 1024, sb = b % 1024, swz = sb ^ (((sb >> 9) & 1) << 5); R = (st >> 1) * 16 + swz / 64; C = (st & 1) * 32 + (swz % 64) / 2; }
__host__ __device__ __forceinline__ int perm32(int rho) { const int n = rho >> 4, i = rho & 15; return 8 * (i >> 2) + 4 * n + (i & 3); }

struct Unit { int pm, pn, hs; };
struct Gemm { const bf16_t* A; const bf16_t* Bt; int M, N, K, lda; };

struct StaticOrder {
    int nM, nN, nwg, G, c, split;
    __host__ __device__ void init(int M, int N, int G_, int c_) { nM = M / BM; nN = N / BM; nwg = nM * nN; G = G_; c = c_; split = 1; }
    __host__ __device__ bool next(int i, Unit& u) const {
        const int nfull = nwg / G, rem = nwg - nfull * G; int L = i * G + c; u.hs = 0;
        if (split && i == nfull && rem > 0 && 2 * rem <= G) { if (c >= 2 * rem) return false; L = nfull * G + (c >> 1); u.hs = 1 + (c & 1); }
        if (L >= nwg) return false;
        int wgid = L; { const int q = nwg / NXCD, r = nwg % NXCD, xcd = wgid % NXCD, off = wgid / NXCD; wgid = (xcd < r ? xcd * (q + 1) : r * (q + 1) + (xcd - r) * q) + off; }
        const int nig = WGM * nN, gid = wgid / nig, fm = gid * WGM, gsz = (nM - fm) < WGM ? (nM - fm) : WGM;
        u.pm = fm + ((wgid % nig) % gsz); u.pn = (wgid % nig) / gsz; return true;
    }
    __device__ __forceinline__ void a_ready(const Unit&) const {}
    __device__ __forceinline__ void done(const Unit&) const {}
};

typedef float f32x2 __attribute__((ext_vector_type(2)));
__device__ __forceinline__ float shx16(float v, int lane, int m) { return __int_as_float(__builtin_amdgcn_ds_bpermute((lane ^ m) << 2, __float_as_int(v))); }
typedef __bf16 bf16x2_t __attribute__((ext_vector_type(2)));
__device__ __forceinline__ unsigned pk4_fp8(float a, float b, float c, float d) { int w = __builtin_amdgcn_cvt_pk_fp8_f32(a, b, 0, false); w = __builtin_amdgcn_cvt_pk_fp8_f32(c, d, w, true); return (unsigned)w; }
__device__ __forceinline__ unsigned cvt_pk_bf16(float lo, float hi) { f32x2 v = {lo, hi}; bf16x2_t b = __builtin_convertvector(v, bf16x2_t); return __builtin_bit_cast(unsigned, b); }

struct EpiProj {
    static constexpr bool PERM = true, AFTER_DRAIN = false, BIAS_LDS = false; static constexpr int NSTORE = 16;
    bf16_t* O; int ldc; const float* ssq_in; float* ssq_out; const f32x2* rope; unsigned rope_heads; float oscale;
    __device__ __forceinline__ void operator()(const f32x4 (&acc)[2][2][4][2], const Unit& u, int wr, int wc, int fr, int fq) const {
        const int row0 = u.pm * BM + (u.hs == 2 ? HALF : 0) + wr * 64 + fr, col0 = u.pn * BM + wc * 32 + 8 * fq;
        const bool do_ssq = (ssq_out != nullptr) && (u.pn == 0);
        const __amdgpu_buffer_rsrc_t ors = __builtin_amdgcn_make_buffer_rsrc((void*)O, 0, 0x7fffffff, 0x00020000);
        const bool any_rope = rope_heads != 0u;
        f32x4 sq_n = {0.f, 0.f, 0.f, 0.f}, cs_n[4];
#pragma unroll
        for (int q = 0; q < 4; ++q) cs_n[q] = (f32x4){0.f, 0.f, 0.f, 0.f};
#define EPI_ROWLOADS(ROW) do { if (ssq_in) sq_n = *(const f32x4*)(ssq_in + (size_t)(ROW) * 4); \
            if (any_rope) { const f32x4* cs_ = (const f32x4*)(rope + (size_t)((ROW) & 4095) * 8); cs_n[0] = cs_[0]; cs_n[1] = cs_[1]; cs_n[2] = cs_[2]; cs_n[3] = cs_[3]; } } while (0)
        EPI_ROWLOADS(row0);
#pragma unroll
        for (int ai = 0; ai < 2; ++ai) if (ai == 0 || u.hs == 0)
#pragma unroll
            for (int m = 0; m < 4; ++m) {
                const int row = row0 + ai * HALF + m * 16;
                const f32x4 s = sq_n, c01 = cs_n[0], c23 = cs_n[1], c45 = cs_n[2], c67 = cs_n[3];
                if (!(ai == 1 && m == 3)) { const int rown = row0 + (m == 3 ? HALF : ai * HALF + (m + 1) * 16); EPI_ROWLOADS(rown); }
                float rs = 1.f;
                if (ssq_in) rs = 1.0f / sqrtf(((s[0] + s[1]) + (s[2] + s[3])) * (1.f / 256.f) + 1e-5f);
                float ss = 0.f;
#pragma unroll
                for (int bj = 0; bj < 2; ++bj) {
                    f32x4 v0 = acc[ai][bj][m][0] * oscale, v1 = acc[ai][bj][m][1] * oscale;
                    if (do_ssq) ss += ((v0[0] * v0[0] + v0[1] * v0[1]) + (v0[2] * v0[2] + v0[3] * v0[3])) + ((v1[0] * v1[0] + v1[1] * v1[1]) + (v1[2] * v1[2] + v1[3] * v1[3]));
                    v0 = v0 * rs; v1 = v1 * rs;
                    const int head = (u.pn * BM + bj * HALF + wc * 32) >> 6;
                    if (((rope_heads >> head) & 1u) && !(wc & 1)) {
                        f32x4 o0, o1;
#pragma unroll
                        for (int j = 0; j < 4; ++j) { o0[j] = shx16(v0[j], fr + 16 * fq, 16); o1[j] = shx16(v1[j], fr + 16 * fq, 16); }
                        if (fq < 2) {
                            const float sg = fq == 0 ? -1.f : 1.f;
                            v0[0] = v0[0] * c01[0] + sg * o0[0] * c01[1]; v0[1] = v0[1] * c01[2] + sg * o0[1] * c01[3];
                            v0[2] = v0[2] * c23[0] + sg * o0[2] * c23[1]; v0[3] = v0[3] * c23[2] + sg * o0[3] * c23[3];
                            v1[0] = v1[0] * c45[0] + sg * o1[0] * c45[1]; v1[1] = v1[1] * c45[2] + sg * o1[1] * c45[3];
                            v1[2] = v1[2] * c67[0] + sg * o1[2] * c67[1]; v1[3] = v1[3] * c67[2] + sg * o1[3] * c67[3];
                        }
                    }
                    u32x4 w; w.x = cvt_pk_bf16(v0[0], v0[1]); w.y = cvt_pk_bf16(v0[2], v0[3]); w.z = cvt_pk_bf16(v1[0], v1[1]); w.w = cvt_pk_bf16(v1[2], v1[3]);
                    __builtin_amdgcn_raw_buffer_store_b128(w, ors, (row * ldc + col0 + bj * HALF) * 2, 0, 0);
                }
                if (do_ssq) { ss += shx16(ss, fr + 16 * fq, 16); ss += shx16(ss, fr + 16 * fq, 32); if (fq == 0) ssq_out[(size_t)row * 4 + wc] = ss; }
            }
#undef EPI_ROWLOADS
    }
};
struct EpiSwiglu {
    static constexpr bool PERM = true, AFTER_DRAIN = false, BIAS_LDS = true; static constexpr int NSTORE = 8;
    bf16_t* O; const float* bias;
    static constexpr float WSC = 1.0f / 64.0f;
    __device__ __forceinline__ void stage_bias(const Unit& u, PG8_LAS void* dst, int lane) const {
        const __amdgpu_buffer_rsrc_t brs = __builtin_amdgcn_make_buffer_rsrc((void*)bias, 0, 32 * 2048 * 4, 0x00020000);
        const int e = u.pn >> 3, t = u.pn & 7;
        __builtin_amdgcn_raw_ptr_buffer_load_lds(brs, dst, 16, (lane & 31) * 16 + (lane >> 5) * 4096, (e * 2048 + t * 128) * 4, 0, 0);
    }
    __device__ __forceinline__ void operator()(const f32x4 (&acc)[2][2][4][2], const Unit& u, int wr, int wc, int fr, int fq, const PG8_LAS float* bl) const {
        const int t = u.pn & 7;
        const int row0 = u.pm * BM + (u.hs == 2 ? HALF : 0) + wr * 64 + fr, jl = wc * 32 + 8 * fq, j0 = t * 128 + jl;
        const f32x4 bg0 = *(const PG8_LAS f32x4*)(bl + jl), bg1 = *(const PG8_LAS f32x4*)(bl + jl + 4), bu0 = *(const PG8_LAS f32x4*)(bl + 128 + jl), bu1 = *(const PG8_LAS f32x4*)(bl + 128 + jl + 4);
#pragma unroll
        for (int ai = 0; ai < 2; ++ai) if (ai == 0 || u.hs == 0)
#pragma unroll
            for (int m = 0; m < 4; ++m) {
                const int row = row0 + ai * HALF + m * 16;
                float r[8];
#pragma unroll
                for (int n = 0; n < 2; ++n) {
                    const f32x4 g4 = acc[ai][0][m][n] * WSC + (n ? bg1 : bg0), u4 = acc[ai][1][m][n] * WSC + (n ? bu1 : bu0);
#pragma unroll
                    for (int j = 0; j < 4; ++j) {
                        const float g = fminf(g4[j], 7.0f), up = fminf(fmaxf(u4[j], -7.0f), 7.0f);
                        const float sg = __builtin_amdgcn_rcpf(1.0f + __builtin_amdgcn_exp2f(g * (-1.702f * 1.4426950408889634f)));
                        r[n * 4 + j] = (up + 1.0f) * g * sg;
                    }
                }
                u32x2 w; w.x = pk4_fp8(r[0], r[1], r[2], r[3]); w.y = pk4_fp8(r[4], r[5], r[6], r[7]);
                *(u32x2*)((unsigned char*)O + (size_t)row * 1024 + j0) = w;
            }
    }
};
struct EpiDown {
    static constexpr bool PERM = true, AFTER_DRAIN = false, BIAS_LDS = true; static constexpr int NSTORE = 16;
    bf16_t* O; const float* bias;
    __device__ __forceinline__ void stage_bias(const Unit& u, PG8_LAS void* dst, int lane) const {
        const __amdgpu_buffer_rsrc_t brs = __builtin_amdgcn_make_buffer_rsrc((void*)bias, 0, 32 * 1024 * 4, 0x00020000);
        const int e = u.pn >> 2, t = u.pn & 3;
        __builtin_amdgcn_raw_ptr_buffer_load_lds(brs, dst, 16, lane * 16, (e * 1024 + t * 256) * 4, 0, 0);
    }
    __device__ __forceinline__ void operator()(const f32x4 (&acc)[2][2][4][2], const Unit& u, int wr, int wc, int fr, int fq, const PG8_LAS float* bl) const {
        const int t = u.pn & 3;
        const int row0 = u.pm * BM + (u.hs == 2 ? HALF : 0) + wr * 64 + fr, cl = wc * 32 + 8 * fq, col0 = t * BM + cl;
        f32x4 bv[2][2];
#pragma unroll
        for (int bj = 0; bj < 2; ++bj)
#pragma unroll
            for (int n = 0; n < 2; ++n) bv[bj][n] = *(const PG8_LAS f32x4*)(bl + cl + bj * HALF + 4 * n);
#pragma unroll
        for (int ai = 0; ai < 2; ++ai) if (ai == 0 || u.hs == 0)
#pragma unroll
            for (int m = 0; m < 4; ++m) { unsigned char* rowp = (unsigned char*)O + (size_t)(row0 + ai * HALF + m * 16) * 1024 + col0;
#pragma unroll
                for (int bj = 0; bj < 2; ++bj) { const f32x4 v0 = (acc[ai][bj][m][0] * (1.0f / 128.0f) + bv[bj][0]) * 16.0f, v1 = (acc[ai][bj][m][1] * (1.0f / 128.0f) + bv[bj][1]) * 16.0f;
                    u32x2 w; w.x = pk4_fp8(v0[0], v0[1], v0[2], v0[3]); w.y = pk4_fp8(v1[0], v1[1], v1[2], v1[3]);
                    *(u32x2*)(rowp + bj * HALF) = w; } }
    }
};
struct MoeOrder {
    const PG8_LAS int* pref; const PG8_LAS int* tiles; int ntn, total, G, vcu;
    __device__ __forceinline__ bool next(int i, Unit& u) const {
        const int nfull = total / G, rem = total - nfull * G; int L = i * G + vcu; u.hs = 0;
        if (i == nfull && rem > 0 && 2 * rem <= G) { if (vcu >= 2 * rem) return false; L = nfull * G + (vcu >> 1); u.hs = 1 + (vcu & 1); }
        if (L >= total) return false;
        int e = 0;
        for (int k = 1; k < 32; ++k) e += (pref[k] <= L) ? 1 : 0;
        const int r = L - pref[e], te = tiles[e];
        const int grp = te * 4, ntq = r / grp, r2 = r - ntq * grp, mt = r2 >> 2, ntl = r2 & 3;
        u.pm = __builtin_amdgcn_readfirstlane(e * 64 + mt); u.pn = __builtin_amdgcn_readfirstlane(e * ntn + ntq * 4 + ntl); return true;
    }
    __device__ __forceinline__ void a_ready(const Unit&) const {}
    __device__ __forceinline__ void done(const Unit&) const {}
};

template <class Epi, class Sched, bool ALIGN_EPI = false, bool SP2 = false, bool FP8 = false>
__device__ __forceinline__ void gemm_phase(PG8_LAS unsigned char* lds, const Gemm g, const Sched& S, const Epi& E, const int tid_in) {
    const int tid_ = tid_in;
    const int tid = tid_, wid = __builtin_amdgcn_readfirstlane(tid >> 6), lane = tid & 63, wr = wid >> 2, wc = wid & 3, fr = lane & 15, fq = lane >> 4;
    const int K = g.K, nt = K / BK;
    unsigned voffA[2], voffB[2];
#pragma unroll
    for (int i = 0; i < 2; ++i) { int R, C; stage_rc(tid * 16 + i * 8192, R, C); const int Rb = Epi::PERM ? ((R & ~31) + perm32(R & 31)) : R;
        voffA[i] = (unsigned)(R * g.lda + C) * 2u; voffB[i] = (unsigned)(Rb * K + C) * 2u; }
    const unsigned kstep = (unsigned)(BK * 2);
    const unsigned hstepA = (unsigned)HALF * g.lda * 2, hstepB = (unsigned)HALF * K * 2;
    const unsigned tstepA = 2 * hstepA, tstepB = 2 * hstepB;
    const unsigned ldsw = (unsigned)wid * 1024u;
    const int aoff = lds_byte(wr * 64 + fr, fq * 8), boff = lds_byte(wc * 32 + fr, fq * 8);
#define PG8_SA(b, h) (((b) * 2 + (h)) * HTB)
#define PG8_SB(b, h) ((4 + (b) * 2 + (h)) * HTB)
    const __amdgpu_buffer_rsrc_t rA = __builtin_amdgcn_make_buffer_rsrc((void*)g.A, 0, 0x7fffffff, 0x00020000), rB = __builtin_amdgcn_make_buffer_rsrc((void*)g.Bt, 0, 0x7fffffff, 0x00020000);
#define PG8_STAGE(bufoff, soff, voff, rs) do { _Pragma("unroll") for (int _i = 0; _i < 2; ++_i) \
        __builtin_amdgcn_raw_ptr_buffer_load_lds(rs, (PG8_LAS void*)(lds + (bufoff) + ldsw + _i * 8192), 16, (int)(voff)[_i], (int)(soff), 0, 0); } while (0)
#define PG8_LD2(P) __builtin_shufflevector(*(const PG8_LAS bf16x8*)(P), *(const PG8_LAS bf16x8*)((P) + 1024), 0, 1, 2, 3, 4, 5, 6, 7, 8, 9, 10, 11, 12, 13, 14, 15)
#define PG8_LDA(dst, b, h) do { _Pragma("unroll") for (int m = 0; m < 4; ++m) dst[m] = PG8_LD2(lds + PG8_SA(b, h) + aoff + m * 2048); } while (0)
#define PG8_LDB(dst, b, h) do { _Pragma("unroll") for (int n = 0; n < 2; ++n) dst[n] = PG8_LD2(lds + PG8_SB(b, h) + boff + n * 2048); } while (0)
#define PG8_LO(X) __builtin_shufflevector((X), (X), 0, 1, 2, 3, 4, 5, 6, 7)
#define PG8_HI(X) __builtin_shufflevector((X), (X), 8, 9, 10, 11, 12, 13, 14, 15)
#define PG8_MMA(ai, bj, At, Bt) do { __builtin_amdgcn_s_setprio(1); if constexpr (FP8) { _Pragma("unroll") for (int m = 0; m < 4; ++m) _Pragma("unroll") for (int n = 0; n < 2; ++n) \
        acc[ai][bj][m][n] = __builtin_amdgcn_mfma_scale_f32_16x16x128_f8f6f4(__builtin_bit_cast(i32x8, Bt[n]), __builtin_bit_cast(i32x8, At[m]), acc[ai][bj][m][n], 0, 0, 0, 0x7f7f7f7f, 0, 0x7f7f7f7f); \
        asm volatile("" : "+v"(acc[ai][bj][0][0]), "+v"(acc[ai][bj][0][1]), "+v"(acc[ai][bj][1][0]), "+v"(acc[ai][bj][1][1]), "+v"(acc[ai][bj][2][0]), "+v"(acc[ai][bj][2][1]), "+v"(acc[ai][bj][3][0]), "+v"(acc[ai][bj][3][1]));   } else { \
        _Pragma("unroll") for (int m = 0; m < 4; ++m) _Pragma("unroll") for (int n = 0; n < 2; ++n) { \
        acc[ai][bj][m][n] = __builtin_amdgcn_mfma_f32_16x16x32_bf16(PG8_LO(Bt[n]), PG8_LO(At[m]), acc[ai][bj][m][n], 0, 0, 0); \
        acc[ai][bj][m][n] = __builtin_amdgcn_mfma_f32_16x16x32_bf16(PG8_HI(Bt[n]), PG8_HI(At[m]), acc[ai][bj][m][n], 0, 0, 0); } } __builtin_amdgcn_s_setprio(0); } while (0)
#define PG8_WAIT_V(n) asm volatile("s_waitcnt vmcnt(" #n ")" ::: "memory")
#define PG8_WAIT_L(n) asm volatile("s_waitcnt lgkmcnt(" #n ")" ::: "memory")
#define PG8_WAIT_V8S do { if (t != 0 || pst == 0) PG8_WAIT_V(8); else if (pst == Epi::NSTORE) asm volatile("s_waitcnt vmcnt(%0)" :: "n"(8 + Epi::NSTORE) : "memory"); else asm volatile("s_waitcnt vmcnt(%0)" :: "n"(8 + Epi::NSTORE / 2) : "memory"); } while (0)
#define PG8_BAR __builtin_amdgcn_s_barrier()
#define PG8_SCHED __builtin_amdgcn_sched_barrier(0)
    Unit cur, nxt; int ui = 0, pst = 0;
    if (!S.next(0, cur)) return;
    f32x4 acc[2][2][4][2];
    float z0_ = 0.f; asm volatile("" : "+v"(z0_));
#pragma unroll
    for (int a = 0; a < 2; ++a)
#pragma unroll
        for (int b = 0; b < 2; ++b)
#pragma unroll
            for (int m = 0; m < 4; ++m)
#pragma unroll
                for (int n = 0; n < 2; ++n) acc[a][b][m][n] = (f32x4){z0_, z0_, z0_, z0_};
    bf16x16 At[4], B0[2], B1[2];
    unsigned cA = (unsigned)cur.pm * tstepA + (cur.hs == 2 ? hstepA : 0u), cB = (unsigned)cur.pn * tstepB;
    S.a_ready(cur);
    if constexpr (SP2) {
        PG8_STAGE(PG8_SB(0, 0), cB, voffB, rB); PG8_STAGE(PG8_SB(0, 1), cB + hstepB, voffB, rB); PG8_STAGE(PG8_SA(0, 0), cA, voffA, rA); PG8_STAGE(PG8_SA(0, 1), cA + hstepA, voffA, rA);
        if (wr == 1) PG8_BAR;
        PG8_WAIT_V(2); PG8_BAR;
        PG8_STAGE(PG8_SB(1, 0), cB + kstep, voffB, rB); PG8_STAGE(PG8_SA(1, 0), cA + kstep, voffA, rA); PG8_STAGE(PG8_SB(1, 1), cB + hstepB + kstep, voffB, rB);
        PG8_WAIT_V(6); PG8_BAR;
    } else {
        PG8_STAGE(PG8_SB(0, 0), cB, voffB, rB); PG8_STAGE(PG8_SA(0, 0), cA, voffA, rA); PG8_STAGE(PG8_SB(0, 1), cB + hstepB, voffB, rB); PG8_STAGE(PG8_SA(0, 1), cA + hstepA, voffA, rA);
        if (wr == 1) PG8_BAR;
        PG8_WAIT_V(4); PG8_BAR;
        PG8_STAGE(PG8_SB(1, 0), cB + kstep, voffB, rB); PG8_STAGE(PG8_SA(1, 0), cA + kstep, voffA, rA); PG8_STAGE(PG8_SB(1, 1), cB + hstepB + kstep, voffB, rB);
        PG8_WAIT_V(6); PG8_BAR;
    }
    for (;;) {
        const bool has_next = S.next(ui + 1, nxt);
        if constexpr (Epi::BIAS_LDS) { if (wid == 0) { int lb_; asm volatile("v_mbcnt_lo_u32_b32 %0, -1, 0\n\tv_mbcnt_hi_u32_b32 %0, -1, %0" : "=v"(lb_)); E.stage_bias(cur, (PG8_LAS void*)(lds + STAGE_BYTES + (ui & 1) * 1024), lb_); } }
        const unsigned nA = has_next ? (unsigned)nxt.pm * tstepA + (nxt.hs == 2 ? hstepA : 0u) : cA, nB = has_next ? (unsigned)nxt.pn * tstepB : cB;
        const bool chalf = cur.hs != 0;
        for (int t = 0; t < nt; t += 2) {
            const bool last = (t == nt - 2);
            const unsigned a1 = cA + (unsigned)(t + 1) * kstep;
            const unsigned a2 = last ? nA : cA + (unsigned)(t + 2) * kstep, b2 = last ? nB : cB + (unsigned)(t + 2) * kstep;
            const unsigned a3 = a2 + kstep, b3 = b2 + kstep;
            if (last && has_next) S.a_ready(nxt);
            if constexpr (SP2) {
            PG8_LDB(B0, 0, 0); PG8_LDB(B1, 0, 1); PG8_SCHED; PG8_LDA(At, 0, 0); PG8_STAGE(PG8_SA(1, 1), a1 + hstepA, voffA, rA);
            PG8_WAIT_V8S; PG8_WAIT_L(0); PG8_BAR; PG8_MMA(0, 0, At, B0); PG8_MMA(0, 1, At, B1); PG8_BAR; PG8_SCHED;
            PG8_LDA(At, 0, 1); PG8_STAGE(PG8_SB(0, 0), b2, voffB, rB); PG8_STAGE(PG8_SB(0, 1), b2 + hstepB, voffB, rB); PG8_STAGE(PG8_SA(0, 0), a2, voffA, rA);
            PG8_WAIT_V8S; PG8_WAIT_L(0); PG8_BAR; if (!chalf) { PG8_MMA(1, 0, At, B0); PG8_MMA(1, 1, At, B1); } PG8_BAR; PG8_SCHED;
            PG8_LDB(B0, 1, 0); PG8_LDB(B1, 1, 1); PG8_SCHED; PG8_LDA(At, 1, 0); PG8_STAGE(PG8_SA(0, 1), a2 + hstepA, voffA, rA);
            PG8_WAIT_V(8); PG8_WAIT_L(0); PG8_BAR; PG8_MMA(0, 0, At, B0); PG8_MMA(0, 1, At, B1); PG8_BAR; PG8_SCHED;
            PG8_LDA(At, 1, 1); PG8_STAGE(PG8_SB(1, 0), b3, voffB, rB); PG8_STAGE(PG8_SB(1, 1), b3 + hstepB, voffB, rB); PG8_STAGE(PG8_SA(1, 0), a3, voffA, rA);
            PG8_WAIT_V(8); PG8_WAIT_L(0); PG8_BAR; if (!chalf) { PG8_MMA(1, 0, At, B0); PG8_MMA(1, 1, At, B1); } PG8_BAR; PG8_SCHED;
            } else {
            PG8_LDB(B0, 0, 0); PG8_SCHED; PG8_LDA(At, 0, 0); PG8_STAGE(PG8_SA(1, 1), a1 + hstepA, voffA, rA);
            PG8_WAIT_L(8); PG8_BAR; PG8_WAIT_L(0); PG8_MMA(0, 0, At, B0); PG8_BAR; PG8_SCHED;
            PG8_LDB(B1, 0, 1); PG8_STAGE(PG8_SB(0, 0), b2, voffB, rB);
            PG8_BAR; PG8_WAIT_L(0); PG8_MMA(0, 1, At, B1); PG8_BAR;
            PG8_LDA(At, 0, 1); PG8_STAGE(PG8_SA(0, 0), a2, voffA, rA);
            PG8_BAR; PG8_WAIT_L(0); PG8_MMA(1, 0, At, B0); PG8_BAR; PG8_SCHED;
            PG8_STAGE(PG8_SB(0, 1), b2 + hstepB, voffB, rB);
            PG8_WAIT_V(6); PG8_BAR; PG8_MMA(1, 1, At, B1); PG8_BAR;
            PG8_LDB(B0, 1, 0); PG8_SCHED; PG8_LDA(At, 1, 0); PG8_STAGE(PG8_SA(0, 1), a2 + hstepA, voffA, rA);
            PG8_WAIT_L(8); PG8_BAR; PG8_WAIT_L(0); PG8_MMA(0, 0, At, B0); PG8_BAR; PG8_SCHED;
            PG8_LDB(B1, 1, 1); PG8_STAGE(PG8_SB(1, 0), b3, voffB, rB);
            PG8_BAR; PG8_WAIT_L(0); PG8_MMA(0, 1, At, B1); PG8_BAR;
            PG8_LDA(At, 1, 1); PG8_STAGE(PG8_SA(1, 0), a3, voffA, rA);
            PG8_BAR; PG8_WAIT_L(0); PG8_MMA(1, 0, At, B0); PG8_BAR; PG8_SCHED;
            PG8_STAGE(PG8_SB(1, 1), b3 + hstepB, voffB, rB);
            PG8_WAIT_V(6); PG8_BAR; PG8_MMA(1, 1, At, B1); PG8_BAR;
            }
        }
        if constexpr (ALIGN_EPI) { if (wr == 0) PG8_BAR; }
        if constexpr (!Epi::AFTER_DRAIN) { int l_; asm volatile("v_mbcnt_lo_u32_b32 %0, -1, 0\n\tv_mbcnt_hi_u32_b32 %0, -1, %0" : "=v"(l_)); if constexpr (Epi::BIAS_LDS) E(acc, cur, wr, wc, l_ & 15, l_ >> 4, (const PG8_LAS float*)(lds + STAGE_BYTES + (ui & 1) * 1024)); else E(acc, cur, wr, wc, l_ & 15, l_ >> 4); S.done(cur); }
        if (!has_next) break;
        asm volatile("" : "+v"(z0_));
#pragma unroll
        for (int a = 0; a < 2; ++a)
#pragma unroll
            for (int b = 0; b < 2; ++b)
#pragma unroll
                for (int m = 0; m < 4; ++m)
#pragma unroll
                    for (int n = 0; n < 2; ++n) acc[a][b][m][n] = (f32x4){z0_, z0_, z0_, z0_};
        pst = cur.hs ? Epi::NSTORE / 2 : Epi::NSTORE; cur = nxt; cA = nA; cB = nB; ++ui;
        if constexpr (ALIGN_EPI) { if (wr == 1) PG8_BAR; }
    }
    PG8_WAIT_V(0);
    if constexpr (!ALIGN_EPI) { if (wr == 0) PG8_BAR; }
    PG8_BAR;
    if constexpr (Epi::AFTER_DRAIN) { E.fused(acc, cur, wr, wc, fr, fq, lds, wid, lane); S.done(cur); }
#undef PG8_SA
#undef PG8_SB
#undef PG8_STAGE
#undef PG8_LDA
#undef PG8_LDB
#undef PG8_MMA
#undef PG8_LD2
#undef PG8_LO
#undef PG8_HI
#undef PG8_WAIT_V
#undef PG8_WAIT_L
#undef PG8_WAIT_V8S
#undef PG8_BAR
#undef PG8_SCHED
}
}

constexpr int NB = 4, SEQ = 4096, T = NB * SEQ, D = 1024, DEPTH = 4, NEXP = 32, DEXP = 1024, MEML = 256;
constexpr int CAPROWS = 16384;
constexpr float LN_EPS = 1e-5f, ALPHA = 1.681792830507429f;
constexpr float LOG2E = 1.4426950408889634f, C2 = 0.125f * 1.4426950408889634f;
constexpr float NEG_BIG = -1.0e30f;
constexpr float NEG_RAW = -0x1p100f;
constexpr int NWAVES = 8, NTHREADS = 512;

constexpr size_t MiB = 1u << 20;
constexpr size_t WS_CTL = 0, CTL_ZERO_BYTES = 65536;
constexpr size_t WS_ROPE = 1 * MiB;
constexpr size_t WS_WUQ = 2 * MiB;
constexpr size_t WS_MEMB = 3 * MiB;
constexpr size_t WS_KVMEM = 5 * MiB;
constexpr size_t WS_WKV = 9 * MiB;
constexpr size_t WS_WOUT = 13 * MiB;
constexpr size_t WS_WIN = 21 * MiB;
constexpr size_t WS_SSQ = 41 * MiB;
constexpr size_t WS_ROWS = 42 * MiB;
constexpr size_t WS_GATES = 43 * MiB;
constexpr size_t WS_MASK = 44 * MiB;
constexpr size_t WS_XB = 52 * MiB;
constexpr size_t WS_CAT = 84 * MiB;
constexpr size_t WS_Y = 116 * MiB;
constexpr size_t WS_QQ = 148 * MiB;
constexpr size_t WS_PROJ = 188 * MiB;
constexpr size_t WS_XB8 = 268 * MiB;
constexpr size_t WS_XA = 268 * MiB;
constexpr size_t WS_XM = 332 * MiB;
constexpr size_t WS_WGU = 400 * MiB;
constexpr size_t WS_WDN = 912 * MiB;
constexpr size_t WS_XP = 1168 * MiB;
constexpr size_t WS_ACT = 2192 * MiB;
constexpr size_t WS_END = 3216 * MiB;
constexpr int CW_TMO = 0, CW_ERR = 2;
constexpr int CW_BAR = 4096;
constexpr int CW_QHEAD = 8192;
constexpr int CW_GCOUNT = 9216;
constexpr int CW_BAR2 = 12288;
constexpr int CW_GDUMMY = 9472;
static_assert((CW_BAR2 + 3456) * 4 <= (int)CTL_ZERO_BYTES && (CW_GDUMMY + 128) * 4 <= (int)CTL_ZERO_BYTES, "CTL words inside the memset region");

constexpr int RING_OFF = 0, RING_BYTES = 131072;
constexpr int LDSCTL_OFF = 143360;
constexpr int L_XB = LDSCTL_OFF + 0;
constexpr int L_Q = LDSCTL_OFF + 16;
constexpr int L_XB2 = LDSCTL_OFF + 32;
constexpr int L_PREF = LDSCTL_OFF + 64;
constexpr int L_TILES = LDSCTL_OFF + 256;
constexpr int L_CNT = LDSCTL_OFF + 384;
constexpr int L_BASE = LDSCTL_OFF + 512;
constexpr int L_ROUTE = LDSCTL_OFF + 1024;
constexpr int LDS_BYTES = 147456;

#define GAS __attribute__((address_space(1)))
#define LAS __attribute__((address_space(3)))
typedef unsigned short bf16;
typedef unsigned u32x4 __attribute__((ext_vector_type(4)));
typedef unsigned u32x2 __attribute__((ext_vector_type(2)));
typedef float f32x4 __attribute__((ext_vector_type(4)));
typedef float f32x2 __attribute__((ext_vector_type(2)));
typedef float f32x16 __attribute__((ext_vector_type(16)));
typedef short bf16x8 __attribute__((ext_vector_type(8)));
typedef short s16x4 __attribute__((ext_vector_type(4)));
typedef short v4i16_t __attribute__((ext_vector_type(4)));
typedef GAS unsigned gu32;
#define RLX_AGENT __ATOMIC_RELAXED, __HIP_MEMORY_SCOPE_AGENT
__device__ __forceinline__ unsigned pk2(float lo, float hi) { return pg8::cvt_pk_bf16(lo, hi); }
__device__ __forceinline__ float bf2f(bf16 b) { return __uint_as_float((unsigned)b << 16); }
__device__ __forceinline__ float bflo(unsigned w) { return __uint_as_float(w << 16); }
__device__ __forceinline__ float bfhi(unsigned w) { return __uint_as_float(w & 0xffff0000u); }
__device__ __forceinline__ int crow(int r, int hi) { return (r & 3) + 8 * (r >> 2) + 4 * hi; }
__device__ __forceinline__ float swapmax(float m) { auto rr = __builtin_amdgcn_permlane32_swap(__float_as_uint(m), __float_as_uint(m), false, false); return fmaxf(__uint_as_float(rr[0]), __uint_as_float(rr[1])); }
__device__ __forceinline__ float swapsum(float m) { auto rr = __builtin_amdgcn_permlane32_swap(__float_as_uint(m), __float_as_uint(m), false, false); return __uint_as_float(rr[0]) + __uint_as_float(rr[1]); }
__device__ __forceinline__ int lane_id_now() { int l; asm volatile("v_mbcnt_lo_u32_b32 %0, -1, 0\n\tv_mbcnt_hi_u32_b32 %0, -1, %0" : "=v"(l)); return l; }
__device__ __forceinline__ float shx(float v, int m) { return __int_as_float(__builtin_amdgcn_ds_bpermute((lane_id_now() ^ m) << 2, __float_as_int(v))); }
__device__ __forceinline__ int shxi(int v, int m) { return __builtin_amdgcn_ds_bpermute((lane_id_now() ^ m) << 2, v); }
__device__ __forceinline__ int shli(int v, int src) { return __builtin_amdgcn_ds_bpermute(src << 2, v); }
__device__ __forceinline__ float wave_sum(float v) {
#pragma unroll
    for (int o = 1; o < 64; o <<= 1) v += shx(v, o);
    return v;
}

#define XB_TMO      128
#define XB_XCNT(j)  (256  + 64 * (j))
#define XB_XSUB(j)  (1280 + 64 * (j))
#define XB_XGEN(j)  (2304 + 64 * (j))
#define XB_TOP      3328
#define XB_TOPGEN   3392
#define XCD_BAR_WORDS 3456
#define XB_SPIN_CAP (1u << 18)

__device__ __forceinline__ unsigned xb_ld(unsigned* p)              { return __hip_atomic_load(p, __ATOMIC_RELAXED, __HIP_MEMORY_SCOPE_AGENT); }
__device__ __forceinline__ unsigned xb_add(unsigned* p, unsigned v) { return __hip_atomic_fetch_add(p, v, __ATOMIC_RELAXED, __HIP_MEMORY_SCOPE_AGENT); }
__device__ __forceinline__ unsigned xb_xcc_id() { return (unsigned)__builtin_amdgcn_s_getreg((3 << 11) | 20) & 0xFu; }
#define XB_SPIN(cond, bar) do { unsigned _sp = 0; while (cond) { __builtin_amdgcn_s_sleep(1); \
    if ((++_sp & 255u) == 0u) { if (xb_ld(&(bar)[XB_TMO])) break; if (_sp > XB_SPIN_CAP) { atomicAdd(&(bar)[XB_TMO], 1u); break; } } } } while (0)

struct XcdBarrier {
    unsigned* bar; unsigned x;
    volatile LAS unsigned* st;
};

__device__ __forceinline__ XcdBarrier xcd_barrier_post(unsigned* bar, volatile LAS unsigned* st) {
    XcdBarrier b; b.bar = bar; b.x = xb_xcc_id(); b.st = st;
    if (threadIdx.x == 0) (void)xb_add(&bar[XB_XCNT(b.x)], 1u);
    return b;
}
__device__ __forceinline__ void xcd_barrier_complete(unsigned* bar, unsigned x, unsigned& nloc, unsigned& nx, const unsigned G) {
    unsigned sum, cnt, mine, sp = 0u;
    for (;;) {
        sum = 0u; cnt = 0u; mine = 0u;
#pragma unroll
        for (unsigned j = 0; j < 16; ++j) { const unsigned c = xb_ld(&bar[XB_XCNT(j)]); sum += c; cnt += (c > 0u) ? 1u : 0u; mine = (j == x) ? c : mine; }
        if (sum == G) break;
        __builtin_amdgcn_s_sleep(1);
        if ((++sp & 255u) == 0u) { if (xb_ld(&bar[XB_TMO])) break; if (sp > XB_SPIN_CAP) { atomicAdd(&bar[XB_TMO], 1u); break; } }
    }
    nloc = mine > 0u ? mine : 1u; nx = cnt > 0u ? cnt : 1u;
}

__device__ __noinline__ void xcd_barrier_ni(unsigned* bar_, unsigned x_, unsigned st_off, bool leader_thread, unsigned G_) {
    XcdBarrier b; b.bar = bar_; b.x = x_; b.st = (volatile LAS unsigned*)(uintptr_t)st_off;
    asm volatile("s_waitcnt vmcnt(0)" ::: "memory");
    __syncthreads();
    if (leader_thread) {
        unsigned* bar = b.bar;
        __builtin_amdgcn_s_waitcnt(0);
        unsigned nloc = b.st[0], nx = b.st[1];
        if (nloc == 0u) { xcd_barrier_complete(bar, b.x, nloc, nx, G_); b.st[0] = nloc; b.st[1] = nx; }
        const unsigned old = xb_add(&bar[XB_XSUB(b.x)], 1u);
        const unsigned gen = old / nloc;
        if (old + 1u == (gen + 1u) * nloc) {
            __builtin_amdgcn_fence(__ATOMIC_RELEASE, "agent");
            asm volatile("s_waitcnt vmcnt(0)" ::: "memory");
            const unsigned og = xb_add(&bar[XB_TOP], 1u);
            const unsigned tg = og / nx;
            if (og + 1u == (tg + 1u) * nx) xb_add(&bar[XB_TOPGEN], 1u);
            else XB_SPIN(xb_ld(&bar[XB_TOPGEN]) == tg, bar);
            __builtin_amdgcn_fence(__ATOMIC_ACQUIRE, "agent");
            xb_add(&bar[XB_XGEN(b.x)], 1u);
            asm volatile("s_waitcnt vmcnt(0)" ::: "memory");
        } else {
            XB_SPIN(xb_ld(&bar[XB_XGEN(b.x)]) == gen, bar);
            __builtin_amdgcn_fence(__ATOMIC_ACQUIRE, "agent");
            asm volatile("s_waitcnt vmcnt(0)" ::: "memory");
        }
    }
    __syncthreads();
}
__device__ __forceinline__ void xcd_barrier(const XcdBarrier& b, bool leader_thread, unsigned G) { xcd_barrier_ni(b.bar, b.x, (unsigned)(uintptr_t)b.st, leader_thread, G); }

struct Frame {
    LAS unsigned char* lds;
    gu32* ctl;
    int tid, lane, wave, bid, G, vcu;
};
struct Job { const float* src; bf16* dst; const float* scale; int ldw, K, col0, nvalid, nblk, row0, item0, f8; float mul; int pad; };
constexpr int NJOBS = 16;
struct Args {
    const float* in[22]; float* out; unsigned char* ws; Job jobs[NJOBS];
    int njob_items, ph_lo, ph_hi, pad;
};
typedef const __attribute__((address_space(4))) Args* ArgsP;

struct TrItem { const float* src; const float* scale; bf16* dst; int ldw, k0, colbase, nvalid, perm, dstK, drow0, f8; float mul; };
__device__ __forceinline__ void tr_load(f32x4 (&v)[16], const TrItem& I, int lane, int wid) {
#pragma unroll
    for (int rr = 0; rr < 16; ++rr) {
        const int k = rr * 8 + wid, n = 4 * lane;
        const float* srow = I.src + (size_t)(I.k0 + k) * I.ldw + I.colbase;
        const int col = (I.perm && n >= 128) ? n + 896 : n;
        if (n + 3 < I.nvalid) v[rr] = __builtin_nontemporal_load((const f32x4*)(srow + col));
        else { f32x4 t; t[0] = (n < I.nvalid) ? srow[col] : 0.f; t[1] = (n + 1 < I.nvalid) ? srow[col + 1] : 0.f; t[2] = (n + 2 < I.nvalid) ? srow[col + 2] : 0.f; t[3] = 0.f; v[rr] = t; }
    }
}
__device__ __forceinline__ void tr_to_lds(const f32x4 (&v)[16], LAS float* scr, const TrItem& I, int lane, int wid) {
#pragma unroll
    for (int rr = 0; rr < 16; ++rr) {
        const int k = rr * 8 + wid;
        const float sc = I.scale ? I.scale[I.k0 + k] * I.mul : I.mul;
        *(LAS f32x4*)(scr + k * 256 + 4 * (lane ^ ((k >> 3) & 15))) = v[rr] * sc;
    }
}
__device__ __forceinline__ void tr_store(const LAS float* scr, const TrItem& I, int lane, int wid) {
#pragma unroll
    for (int q = 0; q < 8; ++q) {
        const int n = wid * 32 + q * 4 + (lane >> 4), a = lane & 15;
        const LAS float* s = scr + (8 * a) * 256 + 4 * ((n >> 2) ^ a) + (n & 3);
        if (I.f8) { u32x2 o; o.x = pg8::pk4_fp8(s[0], s[256], s[2 * 256], s[3 * 256]); o.y = pg8::pk4_fp8(s[4 * 256], s[5 * 256], s[6 * 256], s[7 * 256]);
            __builtin_nontemporal_store(o, (u32x2*)((unsigned char*)I.dst + (size_t)(I.drow0 + n) * I.dstK + I.k0 + 8 * a)); }
        else { u32x4 o; o.x = pk2(s[0], s[256]); o.y = pk2(s[2 * 256], s[3 * 256]); o.z = pk2(s[4 * 256], s[5 * 256]); o.w = pk2(s[6 * 256], s[7 * 256]);
            *(u32x4*)(I.dst + (size_t)(I.drow0 + n) * I.dstK + I.k0 + 8 * a) = o; }
    }
}
__device__ __forceinline__ void sincos_d(double x, float& c, float& s) {
    const double TWO_PI = 6.283185307179586476925, INV_2PI = 0.15915494309189533577;
    const double r = x - TWO_PI * rint(x * INV_2PI), r2 = r * r;
    double sn = 1.0, cs = 1.0;
#pragma unroll
    for (int k = 14; k >= 1; --k) { sn = 1.0 - sn * r2 / (double)((2 * k) * (2 * k + 1)); cs = 1.0 - cs * r2 / (double)((2 * k - 1) * (2 * k)); }
    s = (float)(sn * r); c = (float)cs;
}
constexpr int MOE_ITEMS = DEPTH * NEXP * 96, MOE_ITEMS_LAYER = NEXP * 96;
#ifndef MK_CVT_LAYERS_P0
#define MK_CVT_LAYERS_P0 4
#endif
__device__ __forceinline__ TrItem tr_decode(ArgsP A, unsigned char* ws, int it) {
    TrItem I;
    if (it < MOE_ITEMS) {
        const int le = it / 96, r = it % 96; I.scale = nullptr; I.nvalid = 256; I.dstK = 1024; I.f8 = 1;
        if (r < 64) { const int kb = r >> 3, nb = r & 7; I.src = A->in[16] + (size_t)le * (1024 * 2048); I.ldw = 2048; I.k0 = kb * 128; I.colbase = nb * 128; I.perm = 1;
            I.dst = (bf16*)(ws + WS_WGU + (size_t)le * (2048 * 1024)); I.drow0 = nb * 256; I.mul = 64.0f; }
        else { const int r2 = r - 64, kb = r2 >> 2, nb = r2 & 3; I.src = A->in[18] + (size_t)le * (1024 * 1024); I.ldw = 1024; I.k0 = kb * 128; I.colbase = nb * 256; I.perm = 0;
            I.dst = (bf16*)(ws + WS_WDN + (size_t)le * (1024 * 1024)); I.drow0 = nb * 256; I.mul = 128.0f; }
    } else {
        const int ji = it - MOE_ITEMS; int j = 0;
#pragma unroll
        for (int q = 1; q < NJOBS; ++q) j += (A->jobs[q].item0 <= ji) ? 1 : 0;
        const int K = A->jobs[j].K, r = ji - A->jobs[j].item0, nkb = K >> 7, kb = r % nkb, nb = r / nkb;
        int nv = A->jobs[j].nvalid - nb * 256; nv = nv < 0 ? 0 : (nv > 256 ? 256 : nv);
        I.src = A->jobs[j].src; I.scale = A->jobs[j].scale; I.dst = A->jobs[j].dst; I.ldw = A->jobs[j].ldw; I.k0 = kb * 128; I.colbase = A->jobs[j].col0 + nb * 256; I.nvalid = nv; I.perm = 0;
        I.dstK = K; I.drow0 = A->jobs[j].row0 + nb * 256; I.f8 = A->jobs[j].f8; I.mul = A->jobs[j].mul;
    }
    return I;
}
__device__ __forceinline__ void tr_run(Frame& F, ArgsP A, unsigned char* ws, int j0, int step, int j1, int split, int gap) {
    LAS float* scr = (LAS float*)(F.lds + RING_OFF);
#define TR_ITEM(jj) tr_decode(A, ws, (jj) < split ? (jj) : (jj) + gap)
    if (j0 < j1) {
        f32x4 vA[16], vB[16];
        TrItem ia = TR_ITEM(j0), ib = ia;
        tr_load(vA, ia, F.lane, F.wave);
        if (j0 + step < j1) { ib = TR_ITEM(j0 + step); tr_load(vB, ib, F.lane, F.wave); }
        for (int j = j0; j < j1; j += 2 * step) {
            tr_to_lds(vA, scr, ia, F.lane, F.wave);
            __syncthreads();
            const TrItem ca = ia;
            if (j + 2 * step < j1) { ia = TR_ITEM(j + 2 * step); tr_load(vA, ia, F.lane, F.wave); }
            tr_store(scr, ca, F.lane, F.wave);
            __syncthreads();
            if (j + step < j1) {
                tr_to_lds(vB, scr, ib, F.lane, F.wave);
                __syncthreads();
                const TrItem cb = ib;
                if (j + 3 * step < j1) { ib = TR_ITEM(j + 3 * step); tr_load(vB, ib, F.lane, F.wave); }
                tr_store(scr, cb, F.lane, F.wave);
                __syncthreads();
            }
        }
    }
#undef TR_ITEM
}
__device__ __forceinline__ void p0_prologue(Frame& F, ArgsP A, unsigned char* ws, const int part) {
    constexpr int NP0 = MK_CVT_LAYERS_P0 * MOE_ITEMS_LAYER;
    const int total = NP0 + A->njob_items;
    const int it_lo = (part == 1) ? NP0 : 0, it_hi = (part == 2) ? NP0 : total;
    tr_run(F, A, ws, it_lo + F.bid, F.G, it_hi, NP0, MOE_ITEMS - NP0);
    if (part == 2) return;
    const size_t gt = (size_t)F.bid * NTHREADS + F.tid, NT = (size_t)F.G * NTHREADS;
    { const float* x = A->in[0]; bf16* xb = (bf16*)(ws + WS_XB);
      for (size_t i = gt; i < (size_t)T * D / 8; i += 4 * NT) {
          f32x4 a[4], b[4];
#pragma unroll
          for (int k = 0; k < 4; ++k) if (i + k * NT < (size_t)T * D / 8) { a[k] = *(const f32x4*)(x + (i + k * NT) * 8); b[k] = *(const f32x4*)(x + (i + k * NT) * 8 + 4); }
#pragma unroll
          for (int k = 0; k < 4; ++k) if (i + k * NT < (size_t)T * D / 8) { u32x4 o; o.x = pk2(a[k][0], a[k][1]); o.y = pk2(a[k][2], a[k][3]); o.z = pk2(b[k][0], b[k][1]); o.w = pk2(b[k][2], b[k][3]); *(u32x4*)(xb + (i + k * NT) * 8) = o; } }
      const float* mm = A->in[1]; bf16* mb = (bf16*)(ws + WS_MEMB);
      for (size_t i = gt; i < (size_t)NB * MEML * D / 8; i += NT) { const f32x4 a = *(const f32x4*)(mm + i * 8), b = *(const f32x4*)(mm + i * 8 + 4);
          u32x4 o; o.x = pk2(a[0], a[1]); o.y = pk2(a[2], a[3]); o.z = pk2(b[0], b[1]); o.w = pk2(b[2], b[3]); *(u32x4*)(mb + i * 8) = o; } }
    { f32x2* rt = (f32x2*)(ws + WS_ROPE);
      for (size_t i = gt; i < (size_t)SEQ * 8; i += NT) { const int pos = (int)(i >> 3), k = (int)(i & 7);
          const double inv = k == 0 ? 1.0 : k == 1 ? 0.19392274474868576 : k == 2 ? 0.03760603093086393 : k == 3 ? 0.007292664737217109 : k == 4 ? 0.001414213562373095 : k == 5 ? 0.0002742481756762073 : k == 6 ? 5.318295896944988e-05 : 1.031338537721246e-05;
          float c, s; sincos_d((double)pos * inv, c, s); rt[i] = (f32x2){c, s}; } }
}

struct AttnP {
    const bf16* Q; const bf16* K; const bf16* V; bf16* O; const unsigned long long* mask;
    int ldq, ldk, ldv, ldo, qrow0, krow0, t_lo, t_hi, qpos0, mode, has_sink, o8; float sink2;
};
constexpr int AT_K0 = 0, AT_KSZ = 64 * 144, AT_V0 = 2 * AT_KSZ, AT_VSZ = 8192;
__device__ __forceinline__ s16x4 vtr(const LAS unsigned char* p) { return __builtin_bit_cast(s16x4, __builtin_amdgcn_ds_read_tr16_b64_v4i16((LAS v4i16_t*)p)); }
__device__ __forceinline__ void attn_unit(const Frame& F, const AttnP& P) {
    const int tid = F.tid, lane = F.lane, wid = F.wave, r32 = lane & 31, hi = lane >> 5;
    LAS unsigned char* lds = F.lds + RING_OFF;
    const int skey = tid >> 3, sc = tid & 7;
    const int kdst = skey * 144 + sc * 16;
    const int vdst = (sc >> 2) * 4096 + (skey >> 4) * 1024 + (skey & 15) * 64 + (sc & 3) * 16;
    const bf16* kg = P.K + (size_t)(P.krow0 + skey) * P.ldk + sc * 8;
    const bf16* vg = P.V + (size_t)(P.krow0 + skey) * P.ldv + sc * 8;
    const int qrow = P.qrow0 + wid * 32 + r32;
    bf16x8 qr[4];
#pragma unroll
    for (int d0 = 0; d0 < 4; ++d0) qr[d0] = *(const bf16x8*)(P.Q + (size_t)qrow * P.ldq + d0 * 16 + hi * 8);
    const int qmin = P.qpos0 + wid * 32, qmax = qmin + 31, qpos = qmin + r32;
    float m = P.has_sink ? P.sink2 : NEG_BIG;
    f32x16 o0 = {}, o1 = {}, lacc;
#pragma unroll
    for (int r = 0; r < 16; ++r) lacc[r] = P.has_sink ? 1.f : 0.f;
    const bf16x8 ones8 = (bf16x8){0x3f80, 0x3f80, 0x3f80, 0x3f80, 0x3f80, 0x3f80, 0x3f80, 0x3f80};
    const int vp0 = ((lane >> 4) & 1) * 32 + (lane & 3) * 8 + (4 * hi + ((lane & 15) >> 2)) * 64;
    u32x4 kreg = *(const u32x4*)(kg + (size_t)P.t_lo * 64 * P.ldk), vreg = *(const u32x4*)(vg + (size_t)P.t_lo * 64 * P.ldv);
    const unsigned long long* mrow = P.mode == 2 ? P.mask + (size_t)(wid * 32 + r32) * 64 : nullptr;
    unsigned long long mcur = 0ull, mnxt = P.mode == 2 ? mrow[P.t_lo] : 0ull;
    *(LAS u32x4*)(lds + AT_K0 + kdst) = kreg; *(LAS u32x4*)(lds + AT_V0 + vdst) = vreg;
    __syncthreads();
    for (int t = P.t_lo; t < P.t_hi; ++t) {
        const int cur = (t - P.t_lo) & 1;
        const bool more = (t + 1 < P.t_hi);
        mcur = mnxt;
        if (more) { kreg = *(const u32x4*)(kg + (size_t)(t + 1) * 64 * P.ldk); vreg = *(const u32x4*)(vg + (size_t)(t + 1) * 64 * P.ldv); if (P.mode == 2) mnxt = mrow[t + 1]; }
        bool active = true;
        if (P.mode == 1) active = (64 * t + 63 >= qmin - 127) && (64 * t <= qmax);
        if (P.mode == 2) active = (64 * t <= qmax);
        if (active) {
            const LAS unsigned char* Kb = lds + AT_K0 + cur * AT_KSZ; const LAS unsigned char* Vb = lds + AT_V0 + cur * AT_VSZ;
            f32x16 p0 = {}, p1 = {};
#pragma unroll
            for (int d0 = 0; d0 < 4; ++d0) {
                const bf16x8 a0 = *(const LAS bf16x8*)(Kb + r32 * 144 + (2 * d0 + hi) * 16);
                const bf16x8 a1 = *(const LAS bf16x8*)(Kb + (r32 + 32) * 144 + (2 * d0 + hi) * 16);
                p0 = __builtin_amdgcn_mfma_f32_32x32x16_bf16(a0, qr[d0], p0, 0, 0, 0);
                p1 = __builtin_amdgcn_mfma_f32_32x32x16_bf16(a1, qr[d0], p1, 0, 0, 0);
            }
            float mx = fmaxf(p0[0], p1[0]);
#pragma unroll
            for (int r = 1; r < 16; ++r) mx = fmaxf(fmaxf(mx, p0[r]), p1[r]);
            mx = swapmax(mx) * C2;
            const float mnew = fmaxf(m, mx), alpha = __builtin_amdgcn_exp2f(m - mnew);
            m = mnew;
#pragma unroll
            for (int r = 0; r < 16; r += 2) {
                f32x2 a_ = {p0[r], p0[r + 1]}, b_ = {p1[r], p1[r + 1]}; const f32x2 c2_ = {C2, C2}, nm_ = {-mnew, -mnew};
                a_ = __builtin_elementwise_fma(a_, c2_, nm_); b_ = __builtin_elementwise_fma(b_, c2_, nm_);
                p0[r] = __builtin_amdgcn_exp2f(a_[0]); p0[r + 1] = __builtin_amdgcn_exp2f(a_[1]); p1[r] = __builtin_amdgcn_exp2f(b_[0]); p1[r + 1] = __builtin_amdgcn_exp2f(b_[1]); }
            if (P.mode == 1) {
                const int rel = qpos - 64 * t - 4 * hi;
#pragma unroll
                for (int r = 0; r < 16; ++r) { const int c = (r & 3) + 8 * (r >> 2);
                    p0[r] = ((unsigned)(rel - c) < 128u) ? p0[r] : 0.f; p1[r] = ((unsigned)(rel - c - 32) < 128u) ? p1[r] : 0.f; }
            } else if (P.mode == 2) {
                const unsigned long long w = mcur >> (4 * hi);
                const int wl = (int)(unsigned)w, wh = (int)(unsigned)(w >> 32);
#pragma unroll
                for (int r = 0; r < 16; ++r) { const int c = (r & 3) + 8 * (r >> 2);
                    int d0_ = __builtin_amdgcn_sbfe(wl, c, 1), d1_ = __builtin_amdgcn_sbfe(wh, c, 1); asm("" : "+v"(d0_), "+v"(d1_));
                    p0[r] = __uint_as_float(__float_as_uint(p0[r]) & (unsigned)d0_); p1[r] = __uint_as_float(__float_as_uint(p1[r]) & (unsigned)d1_); }
            }
            if (__any(alpha != 1.0f)) {
#pragma unroll
                for (int r = 0; r < 16; ++r) { o0[r] *= alpha; o1[r] *= alpha; lacc[r] *= alpha; }
            }
            bf16x8 pf[4];
            { u32x4 w;
              w.x = pk2(p0[0], p0[1]); w.y = pk2(p0[2], p0[3]); w.z = pk2(p0[4], p0[5]); w.w = pk2(p0[6], p0[7]); pf[0] = __builtin_bit_cast(bf16x8, w);
              w.x = pk2(p0[8], p0[9]); w.y = pk2(p0[10], p0[11]); w.z = pk2(p0[12], p0[13]); w.w = pk2(p0[14], p0[15]); pf[1] = __builtin_bit_cast(bf16x8, w);
              w.x = pk2(p1[0], p1[1]); w.y = pk2(p1[2], p1[3]); w.z = pk2(p1[4], p1[5]); w.w = pk2(p1[6], p1[7]); pf[2] = __builtin_bit_cast(bf16x8, w);
              w.x = pk2(p1[8], p1[9]); w.y = pk2(p1[10], p1[11]); w.z = pk2(p1[12], p1[13]); w.w = pk2(p1[14], p1[15]); pf[3] = __builtin_bit_cast(bf16x8, w); }
#pragma unroll
            for (int ks = 0; ks < 4; ++ks) {
                const s16x4 a_lo = vtr(Vb + vp0 + ks * 1024), a_hi = vtr(Vb + vp0 + ks * 1024 + 512);
                const s16x4 b_lo = vtr(Vb + vp0 + 4096 + ks * 1024), b_hi = vtr(Vb + vp0 + 4096 + ks * 1024 + 512);
                const bf16x8 va = (bf16x8){a_lo[0], a_lo[1], a_lo[2], a_lo[3], a_hi[0], a_hi[1], a_hi[2], a_hi[3]};
                const bf16x8 vb = (bf16x8){b_lo[0], b_lo[1], b_lo[2], b_lo[3], b_hi[0], b_hi[1], b_hi[2], b_hi[3]};
                o0 = __builtin_amdgcn_mfma_f32_32x32x16_bf16(va, pf[ks], o0, 0, 0, 0);
                o1 = __builtin_amdgcn_mfma_f32_32x32x16_bf16(vb, pf[ks], o1, 0, 0, 0);
                lacc = __builtin_amdgcn_mfma_f32_32x32x16_bf16(ones8, pf[ks], lacc, 0, 0, 0);
            }
        }
        if (more) { *(LAS u32x4*)(lds + AT_K0 + (cur ^ 1) * AT_KSZ + kdst) = kreg; *(LAS u32x4*)(lds + AT_V0 + (cur ^ 1) * AT_VSZ + vdst) = vreg; }
        __syncthreads();
    }
    const float inv = 1.0f / lacc[0];
    if (P.o8) {
        unsigned char* orow8 = (unsigned char*)P.O + (size_t)qrow * P.ldo + 4 * hi;
#pragma unroll
        for (int g = 0; g < 4; ++g) {
            *(unsigned*)(orow8 + 8 * g) = pg8::pk4_fp8(o0[4 * g] * inv, o0[4 * g + 1] * inv, o0[4 * g + 2] * inv, o0[4 * g + 3] * inv);
            *(unsigned*)(orow8 + 32 + 8 * g) = pg8::pk4_fp8(o1[4 * g] * inv, o1[4 * g + 1] * inv, o1[4 * g + 2] * inv, o1[4 * g + 3] * inv);
        }
        return;
    }
    bf16* orow = P.O + (size_t)qrow * P.ldo + 4 * hi;
#pragma unroll
    for (int g = 0; g < 4; ++g) {
        u32x2 w0, w1;
        w0.x = pk2(o0[4 * g] * inv, o0[4 * g + 1] * inv); w0.y = pk2(o0[4 * g + 2] * inv, o0[4 * g + 3] * inv);
        w1.x = pk2(o1[4 * g] * inv, o1[4 * g + 1] * inv); w1.y = pk2(o1[4 * g + 2] * inv, o1[4 * g + 3] * inv);
        *(u32x2*)(orow + 8 * g) = w0; *(u32x2*)(orow + 32 + 8 * g) = w1;
    }
}

__device__ __forceinline__ void conv_item(const bf16* PROJ, const float* cw, bf16* CAT, int idx) {
    const int chunk = idx % 96, run = idx / 96, c0 = chunk * 8, t0 = run * 16;
    float w0[8], w1[8], w2[8];
#pragma unroll
    for (int j = 0; j < 8; ++j) { w0[j] = cw[c0 + j]; w1[j] = cw[768 + c0 + j]; w2[j] = cw[1536 + c0 + j]; }
    float z1[8], z2[8];
#pragma unroll
    for (int j = 0; j < 8; ++j) { z1[j] = 0.f; z2[j] = 0.f; }
    if ((t0 & (SEQ - 1)) != 0) {
#pragma unroll
        for (int back = 2; back >= 1; --back) {
            const bf16* row = PROJ + (size_t)(t0 - back) * 2560;
            const u32x4 uu = *(const u32x4*)(row + c0), cc = *(const u32x4*)(row + 1536 + c0);
            float z[8];
            z[0] = bflo(uu.x) * bflo(cc.x); z[1] = bfhi(uu.x) * bfhi(cc.x); z[2] = bflo(uu.y) * bflo(cc.y); z[3] = bfhi(uu.y) * bfhi(cc.y);
            z[4] = bflo(uu.z) * bflo(cc.z); z[5] = bfhi(uu.z) * bfhi(cc.z); z[6] = bflo(uu.w) * bflo(cc.w); z[7] = bfhi(uu.w) * bfhi(cc.w);
#pragma unroll
            for (int j = 0; j < 8; ++j) { if (back == 2) z2[j] = z[j]; else z1[j] = z[j]; }
        }
    }
    u32x4 in_[2][4][3];
#define CONV_LOADG(G, S) do { _Pragma("unroll") for (int k = 0; k < 4; ++k) { const bf16* row = PROJ + (size_t)(t0 + 4 * (G) + k) * 2560; \
        in_[S][k][0] = *(const u32x4*)(row + c0); in_[S][k][1] = *(const u32x4*)(row + 768 + c0); in_[S][k][2] = *(const u32x4*)(row + 1536 + c0); } } while (0)
    CONV_LOADG(0, 0);
#pragma unroll
    for (int g = 0; g < 4; ++g) {
        if (g < 3) CONV_LOADG(g + 1, (g + 1) & 1);
#pragma unroll
        for (int k = 0; k < 4; ++k) {
            const int i = 4 * g + k;
            const u32x4 uu = in_[g & 1][k][0], bb = in_[g & 1][k][1], cc = in_[g & 1][k][2];
            float z[8], b[8], r[8];
            z[0] = bflo(uu.x) * bflo(cc.x); z[1] = bfhi(uu.x) * bfhi(cc.x); z[2] = bflo(uu.y) * bflo(cc.y); z[3] = bfhi(uu.y) * bfhi(cc.y);
            z[4] = bflo(uu.z) * bflo(cc.z); z[5] = bfhi(uu.z) * bfhi(cc.z); z[6] = bflo(uu.w) * bflo(cc.w); z[7] = bfhi(uu.w) * bfhi(cc.w);
            b[0] = bflo(bb.x); b[1] = bfhi(bb.x); b[2] = bflo(bb.y); b[3] = bfhi(bb.y); b[4] = bflo(bb.z); b[5] = bfhi(bb.z); b[6] = bflo(bb.w); b[7] = bfhi(bb.w);
#pragma unroll
            for (int j = 0; j < 8; ++j) { r[j] = b[j] * ((w0[j] * z2[j] + w1[j] * z1[j]) + w2[j] * z[j]); z2[j] = z1[j]; z1[j] = z[j]; }
            u32x4 o; o.x = pk2(r[0], r[1]); o.y = pk2(r[2], r[3]); o.z = pk2(r[4], r[5]); o.w = pk2(r[6], r[7]);
            (void)o; u32x2 o8_; o8_.x = pg8::pk4_fp8(r[0], r[1], r[2], r[3]); o8_.y = pg8::pk4_fp8(r[4], r[5], r[6], r[7]); *(u32x2*)((unsigned char*)CAT + (size_t)(t0 + i) * 1024 + c0) = o8_;
        }
    }
#undef CONV_LOADG
}

__device__ __forceinline__ void mixer_phase(Frame& F, ArgsP A, unsigned char* ws, int layer, int kind, int qidx) {
    const bf16* PROJ = (const bf16*)(ws + WS_PROJ); bf16* CAT = (bf16*)(ws + WS_CAT); const bf16* KVM = (const bf16*)(ws + WS_KVMEM) + layer * 512;
    const int nproj = kind == 0 ? 2560 : (kind == 1 ? 1280 : 1536), qm_off = kind == 0 ? 2304 : (kind == 1 ? 768 : 1280);
    const int n_main = kind == 0 ? 0 : 768, n_mem = 256, n_conv = kind == 0 ? 192 : 0;
    constexpr int CVT_PER = 12, N_CVT = (DEPTH - MK_CVT_LAYERS_P0) * MOE_ITEMS_LAYER / CVT_PER;
    const int n_cvt = (kind == 1) ? N_CVT : 0;
    const int total = n_main + n_mem + n_conv + n_cvt;
    volatile LAS unsigned* qw = (volatile LAS unsigned*)(F.lds + L_Q);
    for (;;) {
        if (F.tid == 0) *qw = __hip_atomic_fetch_add(F.ctl + CW_QHEAD + 64 * qidx, 1u, RLX_AGENT);
        __syncthreads();
        int u = (int)*qw;
        __syncthreads();
        if (u >= total) break;
        if (n_cvt) {
            if (u < 3 * n_cvt) { if (u % 3 == 2) { const int c = u / 3; tr_run(F, A, ws, MK_CVT_LAYERS_P0 * MOE_ITEMS_LAYER + c * CVT_PER, 1, MK_CVT_LAYERS_P0 * MOE_ITEMS_LAYER + c * CVT_PER + CVT_PER, MOE_ITEMS, 0); continue; } u = (u / 3) * 2 + u % 3; }
            else u -= n_cvt;
        }
        if (u < n_main) {
            AttnP P;
            if (kind == 1) {
                const int qt = 15 - u / 48, rem = u % 48, b = rem / 12, h = rem % 12, g = h / 3;
                P.Q = (const bf16*)(ws + WS_QQ) + h * 64; P.ldq = 1280; P.K = PROJ + 256 + g * 64; P.ldk = 1280; P.V = PROJ + 512 + g * 64; P.ldv = 1280;
                P.O = (bf16*)((unsigned char*)CAT + h * 64); P.ldo = 1024; P.o8 = 1; P.qrow0 = b * SEQ + qt * 256; P.krow0 = b * SEQ; P.t_lo = 0; P.t_hi = qt * 4 + 4; P.qpos0 = qt * 256; P.mode = 2;
                P.mask = (const unsigned long long*)(ws + WS_MASK) + (size_t)P.qrow0 * 64; P.has_sink = 0; P.sink2 = 0.f;
            } else {
                const int b = u / 192, h = (u / 16) % 12, qt = u % 16, g = h / 3;
                P.Q = PROJ + h * 64; P.ldq = 1536; P.K = PROJ + 768 + g * 64; P.ldk = 1536; P.V = PROJ + 1024 + g * 64; P.ldv = 1536;
                P.O = (bf16*)((unsigned char*)CAT + h * 64); P.ldo = 1024; P.o8 = 1; P.qrow0 = b * SEQ + qt * 256; P.krow0 = b * SEQ; P.qpos0 = qt * 256;
                P.t_lo = qt == 0 ? 0 : (qt * 256 - 128) / 64; P.t_hi = qt * 4 + 4; P.mode = 1; P.mask = nullptr; P.has_sink = 1; P.sink2 = A->in[9][h] * LOG2E;
            }
            attn_unit(F, P);
        } else if (u < n_main + n_mem) {
            const int v = u - n_main, b = v / 64, h = (v / 16) % 4, qt = v % 16;
            AttnP P;
            P.Q = PROJ + qm_off + h * 64; P.ldq = nproj; P.K = KVM + h * 64; P.ldk = 2048; P.V = KVM + 256 + h * 64; P.ldv = 2048;
            P.o8 = 1; P.O = P.o8 ? (bf16*)((unsigned char*)CAT + 768 + h * 64) : CAT + 768 + h * 64; P.ldo = 1024; P.qrow0 = b * SEQ + qt * 256; P.krow0 = b * MEML; P.t_lo = 0; P.t_hi = 4; P.qpos0 = qt * 256; P.mode = 0; P.mask = nullptr; P.has_sink = 0; P.sink2 = 0.f;
            attn_unit(F, P);
        } else {
            const int v = u - n_main - n_mem;
            conv_item(PROJ, A->in[3] + (size_t)(layer == 0 ? 0 : 1) * 3 * 768, CAT, v * NTHREADS + F.tid);
        }
    }
}

__device__ __forceinline__ void score_phase(Frame& F, const bf16* QQ, const bf16* PROJ, float* SC) {
    const int lane = F.lane, r32 = lane & 31, hi = lane >> 5;
    LAS float* wtab = (LAS float*)(F.lds + RING_OFF + F.wave * 1024);
    constexpr float WSCALE = 0.04419417382415922f;
    constexpr int PER_B = 576;
    const __amdgpu_buffer_rsrc_t scrs = __builtin_amdgcn_make_buffer_rsrc((void*)SC, 0, T * SEQ * 4, 0x00020000);
    for (int wu = F.bid * NWAVES + F.wave; wu < NB * PER_B; wu += F.G * NWAVES) {
        const int b = wu / PER_B, idx = PER_B - 1 - wu % PER_B;
        int g = 0;
        for (int k = 1; k < 8; ++k) g += (8 * k * (k + 1) <= idx) ? 1 : 0;
        const int r = idx - 8 * g * (g + 1), qb = 16 * g + r / (g + 1), c = r % (g + 1);
        const int kb_lo = 16 * c, kb_hi = (16 * c + 16 < qb + 1) ? 16 * c + 16 : qb + 1;
        const int t0 = b * SEQ + 32 * qb;
#pragma unroll
        for (int k = 0; k < 4; ++k) { const int i4 = lane * 4 + k, h = i4 >> 5, hh = (i4 >> 4) & 1, reg = i4 & 15;
            wtab[i4] = bf2f(PROJ[(size_t)(t0 + crow(reg, hh)) * 1280 + 1088 + h]) * WSCALE; }
        bf16x8 qA[8][4];
#pragma unroll
        for (int h = 0; h < 8; ++h)
#pragma unroll
            for (int st = 0; st < 4; ++st) qA[h][st] = *(const bf16x8*)(QQ + (size_t)(t0 + r32) * 1280 + 768 + h * 64 + st * 16 + hi * 8);
        const bf16* kbase = PROJ + (size_t)(b * SEQ + r32) * 1280 + 1024 + hi * 8;
        bf16x8 kA[4], kBf[4];
#pragma unroll
        for (int st = 0; st < 4; ++st) kA[st] = *(const bf16x8*)(kbase + (size_t)(32 * kb_lo) * 1280 + st * 16);
#define PS_BLOCK(KF, KB) do { f32x16 acc = {}; \
            _Pragma("unroll") for (int h = 0; h < 8; ++h) { f32x16 dd = {}; \
                _Pragma("unroll") for (int st = 0; st < 4; ++st) dd = __builtin_amdgcn_mfma_f32_32x32x16_bf16(qA[h][st], KF[st], dd, 0, 0, 0); \
                const LAS f32x4* wp = (const LAS f32x4*)(wtab + (h * 2 + hi) * 16); const f32x4 w0 = wp[0], w1 = wp[1], w2 = wp[2], w3 = wp[3]; \
                _Pragma("unroll") for (int q = 0; q < 4; ++q) { acc[q] = fmaf(w0[q], fmaxf(dd[q], 0.f), acc[q]); acc[4 + q] = fmaf(w1[q], fmaxf(dd[4 + q], 0.f), acc[4 + q]); \
                    acc[8 + q] = fmaf(w2[q], fmaxf(dd[8 + q], 0.f), acc[8 + q]); acc[12 + q] = fmaf(w3[q], fmaxf(dd[12 + q], 0.f), acc[12 + q]); } \
                if (h & 1) __builtin_amdgcn_sched_barrier(0); } \
            _Pragma("unroll") for (int reg = 0; reg < 16; ++reg) __builtin_amdgcn_raw_buffer_store_b32(__float_as_uint(acc[reg]), scrs, (4 * hi * SEQ + r32) * 4, ((t0 + (reg & 3) + 8 * (reg >> 2)) * SEQ + 32 * (KB)) * 4, 0); } while (0)
        for (int kb = kb_lo; kb < kb_hi; kb += 2) {
            __builtin_amdgcn_sched_barrier(0);
            if (kb + 1 < kb_hi) {
#pragma unroll
                for (int st = 0; st < 4; ++st) kBf[st] = *(const bf16x8*)(kbase + (size_t)(32 * (kb + 1)) * 1280 + st * 16);
            }
            __builtin_amdgcn_sched_barrier(0);
            PS_BLOCK(kA, kb);
            __builtin_amdgcn_sched_barrier(0);
            if (kb + 1 < kb_hi) {
                if (kb + 2 < kb_hi) {
#pragma unroll
                    for (int st = 0; st < 4; ++st) kA[st] = *(const bf16x8*)(kbase + (size_t)(32 * (kb + 2)) * 1280 + st * 16);
                }
                __builtin_amdgcn_sched_barrier(0);
                PS_BLOCK(kBf, kb + 1);
            }
        }
#undef PS_BLOCK
    }
}
__device__ __forceinline__ void select_phase(Frame& F, const float* SC, unsigned long long* MASK) {
    const int qstride = F.G * NWAVES;
    unsigned raw[64];
#define SEL_LOAD(qq) do { const int pos_ = (qq) & (SEQ - 1); if ((qq) < T && pos_ >= 256) { int ln_ = lane_id_now(); const int ni_ = (pos_ >> 6) + 1; const float* row_ = SC + (size_t)(qq) * SEQ; \
        _Pragma("unroll") for (int gq = 0; gq < 4; ++gq) if (ni_ > 16 * gq) { _Pragma("unroll") for (int i = 16 * gq; i < 16 * gq + 16; ++i) { const int s_ = 64 * i + ln_; raw[i] = __float_as_uint(row_[s_ <= pos_ ? s_ : pos_]); } } } } while (0)
    int q0_ = F.bid * NWAVES + F.wave;
    SEL_LOAD(q0_);
    for (int q = q0_; q < T; q += qstride) {
        int lane = F.lane; asm volatile("" : "+v"(lane));
        const int pos = q & (SEQ - 1);
        unsigned long long myword = 0ull;
        if (pos < 256) {
            const int lo = 64 * lane;
            myword = (lo > pos) ? 0ull : ((pos - lo >= 63) ? ~0ull : ((1ull << (pos - lo + 1)) - 1ull));
            SEL_LOAD(q + qstride);
        } else {
            const int ni = (pos >> 6) + 1;
            unsigned key[64];
#pragma unroll
            for (int i = 0; i < 64; ++i) key[i] = 0u;
#pragma unroll
            for (int gq = 0; gq < 4; ++gq) if (ni > 16 * gq) {
#pragma unroll
                for (int i = 16 * gq; i < 16 * gq + 16; ++i) { const int s = 64 * i + lane; unsigned bts = raw[i]; if (bts == 0x80000000u) bts = 0u;
                    const unsigned kk = (bts & 0x80000000u) ? ~bts : (bts | 0x80000000u); key[i] = (s <= pos) ? kk : 0u; } }
            SEL_LOAD(q + qstride);
            auto count_ge = [&](const unsigned Tp) -> int {
                int cA = 0, cB = 0, cC = 0, cD = 0;
#pragma unroll
                for (int gq = 0; gq < 4; ++gq) if (ni > 16 * gq) {
                    unsigned long long m0_, m1_, m2_, m3_;
                    asm("v_cmp_le_u32_e64 %4, %8, %9\n\tv_cmp_le_u32_e64 %5, %8, %10\n\tv_cmp_le_u32_e64 %6, %8, %11\n\tv_cmp_le_u32_e64 %7, %8, %12\n\tv_addc_co_u32_e64 %0, %4, 0, %0, %4\n\tv_addc_co_u32_e64 %1, %5, 0, %1, %5\n\tv_addc_co_u32_e64 %2, %6, 0, %2, %6\n\tv_addc_co_u32_e64 %3, %7, 0, %3, %7\n\tv_cmp_le_u32_e64 %4, %8, %13\n\tv_cmp_le_u32_e64 %5, %8, %14\n\tv_cmp_le_u32_e64 %6, %8, %15\n\tv_cmp_le_u32_e64 %7, %8, %16\n\tv_addc_co_u32_e64 %0, %4, 0, %0, %4\n\tv_addc_co_u32_e64 %1, %5, 0, %1, %5\n\tv_addc_co_u32_e64 %2, %6, 0, %2, %6\n\tv_addc_co_u32_e64 %3, %7, 0, %3, %7\n\tv_cmp_le_u32_e64 %4, %8, %17\n\tv_cmp_le_u32_e64 %5, %8, %18\n\tv_cmp_le_u32_e64 %6, %8, %19\n\tv_cmp_le_u32_e64 %7, %8, %20\n\tv_addc_co_u32_e64 %0, %4, 0, %0, %4\n\tv_addc_co_u32_e64 %1, %5, 0, %1, %5\n\tv_addc_co_u32_e64 %2, %6, 0, %2, %6\n\tv_addc_co_u32_e64 %3, %7, 0, %3, %7\n\tv_cmp_le_u32_e64 %4, %8, %21\n\tv_cmp_le_u32_e64 %5, %8, %22\n\tv_cmp_le_u32_e64 %6, %8, %23\n\tv_cmp_le_u32_e64 %7, %8, %24\n\tv_addc_co_u32_e64 %0, %4, 0, %0, %4\n\tv_addc_co_u32_e64 %1, %5, 0, %1, %5\n\tv_addc_co_u32_e64 %2, %6, 0, %2, %6\n\tv_addc_co_u32_e64 %3, %7, 0, %3, %7"
                        : "+v"(cA), "+v"(cB), "+v"(cC), "+v"(cD), "=&s"(m0_), "=&s"(m1_), "=&s"(m2_), "=&s"(m3_) : "s"(Tp), "v"(key[16 * gq + 0]), "v"(key[16 * gq + 1]), "v"(key[16 * gq + 2]), "v"(key[16 * gq + 3]), "v"(key[16 * gq + 4]), "v"(key[16 * gq + 5]), "v"(key[16 * gq + 6]), "v"(key[16 * gq + 7]), "v"(key[16 * gq + 8]), "v"(key[16 * gq + 9]), "v"(key[16 * gq + 10]), "v"(key[16 * gq + 11]), "v"(key[16 * gq + 12]), "v"(key[16 * gq + 13]), "v"(key[16 * gq + 14]), "v"(key[16 * gq + 15])); }
                const int cl = (cA + cB) + (cC + cD);
                int c = 0;
#pragma unroll
                for (int bb = 0; bb < 7; ++bb) c += __popcll(__ballot((cl >> bb) & 1)) << bb;
                return c; };
            unsigned kmx = 0u;
#pragma unroll
            for (int i = 0; i < 64; ++i) kmx = key[i] > kmx ? key[i] : kmx;
#pragma unroll
            for (int o = 1; o < 64; o <<= 1) { const unsigned ov = (unsigned)shxi((int)kmx, o); kmx = ov > kmx ? ov : kmx; }
            kmx = (unsigned)__builtin_amdgcn_readfirstlane((int)kmx);
            unsigned lo = 0u, hi = kmx + 1u; int clo = pos + 1, chi = 0;
            if (kmx > 0x82000000u) { const unsigned l2 = (kmx & 0xff800000u) - 0x02000000u; const int c2 = count_ge(l2); if (c2 >= 256) { lo = l2; clo = c2; } else { hi = l2; chi = c2; } }
            float flo = (float)clo - 255.5f, fhi = (float)chi - 255.5f; int side = 0;
            for (int it = 0; it < 96; ++it) {
                if (clo == 256 || hi - lo <= 1u) break;
                const unsigned span = hi - lo;
                unsigned mid;
                if (it % 3 == 2) mid = lo + (span >> 1);
                else { const float tt = flo / (flo - fhi); unsigned d = (unsigned)((float)span * tt); d = d < 1u ? 1u : (d > span - 1u ? span - 1u : d); mid = lo + d; }
                mid = (unsigned)__builtin_amdgcn_readfirstlane((int)mid);
                const int c = count_ge(mid);
                if (c >= 256) { lo = mid; clo = c; flo = (float)c - 255.5f; if (side == 1) fhi *= 0.5f; side = 1; }
                else { hi = mid; chi = c; fhi = (float)c - 255.5f; if (side == -1) flo *= 0.5f; side = -1; }
            }
            const unsigned Tk = lo; const int cT = clo;
            int need = 256, base = 0;
            if (cT != 256) {
                int cl = 0;
#pragma unroll
                for (int i = 0; i < 64; ++i) cl += (key[i] > Tk) ? 1 : 0;
                int cgt = 0;
#pragma unroll
                for (int bb = 0; bb < 7; ++bb) cgt += __popcll(__ballot((cl >> bb) & 1)) << bb;
                need = 256 - cgt;
            }
            int wlo = 0, whi = 0;
            if (cT == 256) {
#pragma unroll
                for (int i = 0; i < 64; ++i) { const unsigned long long wsel = __ballot(key[i] >= Tk);
                    asm("s_nop 4\n\tv_writelane_b32 %0, %2, %4\n\tv_writelane_b32 %1, %3, %4" : "+v"(wlo), "+v"(whi) : "s"((int)(unsigned)wsel), "s"((int)(unsigned)(wsel >> 32)), "n"(i)); }
            } else {
                const unsigned long long ltmask = (1ull << lane) - 1ull;
#pragma unroll
                for (int i = 0; i < 64; ++i) {
                    const unsigned long long eq = __ballot(key[i] == Tk); const int rank = base + __popcll(eq & ltmask);
                    const bool sel = (key[i] > Tk) || (key[i] == Tk && rank < need); base += __popcll(eq);
                    const unsigned long long wsel = __ballot(sel);
                    asm("s_nop 4\n\tv_writelane_b32 %0, %2, %4\n\tv_writelane_b32 %1, %3, %4" : "+v"(wlo), "+v"(whi) : "s"((int)(unsigned)wsel), "s"((int)(unsigned)(wsel >> 32)), "n"(i));
                }
            }
            myword = ((unsigned long long)(unsigned)whi << 32) | (unsigned long long)(unsigned)wlo;
        }
        MASK[(size_t)q * 64 + lane] = myword;
    }
}

#undef SEL_LOAD
__device__ __forceinline__ void ln1_phase(Frame& F, const bf16* xres, const bf16* Y, const float* g1, const float* b1, bf16* XMB, const float* rw, const float* rb,
                                          bf16* XP, gu32* gcount, int* ROWS, float* GATES, const int pmode = 3) {
    const int lane = F.lane, wid = F.wave, tid = F.tid;
    float ALPHA_ = ALPHA; asm volatile("" : "+v"(ALPHA_));
    LAS float* x32 = (LAS float*)(F.lds + RING_OFF);
    volatile LAS unsigned* cnt = (volatile LAS unsigned*)(F.lds + L_CNT); volatile LAS unsigned* base = (volatile LAS unsigned*)(F.lds + L_BASE);
    LAS int* route = (LAS int*)(F.lds + L_ROUTE);
    const int e = lane & 31, half = lane >> 5;
    const float rbe = rb[e];
    const __amdgpu_buffer_rsrc_t xrs_ = __builtin_amdgcn_make_buffer_rsrc((void*)xres, 0, T * D * 2, 0x00020000), yrs_ = __builtin_amdgcn_make_buffer_rsrc((void*)Y, 0, T * D * 2, 0x00020000);
    for (int chunk = F.bid; chunk < T / 64; chunk += F.G) {
        if (tid < 32) cnt[tid] = 0u;
        __syncthreads();
        u32x2 rxn[4][4], ryn[4][4];
#define LN1_LOAD(B) do { _Pragma("unroll") for (int rr = 0; rr < 4; ++rr) { const int ro_ = (chunk * 64 + wid * 8 + (B) * 4 + rr) * (D * 2);       \
            _Pragma("unroll") for (int j = 0; j < 4; ++j) { rxn[rr][j] = __builtin_bit_cast(u32x2, __builtin_amdgcn_raw_buffer_load_b64(xrs_, lane * 8, ro_ + 512 * j, 0)); ryn[rr][j] = __builtin_bit_cast(u32x2, __builtin_amdgcn_raw_buffer_load_b64(yrs_, lane * 8, ro_ + 512 * j, 0)); } } } while (0)
        LN1_LOAD(0);
#pragma unroll 1
        for (int batch = 0; batch < 2; ++batch) {
            const int lrow0 = wid * 8 + batch * 4, row0 = chunk * 64 + lrow0;
            u32x2 rx[4][4], ry[4][4];
#pragma unroll
            for (int rr = 0; rr < 4; ++rr)
#pragma unroll
                for (int j = 0; j < 4; ++j) { rx[rr][j] = rxn[rr][j]; ry[rr][j] = ryn[rr][j]; }
            if (batch == 0) LN1_LOAD(1);
            float xv[4][16], mean_[4], rstd_[4];
#pragma unroll
            for (int rr = 0; rr < 4; ++rr) { float s = 0.f;
#pragma unroll
                for (int j = 0; j < 4; ++j) { const u32x2 xx = rx[rr][j], yy = ry[rr][j];
                    xv[rr][4 * j] = ALPHA_ * bflo(xx.x) + bflo(yy.x); xv[rr][4 * j + 1] = ALPHA_ * bfhi(xx.x) + bfhi(yy.x); xv[rr][4 * j + 2] = ALPHA_ * bflo(xx.y) + bflo(yy.y); xv[rr][4 * j + 3] = ALPHA_ * bfhi(xx.y) + bfhi(yy.y);
                    s += (xv[rr][4 * j] + xv[rr][4 * j + 1]) + (xv[rr][4 * j + 2] + xv[rr][4 * j + 3]); }
                mean_[rr] = s; }
#pragma unroll
            for (int o = 1; o < 64; o <<= 1) {
#pragma unroll
                for (int rr = 0; rr < 4; ++rr) mean_[rr] += shx(mean_[rr], o); }
#pragma unroll
            for (int rr = 0; rr < 4; ++rr) { mean_[rr] *= (1.f / D); float s2 = 0.f;
#pragma unroll
                for (int k = 0; k < 16; ++k) { xv[rr][k] -= mean_[rr]; s2 += xv[rr][k] * xv[rr][k]; }
                rstd_[rr] = s2; }
            __builtin_amdgcn_sched_barrier(0);
            f32x4 gg_[4], bb_[4];
#pragma unroll
            for (int j = 0; j < 4; ++j) { gg_[j] = __builtin_bit_cast(f32x4, __builtin_amdgcn_raw_buffer_load_b128(__builtin_amdgcn_make_buffer_rsrc((void*)g1, 0, D * 4, 0x00020000), lane * 16, j * 1024, 0)); bb_[j] = __builtin_bit_cast(f32x4, __builtin_amdgcn_raw_buffer_load_b128(__builtin_amdgcn_make_buffer_rsrc((void*)b1, 0, D * 4, 0x00020000), lane * 16, j * 1024, 0)); }
            __builtin_amdgcn_sched_barrier(0);
#pragma unroll
            for (int o = 1; o < 64; o <<= 1) {
#pragma unroll
                for (int rr = 0; rr < 4; ++rr) rstd_[rr] += shx(rstd_[rr], o); }
#pragma unroll
            for (int rr = 0; rr < 4; ++rr) { const float rstd = 1.0f / sqrtf(rstd_[rr] * (1.f / D) + LN_EPS);
#pragma unroll
                for (int j = 0; j < 4; ++j) { const f32x4 gg = gg_[j], bb = bb_[j];
                    f32x4 o;
#pragma unroll
                    for (int k = 0; k < 4; ++k) o[k] = xv[rr][4 * j + k] * rstd * gg[k] + bb[k];
                    u32x2 pb; pb.x = pk2(o[0], o[1]); pb.y = pk2(o[2], o[3]);
                    *(u32x2*)(XMB + (size_t)(row0 + rr) * D + 4 * lane + 256 * j) = pb;
                    *(LAS f32x4*)(x32 + (wid * 4 + rr) * 1028 + 4 * lane + 256 * j) = o; } }
            float a0 = 0.f, a1 = 0.f, a2 = 0.f, a3 = 0.f;
            float wA[32], wB[32];
            const __amdgpu_buffer_rsrc_t wrs = __builtin_amdgcn_make_buffer_rsrc((void*)rw, 0, D * NEXP * 4, 0x00020000);
            const int wvo = ((wid * 128 + half * 4) * 32 + e) * 4;
            __builtin_amdgcn_sched_barrier(0);
            if (pmode & 1) {
#pragma unroll
                for (int i = 0; i < 8; ++i)
#pragma unroll
                    for (int t = 0; t < 4; ++t) wA[4 * i + t] = __uint_as_float(__builtin_amdgcn_raw_buffer_load_b32(wrs, wvo, (8 * i + t) * 128, 0));
            }
            __builtin_amdgcn_sched_barrier(0);
            __syncthreads();
            if (pmode & 1) {
                f32x16 pacc, pacc1;
#pragma unroll
                for (int r = 0; r < 16; ++r) { pacc[r] = 0.f; pacc1[r] = 0.f; }
                const LAS float* xa = x32 + (lane & 31) * 1028 + wid * 128 + half * 4;
                f32x4 xq[16];
#pragma unroll
                for (int i = 0; i < 8; ++i) xq[i] = *(const LAS f32x4*)(xa + 8 * i);
#pragma unroll
                for (int i = 0; i < 8; ++i)
#pragma unroll
                    for (int t = 0; t < 4; ++t) wB[4 * i + t] = __uint_as_float(__builtin_amdgcn_raw_buffer_load_b32(wrs, wvo, (64 + 8 * i + t) * 128, 0));
#pragma unroll
                for (int i = 0; i < 8; ++i) {
                    pacc = __builtin_amdgcn_mfma_f32_32x32x2f32(xq[i][0], wA[4 * i + 0], pacc, 0, 0, 0); pacc1 = __builtin_amdgcn_mfma_f32_32x32x2f32(xq[i][1], wA[4 * i + 1], pacc1, 0, 0, 0);
                    pacc = __builtin_amdgcn_mfma_f32_32x32x2f32(xq[i][2], wA[4 * i + 2], pacc, 0, 0, 0); pacc1 = __builtin_amdgcn_mfma_f32_32x32x2f32(xq[i][3], wA[4 * i + 3], pacc1, 0, 0, 0); }
                __builtin_amdgcn_sched_barrier(0);
#pragma unroll
                for (int i = 8; i < 16; ++i) xq[i] = *(const LAS f32x4*)(xa + 8 * i);
#pragma unroll
                for (int i = 0; i < 8; ++i) {
                    pacc = __builtin_amdgcn_mfma_f32_32x32x2f32(xq[8 + i][0], wB[4 * i + 0], pacc, 0, 0, 0); pacc1 = __builtin_amdgcn_mfma_f32_32x32x2f32(xq[8 + i][1], wB[4 * i + 1], pacc1, 0, 0, 0);
                    pacc = __builtin_amdgcn_mfma_f32_32x32x2f32(xq[8 + i][2], wB[4 * i + 2], pacc, 0, 0, 0); pacc1 = __builtin_amdgcn_mfma_f32_32x32x2f32(xq[8 + i][3], wB[4 * i + 3], pacc1, 0, 0, 0); }
#pragma unroll
                for (int r = 0; r < 16; ++r) pacc[r] += pacc1[r];
                __syncthreads();
                LAS float* pw = x32 + wid * 1024 + e;
#pragma unroll
                for (int r = 0; r < 16; ++r) pw[crow(r, half) * 32] = pacc[r];
                __syncthreads();
                const LAS float* pr = x32 + (half * 4) * 1024 + (wid * 4) * 32 + e;
#pragma unroll
                for (int q = 0; q < 4; ++q) { a0 += pr[q * 1024]; a1 += pr[q * 1024 + 32]; a2 += pr[q * 1024 + 64]; a3 += pr[q * 1024 + 96]; }
            } else { __syncthreads(); __syncthreads(); }
            __syncthreads();
            float lg[4]; lg[0] = a0 + shx(a0, 32) + rbe; lg[1] = a1 + shx(a1, 32) + rbe; lg[2] = a2 + shx(a2, 32) + rbe; lg[3] = a3 + shx(a3, 32) + rbe;
            float selv[4][4]; int seli[4][4];
#pragma unroll
            for (int rr = 0; rr < 4; ++rr) {
                float v = lg[rr];
#pragma unroll
                for (int k = 0; k < 4; ++k) {
                    float bv = v; int bi = e;
#pragma unroll
                    for (int msk = 1; msk < 32; msk <<= 1) { const float ov = shx(bv, msk); const int oi = shxi(bi, msk); if (ov > bv || (ov == bv && oi < bi)) { bv = ov; bi = oi; } }
                    selv[rr][k] = bv; seli[rr][k] = bi;
                    if (bi == e) v = -INFINITY;
                }
            }
            if (lane < 16) {
                const int rr = lane >> 2, k = lane & 3;
                float sv[4]; int si[4];
#pragma unroll
                for (int q = 0; q < 4; ++q) { sv[q] = rr == 0 ? selv[0][q] : rr == 1 ? selv[1][q] : rr == 2 ? selv[2][q] : selv[3][q]; si[q] = rr == 0 ? seli[0][q] : rr == 1 ? seli[1][q] : rr == 2 ? seli[2][q] : seli[3][q]; }
                const float ex1 = __expf(sv[1] - sv[0]), ex2 = __expf(sv[2] - sv[0]), ex3 = __expf(sv[3] - sv[0]);
                const float isum = 1.0f / (1.0f + ex1 + ex2 + ex3);
                const int me = k == 0 ? si[0] : k == 1 ? si[1] : k == 2 ? si[2] : si[3];
                const float mg = (k == 0 ? 1.0f : k == 1 ? ex1 : k == 2 ? ex2 : ex3) * isum;
                const int mr = (int)__hip_atomic_fetch_add((LAS unsigned*)(F.lds + L_CNT) + me, 1u, __ATOMIC_RELAXED, __HIP_MEMORY_SCOPE_WORKGROUP);
                LAS int* rt = route + ((lrow0 + rr) * 4 + k) * 3;
                rt[0] = me; rt[1] = mr; rt[2] = __float_as_int(mg);
            }
        }
        __syncthreads();
        if (wid == 0) { const int l_ = lane_id_now(); if (l_ < 32) base[l_] = __hip_atomic_fetch_add(gcount + l_, cnt[l_], RLX_AGENT); }
        __syncthreads();
#pragma unroll 1
        for (int batch = 0; batch < 2; ++batch) {
            const int lrow0 = wid * 8 + batch * 4, row0 = chunk * 64 + lrow0;
            u32x4 sa[4], sb[4];
#pragma unroll
            for (int rr = 0; rr < 4; ++rr) { const bf16* src = XMB + (size_t)(row0 + rr) * D; sa[rr] = *(const u32x4*)(src + lane * 16); sb[rr] = *(const u32x4*)(src + lane * 16 + 8); }
            int vrow = 0;
            if (lane < 16) { const int rr = lane >> 2, k = lane & 3; const LAS int* rt = route + ((lrow0 + rr) * 4 + k) * 3; const int me = rt[0];
                vrow = me * CAPROWS + (int)base[me] + rt[1]; ROWS[(size_t)(row0 + rr) * 4 + k] = vrow; GATES[(size_t)(row0 + rr) * 4 + k] = __int_as_float(rt[2]); }
            if (pmode & 2) {
#pragma unroll
                for (int rr = 0; rr < 4; ++rr) {
                    const u32x4 a = sa[rr], b = sb[rr];
                    u32x4 o; o.x = pg8::pk4_fp8(bflo(a.x), bfhi(a.x), bflo(a.y), bfhi(a.y)); o.y = pg8::pk4_fp8(bflo(a.z), bfhi(a.z), bflo(a.w), bfhi(a.w));
                    o.z = pg8::pk4_fp8(bflo(b.x), bfhi(b.x), bflo(b.y), bfhi(b.y)); o.w = pg8::pk4_fp8(bflo(b.z), bfhi(b.z), bflo(b.w), bfhi(b.w));
#pragma unroll
                    for (int k = 0; k < 4; ++k) { const int vr = shli(vrow, rr * 4 + k); unsigned char* dst = (unsigned char*)XP + (size_t)vr * D;
                        *(u32x4*)(dst + lane * 16) = o; }
                }
            }
        }
        __syncthreads();
    }
}
#undef LN1_LOAD
__device__ __forceinline__ void ln2_phase(Frame& F, const bf16* XMB, const bf16* YP, const int* ROWS, const float* GATES, const float* g2, const float* b2, float* out, bf16* XB, unsigned char* XB8) {
    const int lane = F.lane;
    float ALPHA_ = ALPHA; asm volatile("" : "+v"(ALPHA_));
    const int rstride = F.G * NWAVES, row_first = F.bid * NWAVES + F.wave;
    const unsigned char* yp8 = (const unsigned char*)YP;
    int ix0 = 0, ix1 = 0, ix2 = 0, ix3 = 0; f32x4 gtn = {0.f, 0.f, 0.f, 0.f};
    u32x2 xbn[4]; int qn[4][4]; f32x4 gtc = {0.f, 0.f, 0.f, 0.f};
#define LN2_IDX(R) do { if ((R) < T) { ix0 = ROWS[(size_t)(R) * 4]; ix1 = ROWS[(size_t)(R) * 4 + 1]; ix2 = ROWS[(size_t)(R) * 4 + 2]; ix3 = ROWS[(size_t)(R) * 4 + 3]; gtn = *(const f32x4*)(GATES + (size_t)(R) * 4); } } while (0)
#define LN2_DATA(R) do { if ((R) < T) { gtc = gtn; _Pragma("unroll") for (int j = 0; j < 4; ++j) { const int c = 4 * lane + 256 * j; xbn[j] = *(const u32x2*)(XMB + (size_t)(R) * D + c); \
        qn[j][0] = *(const int*)(yp8 + (size_t)ix0 * D + c); qn[j][1] = *(const int*)(yp8 + (size_t)ix1 * D + c); qn[j][2] = *(const int*)(yp8 + (size_t)ix2 * D + c); qn[j][3] = *(const int*)(yp8 + (size_t)ix3 * D + c); } } } while (0)
    f32x4 gg_[4], bb_[4];
#pragma unroll
    for (int j = 0; j < 4; ++j) { gg_[j] = *(const f32x4*)(g2 + 4 * lane + 256 * j); bb_[j] = *(const f32x4*)(b2 + 4 * lane + 256 * j); }
    LN2_IDX(row_first);
    LN2_DATA(row_first);
    LN2_IDX(row_first + rstride);
    for (int row = row_first; row < T; row += rstride) {
        u32x2 xbc[4]; int qc[4][4]; const f32x4 gt = gtc;
#pragma unroll
        for (int j = 0; j < 4; ++j) { xbc[j] = xbn[j]; qc[j][0] = qn[j][0]; qc[j][1] = qn[j][1]; qc[j][2] = qn[j][2]; qc[j][3] = qn[j][3]; }
        LN2_DATA(row + rstride);
        LN2_IDX(row + 2 * rstride);
        float v[16]; float s = 0.f;
#pragma unroll
        for (int j = 0; j < 4; ++j) {
            const u32x2 xb_ = xbc[j]; const f32x4 xx = {bflo(xb_.x), bfhi(xb_.x), bflo(xb_.y), bfhi(xb_.y)};
            const int q0 = qc[j][0], q1 = qc[j][1], q2 = qc[j][2], q3 = qc[j][3];
            const f32x2 a0 = __builtin_amdgcn_cvt_pk_f32_fp8(q0, false), b0 = __builtin_amdgcn_cvt_pk_f32_fp8(q0, true), a1 = __builtin_amdgcn_cvt_pk_f32_fp8(q1, false), b1 = __builtin_amdgcn_cvt_pk_f32_fp8(q1, true);
            const f32x2 a2 = __builtin_amdgcn_cvt_pk_f32_fp8(q2, false), b2_ = __builtin_amdgcn_cvt_pk_f32_fp8(q2, true), a3 = __builtin_amdgcn_cvt_pk_f32_fp8(q3, false), b3 = __builtin_amdgcn_cvt_pk_f32_fp8(q3, true);
            const float g0 = gt[0] * (1.0f / 16.0f), g1 = gt[1] * (1.0f / 16.0f), g2_ = gt[2] * (1.0f / 16.0f), g3 = gt[3] * (1.0f / 16.0f);
            v[4 * j]     = ALPHA_ * xx[0] + ((g0 * a0[0] + g1 * a1[0]) + (g2_ * a2[0] + g3 * a3[0]));
            v[4 * j + 1] = ALPHA_ * xx[1] + ((g0 * a0[1] + g1 * a1[1]) + (g2_ * a2[1] + g3 * a3[1]));
            v[4 * j + 2] = ALPHA_ * xx[2] + ((g0 * b0[0] + g1 * b1[0]) + (g2_ * b2_[0] + g3 * b3[0]));
            v[4 * j + 3] = ALPHA_ * xx[3] + ((g0 * b0[1] + g1 * b1[1]) + (g2_ * b2_[1] + g3 * b3[1]));
            s += (v[4 * j] + v[4 * j + 1]) + (v[4 * j + 2] + v[4 * j + 3]); }
        const float mean = wave_sum(s) * (1.f / D); float s2 = 0.f;
#pragma unroll
        for (int k = 0; k < 16; ++k) { v[k] -= mean; s2 += v[k] * v[k]; }
        const float rstd = 1.0f / sqrtf(wave_sum(s2) * (1.f / D) + LN_EPS);
#pragma unroll
        for (int j = 0; j < 4; ++j) { const int c = 4 * lane + 256 * j; const f32x4 gg = gg_[j], bb = bb_[j];
            f32x4 o;
#pragma unroll
            for (int k = 0; k < 4; ++k) o[k] = v[4 * j + k] * rstd * gg[k] + bb[k];
            if (out) *(f32x4*)(out + (size_t)row * D + c) = o;
            u32x2 pb; pb.x = pk2(o[0], o[1]); pb.y = pk2(o[2], o[3]); *(u32x2*)(XB + (size_t)row * D + c) = pb;
            if (XB8) *(unsigned*)(XB8 + (size_t)row * D + c) = pg8::pk4_fp8(o[0], o[1], o[2], o[3]); }
    }
}
#undef LN2_IDX
#undef LN2_DATA

#ifndef MK_FP8TEST
#define MK_FP8TEST 0
#endif
typedef int i32x8 __attribute__((ext_vector_type(8)));
__device__ __forceinline__ int t8_val(int which, int rc, int g, int j) { unsigned h = (unsigned)(which * 7919 + rc * 104729 + g * 1299709 + j * 15485863 + 12345); h ^= h >> 13; h *= 0x5bd1e995u; h ^= h >> 15; return (int)(h % 9u) - 4; }
__device__ __forceinline__ void fp8_selftest(gu32* ctl, int lane) {
    const int rc = lane & 15, g = lane >> 4;
    i32x8 a, b;
#pragma unroll
    for (int w = 0; w < 8; ++w) {
        int wa = __builtin_amdgcn_cvt_pk_fp8_f32((float)t8_val(0, rc, g, 4 * w), (float)t8_val(0, rc, g, 4 * w + 1), 0, false);
        wa = __builtin_amdgcn_cvt_pk_fp8_f32((float)t8_val(0, rc, g, 4 * w + 2), (float)t8_val(0, rc, g, 4 * w + 3), wa, true);
        int wb = __builtin_amdgcn_cvt_pk_fp8_f32((float)t8_val(1, rc, g, 4 * w), (float)t8_val(1, rc, g, 4 * w + 1), 0, false);
        wb = __builtin_amdgcn_cvt_pk_fp8_f32((float)t8_val(1, rc, g, 4 * w + 2), (float)t8_val(1, rc, g, 4 * w + 3), wb, true);
        a[w] = wa; b[w] = wb;
    }
    f32x4 c = {0.f, 0.f, 0.f, 0.f};
    c = __builtin_amdgcn_mfma_scale_f32_16x16x128_f8f6f4(a, b, c, 0, 0, 0, 0x7f7f7f7f, 0, 0x7f7f7f7f);
    int bad = 0, scaled = 0;
#pragma unroll
    for (int reg = 0; reg < 4; ++reg) {
        const int row = 4 * (lane >> 4) + reg, col = lane & 15; int e = 0;
        for (int gg = 0; gg < 4; ++gg) for (int j = 0; j < 32; ++j) e += t8_val(0, row, gg, j) * t8_val(1, col, gg, j);
        if (c[reg] != (float)e) { bad = 1; if (e != 0 && (c[reg] == (float)e * 0.5f || c[reg] == (float)e * 2.0f || c[reg] == (float)e * 0.25f || c[reg] == (float)e * 4.0f)) scaled = 1; }
    }
    const unsigned long long mb = __ballot(bad), ms = __ballot(bad && scaled);
    if (lane == 0 && mb) __hip_atomic_store(ctl + CW_ERR, (mb == ms) ? 2u : 1u, RLX_AGENT);
}

constexpr int N_STEPS = 6, LAST_PHASE = 1 + 10 * 5 + 8;
__host__ __device__ constexpr bool phase_exists(int id) {
    if (id == 0) return true;
    if (id < 1 || id > LAST_PHASE) return false;
    const int s = (id - 1) / 10, p = (id - 1) % 10;
    if (p == 0) return true;
    if (p == 9) return false;
    if (s == 0 || s == 2) return false;
    if (p == 1 || p == 2) return s == 3;
    return true;
}
__global__ void __launch_bounds__(NTHREADS, 2) mk_fwd(Args args) {
    extern __shared__ __attribute__((aligned(16))) unsigned char lds_raw[];
    Frame F;
    F.lds = (LAS unsigned char*)lds_raw;
    F.tid = threadIdx.x; F.lane = F.tid & 63; F.wave = __builtin_amdgcn_readfirstlane(F.tid >> 6);
    F.bid = blockIdx.x; F.G = gridDim.x; F.vcu = (F.G % 8 == 0) ? (F.bid % 8) * (F.G / 8) + F.bid / 8 : F.bid;
    F.ctl = (gu32*)(args.ws + WS_CTL);
    const int lo = args.ph_lo, hi = args.ph_hi;
    const bool fused = (hi - lo) > 1;
    for (int u = F.tid; u < (LDS_BYTES - LDSCTL_OFF) / 4; u += NTHREADS) ((LAS unsigned*)(F.lds + LDSCTL_OFF))[u] = 0u;
    __syncthreads();
    XcdBarrier bar; bar.bar = (unsigned*)(F.ctl + CW_BAR); bar.x = 0; bar.st = nullptr;
    if (fused) bar = xcd_barrier_post((unsigned*)(F.ctl + CW_BAR), (volatile LAS unsigned*)(F.lds + L_XB));
    const bool split = fused && MK_SPLIT && (F.G % 16 == 0) && lo == 0 && hi > 16;
    const int NCV = split ? F.G / 2 : 0;
    const bool is_conv = split && F.bid < NCV;
    XcdBarrier bar2; bar2.bar = (unsigned*)(F.ctl + CW_BAR2); bar2.x = 0; bar2.st = nullptr;
    if (split && !is_conv) bar2 = xcd_barrier_post((unsigned*)(F.ctl + CW_BAR2), (volatile LAS unsigned*)(F.lds + L_XB2));
#ifndef MK_PROBE
#define MK_PROBE 0
#endif
#define IN(id) (lo <= (id) && (id) < hi)
#define PHASE_BEGIN ArgsP ap = (ArgsP)__builtin_amdgcn_kernarg_segment_ptr(); asm volatile("" : "+s"(ap)); GAS unsigned char* wsg_ = (GAS unsigned char*)ap->ws; asm volatile("" : "+s"(wsg_)); unsigned char* ws = (unsigned char*)wsg_; Frame Fp = F; { const int l_ = lane_id_now(); Fp.lane = l_; Fp.tid = F.wave * 64 + l_; } Fp.ctl = (gu32*)(ws + WS_CTL);
#define SEAM(id) do { if (fused && (id) != LAST_PHASE) { xcd_barrier(bar, F.wave == 0 && lane_id_now() == 0, (unsigned)F.G); if (MK_PROBE == 10) xcd_barrier(bar, F.wave == 0 && lane_id_now() == 0, (unsigned)F.G); } } while (0)
#define SEAMW(id, sync, last) do { if (!split) SEAM(id); else if (last) SEAM(id); else if ((sync) && !is_conv) xcd_barrier(bar2, F.wave == 0 && lane_id_now() == 0, (unsigned)(F.G - NCV)); } while (0)
#define WIN_FRAME do { if (split) { Fp.G = F.G - NCV; Fp.bid = F.bid - NCV; Fp.vcu = (Fp.G % 8 == 0) ? (Fp.bid % 8) * (Fp.G / 8) + Fp.bid / 8 : Fp.bid; } } while (0)
#define REPS(k) ((MK_PROBE) == (k) ? 2 : 1)

#ifndef SKIP_P0
    if (MK_FP8TEST && lo == 0 && F.bid == 0 && F.wave == 0) fp8_selftest(F.ctl, F.lane);
    if (IN(0)) { PHASE_BEGIN for (int rep = 0; rep < REPS(1); ++rep) p0_prologue(Fp, ap, ws, split ? 1 : 0); SEAM(0); }
#endif

    for (int s = 0; s < N_STEPS; ++s) {
        const int pb = 1 + 10 * s;
        const int layer = s == 0 ? 0 : (s == 1 ? 0 : (s <= 3 ? 1 : s - 2));
        const int kind = layer % 3;
        const bool rest = !(s == 0 || s == 2);
#ifndef SKIP_G1
        const bool inw = split && s <= 1;
        if (IN(pb) && inw && is_conv) {
            if (s == 0) { PHASE_BEGIN Fp.G = NCV; p0_prologue(Fp, ap, ws, 2); }
        } else
        if (IN(pb)) {
            PHASE_BEGIN
            if (inw) WIN_FRAME;
            pg8::Gemm g; pg8::EpiProj E; E.ssq_in = nullptr; E.ssq_out = nullptr; E.rope = (const pg8::f32x2*)(ws + WS_ROPE); E.rope_heads = 0u; E.oscale = 1.0f;
            if (s == 0) { g = pg8::Gemm{(const bf16*)(ws + WS_MEMB), (const bf16*)(ws + WS_WKV), NB * MEML, 2048, 1024, 1024}; E.O = (bf16*)(ws + WS_KVMEM); E.ldc = 2048; }
            else if (s == 3) { g = pg8::Gemm{(const bf16*)(ws + WS_PROJ), (const bf16*)(ws + WS_WUQ), T, 1280, 256, 1280}; E.O = (bf16*)(ws + WS_QQ); E.ldc = 1280; E.ssq_in = (const float*)(ws + WS_SSQ); E.rope_heads = 0xFFFFFu; }
            else { const int n = kind == 0 ? 2560 : (kind == 1 ? 1280 : 1536);
                g = pg8::Gemm{(const bf16*)(ws + WS_XB), (const bf16*)(ws + WS_WIN + (size_t)layer * 5 * MiB), T, n, 1024, 1024}; E.O = (bf16*)(ws + WS_PROJ); E.ldc = n;
                if (layer != 0) { g.A = (const bf16*)(ws + WS_XB8); g.K = 512; g.lda = 512; E.oscale = 1.0f / 64.0f; }
                if (kind == 1) { E.ssq_out = (float*)(ws + WS_SSQ); E.rope_heads = 0xF0u | (1u << 16); }
                if (kind == 2) E.rope_heads = 0xFFFFu; }
            pg8::StaticOrder S; S.init(g.M, g.N, Fp.G, (s == 0 && !inw) ? Fp.G - 1 - Fp.bid : Fp.bid); if (s <= 1) S.split = 0;
            if (!(s == 0 || s == 1 || s == 3)) { for (int rep = 0; rep < REPS(2); ++rep) pg8::gemm_phase<pg8::EpiProj, pg8::StaticOrder, true, true, true>(F.lds + RING_OFF, g, S, E, F.wave * 64 + lane_id_now()); }
            else { for (int rep = 0; rep < REPS(2); ++rep) pg8::gemm_phase<pg8::EpiProj, pg8::StaticOrder, true, true, false>(F.lds + RING_OFF, g, S, E, F.wave * 64 + lane_id_now()); }
        }
        if (IN(pb)) { if (inw) SEAMW(pb, s == 1, false); else if (!(s == 0 && fused)) SEAM(pb); }
#endif
        if (s == 3) {
#ifndef SKIP_PS
            if (IN(pb + 1)) { PHASE_BEGIN for (int rep = 0; rep < ((MK_PROBE == 3 || MK_PROBE == 31) ? 2 : 1); ++rep) score_phase(Fp, (const bf16*)(ws + WS_QQ), (const bf16*)(ws + WS_PROJ), (float*)(ws + WS_ACT)); SEAM(pb + 1); }
#endif
#ifndef SKIP_PT
            if (IN(pb + 2)) { PHASE_BEGIN for (int rep = 0; rep < ((MK_PROBE == 3 || MK_PROBE == 32) ? 2 : 1); ++rep) select_phase(Fp, (const float*)(ws + WS_ACT), (unsigned long long*)(ws + WS_MASK)); SEAM(pb + 2); }
#endif
        }
        if (!rest) continue;
#ifndef SKIP_MIX
        if (IN(pb + 3) && !(inw && is_conv)) { PHASE_BEGIN if (inw) WIN_FRAME; for (int rep = 0; rep < ((MK_PROBE == 4 || (MK_PROBE == 41 && kind == 1) || (MK_PROBE == 42 && kind == 2) || (MK_PROBE == 43 && kind == 0)) ? 2 : 1); ++rep) mixer_phase(Fp, ap, ws, layer, kind, s + 8 * rep); }
        if (IN(pb + 3)) { if (inw) SEAMW(pb + 3, true, false); else SEAM(pb + 3); }
#endif
#ifndef SKIP_G2
        if (IN(pb + 4) && !(inw && is_conv)) {
            PHASE_BEGIN
            if (inw) WIN_FRAME;
            pg8::Gemm g{(const bf16*)(ws + WS_CAT), (const bf16*)(ws + WS_WOUT + (size_t)layer * 2 * MiB), T, 1024, 512, 512};
            pg8::EpiProj E; E.O = (bf16*)(ws + WS_Y); E.ldc = 1024; E.ssq_in = nullptr; E.ssq_out = nullptr; E.rope = nullptr; E.rope_heads = 0u; E.oscale = 1.0f / 128.0f;
            pg8::StaticOrder S; S.init(T, 1024, Fp.G, Fp.bid);
            for (int rep = 0; rep < REPS(5); ++rep) pg8::gemm_phase<pg8::EpiProj, pg8::StaticOrder, true, true, true>(F.lds + RING_OFF, g, S, E, F.wave * 64 + lane_id_now());
        }
        if (IN(pb + 4)) { if (inw) SEAMW(pb + 4, true, false); else SEAM(pb + 4); }
#endif
#ifndef SKIP_LN1
        if (IN(pb + 5) && !(inw && is_conv)) {
            PHASE_BEGIN
            if (inw) WIN_FRAME;
            for (int rep = 0; rep < ((MK_PROBE == 6 || MK_PROBE == 61 || MK_PROBE == 62 || MK_PROBE == 63) ? 2 : 1); ++rep)
            ln1_phase(Fp, (const bf16*)(ws + WS_XB), (const bf16*)(ws + WS_Y), ap->in[12] + layer * D, ap->in[13] + layer * D, (bf16*)(ws + WS_QQ),
                      ap->in[14] + (size_t)layer * D * NEXP, ap->in[15] + layer * NEXP, (bf16*)(ws + (rep ? WS_ACT : WS_XP)), Fp.ctl + (rep ? CW_GDUMMY : CW_GCOUNT) + layer * NEXP,
                      (int*)(ws + (rep ? WS_SSQ : WS_ROWS)), (float*)(ws + (rep ? WS_MASK : WS_GATES)), (rep && MK_PROBE == 61) ? 2 : (rep && MK_PROBE == 62) ? 1 : (rep && MK_PROBE == 63) ? 0 : 3);
        }
        if (IN(pb + 5)) { if (inw) SEAMW(pb + 5, true, true); else SEAM(pb + 5); }
#endif
        if (IN(pb + 6) || IN(pb + 7)) {
            LAS int* pref = (LAS int*)(F.lds + L_PREF); LAS int* tiles = (LAS int*)(F.lds + L_TILES);
#ifndef SKIP_G3
            if (IN(pb + 6)) {
                PHASE_BEGIN
                if (Fp.wave == 0) {
                    const int l_ = Fp.lane; const int tl_ = l_ < 32 ? (int)((__hip_atomic_load(Fp.ctl + CW_GCOUNT + layer * NEXP + (l_ & 31), RLX_AGENT) + 255u) >> 8) : 0;
                    int v_ = tl_ * 8;
#pragma unroll
                    for (int d_ = 1; d_ < 32; d_ <<= 1) { const int t_ = __builtin_amdgcn_ds_bpermute(((l_ - d_) & 63) << 2, v_); if (l_ >= d_) v_ += t_; }
                    if (l_ < 32) { tiles[l_] = tl_; pref[l_] = v_ - tl_ * 8; } if (l_ == 31) pref[32] = v_; }
                __syncthreads();
                pg8::Gemm g{(const bf16*)(ws + WS_XP), (const bf16*)(ws + WS_WGU + (size_t)layer * 64 * MiB), NEXP * CAPROWS, NEXP * 2048, 512, 512};
                pg8::EpiSwiglu E{(bf16*)(ws + WS_ACT), ap->in[17] + (size_t)layer * NEXP * 2048};
                pg8::MoeOrder S{pref, tiles, 8, pref[32], F.G, F.vcu};
                for (int rep = 0; rep < REPS(7); ++rep) pg8::gemm_phase<pg8::EpiSwiglu, pg8::MoeOrder, true, true, true>(F.lds + RING_OFF, g, S, E, F.wave * 64 + lane_id_now());
                SEAM(pb + 6);
            }
#endif
#ifndef SKIP_G4
            if (IN(pb + 7)) {
                PHASE_BEGIN
                if (Fp.wave == 0) {
                    const int l_ = Fp.lane; const int tl_ = l_ < 32 ? (int)((__hip_atomic_load(Fp.ctl + CW_GCOUNT + layer * NEXP + (l_ & 31), RLX_AGENT) + 255u) >> 8) : 0;
                    int v_ = tl_ * 4;
#pragma unroll
                    for (int d_ = 1; d_ < 32; d_ <<= 1) { const int t_ = __builtin_amdgcn_ds_bpermute(((l_ - d_) & 63) << 2, v_); if (l_ >= d_) v_ += t_; }
                    if (l_ < 32) { tiles[l_] = tl_; pref[l_] = v_ - tl_ * 4; } if (l_ == 31) pref[32] = v_; }
                __syncthreads();
                pg8::Gemm g{(const bf16*)(ws + WS_ACT), (const bf16*)(ws + WS_WDN + (size_t)layer * 32 * MiB), NEXP * CAPROWS, NEXP * 1024, 512, 512};
                pg8::EpiDown E{(bf16*)(ws + WS_XP), ap->in[19] + (size_t)layer * NEXP * 1024};
                pg8::MoeOrder S{pref, tiles, 4, pref[32], F.G, F.vcu};
                for (int rep = 0; rep < REPS(8); ++rep) pg8::gemm_phase<pg8::EpiDown, pg8::MoeOrder, true, true, true>(F.lds + RING_OFF, g, S, E, F.wave * 64 + lane_id_now());
                SEAM(pb + 7);
            }
#endif
        }
#ifndef SKIP_LN2
        if (IN(pb + 8)) {
            PHASE_BEGIN
            for (int rep = 0; rep < REPS(9); ++rep)
            ln2_phase(Fp, (const bf16*)(ws + WS_QQ), (const bf16*)(ws + WS_XP), (const int*)(ws + WS_ROWS), (const float*)(ws + WS_GATES), ap->in[20] + layer * D, ap->in[21] + layer * D,
                      layer == DEPTH - 1 ? ap->out : (float*)nullptr, (bf16*)(ws + WS_XB), (layer + 1 < DEPTH) ? (unsigned char*)(ws + WS_XB8) : (unsigned char*)nullptr);
            SEAM(pb + 8);
        }
#endif
    }
    if (MK_FP8TEST && hi > LAST_PHASE) {
        const unsigned code = __hip_atomic_load(F.ctl + CW_ERR, RLX_AGENT);
        if (code) { const float v = code == 2u ? 100.f : 10.f;
            for (int row = F.bid * NWAVES + F.wave; row < T; row += F.G * NWAVES) { f32x4* o = (f32x4*)(args.out + (size_t)row * D) + F.lane;
#pragma unroll
                for (int j = 0; j < 4; ++j) o[64 * j] = (f32x4){v, v, v, v}; } }
    }
#undef IN
#undef SEAM
}

extern "C" void kernel_launch(void* const* d_in, const int* in_sizes, int n_in, void* d_out, int out_size, void* d_ws, size_t ws_size, hipStream_t stream) {
    static int grid = 0;
    if (grid == 0) {
        if (n_in != 22 || in_sizes[0] != T * D || out_size != T * D || ws_size < WS_END) { fprintf(stderr, "kernel_launch: unexpected shapes (n_in %d, in0 %d, out %d, ws %zu < %zu); nothing launched\n", n_in, n_in > 0 ? in_sizes[0] : -1, out_size, ws_size, (size_t)WS_END); grid = -1; return; }
        int dev = 0, cus = 0, per_cu = 0;
        if (hipGetDevice(&dev) != hipSuccess || hipDeviceGetAttribute(&cus, hipDeviceAttributeMultiprocessorCount, dev) != hipSuccess) { fprintf(stderr, "kernel_launch: device query failed\n"); grid = -1; return; }
        if (hipFuncSetAttribute((const void*)mk_fwd, hipFuncAttributeMaxDynamicSharedMemorySize, LDS_BYTES) != hipSuccess) { fprintf(stderr, "kernel_launch: hipFuncSetAttribute failed\n"); grid = -1; return; }
        if (hipOccupancyMaxActiveBlocksPerMultiprocessor(&per_cu, (const void*)mk_fwd, NTHREADS, LDS_BYTES) != hipSuccess || per_cu < 1) fprintf(stderr, "kernel_launch: note: occupancy query reports %d workgroups per CU\n", per_cu);
        (void)hipGetLastError();
        grid = cus;
    }
    if (grid < 0) return;
    if (hipMemsetAsync((char*)d_ws + WS_CTL, 0, CTL_ZERO_BYTES, stream) != hipSuccess) { fprintf(stderr, "kernel_launch: hipMemsetAsync failed\n"); return; }
    Args a{};
    for (int i = 0; i < 22; ++i) a.in[i] = (const float*)d_in[i];
    a.out = (float*)d_out; a.ws = (unsigned char*)d_ws;
    unsigned char* ws = (unsigned char*)d_ws;
    { int nj = 0, items = 0;
      auto add = [&](const float* src, int ldw, int K, int col0, int nvalid, int nblk, size_t dst_off, int row0, const float* scale, int f8 = 0, float mul = 1.0f) {
          Job& j = a.jobs[nj++]; j.src = src; j.dst = (bf16*)(ws + dst_off); j.scale = scale; j.ldw = ldw; j.K = K; j.col0 = col0; j.nvalid = nvalid; j.nblk = nblk; j.row0 = row0; j.item0 = items; j.f8 = f8; j.mul = mul; j.pad = 0;
          items += nblk * (K / 128); };
      const float* a_w_in = a.in[2]; const float* b_w_in = a.in[4]; const float* c_w_in = a.in[8];
      add(a_w_in, 2560, 1024, 0, 2560, 10, WS_WIN + 0 * 5 * MiB, 0, nullptr);
      add(a_w_in + (size_t)1024 * 2560, 2560, 1024, 0, 2560, 10, WS_WIN + 3 * 5 * MiB, 0, nullptr, 1, 64.0f);
      add(b_w_in, 1096, 1024, 0, 768, 3, WS_WIN + 1 * 5 * MiB, 0, nullptr, 1, 64.0f);
      add(b_w_in, 1096, 1024, 840, 256, 1, WS_WIN + 1 * 5 * MiB, 768, nullptr, 1, 64.0f);
      add(b_w_in, 1096, 1024, 768, 72, 1, WS_WIN + 1 * 5 * MiB, 1024, nullptr, 1, 64.0f);
      add(c_w_in, 1536, 1024, 0, 1536, 6, WS_WIN + 2 * 5 * MiB, 0, nullptr, 1, 64.0f);
      for (int l = 0; l < 4; ++l) add(a.in[10] + (size_t)l * 1024 * 1024, 1024, 1024, 0, 1024, 4, WS_WOUT + (size_t)l * 2 * MiB, 0, nullptr, 1, 128.0f);
      for (int l = 0; l < 4; ++l) add(a.in[11] + (size_t)l * 1024 * 512, 512, 1024, 0, 512, 2, WS_WKV, 512 * l, nullptr);
      add(a.in[6], 768, 256, 0, 768, 3, WS_WUQ, 0, a.in[5]);
      add(a.in[7], 512, 256, 0, 512, 2, WS_WUQ, 768, a.in[5]);
      a.njob_items = items; }
    a.pad = 0;
#if MK_MULTI
    for (int id = 0; id <= LAST_PHASE; ++id) {
        if (!phase_exists(id)) continue;
        a.ph_lo = id; a.ph_hi = id + 1;
        hipLaunchKernelGGL(mk_fwd, dim3(grid), dim3(NTHREADS), LDS_BYTES, stream, a);
    }
#else
    a.ph_lo = 0; a.ph_hi = LAST_PHASE + 1;
    hipLaunchKernelGGL(mk_fwd, dim3(grid), dim3(NTHREADS), LDS_BYTES, stream, a);
#endif
    const hipError_t le = hipPeekAtLastError();
    if (le != hipSuccess) fprintf(stderr, "kernel_launch: launch failed: %s (grid %d)\n", hipGetErrorName(le), grid);
}
```

```cpp
#include <hip/hip_runtime.h>
#include <cstdio>
#include <cstdint>
#include <cmath>

#ifndef MK_MULTI
#define MK_MULTI 0
#endif
#ifndef MK_SPLIT
#define MK_SPLIT 0
#endif
#ifndef MK_CHECK
#define MK_CHECK 0
#endif

namespace pg8 {
#define PG8_LAS __attribute__((address_space(3)))
typedef unsigned short bf16_t;
typedef short bf16x8 __attribute__((ext_vector_type(8)));
typedef float f32x4 __attribute__((ext_vector_type(4)));
typedef unsigned u32x4 __attribute__((ext_vector_type(4)));
typedef int i32x8 __attribute__((ext_vector_type(8)));
typedef short bf16x16 __attribute__((ext_vector_type(16)));
typedef unsigned u32x2 __attribute__((ext_vector_type(2)));
constexpr int BM = 256, BK = 64, HALF = 128, HTB = HALF * BK * 2  , STAGE_BYTES = 8 * HTB, NXCD = 8, WGM = 8;

__host__ __device__ __forceinline__ int lds_byte(int r, int c) { const int st = (r >> 4) * 2 + (c >> 5), rr = r & 15, cc = c & 31, ob = rr * 64 + cc * 2; return st * 1024 + (ob ^ (((ob >> 9) & 1) << 5)); }
__host__ __device__ __forceinline__ void stage_rc(int b, int& R, int& C) { const int st = b / 1024, sb = b % 1024, swz = sb ^ (((sb >> 9) & 1) << 5); R = (st >> 1) * 16 + swz / 64; C = (st & 1) * 32 + (swz % 64) / 2; }
__host__ __device__ __forceinline__ int perm32(int rho) { const int n = rho >> 4, i = rho & 15; return 8 * (i >> 2) + 4 * n + (i & 3); }

struct Unit { int pm, pn, hs; };
struct Gemm { const bf16_t* A; const bf16_t* Bt; int M, N, K, lda; };

struct StaticOrder {
    int nM, nN, nwg, G, c, split;
    __host__ __device__ void init(int M, int N, int G_, int c_) { nM = M / BM; nN = N / BM; nwg = nM * nN; G = G_; c = c_; split = 1; }
    __host__ __device__ bool next(int i, Unit& u) const {
        const int nfull = nwg / G, rem = nwg - nfull * G; int L = i * G + c; u.hs = 0;
        if (split && i == nfull && rem > 0 && 2 * rem <= G) { if (c >= 2 * rem) return false; L = nfull * G + (c >> 1); u.hs = 1 + (c & 1); }
        if (L >= nwg) return false;
        int wgid = L; { const int q = nwg / NXCD, r = nwg % NXCD, xcd = wgid % NXCD, off = wgid / NXCD; wgid = (xcd < r ? xcd * (q + 1) : r * (q + 1) + (xcd - r) * q) + off; }
        const int nig = WGM * nN, gid = wgid / nig, fm = gid * WGM, gsz = (nM - fm) < WGM ? (nM - fm) : WGM;
        u.pm = fm + ((wgid % nig) % gsz); u.pn = (wgid % nig) / gsz; return true;
    }
    __device__ __forceinline__ void a_ready(const Unit&) const {}
    __device__ __forceinline__ void done(const Unit&) const {}
};

typedef float f32x2 __attribute__((ext_vector_type(2)));
__device__ __forceinline__ float shx16(float v, int lane, int m) { return __int_as_float(__builtin_amdgcn_ds_bpermute((lane ^ m) << 2, __float_as_int(v))); }
typedef __bf16 bf16x2_t __attribute__((ext_vector_type(2)));
__device__ __forceinline__ unsigned pk4_fp8(float a, float b, float c, float d) { int w = __builtin_amdgcn_cvt_pk_fp8_f32(a, b, 0, false); w = __builtin_amdgcn_cvt_pk_fp8_f32(c, d, w, true); return (unsigned)w; }
__device__ __forceinline__ unsigned cvt_pk_bf16(float lo, float hi) { f32x2 v = {lo, hi}; bf16x2_t b = __builtin_convertvector(v, bf16x2_t); return __builtin_bit_cast(unsigned, b); }

struct EpiProj {
    static constexpr bool PERM = true, AFTER_DRAIN = false, BIAS_LDS = false; static constexpr int NSTORE = 16;
    bf16_t* O; int ldc; const float* ssq_in; float* ssq_out; const f32x2* rope; unsigned rope_heads; float oscale;
    __device__ __forceinline__ void operator()(const f32x4 (&acc)[2][2][4][2], const Unit& u, int wr, int wc, int fr, int fq) const {
        const int row0 = u.pm * BM + (u.hs == 2 ? HALF : 0) + wr * 64 + fr, col0 = u.pn * BM + wc * 32 + 8 * fq;
        const bool do_ssq = (ssq_out != nullptr) && (u.pn == 0);
        const __amdgpu_buffer_rsrc_t ors = __builtin_amdgcn_make_buffer_rsrc((void*)O, 0, 0x7fffffff, 0x00020000);
        const bool any_rope = rope_heads != 0u;
        f32x4 sq_n = {0.f, 0.f, 0.f, 0.f}, cs_n[4];
#pragma unroll
        for (int q = 0; q < 4; ++q) cs_n[q] = (f32x4){0.f, 0.f, 0.f, 0.f};
#define EPI_ROWLOADS(ROW) do { if (ssq_in) sq_n = *(const f32x4*)(ssq_in + (size_t)(ROW) * 4); \
            if (any_rope) { const f32x4* cs_ = (const f32x4*)(rope + (size_t)((ROW) & 4095) * 8); cs_n[0] = cs_[0]; cs_n[1] = cs_[1]; cs_n[2] = cs_[2]; cs_n[3] = cs_[3]; } } while (0)
        EPI_ROWLOADS(row0);
#pragma unroll
        for (int ai = 0; ai < 2; ++ai) if (ai == 0 || u.hs == 0)
#pragma unroll
            for (int m = 0; m < 4; ++m) {
                const int row = row0 + ai * HALF + m * 16;
                const f32x4 s = sq_n, c01 = cs_n[0], c23 = cs_n[1], c45 = cs_n[2], c67 = cs_n[3];
                if (!(ai == 1 && m == 3)) { const int rown = row0 + (m == 3 ? HALF : ai * HALF + (m + 1) * 16); EPI_ROWLOADS(rown); }
                float rs = 1.f;
                if (ssq_in) rs = 1.0f / sqrtf(((s[0] + s[1]) + (s[2] + s[3])) * (1.f / 256.f) + 1e-5f);
                float ss = 0.f;
#pragma unroll
                for (int bj = 0; bj < 2; ++bj) {
                    f32x4 v0 = acc[ai][bj][m][0] * oscale, v1 = acc[ai][bj][m][1] * oscale;
                    if (do_ssq) ss += ((v0[0] * v0[0] + v0[1] * v0[1]) + (v0[2] * v0[2] + v0[3] * v0[3])) + ((v1[0] * v1[0] + v1[1] * v1[1]) + (v1[2] * v1[2] + v1[3] * v1[3]));
                    v0 = v0 * rs; v1 = v1 * rs;
                    const int head = (u.pn * BM + bj * HALF + wc * 32) >> 6;
                    if (((rope_heads >> head) & 1u) && !(wc & 1)) {
                        f32x4 o0, o1;
#pragma unroll
                        for (int j = 0; j < 4; ++j) { o0[j] = shx16(v0[j], fr + 16 * fq, 16); o1[j] = shx16(v1[j], fr + 16 * fq, 16); }
                        if (fq < 2) {
                            const float sg = fq == 0 ? -1.f : 1.f;
                            v0[0] = v0[0] * c01[0] + sg * o0[0] * c01[1]; v0[1] = v0[1] * c01[2] + sg * o0[1] * c01[3];
                            v0[2] = v0[2] * c23[0] + sg * o0[2] * c23[1]; v0[3] = v0[3] * c23[2] + sg * o0[3] * c23[3];
                            v1[0] = v1[0] * c45[0] + sg * o1[0] * c45[1]; v1[1] = v1[1] * c45[2] + sg * o1[1] * c45[3];
                            v1[2] = v1[2] * c67[0] + sg * o1[2] * c67[1]; v1[3] = v1[3] * c67[2] + sg * o1[3] * c67[3];
                        }
                    }
                    u32x4 w; w.x = cvt_pk_bf16(v0[0], v0[1]); w.y = cvt_pk_bf16(v0[2], v0[3]); w.z = cvt_pk_bf16(v1[0], v1[1]); w.w = cvt_pk_bf16(v1[2], v1[3]);
                    __builtin_amdgcn_raw_buffer_store_b128(w, ors, (row * ldc + col0 + bj * HALF) * 2, 0, 0);
                }
                if (do_ssq) { ss += shx16(ss, fr + 16 * fq, 16); ss += shx16(ss, fr + 16 * fq, 32); if (fq == 0) ssq_out[(size_t)row * 4 + wc] = ss; }
            }
#undef EPI_ROWLOADS
    }
};
struct EpiSwiglu {
    static constexpr bool PERM = true, AFTER_DRAIN = false, BIAS_LDS = true; static constexpr int NSTORE = 8;
    bf16_t* O; const float* bias;
    static constexpr float WSC = 1.0f / 64.0f;
    __device__ __forceinline__ void stage_bias(const Unit& u, PG8_LAS void* dst, int lane) const {
        const __amdgpu_buffer_rsrc_t brs = __builtin_amdgcn_make_buffer_rsrc((void*)bias, 0, 32 * 2048 * 4, 0x00020000);
        const int e = u.pn >> 3, t = u.pn & 7;
        __builtin_amdgcn_raw_ptr_buffer_load_lds(brs, dst, 16, (lane & 31) * 16 + (lane >> 5) * 4096, (e * 2048 + t * 128) * 4, 0, 0);
    }
    __device__ __forceinline__ void operator()(const f32x4 (&acc)[2][2][4][2], const Unit& u, int wr, int wc, int fr, int fq, const PG8_LAS float* bl) const {
        const int t = u.pn & 7;
        const int row0 = u.pm * BM + (u.hs == 2 ? HALF : 0) + wr * 64 + fr, jl = wc * 32 + 8 * fq, j0 = t * 128 + jl;
        const f32x4 bg0 = *(const PG8_LAS f32x4*)(bl + jl), bg1 = *(const PG8_LAS f32x4*)(bl + jl + 4), bu0 = *(const PG8_LAS f32x4*)(bl + 128 + jl), bu1 = *(const PG8_LAS f32x4*)(bl + 128 + jl + 4);
#pragma unroll
        for (int ai = 0; ai < 2; ++ai) if (ai == 0 || u.hs == 0)
#pragma unroll
            for (int m = 0; m < 4; ++m) {
                const int row = row0 + ai * HALF + m * 16;
                float r[8];
#pragma unroll
                for (int n = 0; n < 2; ++n) {
                    const f32x4 g4 = acc[ai][0][m][n] * WSC + (n ? bg1 : bg0), u4 = acc[ai][1][m][n] * WSC + (n ? bu1 : bu0);
#pragma unroll
                    for (int j = 0; j < 4; ++j) {
                        const float g = fminf(g4[j], 7.0f), up = fminf(fmaxf(u4[j], -7.0f), 7.0f);
                        const float sg = __builtin_amdgcn_rcpf(1.0f + __builtin_amdgcn_exp2f(g * (-1.702f * 1.4426950408889634f)));
                        r[n * 4 + j] = (up + 1.0f) * g * sg;
                    }
                }
                u32x2 w; w.x = pk4_fp8(r[0], r[1], r[2], r[3]); w.y = pk4_fp8(r[4], r[5], r[6], r[7]);
                *(u32x2*)((unsigned char*)O + (size_t)row * 1024 + j0) = w;
            }
    }
};
struct EpiDown {
    static constexpr bool PERM = true, AFTER_DRAIN = false, BIAS_LDS = true; static constexpr int NSTORE = 16;
    bf16_t* O; const float* bias;
    __device__ __forceinline__ void stage_bias(const Unit& u, PG8_LAS void* dst, int lane) const {
        const __amdgpu_buffer_rsrc_t brs = __builtin_amdgcn_make_buffer_rsrc((void*)bias, 0, 32 * 1024 * 4, 0x00020000);
        const int e = u.pn >> 2, t = u.pn & 3;
        __builtin_amdgcn_raw_ptr_buffer_load_lds(brs, dst, 16, lane * 16, (e * 1024 + t * 256) * 4, 0, 0);
    }
    __device__ __forceinline__ void operator()(const f32x4 (&acc)[2][2][4][2], const Unit& u, int wr, int wc, int fr, int fq, const PG8_LAS float* bl) const {
        const int t = u.pn & 3;
        const int row0 = u.pm * BM + (u.hs == 2 ? HALF : 0) + wr * 64 + fr, cl = wc * 32 + 8 * fq, col0 = t * BM + cl;
        f32x4 bv[2][2];
#pragma unroll
        for (int bj = 0; bj < 2; ++bj)
#pragma unroll
            for (int n = 0; n < 2; ++n) bv[bj][n] = *(const PG8_LAS f32x4*)(bl + cl + bj * HALF + 4 * n);
#pragma unroll
        for (int ai = 0; ai < 2; ++ai) if (ai == 0 || u.hs == 0)
#pragma unroll
            for (int m = 0; m < 4; ++m) { unsigned char* rowp = (unsigned char*)O + (size_t)(row0 + ai * HALF + m * 16) * 1024 + col0;
#pragma unroll
                for (int bj = 0; bj < 2; ++bj) { const f32x4 v0 = (acc[ai][bj][m][0] * (1.0f / 128.0f) + bv[bj][0]) * 16.0f, v1 = (acc[ai][bj][m][1] * (1.0f / 128.0f) + bv[bj][1]) * 16.0f;
                    u32x2 w; w.x = pk4_fp8(v0[0], v0[1], v0[2], v0[3]); w.y = pk4_fp8(v1[0], v1[1], v1[2], v1[3]);
                    *(u32x2*)(rowp + bj * HALF) = w; } }
    }
};
struct MoeOrder {
    const PG8_LAS int* pref; const PG8_LAS int* tiles; int ntn, total, G, vcu;
    __device__ __forceinline__ bool next(int i, Unit& u) const {
        const int nfull = total / G, rem = total - nfull * G; int L = i * G + vcu; u.hs = 0;
        if (i == nfull && rem > 0 && 2 * rem <= G) { if (vcu >= 2 * rem) return false; L = nfull * G + (vcu >> 1); u.hs = 1 + (vcu & 1); }
        if (L >= total) return false;
        int e = 0;
        for (int k = 1; k < 32; ++k) e += (pref[k] <= L) ? 1 : 0;
        const int r = L - pref[e], te = tiles[e];
        const int grp = te * 4, ntq = r / grp, r2 = r - ntq * grp, mt = r2 >> 2, ntl = r2 & 3;
        u.pm = __builtin_amdgcn_readfirstlane(e * 64 + mt); u.pn = __builtin_amdgcn_readfirstlane(e * ntn + ntq * 4 + ntl); return true;
    }
    __device__ __forceinline__ void a_ready(const Unit&) const {}
    __device__ __forceinline__ void done(const Unit&) const {}
};

template <class Epi, class Sched, bool ALIGN_EPI = false, bool SP2 = false, bool FP8 = false>
__device__ __forceinline__ void gemm_phase(PG8_LAS unsigned char* lds, const Gemm g, const Sched& S, const Epi& E, const int tid_in) {
    const int tid_ = tid_in;
    const int tid = tid_, wid = __builtin_amdgcn_readfirstlane(tid >> 6), lane = tid & 63, wr = wid >> 2, wc = wid & 3, fr = lane & 15, fq = lane >> 4;
    const int K = g.K, nt = K / BK;
    unsigned voffA[2], voffB[2];
#pragma unroll
    for (int i = 0; i < 2; ++i) { int R, C; stage_rc(tid * 16 + i * 8192, R, C); const int Rb = Epi::PERM ? ((R & ~31) + perm32(R & 31)) : R;
        voffA[i] = (unsigned)(R * g.lda + C) * 2u; voffB[i] = (unsigned)(Rb * K + C) * 2u; }
    const unsigned kstep = (unsigned)(BK * 2);
    const unsigned hstepA = (unsigned)HALF * g.lda * 2, hstepB = (unsigned)HALF * K * 2;
    const unsigned tstepA = 2 * hstepA, tstepB = 2 * hstepB;
    const unsigned ldsw = (unsigned)wid * 1024u;
    const int aoff = lds_byte(wr * 64 + fr, fq * 8), boff = lds_byte(wc * 32 + fr, fq * 8);
#define PG8_SA(b, h) (((b) * 2 + (h)) * HTB)
#define PG8_SB(b, h) ((4 + (b) * 2 + (h)) * HTB)
    const __amdgpu_buffer_rsrc_t rA = __builtin_amdgcn_make_buffer_rsrc((void*)g.A, 0, 0x7fffffff, 0x00020000), rB = __builtin_amdgcn_make_buffer_rsrc((void*)g.Bt, 0, 0x7fffffff, 0x00020000);
#define PG8_STAGE(bufoff, soff, voff, rs) do { _Pragma("unroll") for (int _i = 0; _i < 2; ++_i) \
        __builtin_amdgcn_raw_ptr_buffer_load_lds(rs, (PG8_LAS void*)(lds + (bufoff) + ldsw + _i * 8192), 16, (int)(voff)[_i], (int)(soff), 0, 0); } while (0)
#define PG8_LD2(P) __builtin_shufflevector(*(const PG8_LAS bf16x8*)(P), *(const PG8_LAS bf16x8*)((P) + 1024), 0, 1, 2, 3, 4, 5, 6, 7, 8, 9, 10, 11, 12, 13, 14, 15)
#define PG8_LDA(dst, b, h) do { _Pragma("unroll") for (int m = 0; m < 4; ++m) dst[m] = PG8_LD2(lds + PG8_SA(b, h) + aoff + m * 2048); } while (0)
#define PG8_LDB(dst, b, h) do { _Pragma("unroll") for (int n = 0; n < 2; ++n) dst[n] = PG8_LD2(lds + PG8_SB(b, h) + boff + n * 2048); } while (0)
#define PG8_LO(X) __builtin_shufflevector((X), (X), 0, 1, 2, 3, 4, 5, 6, 7)
#define PG8_HI(X) __builtin_shufflevector((X), (X), 8, 9, 10, 11, 12, 13, 14, 15)
#define PG8_MMA(ai, bj, At, Bt) do { __builtin_amdgcn_s_setprio(1); if constexpr (FP8) { _Pragma("unroll") for (int m = 0; m < 4; ++m) _Pragma("unroll") for (int n = 0; n < 2; ++n) \
        acc[ai][bj][m][n] = __builtin_amdgcn_mfma_scale_f32_16x16x128_f8f6f4(__builtin_bit_cast(i32x8, Bt[n]), __builtin_bit_cast(i32x8, At[m]), acc[ai][bj][m][n], 0, 0, 0, 0x7f7f7f7f, 0, 0x7f7f7f7f); \
        asm volatile("" : "+v"(acc[ai][bj][0][0]), "+v"(acc[ai][bj][0][1]), "+v"(acc[ai][bj][1][0]), "+v"(acc[ai][bj][1][1]), "+v"(acc[ai][bj][2][0]), "+v"(acc[ai][bj][2][1]), "+v"(acc[ai][bj][3][0]), "+v"(acc[ai][bj][3][1]));   } else { \
        _Pragma("unroll") for (int m = 0; m < 4; ++m) _Pragma("unroll") for (int n = 0; n < 2; ++n) { \
        acc[ai][bj][m][n] = __builtin_amdgcn_mfma_f32_16x16x32_bf16(PG8_LO(Bt[n]), PG8_LO(At[m]), acc[ai][bj][m][n], 0, 0, 0); \
        acc[ai][bj][m][n] = __builtin_amdgcn_mfma_f32_16x16x32_bf16(PG8_HI(Bt[n]), PG8_HI(At[m]), acc[ai][bj][m][n], 0, 0, 0); } } __builtin_amdgcn_s_setprio(0); } while (0)
#define PG8_WAIT_V(n) asm volatile("s_waitcnt vmcnt(" #n ")" ::: "memory")
#define PG8_WAIT_L(n) asm volatile("s_waitcnt lgkmcnt(" #n ")" ::: "memory")
#define PG8_WAIT_V8S do { if (t != 0 || pst == 0) PG8_WAIT_V(8); else if (pst == Epi::NSTORE) asm volatile("s_waitcnt vmcnt(%0)" :: "n"(8 + Epi::NSTORE) : "memory"); else asm volatile("s_waitcnt vmcnt(%0)" :: "n"(8 + Epi::NSTORE / 2) : "memory"); } while (0)
#define PG8_BAR __builtin_amdgcn_s_barrier()
#define PG8_SCHED __builtin_amdgcn_sched_barrier(0)
    Unit cur, nxt; int ui = 0, pst = 0;
    if (!S.next(0, cur)) return;
    f32x4 acc[2][2][4][2];
    float z0_ = 0.f; asm volatile("" : "+v"(z0_));
#pragma unroll
    for (int a = 0; a < 2; ++a)
#pragma unroll
        for (int b = 0; b < 2; ++b)
#pragma unroll
            for (int m = 0; m < 4; ++m)
#pragma unroll
                for (int n = 0; n < 2; ++n) acc[a][b][m][n] = (f32x4){z0_, z0_, z0_, z0_};
    bf16x16 At[4], B0[2], B1[2];
    unsigned cA = (unsigned)cur.pm * tstepA + (cur.hs == 2 ? hstepA : 0u), cB = (unsigned)cur.pn * tstepB;
    S.a_ready(cur);
    if constexpr (SP2) {
        PG8_STAGE(PG8_SB(0, 0), cB, voffB, rB); PG8_STAGE(PG8_SB(0, 1), cB + hstepB, voffB, rB); PG8_STAGE(PG8_SA(0, 0), cA, voffA, rA); PG8_STAGE(PG8_SA(0, 1), cA + hstepA, voffA, rA);
        if (wr == 1) PG8_BAR;
        PG8_WAIT_V(2); PG8_BAR;
        PG8_STAGE(PG8_SB(1, 0), cB + kstep, voffB, rB); PG8_STAGE(PG8_SA(1, 0), cA + kstep, voffA, rA); PG8_STAGE(PG8_SB(1, 1), cB + hstepB + kstep, voffB, rB);
        PG8_WAIT_V(6); PG8_BAR;
    } else {
        PG8_STAGE(PG8_SB(0, 0), cB, voffB, rB); PG8_STAGE(PG8_SA(0, 0), cA, voffA, rA); PG8_STAGE(PG8_SB(0, 1), cB + hstepB, voffB, rB); PG8_STAGE(PG8_SA(0, 1), cA + hstepA, voffA, rA);
        if (wr == 1) PG8_BAR;
        PG8_WAIT_V(4); PG8_BAR;
        PG8_STAGE(PG8_SB(1, 0), cB + kstep, voffB, rB); PG8_STAGE(PG8_SA(1, 0), cA + kstep, voffA, rA); PG8_STAGE(PG8_SB(1, 1), cB + hstepB + kstep, voffB, rB);
        PG8_WAIT_V(6); PG8_BAR;
    }
    for (;;) {
        const bool has_next = S.next(ui + 1, nxt);
        if constexpr (Epi::BIAS_LDS) { if (wid == 0) { int lb_; asm volatile("v_mbcnt_lo_u32_b32 %0, -1, 0\n\tv_mbcnt_hi_u32_b32 %0, -1, %0" : "=v"(lb_)); E.stage_bias(cur, (PG8_LAS void*)(lds + STAGE_BYTES + (ui & 1) * 1024), lb_); } }
        const unsigned nA = has_next ? (unsigned)nxt.pm * tstepA + (nxt.hs == 2 ? hstepA : 0u) : cA, nB = has_next ? (unsigned)nxt.pn * tstepB : cB;
        const bool chalf = cur.hs != 0;
        for (int t = 0; t < nt; t += 2) {
            const bool last = (t == nt - 2);
            const unsigned a1 = cA + (unsigned)(t + 1) * kstep;
            const unsigned a2 = last ? nA : cA + (unsigned)(t + 2) * kstep, b2 = last ? nB : cB + (unsigned)(t + 2) * kstep;
            const unsigned a3 = a2 + kstep, b3 = b2 + kstep;
            if (last && has_next) S.a_ready(nxt);
            if constexpr (SP2) {
            PG8_LDB(B0, 0, 0); PG8_LDB(B1, 0, 1); PG8_SCHED; PG8_LDA(At, 0, 0); PG8_STAGE(PG8_SA(1, 1), a1 + hstepA, voffA, rA);
            PG8_WAIT_V8S; PG8_WAIT_L(0); PG8_BAR; PG8_MMA(0, 0, At, B0); PG8_MMA(0, 1, At, B1); PG8_BAR; PG8_SCHED;
            PG8_LDA(At, 0, 1); PG8_STAGE(PG8_SB(0, 0), b2, voffB, rB); PG8_STAGE(PG8_SB(0, 1), b2 + hstepB, voffB, rB); PG8_STAGE(PG8_SA(0, 0), a2, voffA, rA);
            PG8_WAIT_V8S; PG8_WAIT_L(0); PG8_BAR; if (!chalf) { PG8_MMA(1, 0, At, B0); PG8_MMA(1, 1, At, B1); } PG8_BAR; PG8_SCHED;
            PG8_LDB(B0, 1, 0); PG8_LDB(B1, 1, 1); PG8_SCHED; PG8_LDA(At, 1, 0); PG8_STAGE(PG8_SA(0, 1), a2 + hstepA, voffA, rA);
            PG8_WAIT_V(8); PG8_WAIT_L(0); PG8_BAR; PG8_MMA(0, 0, At, B0); PG8_MMA(0, 1, At, B1); PG8_BAR; PG8_SCHED;
            PG8_LDA(At, 1, 1); PG8_STAGE(PG8_SB(1, 0), b3, voffB, rB); PG8_STAGE(PG8_SB(1, 1), b3 + hstepB, voffB, rB); PG8_STAGE(PG8_SA(1, 0), a3, voffA, rA);
            PG8_WAIT_V(8); PG8_WAIT_L(0); PG8_BAR; if (!chalf) { PG8_MMA(1, 0, At, B0); PG8_MMA(1, 1, At, B1); } PG8_BAR; PG8_SCHED;
            } else {
            PG8_LDB(B0, 0, 0); PG8_SCHED; PG8_LDA(At, 0, 0); PG8_STAGE(PG8_SA(1, 1), a1 + hstepA, voffA, rA);
            PG8_WAIT_L(8); PG8_BAR; PG8_WAIT_L(0); PG8_MMA(0, 0, At, B0); PG8_BAR; PG8_SCHED;
            PG8_LDB(B1, 0, 1); PG8_STAGE(PG8_SB(0, 0), b2, voffB, rB);
            PG8_BAR; PG8_WAIT_L(0); PG8_MMA(0, 1, At, B1); PG8_BAR;
            PG8_LDA(At, 0, 1); PG8_STAGE(PG8_SA(0, 0), a2, voffA, rA);
            PG8_BAR; PG8_WAIT_L(0); PG8_MMA(1, 0, At, B0); PG8_BAR; PG8_SCHED;
            PG8_STAGE(PG8_SB(0, 1), b2 + hstepB, voffB, rB);
            PG8_WAIT_V(6); PG8_BAR; PG8_MMA(1, 1, At, B1); PG8_BAR;
            PG8_LDB(B0, 1, 0); PG8_SCHED; PG8_LDA(At, 1, 0); PG8_STAGE(PG8_SA(0, 1), a2 + hstepA, voffA, rA);
            PG8_WAIT_L(8); PG8_BAR; PG8_WAIT_L(0); PG8_MMA(0, 0, At, B0); PG8_BAR; PG8_SCHED;
            PG8_LDB(B1, 1, 1); PG8_STAGE(PG8_SB(1, 0), b3, voffB, rB);
            PG8_BAR; PG8_WAIT_L(0); PG8_MMA(0, 1, At, B1); PG8_BAR;
            PG8_LDA(At, 1, 1); PG8_STAGE(PG8_SA(1, 0), a3, voffA, rA);
            PG8_BAR; PG8_WAIT_L(0); PG8_MMA(1, 0, At, B0); PG8_BAR; PG8_SCHED;
            PG8_STAGE(PG8_SB(1, 1), b3 + hstepB, voffB, rB);
            PG8_WAIT_V(6); PG8_BAR; PG8_MMA(1, 1, At, B1); PG8_BAR;
            }
        }
        if constexpr (ALIGN_EPI) { if (wr == 0) PG8_BAR; }
        if constexpr (!Epi::AFTER_DRAIN) { int l_; asm volatile("v_mbcnt_lo_u32_b32 %0, -1, 0\n\tv_mbcnt_hi_u32_b32 %0, -1, %0" : "=v"(l_)); if constexpr (Epi::BIAS_LDS) E(acc, cur, wr, wc, l_ & 15, l_ >> 4, (const PG8_LAS float*)(lds + STAGE_BYTES + (ui & 1) * 1024)); else E(acc, cur, wr, wc, l_ & 15, l_ >> 4); S.done(cur); }
        if (!has_next) break;
        asm volatile("" : "+v"(z0_));
#pragma unroll
        for (int a = 0; a < 2; ++a)
#pragma unroll
            for (int b = 0; b < 2; ++b)
#pragma unroll
                for (int m = 0; m < 4; ++m)
#pragma unroll
                    for (int n = 0; n < 2; ++n) acc[a][b][m][n] = (f32x4){z0_, z0_, z0_, z0_};
        pst = cur.hs ? Epi::NSTORE / 2 : Epi::NSTORE; cur = nxt; cA = nA; cB = nB; ++ui;
        if constexpr (ALIGN_EPI) { if (wr == 1) PG8_BAR; }
    }
    PG8_WAIT_V(0);
    if constexpr (!ALIGN_EPI) { if (wr == 0) PG8_BAR; }
    PG8_BAR;
    if constexpr (Epi::AFTER_DRAIN) { E.fused(acc, cur, wr, wc, fr, fq, lds, wid, lane); S.done(cur); }
#undef PG8_SA
#undef PG8_SB
#undef PG8_STAGE
#undef PG8_LDA
#undef PG8_LDB
#undef PG8_MMA
#undef PG8_LD2
#undef PG8_LO
#undef PG8_HI
#undef PG8_WAIT_V
#undef PG8_WAIT_L
#undef PG8_WAIT_V8S
#undef PG8_BAR
#undef PG8_SCHED
}
}

constexpr int NB = 4, SEQ = 4096, T = NB * SEQ, D = 1024, DEPTH = 4, NEXP = 32, DEXP = 1024, MEML = 256;
constexpr int CAPROWS = 16384;
constexpr float LN_EPS = 1e-5f, ALPHA = 1.681792830507429f;
constexpr float LOG2E = 1.4426950408889634f, C2 = 0.125f * 1.4426950408889634f;
constexpr float NEG_BIG = -1.0e30f;
constexpr float NEG_RAW = -0x1p100f;
constexpr int NWAVES = 8, NTHREADS = 512;

constexpr size_t MiB = 1u << 20;
constexpr size_t WS_CTL = 0, CTL_ZERO_BYTES = 65536;
constexpr size_t WS_ROPE = 1 * MiB;
constexpr size_t WS_WUQ = 2 * MiB;
constexpr size_t WS_MEMB = 3 * MiB;
constexpr size_t WS_KVMEM = 5 * MiB;
constexpr size_t WS_WKV = 9 * MiB;
constexpr size_t WS_WOUT = 13 * MiB;
constexpr size_t WS_WIN = 21 * MiB;
constexpr size_t WS_SSQ = 41 * MiB;
constexpr size_t WS_ROWS = 42 * MiB;
constexpr size_t WS_GATES = 43 * MiB;
constexpr size_t WS_MASK = 44 * MiB;
constexpr size_t WS_XB = 52 * MiB;
constexpr size_t WS_CAT = 84 * MiB;
constexpr size_t WS_Y = 116 * MiB;
constexpr size_t WS_QQ = 148 * MiB;
constexpr size_t WS_PROJ = 188 * MiB;
constexpr size_t WS_XB8 = 268 * MiB;
constexpr size_t WS_XA = 268 * MiB;
constexpr size_t WS_XM = 332 * MiB;
constexpr size_t WS_WGU = 400 * MiB;
constexpr size_t WS_WDN = 912 * MiB;
constexpr size_t WS_XP = 1168 * MiB;
constexpr size_t WS_ACT = 2192 * MiB;
constexpr size_t WS_END = 3216 * MiB;
constexpr int CW_TMO = 0, CW_ERR = 2;
constexpr int CW_BAR = 4096;
constexpr int CW_QHEAD = 8192;
constexpr int CW_GCOUNT = 9216;
constexpr int CW_BAR2 = 12288;
constexpr int CW_GDUMMY = 9472;
static_assert((CW_BAR2 + 3456) * 4 <= (int)CTL_ZERO_BYTES && (CW_GDUMMY + 128) * 4 <= (int)CTL_ZERO_BYTES, "CTL words inside the memset region");

constexpr int RING_OFF = 0, RING_BYTES = 131072;
constexpr int LDSCTL_OFF = 143360;
constexpr int L_XB = LDSCTL_OFF + 0;
constexpr int L_Q = LDSCTL_OFF + 16;
constexpr int L_XB2 = LDSCTL_OFF + 32;
constexpr int L_PREF = LDSCTL_OFF + 64;
constexpr int L_TILES = LDSCTL_OFF + 256;
constexpr int L_CNT = LDSCTL_OFF + 384;
constexpr int L_BASE = LDSCTL_OFF + 512;
constexpr int L_ROUTE = LDSCTL_OFF + 1024;
constexpr int LDS_BYTES = 147456;

#define GAS __attribute__((address_space(1)))
#define LAS __attribute__((address_space(3)))
typedef unsigned short bf16;
typedef unsigned u32x4 __attribute__((ext_vector_type(4)));
typedef unsigned u32x2 __attribute__((ext_vector_type(2)));
typedef float f32x4 __attribute__((ext_vector_type(4)));
typedef float f32x2 __attribute__((ext_vector_type(2)));
typedef float f32x16 __attribute__((ext_vector_type(16)));
typedef short bf16x8 __attribute__((ext_vector_type(8)));
typedef short s16x4 __attribute__((ext_vector_type(4)));
typedef short v4i16_t __attribute__((ext_vector_type(4)));
typedef GAS unsigned gu32;
#define RLX_AGENT __ATOMIC_RELAXED, __HIP_MEMORY_SCOPE_AGENT
__device__ __forceinline__ unsigned pk2(float lo, float hi) { return pg8::cvt_pk_bf16(lo, hi); }
__device__ __forceinline__ float bf2f(bf16 b) { return __uint_as_float((unsigned)b << 16); }
__device__ __forceinline__ float bflo(unsigned w) { return __uint_as_float(w << 16); }
__device__ __forceinline__ float bfhi(unsigned w) { return __uint_as_float(w & 0xffff0000u); }
__device__ __forceinline__ int crow(int r, int hi) { return (r & 3) + 8 * (r >> 2) + 4 * hi; }
__device__ __forceinline__ float swapmax(float m) { auto rr = __builtin_amdgcn_permlane32_swap(__float_as_uint(m), __float_as_uint(m), false, false); return fmaxf(__uint_as_float(rr[0]), __uint_as_float(rr[1])); }
__device__ __forceinline__ float swapsum(float m) { auto rr = __builtin_amdgcn_permlane32_swap(__float_as_uint(m), __float_as_uint(m), false, false); return __uint_as_float(rr[0]) + __uint_as_float(rr[1]); }
__device__ __forceinline__ int lane_id_now() { int l; asm volatile("v_mbcnt_lo_u32_b32 %0, -1, 0\n\tv_mbcnt_hi_u32_b32 %0, -1, %0" : "=v"(l)); return l; }
__device__ __forceinline__ float shx(float v, int m) { return __int_as_float(__builtin_amdgcn_ds_bpermute((lane_id_now() ^ m) << 2, __float_as_int(v))); }
__device__ __forceinline__ int shxi(int v, int m) { return __builtin_amdgcn_ds_bpermute((lane_id_now() ^ m) << 2, v); }
__device__ __forceinline__ int shli(int v, int src) { return __builtin_amdgcn_ds_bpermute(src << 2, v); }
__device__ __forceinline__ float wave_sum(float v) {
#define WS_DPP(CTRL) v += __int_as_float(__builtin_amdgcn_update_dpp(0, __float_as_int(v), (CTRL), 0xF, 0xF, false))
    WS_DPP(0xB1); WS_DPP(0x4E); WS_DPP(0x141); WS_DPP(0x140);
#undef WS_DPP
    const float r0 = __int_as_float(__builtin_amdgcn_readlane(__float_as_int(v), 0)), r1 = __int_as_float(__builtin_amdgcn_readlane(__float_as_int(v), 16));
    const float r2 = __int_as_float(__builtin_amdgcn_readlane(__float_as_int(v), 32)), r3 = __int_as_float(__builtin_amdgcn_readlane(__float_as_int(v), 48));
    return (r0 + r1) + (r2 + r3);
}

#define XB_TMO      128
#define XB_XCNT(j)  (256  + 64 * (j))
#define XB_XSUB(j)  (1280 + 64 * (j))
#define XB_XGEN(j)  (2304 + 64 * (j))
#define XB_TOP      3328
#define XB_TOPGEN   3392
#define XCD_BAR_WORDS 3456
#define XB_SPIN_CAP (1u << 18)

__device__ __forceinline__ unsigned xb_ld(unsigned* p)              { return __hip_atomic_load(p, __ATOMIC_RELAXED, __HIP_MEMORY_SCOPE_AGENT); }
__device__ __forceinline__ unsigned xb_add(unsigned* p, unsigned v) { return __hip_atomic_fetch_add(p, v, __ATOMIC_RELAXED, __HIP_MEMORY_SCOPE_AGENT); }
__device__ __forceinline__ unsigned xb_xcc_id() { return (unsigned)__builtin_amdgcn_s_getreg((3 << 11) | 20) & 0xFu; }
#define XB_SPIN(cond, bar) do { unsigned _sp = 0; while (cond) { __builtin_amdgcn_s_sleep(1); \
    if ((++_sp & 255u) == 0u) { if (xb_ld(&(bar)[XB_TMO])) break; if (_sp > XB_SPIN_CAP) { atomicAdd(&(bar)[XB_TMO], 1u); break; } } } } while (0)

struct XcdBarrier {
    unsigned* bar; unsigned x;
    volatile LAS unsigned* st;
};

__device__ __forceinline__ XcdBarrier xcd_barrier_post(unsigned* bar, volatile LAS unsigned* st) {
    XcdBarrier b; b.bar = bar; b.x = xb_xcc_id(); b.st = st;
    if (threadIdx.x == 0) (void)xb_add(&bar[XB_XCNT(b.x)], 1u);
    return b;
}
__device__ __forceinline__ void xcd_barrier_complete(unsigned* bar, unsigned x, unsigned& nloc, unsigned& nx, const unsigned G) {
    unsigned sum, cnt, mine, sp = 0u;
    for (;;) {
        sum = 0u; cnt = 0u; mine = 0u;
#pragma unroll
        for (unsigned j = 0; j < 16; ++j) { const unsigned c = xb_ld(&bar[XB_XCNT(j)]); sum += c; cnt += (c > 0u) ? 1u : 0u; mine = (j == x) ? c : mine; }
        if (sum == G) break;
        __builtin_amdgcn_s_sleep(1);
        if ((++sp & 255u) == 0u) { if (xb_ld(&bar[XB_TMO])) break; if (sp > XB_SPIN_CAP) { atomicAdd(&bar[XB_TMO], 1u); break; } }
    }
    nloc = mine > 0u ? mine : 1u; nx = cnt > 0u ? cnt : 1u;
}

__device__ __noinline__ void xcd_barrier_ni(unsigned* bar_, unsigned x_, unsigned st_off, bool leader_thread, unsigned G_) {
    XcdBarrier b; b.bar = bar_; b.x = x_; b.st = (volatile LAS unsigned*)(uintptr_t)st_off;
    asm volatile("s_waitcnt vmcnt(0)" ::: "memory");
    __syncthreads();
    if (leader_thread) {
        unsigned* bar = b.bar;
        __builtin_amdgcn_s_waitcnt(0);
        unsigned nloc = b.st[0], nx = b.st[1];
        if (nloc == 0u) { xcd_barrier_complete(bar, b.x, nloc, nx, G_); b.st[0] = nloc; b.st[1] = nx; }
        const unsigned old = xb_add(&bar[XB_XSUB(b.x)], 1u);
        const unsigned gen = old / nloc;
        if (old + 1u == (gen + 1u) * nloc) {
            __builtin_amdgcn_fence(__ATOMIC_RELEASE, "agent");
            asm volatile("s_waitcnt vmcnt(0)" ::: "memory");
            const unsigned og = xb_add(&bar[XB_TOP], 1u);
            const unsigned tg = og / nx;
            if (og + 1u == (tg + 1u) * nx) xb_add(&bar[XB_TOPGEN], 1u);
            else XB_SPIN(xb_ld(&bar[XB_TOPGEN]) == tg, bar);
            __builtin_amdgcn_fence(__ATOMIC_ACQUIRE, "agent");
            xb_add(&bar[XB_XGEN(b.x)], 1u);
            asm volatile("s_waitcnt vmcnt(0)" ::: "memory");
        } else {
            XB_SPIN(xb_ld(&bar[XB_XGEN(b.x)]) == gen, bar);
            __builtin_amdgcn_fence(__ATOMIC_ACQUIRE, "agent");
            asm volatile("s_waitcnt vmcnt(0)" ::: "memory");
        }
    }
    __syncthreads();
}
__device__ __forceinline__ void xcd_barrier(const XcdBarrier& b, bool leader_thread, unsigned G) { xcd_barrier_ni(b.bar, b.x, (unsigned)(uintptr_t)b.st, leader_thread, G); }

struct Frame {
    LAS unsigned char* lds;
    gu32* ctl;
    int tid, lane, wave, bid, G, vcu;
};
struct Job { const float* src; bf16* dst; const float* scale; int ldw, K, col0, nvalid, nblk, row0, item0, f8; float mul; int pad; };
constexpr int NJOBS = 16;
struct Args {
    const float* in[22]; float* out; unsigned char* ws; Job jobs[NJOBS];
    int njob_items, ph_lo, ph_hi, pad;
};
typedef const __attribute__((address_space(4))) Args* ArgsP;

struct TrItem { const float* src; const float* scale; bf16* dst; int ldw, k0, colbase, nvalid, perm, dstK, drow0, f8; float mul; };
__device__ __forceinline__ void tr_load(f32x4 (&v)[16], const TrItem& I, int lane, int wid) {
#pragma unroll
    for (int rr = 0; rr < 16; ++rr) {
        const int k = rr * 8 + wid, n = 4 * lane;
        const float* srow = I.src + (size_t)(I.k0 + k) * I.ldw + I.colbase;
        const int col = (I.perm && n >= 128) ? n + 896 : n;
        if (n + 3 < I.nvalid) v[rr] = __builtin_nontemporal_load((const f32x4*)(srow + col));
        else { f32x4 t; t[0] = (n < I.nvalid) ? srow[col] : 0.f; t[1] = (n + 1 < I.nvalid) ? srow[col + 1] : 0.f; t[2] = (n + 2 < I.nvalid) ? srow[col + 2] : 0.f; t[3] = 0.f; v[rr] = t; }
    }
}
__device__ __forceinline__ void tr_to_lds(const f32x4 (&v)[16], LAS float* scr, const TrItem& I, int lane, int wid) {
#pragma unroll
    for (int rr = 0; rr < 16; ++rr) {
        const int k = rr * 8 + wid;
        const float sc = I.scale ? I.scale[I.k0 + k] * I.mul : I.mul;
        *(LAS f32x4*)(scr + k * 256 + 4 * (lane ^ ((k >> 3) & 15))) = v[rr] * sc;
    }
}
__device__ __forceinline__ void tr_store(const LAS float* scr, const TrItem& I, int lane, int wid) {
#pragma unroll
    for (int q = 0; q < 8; ++q) {
        const int n = wid * 32 + q * 4 + (lane >> 4), a = lane & 15;
        const LAS float* s = scr + (8 * a) * 256 + 4 * ((n >> 2) ^ a) + (n & 3);
        if (I.f8) { u32x2 o; o.x = pg8::pk4_fp8(s[0], s[256], s[2 * 256], s[3 * 256]); o.y = pg8::pk4_fp8(s[4 * 256], s[5 * 256], s[6 * 256], s[7 * 256]);
            __builtin_nontemporal_store(o, (u32x2*)((unsigned char*)I.dst + (size_t)(I.drow0 + n) * I.dstK + I.k0 + 8 * a)); }
        else { u32x4 o; o.x = pk2(s[0], s[256]); o.y = pk2(s[2 * 256], s[3 * 256]); o.z = pk2(s[4 * 256], s[5 * 256]); o.w = pk2(s[6 * 256], s[7 * 256]);
            *(u32x4*)(I.dst + (size_t)(I.drow0 + n) * I.dstK + I.k0 + 8 * a) = o; }
    }
}
__device__ __forceinline__ void sincos_d(double x, float& c, float& s) {
    const double TWO_PI = 6.283185307179586476925, INV_2PI = 0.15915494309189533577;
    const double r = x - TWO_PI * rint(x * INV_2PI), r2 = r * r;
    double sn = 1.0, cs = 1.0;
#pragma unroll
    for (int k = 14; k >= 1; --k) { sn = 1.0 - sn * r2 / (double)((2 * k) * (2 * k + 1)); cs = 1.0 - cs * r2 / (double)((2 * k - 1) * (2 * k)); }
    s = (float)(sn * r); c = (float)cs;
}
constexpr int MOE_ITEMS = DEPTH * NEXP * 96, MOE_ITEMS_LAYER = NEXP * 96;
#ifndef MK_CVT_LAYERS_P0
#define MK_CVT_LAYERS_P0 4
#endif
__device__ __forceinline__ TrItem tr_decode(ArgsP A, unsigned char* ws, int it) {
    TrItem I;
    if (it < MOE_ITEMS) {
        const int le = it / 96, r = it % 96; I.scale = nullptr; I.nvalid = 256; I.dstK = 1024; I.f8 = 1;
        if (r < 64) { const int kb = r >> 3, nb = r & 7; I.src = A->in[16] + (size_t)le * (1024 * 2048); I.ldw = 2048; I.k0 = kb * 128; I.colbase = nb * 128; I.perm = 1;
            I.dst = (bf16*)(ws + WS_WGU + (size_t)le * (2048 * 1024)); I.drow0 = nb * 256; I.mul = 64.0f; }
        else { const int r2 = r - 64, kb = r2 >> 2, nb = r2 & 3; I.src = A->in[18] + (size_t)le * (1024 * 1024); I.ldw = 1024; I.k0 = kb * 128; I.colbase = nb * 256; I.perm = 0;
            I.dst = (bf16*)(ws + WS_WDN + (size_t)le * (1024 * 1024)); I.drow0 = nb * 256; I.mul = 128.0f; }
    } else {
        const int ji = it - MOE_ITEMS; int j = 0;
#pragma unroll
        for (int q = 1; q < NJOBS; ++q) j += (A->jobs[q].item0 <= ji) ? 1 : 0;
        const int K = A->jobs[j].K, r = ji - A->jobs[j].item0, nkb = K >> 7, kb = r % nkb, nb = r / nkb;
        int nv = A->jobs[j].nvalid - nb * 256; nv = nv < 0 ? 0 : (nv > 256 ? 256 : nv);
        I.src = A->jobs[j].src; I.scale = A->jobs[j].scale; I.dst = A->jobs[j].dst; I.ldw = A->jobs[j].ldw; I.k0 = kb * 128; I.colbase = A->jobs[j].col0 + nb * 256; I.nvalid = nv; I.perm = 0;
        I.dstK = K; I.drow0 = A->jobs[j].row0 + nb * 256; I.f8 = A->jobs[j].f8; I.mul = A->jobs[j].mul;
    }
    return I;
}
__device__ __forceinline__ void tr_run(Frame& F, ArgsP A, unsigned char* ws, int j0, int step, int j1, int split, int gap) {
    LAS float* scr = (LAS float*)(F.lds + RING_OFF);
#define TR_ITEM(jj) tr_decode(A, ws, (jj) < split ? (jj) : (jj) + gap)
    if (j0 < j1) {
        f32x4 vA[16], vB[16];
        TrItem ia = TR_ITEM(j0), ib = ia;
        tr_load(vA, ia, F.lane, F.wave);
        if (j0 + step < j1) { ib = TR_ITEM(j0 + step); tr_load(vB, ib, F.lane, F.wave); }
        for (int j = j0; j < j1; j += 2 * step) {
            tr_to_lds(vA, scr, ia, F.lane, F.wave);
            __syncthreads();
            const TrItem ca = ia;
            if (j + 2 * step < j1) { ia = TR_ITEM(j + 2 * step); tr_load(vA, ia, F.lane, F.wave); }
            tr_store(scr, ca, F.lane, F.wave);
            __syncthreads();
            if (j + step < j1) {
                tr_to_lds(vB, scr, ib, F.lane, F.wave);
                __syncthreads();
                const TrItem cb = ib;
                if (j + 3 * step < j1) { ib = TR_ITEM(j + 3 * step); tr_load(vB, ib, F.lane, F.wave); }
                tr_store(scr, cb, F.lane, F.wave);
                __syncthreads();
            }
        }
    }
#undef TR_ITEM
}
__device__ __forceinline__ void p0_prologue(Frame& F, ArgsP A, unsigned char* ws, const int part) {
    constexpr int NP0 = MK_CVT_LAYERS_P0 * MOE_ITEMS_LAYER;
    const int total = NP0 + A->njob_items;
    const int it_lo = (part == 1) ? NP0 : 0, it_hi = (part == 2) ? NP0 : total;
    tr_run(F, A, ws, it_lo + F.bid, F.G, it_hi, NP0, MOE_ITEMS - NP0);
    if (part == 2) return;
    const size_t gt = (size_t)F.bid * NTHREADS + F.tid, NT = (size_t)F.G * NTHREADS;
    { const float* x = A->in[0]; bf16* xb = (bf16*)(ws + WS_XB);
      for (size_t i = gt; i < (size_t)T * D / 8; i += 4 * NT) {
          f32x4 a[4], b[4];
#pragma unroll
          for (int k = 0; k < 4; ++k) if (i + k * NT < (size_t)T * D / 8) { a[k] = *(const f32x4*)(x + (i + k * NT) * 8); b[k] = *(const f32x4*)(x + (i + k * NT) * 8 + 4); }
#pragma unroll
          for (int k = 0; k < 4; ++k) if (i + k * NT < (size_t)T * D / 8) { u32x4 o; o.x = pk2(a[k][0], a[k][1]); o.y = pk2(a[k][2], a[k][3]); o.z = pk2(b[k][0], b[k][1]); o.w = pk2(b[k][2], b[k][3]); *(u32x4*)(xb + (i + k * NT) * 8) = o; } }
      const float* mm = A->in[1]; bf16* mb = (bf16*)(ws + WS_MEMB);
      for (size_t i = gt; i < (size_t)NB * MEML * D / 8; i += NT) { const f32x4 a = *(const f32x4*)(mm + i * 8), b = *(const f32x4*)(mm + i * 8 + 4);
          u32x4 o; o.x = pk2(a[0], a[1]); o.y = pk2(a[2], a[3]); o.z = pk2(b[0], b[1]); o.w = pk2(b[2], b[3]); *(u32x4*)(mb + i * 8) = o; } }
    { f32x2* rt = (f32x2*)(ws + WS_ROPE);
      for (size_t i = gt; i < (size_t)SEQ * 8; i += NT) { const int pos = (int)(i >> 3), k = (int)(i & 7);
          const double inv = k == 0 ? 1.0 : k == 1 ? 0.19392274474868576 : k == 2 ? 0.03760603093086393 : k == 3 ? 0.007292664737217109 : k == 4 ? 0.001414213562373095 : k == 5 ? 0.0002742481756762073 : k == 6 ? 5.318295896944988e-05 : 1.031338537721246e-05;
          float c, s; sincos_d((double)pos * inv, c, s); rt[i] = (f32x2){c, s}; } }
}

struct AttnP {
    const bf16* Q; const bf16* K; const bf16* V; bf16* O; const unsigned long long* mask;
    int ldq, ldk, ldv, ldo, qrow0, krow0, t_lo, t_hi, qpos0, mode, has_sink, o8; float sink2;
};
constexpr int AT_K0 = 0, AT_KSZ = 64 * 144, AT_V0 = 2 * AT_KSZ, AT_VSZ = 8192;
__device__ __forceinline__ s16x4 vtr(const LAS unsigned char* p) { return __builtin_bit_cast(s16x4, __builtin_amdgcn_ds_read_tr16_b64_v4i16((LAS v4i16_t*)p)); }
__device__ __forceinline__ void attn_unit(const Frame& F, const AttnP& P) {
    const int tid = F.tid, lane = F.lane, wid = F.wave, r32 = lane & 31, hi = lane >> 5;
    LAS unsigned char* lds = F.lds + RING_OFF;
    const int skey = tid >> 3, sc = tid & 7;
    const int kdst = skey * 144 + sc * 16;
    const int vdst = (sc >> 2) * 4096 + (skey >> 4) * 1024 + (skey & 15) * 64 + (sc & 3) * 16;
    const bf16* kg = P.K + (size_t)(P.krow0 + skey) * P.ldk + sc * 8;
    const bf16* vg = P.V + (size_t)(P.krow0 + skey) * P.ldv + sc * 8;
    const int qrow = P.qrow0 + wid * 32 + r32;
    bf16x8 qr[4];
#pragma unroll
    for (int d0 = 0; d0 < 4; ++d0) qr[d0] = *(const bf16x8*)(P.Q + (size_t)qrow * P.ldq + d0 * 16 + hi * 8);
    const int qmin = P.qpos0 + wid * 32, qmax = qmin + 31, qpos = qmin + r32;
    float m = P.has_sink ? P.sink2 : NEG_BIG;
    f32x16 o0 = {}, o1 = {}, lacc;
#pragma unroll
    for (int r = 0; r < 16; ++r) lacc[r] = P.has_sink ? 1.f : 0.f;
    const bf16x8 ones8 = (bf16x8){0x3f80, 0x3f80, 0x3f80, 0x3f80, 0x3f80, 0x3f80, 0x3f80, 0x3f80};
    const int vp0 = ((lane >> 4) & 1) * 32 + (lane & 3) * 8 + (4 * hi + ((lane & 15) >> 2)) * 64;
    u32x4 kreg = *(const u32x4*)(kg + (size_t)P.t_lo * 64 * P.ldk), vreg = *(const u32x4*)(vg + (size_t)P.t_lo * 64 * P.ldv);
    const unsigned long long* mrow = P.mode == 2 ? P.mask + (size_t)(wid * 32 + r32) * 64 : nullptr;
    unsigned long long mcur = 0ull, mnxt = P.mode == 2 ? mrow[P.t_lo] : 0ull;
    *(LAS u32x4*)(lds + AT_K0 + kdst) = kreg; *(LAS u32x4*)(lds + AT_V0 + vdst) = vreg;
    __syncthreads();
    for (int t = P.t_lo; t < P.t_hi; ++t) {
        const int cur = (t - P.t_lo) & 1;
        const bool more = (t + 1 < P.t_hi);
        mcur = mnxt;
        if (more) { kreg = *(const u32x4*)(kg + (size_t)(t + 1) * 64 * P.ldk); vreg = *(const u32x4*)(vg + (size_t)(t + 1) * 64 * P.ldv); if (P.mode == 2) mnxt = mrow[t + 1]; }
        bool active = true;
        if (P.mode == 1) active = (64 * t + 63 >= qmin - 127) && (64 * t <= qmax);
        if (P.mode == 2) active = (64 * t <= qmax);
        if (active) {
            const LAS unsigned char* Kb = lds + AT_K0 + cur * AT_KSZ; const LAS unsigned char* Vb = lds + AT_V0 + cur * AT_VSZ;
            f32x16 p0 = {}, p1 = {};
#pragma unroll
            for (int d0 = 0; d0 < 4; ++d0) {
                const bf16x8 a0 = *(const LAS bf16x8*)(Kb + r32 * 144 + (2 * d0 + hi) * 16);
                const bf16x8 a1 = *(const LAS bf16x8*)(Kb + (r32 + 32) * 144 + (2 * d0 + hi) * 16);
                p0 = __builtin_amdgcn_mfma_f32_32x32x16_bf16(a0, qr[d0], p0, 0, 0, 0);
                p1 = __builtin_amdgcn_mfma_f32_32x32x16_bf16(a1, qr[d0], p1, 0, 0, 0);
            }
            float mx = fmaxf(p0[0], p1[0]);
#pragma unroll
            for (int r = 1; r < 16; ++r) mx = fmaxf(fmaxf(mx, p0[r]), p1[r]);
            mx = swapmax(mx) * C2;
            const float mnew = fmaxf(m, mx), alpha = __builtin_amdgcn_exp2f(m - mnew);
            m = mnew;
#pragma unroll
            for (int r = 0; r < 16; r += 2) {
                f32x2 a_ = {p0[r], p0[r + 1]}, b_ = {p1[r], p1[r + 1]}; const f32x2 c2_ = {C2, C2}, nm_ = {-mnew, -mnew};
                a_ = __builtin_elementwise_fma(a_, c2_, nm_); b_ = __builtin_elementwise_fma(b_, c2_, nm_);
                p0[r] = __builtin_amdgcn_exp2f(a_[0]); p0[r + 1] = __builtin_amdgcn_exp2f(a_[1]); p1[r] = __builtin_amdgcn_exp2f(b_[0]); p1[r + 1] = __builtin_amdgcn_exp2f(b_[1]); }
            if (P.mode == 1) {
                const int rel = qpos - 64 * t - 4 * hi;
#pragma unroll
                for (int r = 0; r < 16; ++r) { const int c = (r & 3) + 8 * (r >> 2);
                    p0[r] = ((unsigned)(rel - c) < 128u) ? p0[r] : 0.f; p1[r] = ((unsigned)(rel - c - 32) < 128u) ? p1[r] : 0.f; }
            } else if (P.mode == 2) {
                const unsigned long long w = mcur >> (4 * hi);
                const int wl = (int)(unsigned)w, wh = (int)(unsigned)(w >> 32);
#pragma unroll
                for (int r = 0; r < 16; ++r) { const int c = (r & 3) + 8 * (r >> 2);
                    int d0_ = __builtin_amdgcn_sbfe(wl, c, 1), d1_ = __builtin_amdgcn_sbfe(wh, c, 1); asm("" : "+v"(d0_), "+v"(d1_));
                    p0[r] = __uint_as_float(__float_as_uint(p0[r]) & (unsigned)d0_); p1[r] = __uint_as_float(__float_as_uint(p1[r]) & (unsigned)d1_); }
            }
            if (__any(alpha != 1.0f)) {
#pragma unroll
                for (int r = 0; r < 16; ++r) { o0[r] *= alpha; o1[r] *= alpha; lacc[r] *= alpha; }
            }
            bf16x8 pf[4];
            { u32x4 w;
              w.x = pk2(p0[0], p0[1]); w.y = pk2(p0[2], p0[3]); w.z = pk2(p0[4], p0[5]); w.w = pk2(p0[6], p0[7]); pf[0] = __builtin_bit_cast(bf16x8, w);
              w.x = pk2(p0[8], p0[9]); w.y = pk2(p0[10], p0[11]); w.z = pk2(p0[12], p0[13]); w.w = pk2(p0[14], p0[15]); pf[1] = __builtin_bit_cast(bf16x8, w);
              w.x = pk2(p1[0], p1[1]); w.y = pk2(p1[2], p1[3]); w.z = pk2(p1[4], p1[5]); w.w = pk2(p1[6], p1[7]); pf[2] = __builtin_bit_cast(bf16x8, w);
              w.x = pk2(p1[8], p1[9]); w.y = pk2(p1[10], p1[11]); w.z = pk2(p1[12], p1[13]); w.w = pk2(p1[14], p1[15]); pf[3] = __builtin_bit_cast(bf16x8, w); }
#pragma unroll
            for (int ks = 0; ks < 4; ++ks) {
                const s16x4 a_lo = vtr(Vb + vp0 + ks * 1024), a_hi = vtr(Vb + vp0 + ks * 1024 + 512);
                const s16x4 b_lo = vtr(Vb + vp0 + 4096 + ks * 1024), b_hi = vtr(Vb + vp0 + 4096 + ks * 1024 + 512);
                const bf16x8 va = (bf16x8){a_lo[0], a_lo[1], a_lo[2], a_lo[3], a_hi[0], a_hi[1], a_hi[2], a_hi[3]};
                const bf16x8 vb = (bf16x8){b_lo[0], b_lo[1], b_lo[2], b_lo[3], b_hi[0], b_hi[1], b_hi[2], b_hi[3]};
                o0 = __builtin_amdgcn_mfma_f32_32x32x16_bf16(va, pf[ks], o0, 0, 0, 0);
                o1 = __builtin_amdgcn_mfma_f32_32x32x16_bf16(vb, pf[ks], o1, 0, 0, 0);
                lacc = __builtin_amdgcn_mfma_f32_32x32x16_bf16(ones8, pf[ks], lacc, 0, 0, 0);
            }
        }
        if (more) { *(LAS u32x4*)(lds + AT_K0 + (cur ^ 1) * AT_KSZ + kdst) = kreg; *(LAS u32x4*)(lds + AT_V0 + (cur ^ 1) * AT_VSZ + vdst) = vreg; }
        __syncthreads();
    }
    const float inv = 1.0f / lacc[0];
    if (P.o8) {
        unsigned char* orow8 = (unsigned char*)P.O + (size_t)qrow * P.ldo + 4 * hi;
#pragma unroll
        for (int g = 0; g < 4; ++g) {
            *(unsigned*)(orow8 + 8 * g) = pg8::pk4_fp8(o0[4 * g] * inv, o0[4 * g + 1] * inv, o0[4 * g + 2] * inv, o0[4 * g + 3] * inv);
            *(unsigned*)(orow8 + 32 + 8 * g) = pg8::pk4_fp8(o1[4 * g] * inv, o1[4 * g + 1] * inv, o1[4 * g + 2] * inv, o1[4 * g + 3] * inv);
        }
        return;
    }
    bf16* orow = P.O + (size_t)qrow * P.ldo + 4 * hi;
#pragma unroll
    for (int g = 0; g < 4; ++g) {
        u32x2 w0, w1;
        w0.x = pk2(o0[4 * g] * inv, o0[4 * g + 1] * inv); w0.y = pk2(o0[4 * g + 2] * inv, o0[4 * g + 3] * inv);
        w1.x = pk2(o1[4 * g] * inv, o1[4 * g + 1] * inv); w1.y = pk2(o1[4 * g + 2] * inv, o1[4 * g + 3] * inv);
        *(u32x2*)(orow + 8 * g) = w0; *(u32x2*)(orow + 32 + 8 * g) = w1;
    }
}

__device__ __forceinline__ void conv_item(const bf16* PROJ, const float* cw, bf16* CAT, int idx) {
    const int chunk = idx % 96, run = idx / 96, c0 = chunk * 8, t0 = run * 16;
    float w0[8], w1[8], w2[8];
#pragma unroll
    for (int j = 0; j < 8; ++j) { w0[j] = cw[c0 + j]; w1[j] = cw[768 + c0 + j]; w2[j] = cw[1536 + c0 + j]; }
    float z1[8], z2[8];
#pragma unroll
    for (int j = 0; j < 8; ++j) { z1[j] = 0.f; z2[j] = 0.f; }
    if ((t0 & (SEQ - 1)) != 0) {
#pragma unroll
        for (int back = 2; back >= 1; --back) {
            const bf16* row = PROJ + (size_t)(t0 - back) * 2560;
            const u32x4 uu = *(const u32x4*)(row + c0), cc = *(const u32x4*)(row + 1536 + c0);
            float z[8];
            z[0] = bflo(uu.x) * bflo(cc.x); z[1] = bfhi(uu.x) * bfhi(cc.x); z[2] = bflo(uu.y) * bflo(cc.y); z[3] = bfhi(uu.y) * bfhi(cc.y);
            z[4] = bflo(uu.z) * bflo(cc.z); z[5] = bfhi(uu.z) * bfhi(cc.z); z[6] = bflo(uu.w) * bflo(cc.w); z[7] = bfhi(uu.w) * bfhi(cc.w);
#pragma unroll
            for (int j = 0; j < 8; ++j) { if (back == 2) z2[j] = z[j]; else z1[j] = z[j]; }
        }
    }
    u32x4 in_[2][4][3];
#define CONV_LOADG(G, S) do { _Pragma("unroll") for (int k = 0; k < 4; ++k) { const bf16* row = PROJ + (size_t)(t0 + 4 * (G) + k) * 2560; \
        in_[S][k][0] = *(const u32x4*)(row + c0); in_[S][k][1] = *(const u32x4*)(row + 768 + c0); in_[S][k][2] = *(const u32x4*)(row + 1536 + c0); } } while (0)
    CONV_LOADG(0, 0);
#pragma unroll
    for (int g = 0; g < 4; ++g) {
        if (g < 3) CONV_LOADG(g + 1, (g + 1) & 1);
#pragma unroll
        for (int k = 0; k < 4; ++k) {
            const int i = 4 * g + k;
            const u32x4 uu = in_[g & 1][k][0], bb = in_[g & 1][k][1], cc = in_[g & 1][k][2];
            float z[8], b[8], r[8];
            z[0] = bflo(uu.x) * bflo(cc.x); z[1] = bfhi(uu.x) * bfhi(cc.x); z[2] = bflo(uu.y) * bflo(cc.y); z[3] = bfhi(uu.y) * bfhi(cc.y);
            z[4] = bflo(uu.z) * bflo(cc.z); z[5] = bfhi(uu.z) * bfhi(cc.z); z[6] = bflo(uu.w) * bflo(cc.w); z[7] = bfhi(uu.w) * bfhi(cc.w);
            b[0] = bflo(bb.x); b[1] = bfhi(bb.x); b[2] = bflo(bb.y); b[3] = bfhi(bb.y); b[4] = bflo(bb.z); b[5] = bfhi(bb.z); b[6] = bflo(bb.w); b[7] = bfhi(bb.w);
#pragma unroll
            for (int j = 0; j < 8; ++j) { r[j] = b[j] * ((w0[j] * z2[j] + w1[j] * z1[j]) + w2[j] * z[j]); z2[j] = z1[j]; z1[j] = z[j]; }
            u32x4 o; o.x = pk2(r[0], r[1]); o.y = pk2(r[2], r[3]); o.z = pk2(r[4], r[5]); o.w = pk2(r[6], r[7]);
            (void)o; u32x2 o8_; o8_.x = pg8::pk4_fp8(r[0], r[1], r[2], r[3]); o8_.y = pg8::pk4_fp8(r[4], r[5], r[6], r[7]); *(u32x2*)((unsigned char*)CAT + (size_t)(t0 + i) * 1024 + c0) = o8_;
        }
    }
#undef CONV_LOADG
}

__device__ __forceinline__ void mixer_phase(Frame& F, ArgsP A, unsigned char* ws, int layer, int kind, int qidx) {
    const bf16* PROJ = (const bf16*)(ws + WS_PROJ); bf16* CAT = (bf16*)(ws + WS_CAT); const bf16* KVM = (const bf16*)(ws + WS_KVMEM) + layer * 512;
    const int nproj = kind == 0 ? 2560 : (kind == 1 ? 1280 : 1536), qm_off = kind == 0 ? 2304 : (kind == 1 ? 768 : 1280);
    const int n_main = kind == 0 ? 0 : 768, n_mem = 256, n_conv = kind == 0 ? 192 : 0;
    constexpr int CVT_PER = 12, N_CVT = (DEPTH - MK_CVT_LAYERS_P0) * MOE_ITEMS_LAYER / CVT_PER;
    const int n_cvt = (kind == 1) ? N_CVT : 0;
    const int total = n_main + n_mem + n_conv + n_cvt;
    volatile LAS unsigned* qw = (volatile LAS unsigned*)(F.lds + L_Q);
    for (;;) {
        if (F.tid == 0) *qw = __hip_atomic_fetch_add(F.ctl + CW_QHEAD + 64 * qidx, 1u, RLX_AGENT);
        __syncthreads();
        int u = (int)*qw;
        __syncthreads();
        if (u >= total) break;
        if (n_cvt) {
            if (u < 3 * n_cvt) { if (u % 3 == 2) { const int c = u / 3; tr_run(F, A, ws, MK_CVT_LAYERS_P0 * MOE_ITEMS_LAYER + c * CVT_PER, 1, MK_CVT_LAYERS_P0 * MOE_ITEMS_LAYER + c * CVT_PER + CVT_PER, MOE_ITEMS, 0); continue; } u = (u / 3) * 2 + u % 3; }
            else u -= n_cvt;
        }
        if (u < n_main) {
            AttnP P;
            if (kind == 1) {
                const int qt = 15 - u / 48, rem = u % 48, b = rem / 12, h = rem % 12, g = h / 3;
                P.Q = (const bf16*)(ws + WS_QQ) + h * 64; P.ldq = 1280; P.K = PROJ + 256 + g * 64; P.ldk = 1280; P.V = PROJ + 512 + g * 64; P.ldv = 1280;
                P.O = (bf16*)((unsigned char*)CAT + h * 64); P.ldo = 1024; P.o8 = 1; P.qrow0 = b * SEQ + qt * 256; P.krow0 = b * SEQ; P.t_lo = 0; P.t_hi = qt * 4 + 4; P.qpos0 = qt * 256; P.mode = 2;
                P.mask = (const unsigned long long*)(ws + WS_MASK) + (size_t)P.qrow0 * 64; P.has_sink = 0; P.sink2 = 0.f;
            } else {
                const int b = u / 192, h = (u / 16) % 12, qt = u % 16, g = h / 3;
                P.Q = PROJ + h * 64; P.ldq = 1536; P.K = PROJ + 768 + g * 64; P.ldk = 1536; P.V = PROJ + 1024 + g * 64; P.ldv = 1536;
                P.O = (bf16*)((unsigned char*)CAT + h * 64); P.ldo = 1024; P.o8 = 1; P.qrow0 = b * SEQ + qt * 256; P.krow0 = b * SEQ; P.qpos0 = qt * 256;
                P.t_lo = qt == 0 ? 0 : (qt * 256 - 128) / 64; P.t_hi = qt * 4 + 4; P.mode = 1; P.mask = nullptr; P.has_sink = 1; P.sink2 = A->in[9][h] * LOG2E;
            }
            attn_unit(F, P);
        } else if (u < n_main + n_mem) {
            const int v = u - n_main, b = v / 64, h = (v / 16) % 4, qt = v % 16;
            AttnP P;
            P.Q = PROJ + qm_off + h * 64; P.ldq = nproj; P.K = KVM + h * 64; P.ldk = 2048; P.V = KVM + 256 + h * 64; P.ldv = 2048;
            P.o8 = 1; P.O = P.o8 ? (bf16*)((unsigned char*)CAT + 768 + h * 64) : CAT + 768 + h * 64; P.ldo = 1024; P.qrow0 = b * SEQ + qt * 256; P.krow0 = b * MEML; P.t_lo = 0; P.t_hi = 4; P.qpos0 = qt * 256; P.mode = 0; P.mask = nullptr; P.has_sink = 0; P.sink2 = 0.f;
            attn_unit(F, P);
        } else {
            const int v = u - n_main - n_mem;
            conv_item(PROJ, A->in[3] + (size_t)(layer == 0 ? 0 : 1) * 3 * 768, CAT, v * NTHREADS + F.tid);
        }
    }
}

__device__ __forceinline__ void score_phase(Frame& F, const bf16* QQ, const bf16* PROJ, float* SC) {
    const int lane = F.lane, r32 = lane & 31, hi = lane >> 5;
    LAS float* wtab = (LAS float*)(F.lds + RING_OFF + F.wave * 1024);
    constexpr float WSCALE = 0.04419417382415922f;
    constexpr int PER_B = 576;
    const __amdgpu_buffer_rsrc_t scrs = __builtin_amdgcn_make_buffer_rsrc((void*)SC, 0, T * SEQ * 4, 0x00020000);
    for (int wu = F.bid * NWAVES + F.wave; wu < NB * PER_B; wu += F.G * NWAVES) {
        const int b = wu / PER_B, idx = PER_B - 1 - wu % PER_B;
        int g = 0;
        for (int k = 1; k < 8; ++k) g += (8 * k * (k + 1) <= idx) ? 1 : 0;
        const int r = idx - 8 * g * (g + 1), qb = 16 * g + r / (g + 1), c = r % (g + 1);
        const int kb_lo = 16 * c, kb_hi = (16 * c + 16 < qb + 1) ? 16 * c + 16 : qb + 1;
        const int t0 = b * SEQ + 32 * qb;
#pragma unroll
        for (int k = 0; k < 4; ++k) { const int i4 = lane * 4 + k, h = i4 >> 5, hh = (i4 >> 4) & 1, reg = i4 & 15;
            wtab[i4] = bf2f(PROJ[(size_t)(t0 + crow(reg, hh)) * 1280 + 1088 + h]) * WSCALE; }
        bf16x8 qA[8][4];
#pragma unroll
        for (int h = 0; h < 8; ++h)
#pragma unroll
            for (int st = 0; st < 4; ++st) qA[h][st] = *(const bf16x8*)(QQ + (size_t)(t0 + r32) * 1280 + 768 + h * 64 + st * 16 + hi * 8);
        const bf16* kbase = PROJ + (size_t)(b * SEQ + r32) * 1280 + 1024 + hi * 8;
        bf16x8 kA[4], kBf[4];
#pragma unroll
        for (int st = 0; st < 4; ++st) kA[st] = *(const bf16x8*)(kbase + (size_t)(32 * kb_lo) * 1280 + st * 16);
#define PS_BLOCK(KF, KB) do { f32x16 acc = {}; \
            _Pragma("unroll") for (int h = 0; h < 8; ++h) { f32x16 dd = {}; \
                _Pragma("unroll") for (int st = 0; st < 4; ++st) dd = __builtin_amdgcn_mfma_f32_32x32x16_bf16(qA[h][st], KF[st], dd, 0, 0, 0); \
                const LAS f32x4* wp = (const LAS f32x4*)(wtab + (h * 2 + hi) * 16); const f32x4 w0 = wp[0], w1 = wp[1], w2 = wp[2], w3 = wp[3]; \
                _Pragma("unroll") for (int q = 0; q < 4; ++q) { acc[q] = fmaf(w0[q], fmaxf(dd[q], 0.f), acc[q]); acc[4 + q] = fmaf(w1[q], fmaxf(dd[4 + q], 0.f), acc[4 + q]); \
                    acc[8 + q] = fmaf(w2[q], fmaxf(dd[8 + q], 0.f), acc[8 + q]); acc[12 + q] = fmaf(w3[q], fmaxf(dd[12 + q], 0.f), acc[12 + q]); } \
                if (h & 1) __builtin_amdgcn_sched_barrier(0); } \
            _Pragma("unroll") for (int reg = 0; reg < 16; ++reg) __builtin_amdgcn_raw_buffer_store_b32(__float_as_uint(acc[reg]), scrs, (4 * hi * SEQ + r32) * 4, ((t0 + (reg & 3) + 8 * (reg >> 2)) * SEQ + 32 * (KB)) * 4, 0); } while (0)
        for (int kb = kb_lo; kb < kb_hi; kb += 2) {
            __builtin_amdgcn_sched_barrier(0);
            if (kb + 1 < kb_hi) {
#pragma unroll
                for (int st = 0; st < 4; ++st) kBf[st] = *(const bf16x8*)(kbase + (size_t)(32 * (kb + 1)) * 1280 + st * 16);
            }
            __builtin_amdgcn_sched_barrier(0);
            PS_BLOCK(kA, kb);
            __builtin_amdgcn_sched_barrier(0);
            if (kb + 1 < kb_hi) {
                if (kb + 2 < kb_hi) {
#pragma unroll
                    for (int st = 0; st < 4; ++st) kA[st] = *(const bf16x8*)(kbase + (size_t)(32 * (kb + 2)) * 1280 + st * 16);
                }
                __builtin_amdgcn_sched_barrier(0);
                PS_BLOCK(kBf, kb + 1);
            }
        }
#undef PS_BLOCK
    }
}
__device__ __forceinline__ void select_phase(Frame& F, const float* SC, unsigned long long* MASK) {
    const int qstride = F.G * NWAVES;
    unsigned raw[64];
#define SEL_LOAD(qq) do { const int pos_ = (qq) & (SEQ - 1); if ((qq) < T && pos_ >= 256) { int ln_ = lane_id_now(); const int ni_ = (pos_ >> 6) + 1; const float* row_ = SC + (size_t)(qq) * SEQ; \
        _Pragma("unroll") for (int gq = 0; gq < 4; ++gq) if (ni_ > 16 * gq) { _Pragma("unroll") for (int i = 16 * gq; i < 16 * gq + 16; ++i) { const int s_ = 64 * i + ln_; raw[i] = __float_as_uint(row_[s_ <= pos_ ? s_ : pos_]); } } } } while (0)
    int q0_ = F.bid * NWAVES + F.wave;
    SEL_LOAD(q0_);
    for (int q = q0_; q < T; q += qstride) {
        int lane = F.lane; asm volatile("" : "+v"(lane));
        const int pos = q & (SEQ - 1);
        unsigned long long myword = 0ull;
        if (pos < 256) {
            const int lo = 64 * lane;
            myword = (lo > pos) ? 0ull : ((pos - lo >= 63) ? ~0ull : ((1ull << (pos - lo + 1)) - 1ull));
            SEL_LOAD(q + qstride);
        } else {
            const int ni = (pos >> 6) + 1;
            unsigned key[64];
#pragma unroll
            for (int i = 0; i < 64; ++i) key[i] = 0u;
#pragma unroll
            for (int gq = 0; gq < 4; ++gq) if (ni > 16 * gq) {
#pragma unroll
                for (int i = 16 * gq; i < 16 * gq + 16; ++i) { const int s = 64 * i + lane; unsigned bts = raw[i]; if (bts == 0x80000000u) bts = 0u;
                    const unsigned kk = (bts & 0x80000000u) ? ~bts : (bts | 0x80000000u); key[i] = (s <= pos) ? kk : 0u; } }
            SEL_LOAD(q + qstride);
            auto count_ge = [&](const unsigned Tp) -> int {
                int cA = 0, cB = 0, cC = 0, cD = 0;
#pragma unroll
                for (int gq = 0; gq < 4; ++gq) if (ni > 16 * gq) {
                    unsigned long long m0_, m1_, m2_, m3_;
                    asm("v_cmp_le_u32_e64 %4, %8, %9\n\tv_cmp_le_u32_e64 %5, %8, %10\n\tv_cmp_le_u32_e64 %6, %8, %11\n\tv_cmp_le_u32_e64 %7, %8, %12\n\tv_addc_co_u32_e64 %0, %4, 0, %0, %4\n\tv_addc_co_u32_e64 %1, %5, 0, %1, %5\n\tv_addc_co_u32_e64 %2, %6, 0, %2, %6\n\tv_addc_co_u32_e64 %3, %7, 0, %3, %7\n\tv_cmp_le_u32_e64 %4, %8, %13\n\tv_cmp_le_u32_e64 %5, %8, %14\n\tv_cmp_le_u32_e64 %6, %8, %15\n\tv_cmp_le_u32_e64 %7, %8, %16\n\tv_addc_co_u32_e64 %0, %4, 0, %0, %4\n\tv_addc_co_u32_e64 %1, %5, 0, %1, %5\n\tv_addc_co_u32_e64 %2, %6, 0, %2, %6\n\tv_addc_co_u32_e64 %3, %7, 0, %3, %7\n\tv_cmp_le_u32_e64 %4, %8, %17\n\tv_cmp_le_u32_e64 %5, %8, %18\n\tv_cmp_le_u32_e64 %6, %8, %19\n\tv_cmp_le_u32_e64 %7, %8, %20\n\tv_addc_co_u32_e64 %0, %4, 0, %0, %4\n\tv_addc_co_u32_e64 %1, %5, 0, %1, %5\n\tv_addc_co_u32_e64 %2, %6, 0, %2, %6\n\tv_addc_co_u32_e64 %3, %7, 0, %3, %7\n\tv_cmp_le_u32_e64 %4, %8, %21\n\tv_cmp_le_u32_e64 %5, %8, %22\n\tv_cmp_le_u32_e64 %6, %8, %23\n\tv_cmp_le_u32_e64 %7, %8, %24\n\tv_addc_co_u32_e64 %0, %4, 0, %0, %4\n\tv_addc_co_u32_e64 %1, %5, 0, %1, %5\n\tv_addc_co_u32_e64 %2, %6, 0, %2, %6\n\tv_addc_co_u32_e64 %3, %7, 0, %3, %7"
                        : "+v"(cA), "+v"(cB), "+v"(cC), "+v"(cD), "=&s"(m0_), "=&s"(m1_), "=&s"(m2_), "=&s"(m3_) : "s"(Tp), "v"(key[16 * gq + 0]), "v"(key[16 * gq + 1]), "v"(key[16 * gq + 2]), "v"(key[16 * gq + 3]), "v"(key[16 * gq + 4]), "v"(key[16 * gq + 5]), "v"(key[16 * gq + 6]), "v"(key[16 * gq + 7]), "v"(key[16 * gq + 8]), "v"(key[16 * gq + 9]), "v"(key[16 * gq + 10]), "v"(key[16 * gq + 11]), "v"(key[16 * gq + 12]), "v"(key[16 * gq + 13]), "v"(key[16 * gq + 14]), "v"(key[16 * gq + 15])); }
                const int cl = (cA + cB) + (cC + cD);
                int c = 0;
#pragma unroll
                for (int bb = 0; bb < 7; ++bb) c += __popcll(__ballot((cl >> bb) & 1)) << bb;
                return c; };
            unsigned kmx = 0u;
#pragma unroll
            for (int i = 0; i < 64; ++i) kmx = key[i] > kmx ? key[i] : kmx;
#pragma unroll
            for (int o = 1; o < 64; o <<= 1) { const unsigned ov = (unsigned)shxi((int)kmx, o); kmx = ov > kmx ? ov : kmx; }
            kmx = (unsigned)__builtin_amdgcn_readfirstlane((int)kmx);
            unsigned lo = 0u, hi = kmx + 1u; int clo = pos + 1, chi = 0;
            if (kmx > 0x82000000u) { const unsigned l2 = (kmx & 0xff800000u) - 0x02000000u; const int c2 = count_ge(l2); if (c2 >= 256) { lo = l2; clo = c2; } else { hi = l2; chi = c2; } }
            float flo = (float)clo - 255.5f, fhi = (float)chi - 255.5f; int side = 0;
            for (int it = 0; it < 96; ++it) {
                if (clo == 256 || hi - lo <= 1u) break;
                const unsigned span = hi - lo;
                unsigned mid;
                if (it % 3 == 2) mid = lo + (span >> 1);
                else { const float tt = flo / (flo - fhi); unsigned d = (unsigned)((float)span * tt); d = d < 1u ? 1u : (d > span - 1u ? span - 1u : d); mid = lo + d; }
                mid = (unsigned)__builtin_amdgcn_readfirstlane((int)mid);
                const int c = count_ge(mid);
                if (c >= 256) { lo = mid; clo = c; flo = (float)c - 255.5f; if (side == 1) fhi *= 0.5f; side = 1; }
                else { hi = mid; chi = c; fhi = (float)c - 255.5f; if (side == -1) flo *= 0.5f; side = -1; }
            }
            const unsigned Tk = lo; const int cT = clo;
            int need = 256, base = 0;
            if (cT != 256) {
                int cl = 0;
#pragma unroll
                for (int i = 0; i < 64; ++i) cl += (key[i] > Tk) ? 1 : 0;
                int cgt = 0;
#pragma unroll
                for (int bb = 0; bb < 7; ++bb) cgt += __popcll(__ballot((cl >> bb) & 1)) << bb;
                need = 256 - cgt;
            }
            int wlo = 0, whi = 0;
            if (cT == 256) {
#pragma unroll
                for (int i = 0; i < 64; ++i) { const unsigned long long wsel = __ballot(key[i] >= Tk);
                    asm("s_nop 4\n\tv_writelane_b32 %0, %2, %4\n\tv_writelane_b32 %1, %3, %4" : "+v"(wlo), "+v"(whi) : "s"((int)(unsigned)wsel), "s"((int)(unsigned)(wsel >> 32)), "n"(i)); }
            } else {
                const unsigned long long ltmask = (1ull << lane) - 1ull;
#pragma unroll
                for (int i = 0; i < 64; ++i) {
                    const unsigned long long eq = __ballot(key[i] == Tk); const int rank = base + __popcll(eq & ltmask);
                    const bool sel = (key[i] > Tk) || (key[i] == Tk && rank < need); base += __popcll(eq);
                    const unsigned long long wsel = __ballot(sel);
                    asm("s_nop 4\n\tv_writelane_b32 %0, %2, %4\n\tv_writelane_b32 %1, %3, %4" : "+v"(wlo), "+v"(whi) : "s"((int)(unsigned)wsel), "s"((int)(unsigned)(wsel >> 32)), "n"(i));
                }
            }
            myword = ((unsigned long long)(unsigned)whi << 32) | (unsigned long long)(unsigned)wlo;
        }
        MASK[(size_t)q * 64 + lane] = myword;
    }
}

#undef SEL_LOAD
__device__ __forceinline__ void ln1_phase(Frame& F, const bf16* xres, const bf16* Y, const float* g1, const float* b1, bf16* XMB, const float* rw, const float* rb,
                                          bf16* XP, gu32* gcount, int* ROWS, float* GATES, const int pmode = 3) {
    const int lane = F.lane, wid = F.wave, tid = F.tid;
    float ALPHA_ = ALPHA; asm volatile("" : "+v"(ALPHA_));
    LAS float* x32 = (LAS float*)(F.lds + RING_OFF);
    volatile LAS unsigned* cnt = (volatile LAS unsigned*)(F.lds + L_CNT); volatile LAS unsigned* base = (volatile LAS unsigned*)(F.lds + L_BASE);
    LAS int* route = (LAS int*)(F.lds + L_ROUTE);
    const int e = lane & 31, half = lane >> 5;
    const float rbe = rb[e];
    const __amdgpu_buffer_rsrc_t xrs_ = __builtin_amdgcn_make_buffer_rsrc((void*)xres, 0, T * D * 2, 0x00020000), yrs_ = __builtin_amdgcn_make_buffer_rsrc((void*)Y, 0, T * D * 2, 0x00020000);
    for (int chunk = F.bid; chunk < T / 64; chunk += F.G) {
        if (tid < 32) cnt[tid] = 0u;
        __syncthreads();
        u32x2 rxn[4][4], ryn[4][4];
#define LN1_LOAD(B) do { _Pragma("unroll") for (int rr = 0; rr < 4; ++rr) { const int ro_ = (chunk * 64 + wid * 8 + (B) * 4 + rr) * (D * 2);       \
            _Pragma("unroll") for (int j = 0; j < 4; ++j) { rxn[rr][j] = __builtin_bit_cast(u32x2, __builtin_amdgcn_raw_buffer_load_b64(xrs_, lane * 8, ro_ + 512 * j, 0)); ryn[rr][j] = __builtin_bit_cast(u32x2, __builtin_amdgcn_raw_buffer_load_b64(yrs_, lane * 8, ro_ + 512 * j, 0)); } } } while (0)
        LN1_LOAD(0);
#pragma unroll 1
        for (int batch = 0; batch < 2; ++batch) {
            const int lrow0 = wid * 8 + batch * 4, row0 = chunk * 64 + lrow0;
            u32x2 rx[4][4], ry[4][4];
#pragma unroll
            for (int rr = 0; rr < 4; ++rr)
#pragma unroll
                for (int j = 0; j < 4; ++j) { rx[rr][j] = rxn[rr][j]; ry[rr][j] = ryn[rr][j]; }
            if (batch == 0) LN1_LOAD(1);
            float xv[4][16], mean_[4], rstd_[4];
#pragma unroll
            for (int rr = 0; rr < 4; ++rr) { float s = 0.f;
#pragma unroll
                for (int j = 0; j < 4; ++j) { const u32x2 xx = rx[rr][j], yy = ry[rr][j];
                    xv[rr][4 * j] = ALPHA_ * bflo(xx.x) + bflo(yy.x); xv[rr][4 * j + 1] = ALPHA_ * bfhi(xx.x) + bfhi(yy.x); xv[rr][4 * j + 2] = ALPHA_ * bflo(xx.y) + bflo(yy.y); xv[rr][4 * j + 3] = ALPHA_ * bfhi(xx.y) + bfhi(yy.y);
                    s += (xv[rr][4 * j] + xv[rr][4 * j + 1]) + (xv[rr][4 * j + 2] + xv[rr][4 * j + 3]); }
                mean_[rr] = s; }
#pragma unroll
            for (int rr = 0; rr < 4; ++rr) mean_[rr] = wave_sum(mean_[rr]);
#pragma unroll
            for (int rr = 0; rr < 4; ++rr) { mean_[rr] *= (1.f / D); float s2 = 0.f;
#pragma unroll
                for (int k = 0; k < 16; ++k) { xv[rr][k] -= mean_[rr]; s2 += xv[rr][k] * xv[rr][k]; }
                rstd_[rr] = s2; }
            __builtin_amdgcn_sched_barrier(0);
            f32x4 gg_[4], bb_[4];
#pragma unroll
            for (int j = 0; j < 4; ++j) { gg_[j] = __builtin_bit_cast(f32x4, __builtin_amdgcn_raw_buffer_load_b128(__builtin_amdgcn_make_buffer_rsrc((void*)g1, 0, D * 4, 0x00020000), lane * 16, j * 1024, 0)); bb_[j] = __builtin_bit_cast(f32x4, __builtin_amdgcn_raw_buffer_load_b128(__builtin_amdgcn_make_buffer_rsrc((void*)b1, 0, D * 4, 0x00020000), lane * 16, j * 1024, 0)); }
            __builtin_amdgcn_sched_barrier(0);
#pragma unroll
            for (int rr = 0; rr < 4; ++rr) rstd_[rr] = wave_sum(rstd_[rr]);
#pragma unroll
            for (int rr = 0; rr < 4; ++rr) { const float rstd = 1.0f / sqrtf(rstd_[rr] * (1.f / D) + LN_EPS);
#pragma unroll
                for (int j = 0; j < 4; ++j) { const f32x4 gg = gg_[j], bb = bb_[j];
                    f32x4 o;
#pragma unroll
                    for (int k = 0; k < 4; ++k) o[k] = xv[rr][4 * j + k] * rstd * gg[k] + bb[k];
                    u32x2 pb; pb.x = pk2(o[0], o[1]); pb.y = pk2(o[2], o[3]);
                    *(u32x2*)(XMB + (size_t)(row0 + rr) * D + 4 * lane + 256 * j) = pb;
                    *(LAS f32x4*)(x32 + (wid * 4 + rr) * 1028 + 4 * lane + 256 * j) = o; } }
            float a0 = 0.f, a1 = 0.f, a2 = 0.f, a3 = 0.f;
            float wA[32], wB[32];
            const __amdgpu_buffer_rsrc_t wrs = __builtin_amdgcn_make_buffer_rsrc((void*)rw, 0, D * NEXP * 4, 0x00020000);
            const int wvo = ((wid * 128 + half * 4) * 32 + e) * 4;
            __builtin_amdgcn_sched_barrier(0);
            if (pmode & 1) {
#pragma unroll
                for (int i = 0; i < 8; ++i)
#pragma unroll
                    for (int t = 0; t < 4; ++t) wA[4 * i + t] = __uint_as_float(__builtin_amdgcn_raw_buffer_load_b32(wrs, wvo, (8 * i + t) * 128, 0));
            }
            __builtin_amdgcn_sched_barrier(0);
            __syncthreads();
            if (pmode & 1) {
                f32x16 pacc, pacc1;
#pragma unroll
                for (int r = 0; r < 16; ++r) { pacc[r] = 0.f; pacc1[r] = 0.f; }
                const LAS float* xa = x32 + (lane & 31) * 1028 + wid * 128 + half * 4;
                f32x4 xq[16];
#pragma unroll
                for (int i = 0; i < 8; ++i) xq[i] = *(const LAS f32x4*)(xa + 8 * i);
#pragma unroll
                for (int i = 0; i < 8; ++i)
#pragma unroll
                    for (int t = 0; t < 4; ++t) wB[4 * i + t] = __uint_as_float(__builtin_amdgcn_raw_buffer_load_b32(wrs, wvo, (64 + 8 * i + t) * 128, 0));
#pragma unroll
                for (int i = 0; i < 8; ++i) {
                    pacc = __builtin_amdgcn_mfma_f32_32x32x2f32(xq[i][0], wA[4 * i + 0], pacc, 0, 0, 0); pacc1 = __builtin_amdgcn_mfma_f32_32x32x2f32(xq[i][1], wA[4 * i + 1], pacc1, 0, 0, 0);
                    pacc = __builtin_amdgcn_mfma_f32_32x32x2f32(xq[i][2], wA[4 * i + 2], pacc, 0, 0, 0); pacc1 = __builtin_amdgcn_mfma_f32_32x32x2f32(xq[i][3], wA[4 * i + 3], pacc1, 0, 0, 0); }
                __builtin_amdgcn_sched_barrier(0);
#pragma unroll
                for (int i = 8; i < 16; ++i) xq[i] = *(const LAS f32x4*)(xa + 8 * i);
#pragma unroll
                for (int i = 0; i < 8; ++i) {
                    pacc = __builtin_amdgcn_mfma_f32_32x32x2f32(xq[8 + i][0], wB[4 * i + 0], pacc, 0, 0, 0); pacc1 = __builtin_amdgcn_mfma_f32_32x32x2f32(xq[8 + i][1], wB[4 * i + 1], pacc1, 0, 0, 0);
                    pacc = __builtin_amdgcn_mfma_f32_32x32x2f32(xq[8 + i][2], wB[4 * i + 2], pacc, 0, 0, 0); pacc1 = __builtin_amdgcn_mfma_f32_32x32x2f32(xq[8 + i][3], wB[4 * i + 3], pacc1, 0, 0, 0); }
#pragma unroll
                for (int r = 0; r < 16; ++r) pacc[r] += pacc1[r];
                __syncthreads();
                LAS float* pw = x32 + wid * 1024 + e;
#pragma unroll
                for (int r = 0; r < 16; ++r) pw[crow(r, half) * 32] = pacc[r];
                __syncthreads();
                const LAS float* pr = x32 + (half * 4) * 1024 + (wid * 4) * 32 + e;
#pragma unroll
                for (int q = 0; q < 4; ++q) { a0 += pr[q * 1024]; a1 += pr[q * 1024 + 32]; a2 += pr[q * 1024 + 64]; a3 += pr[q * 1024 + 96]; }
            } else { __syncthreads(); __syncthreads(); }
            __syncthreads();
            float lg[4]; lg[0] = a0 + shx(a0, 32) + rbe; lg[1] = a1 + shx(a1, 32) + rbe; lg[2] = a2 + shx(a2, 32) + rbe; lg[3] = a3 + shx(a3, 32) + rbe;
            float selv[4][4]; int seli[4][4];
#pragma unroll
            for (int rr = 0; rr < 4; ++rr) {
                float v = lg[rr];
#pragma unroll
                for (int k = 0; k < 4; ++k) {
                    float bv = v; int bi = e;
#pragma unroll
                    for (int msk = 1; msk < 32; msk <<= 1) { const float ov = shx(bv, msk); const int oi = shxi(bi, msk); if (ov > bv || (ov == bv && oi < bi)) { bv = ov; bi = oi; } }
                    selv[rr][k] = bv; seli[rr][k] = bi;
                    if (bi == e) v = -INFINITY;
                }
            }
            if (lane < 16) {
                const int rr = lane >> 2, k = lane & 3;
                float sv[4]; int si[4];
#pragma unroll
                for (int q = 0; q < 4; ++q) { sv[q] = rr == 0 ? selv[0][q] : rr == 1 ? selv[1][q] : rr == 2 ? selv[2][q] : selv[3][q]; si[q] = rr == 0 ? seli[0][q] : rr == 1 ? seli[1][q] : rr == 2 ? seli[2][q] : seli[3][q]; }
                const float ex1 = __expf(sv[1] - sv[0]), ex2 = __expf(sv[2] - sv[0]), ex3 = __expf(sv[3] - sv[0]);
                const float isum = 1.0f / (1.0f + ex1 + ex2 + ex3);
                const int me = k == 0 ? si[0] : k == 1 ? si[1] : k == 2 ? si[2] : si[3];
                const float mg = (k == 0 ? 1.0f : k == 1 ? ex1 : k == 2 ? ex2 : ex3) * isum;
                const int mr = (int)__hip_atomic_fetch_add((LAS unsigned*)(F.lds + L_CNT) + me, 1u, __ATOMIC_RELAXED, __HIP_MEMORY_SCOPE_WORKGROUP);
                LAS int* rt = route + ((lrow0 + rr) * 4 + k) * 3;
                rt[0] = me; rt[1] = mr; rt[2] = __float_as_int(mg);
            }
        }
        __syncthreads();
        if (wid == 0) { const int l_ = lane_id_now(); if (l_ < 32) base[l_] = __hip_atomic_fetch_add(gcount + l_, cnt[l_], RLX_AGENT); }
        __syncthreads();
#pragma unroll 1
        for (int batch = 0; batch < 2; ++batch) {
            const int lrow0 = wid * 8 + batch * 4, row0 = chunk * 64 + lrow0;
            u32x4 sa[4], sb[4];
#pragma unroll
            for (int rr = 0; rr < 4; ++rr) { const bf16* src = XMB + (size_t)(row0 + rr) * D; sa[rr] = *(const u32x4*)(src + lane * 16); sb[rr] = *(const u32x4*)(src + lane * 16 + 8); }
            int vrow = 0;
            if (lane < 16) { const int rr = lane >> 2, k = lane & 3; const LAS int* rt = route + ((lrow0 + rr) * 4 + k) * 3; const int me = rt[0];
                vrow = me * CAPROWS + (int)base[me] + rt[1]; ROWS[(size_t)(row0 + rr) * 4 + k] = vrow; GATES[(size_t)(row0 + rr) * 4 + k] = __int_as_float(rt[2]); }
            if (pmode & 2) {
#pragma unroll
                for (int rr = 0; rr < 4; ++rr) {
                    const u32x4 a = sa[rr], b = sb[rr];
                    u32x4 o; o.x = pg8::pk4_fp8(bflo(a.x), bfhi(a.x), bflo(a.y), bfhi(a.y)); o.y = pg8::pk4_fp8(bflo(a.z), bfhi(a.z), bflo(a.w), bfhi(a.w));
                    o.z = pg8::pk4_fp8(bflo(b.x), bfhi(b.x), bflo(b.y), bfhi(b.y)); o.w = pg8::pk4_fp8(bflo(b.z), bfhi(b.z), bflo(b.w), bfhi(b.w));
#pragma unroll
                    for (int k = 0; k < 4; ++k) { const int vr = shli(vrow, rr * 4 + k); unsigned char* dst = (unsigned char*)XP + (size_t)vr * D;
                        *(u32x4*)(dst + lane * 16) = o; }
                }
            }
        }
        __syncthreads();
    }
}
#undef LN1_LOAD
__device__ __forceinline__ void ln2_phase(Frame& F, const bf16* XMB, const bf16* YP, const int* ROWS, const float* GATES, const float* g2, const float* b2, float* out, bf16* XB, unsigned char* XB8) {
    const int lane = F.lane;
    float ALPHA_ = ALPHA; asm volatile("" : "+v"(ALPHA_));
    const int rstride = F.G * NWAVES, row_first = F.bid * NWAVES + F.wave;
    const unsigned char* yp8 = (const unsigned char*)YP;
    int ix0 = 0, ix1 = 0, ix2 = 0, ix3 = 0; f32x4 gtn = {0.f, 0.f, 0.f, 0.f};
    u32x2 xbn[4]; int qn[4][4]; f32x4 gtc = {0.f, 0.f, 0.f, 0.f};
#define LN2_IDX(R) do { if ((R) < T) { ix0 = ROWS[(size_t)(R) * 4]; ix1 = ROWS[(size_t)(R) * 4 + 1]; ix2 = ROWS[(size_t)(R) * 4 + 2]; ix3 = ROWS[(size_t)(R) * 4 + 3]; gtn = *(const f32x4*)(GATES + (size_t)(R) * 4); } } while (0)
#define LN2_DATA(R) do { if ((R) < T) { gtc = gtn; _Pragma("unroll") for (int j = 0; j < 4; ++j) { const int c = 4 * lane + 256 * j; xbn[j] = *(const u32x2*)(XMB + (size_t)(R) * D + c); \
        qn[j][0] = *(const int*)(yp8 + (size_t)ix0 * D + c); qn[j][1] = *(const int*)(yp8 + (size_t)ix1 * D + c); qn[j][2] = *(const int*)(yp8 + (size_t)ix2 * D + c); qn[j][3] = *(const int*)(yp8 + (size_t)ix3 * D + c); } } } while (0)
    f32x4 gg_[4], bb_[4];
#pragma unroll
    for (int j = 0; j < 4; ++j) { gg_[j] = *(const f32x4*)(g2 + 4 * lane + 256 * j); bb_[j] = *(const f32x4*)(b2 + 4 * lane + 256 * j); }
    LN2_IDX(row_first);
    LN2_DATA(row_first);
    LN2_IDX(row_first + rstride);
    for (int row = row_first; row < T; row += rstride) {
        u32x2 xbc[4]; int qc[4][4]; const f32x4 gt = gtc;
#pragma unroll
        for (int j = 0; j < 4; ++j) { xbc[j] = xbn[j]; qc[j][0] = qn[j][0]; qc[j][1] = qn[j][1]; qc[j][2] = qn[j][2]; qc[j][3] = qn[j][3]; }
        LN2_DATA(row + rstride);
        LN2_IDX(row + 2 * rstride);
        float v[16]; float s = 0.f;
#pragma unroll
        for (int j = 0; j < 4; ++j) {
            const u32x2 xb_ = xbc[j]; const f32x4 xx = {bflo(xb_.x), bfhi(xb_.x), bflo(xb_.y), bfhi(xb_.y)};
            const int q0 = qc[j][0], q1 = qc[j][1], q2 = qc[j][2], q3 = qc[j][3];
            const f32x2 a0 = __builtin_amdgcn_cvt_pk_f32_fp8(q0, false), b0 = __builtin_amdgcn_cvt_pk_f32_fp8(q0, true), a1 = __builtin_amdgcn_cvt_pk_f32_fp8(q1, false), b1 = __builtin_amdgcn_cvt_pk_f32_fp8(q1, true);
            const f32x2 a2 = __builtin_amdgcn_cvt_pk_f32_fp8(q2, false), b2_ = __builtin_amdgcn_cvt_pk_f32_fp8(q2, true), a3 = __builtin_amdgcn_cvt_pk_f32_fp8(q3, false), b3 = __builtin_amdgcn_cvt_pk_f32_fp8(q3, true);
            const float g0 = gt[0] * (1.0f / 16.0f), g1 = gt[1] * (1.0f / 16.0f), g2_ = gt[2] * (1.0f / 16.0f), g3 = gt[3] * (1.0f / 16.0f);
            v[4 * j]     = ALPHA_ * xx[0] + ((g0 * a0[0] + g1 * a1[0]) + (g2_ * a2[0] + g3 * a3[0]));
            v[4 * j + 1] = ALPHA_ * xx[1] + ((g0 * a0[1] + g1 * a1[1]) + (g2_ * a2[1] + g3 * a3[1]));
            v[4 * j + 2] = ALPHA_ * xx[2] + ((g0 * b0[0] + g1 * b1[0]) + (g2_ * b2_[0] + g3 * b3[0]));
            v[4 * j + 3] = ALPHA_ * xx[3] + ((g0 * b0[1] + g1 * b1[1]) + (g2_ * b2_[1] + g3 * b3[1]));
            s += (v[4 * j] + v[4 * j + 1]) + (v[4 * j + 2] + v[4 * j + 3]); }
        const float mean = wave_sum(s) * (1.f / D); float s2 = 0.f;
#pragma unroll
        for (int k = 0; k < 16; ++k) { v[k] -= mean; s2 += v[k] * v[k]; }
        const float rstd = 1.0f / sqrtf(wave_sum(s2) * (1.f / D) + LN_EPS);
#pragma unroll
        for (int j = 0; j < 4; ++j) { const int c = 4 * lane + 256 * j; const f32x4 gg = gg_[j], bb = bb_[j];
            f32x4 o;
#pragma unroll
            for (int k = 0; k < 4; ++k) o[k] = v[4 * j + k] * rstd * gg[k] + bb[k];
            if (out) *(f32x4*)(out + (size_t)row * D + c) = o;
            u32x2 pb; pb.x = pk2(o[0], o[1]); pb.y = pk2(o[2], o[3]); *(u32x2*)(XB + (size_t)row * D + c) = pb;
            if (XB8) *(unsigned*)(XB8 + (size_t)row * D + c) = pg8::pk4_fp8(o[0], o[1], o[2], o[3]); }
    }
}
#undef LN2_IDX
#undef LN2_DATA

#ifndef MK_FP8TEST
#define MK_FP8TEST 0
#endif
typedef int i32x8 __attribute__((ext_vector_type(8)));
__device__ __forceinline__ int t8_val(int which, int rc, int g, int j) { unsigned h = (unsigned)(which * 7919 + rc * 104729 + g * 1299709 + j * 15485863 + 12345); h ^= h >> 13; h *= 0x5bd1e995u; h ^= h >> 15; return (int)(h % 9u) - 4; }
__device__ __forceinline__ void fp8_selftest(gu32* ctl, int lane) {
    const int rc = lane & 15, g = lane >> 4;
    i32x8 a, b;
#pragma unroll
    for (int w = 0; w < 8; ++w) {
        int wa = __builtin_amdgcn_cvt_pk_fp8_f32((float)t8_val(0, rc, g, 4 * w), (float)t8_val(0, rc, g, 4 * w + 1), 0, false);
        wa = __builtin_amdgcn_cvt_pk_fp8_f32((float)t8_val(0, rc, g, 4 * w + 2), (float)t8_val(0, rc, g, 4 * w + 3), wa, true);
        int wb = __builtin_amdgcn_cvt_pk_fp8_f32((float)t8_val(1, rc, g, 4 * w), (float)t8_val(1, rc, g, 4 * w + 1), 0, false);
        wb = __builtin_amdgcn_cvt_pk_fp8_f32((float)t8_val(1, rc, g, 4 * w + 2), (float)t8_val(1, rc, g, 4 * w + 3), wb, true);
        a[w] = wa; b[w] = wb;
    }
    f32x4 c = {0.f, 0.f, 0.f, 0.f};
    c = __builtin_amdgcn_mfma_scale_f32_16x16x128_f8f6f4(a, b, c, 0, 0, 0, 0x7f7f7f7f, 0, 0x7f7f7f7f);
    int bad = 0, scaled = 0;
#pragma unroll
    for (int reg = 0; reg < 4; ++reg) {
        const int row = 4 * (lane >> 4) + reg, col = lane & 15; int e = 0;
        for (int gg = 0; gg < 4; ++gg) for (int j = 0; j < 32; ++j) e += t8_val(0, row, gg, j) * t8_val(1, col, gg, j);
        if (c[reg] != (float)e) { bad = 1; if (e != 0 && (c[reg] == (float)e * 0.5f || c[reg] == (float)e * 2.0f || c[reg] == (float)e * 0.25f || c[reg] == (float)e * 4.0f)) scaled = 1; }
    }
    const unsigned long long mb = __ballot(bad), ms = __ballot(bad && scaled);
    if (lane == 0 && mb) __hip_atomic_store(ctl + CW_ERR, (mb == ms) ? 2u : 1u, RLX_AGENT);
}

constexpr int N_STEPS = 6, LAST_PHASE = 1 + 10 * 5 + 8;
__host__ __device__ constexpr bool phase_exists(int id) {
    if (id == 0) return true;
    if (id < 1 || id > LAST_PHASE) return false;
    const int s = (id - 1) / 10, p = (id - 1) % 10;
    if (p == 0) return true;
    if (p == 9) return false;
    if (s == 0 || s == 2) return false;
    if (p == 1 || p == 2) return s == 3;
    return true;
}
__global__ void __launch_bounds__(NTHREADS, 2) mk_fwd(Args args) {
    extern __shared__ __attribute__((aligned(16))) unsigned char lds_raw[];
    Frame F;
    F.lds = (LAS unsigned char*)lds_raw;
    F.tid = threadIdx.x; F.lane = F.tid & 63; F.wave = __builtin_amdgcn_readfirstlane(F.tid >> 6);
    F.bid = blockIdx.x; F.G = gridDim.x; F.vcu = (F.G % 8 == 0) ? (F.bid % 8) * (F.G / 8) + F.bid / 8 : F.bid;
    F.ctl = (gu32*)(args.ws + WS_CTL);
    const int lo = args.ph_lo, hi = args.ph_hi;
    const bool fused = (hi - lo) > 1;
    for (int u = F.tid; u < (LDS_BYTES - LDSCTL_OFF) / 4; u += NTHREADS) ((LAS unsigned*)(F.lds + LDSCTL_OFF))[u] = 0u;
    __syncthreads();
    XcdBarrier bar; bar.bar = (unsigned*)(F.ctl + CW_BAR); bar.x = 0; bar.st = nullptr;
    if (fused) bar = xcd_barrier_post((unsigned*)(F.ctl + CW_BAR), (volatile LAS unsigned*)(F.lds + L_XB));
    const bool split = fused && MK_SPLIT && (F.G % 16 == 0) && lo == 0 && hi > 16;
    const int NCV = split ? F.G / 2 : 0;
    const bool is_conv = split && F.bid < NCV;
    XcdBarrier bar2; bar2.bar = (unsigned*)(F.ctl + CW_BAR2); bar2.x = 0; bar2.st = nullptr;
    if (split && !is_conv) bar2 = xcd_barrier_post((unsigned*)(F.ctl + CW_BAR2), (volatile LAS unsigned*)(F.lds + L_XB2));
#ifndef MK_PROBE
#define MK_PROBE 0
#endif
#define IN(id) (lo <= (id) && (id) < hi)
#define PHASE_BEGIN ArgsP ap = (ArgsP)__builtin_amdgcn_kernarg_segment_ptr(); asm volatile("" : "+s"(ap)); GAS unsigned char* wsg_ = (GAS unsigned char*)ap->ws; asm volatile("" : "+s"(wsg_)); unsigned char* ws = (unsigned char*)wsg_; Frame Fp = F; { const int l_ = lane_id_now(); Fp.lane = l_; Fp.tid = F.wave * 64 + l_; } Fp.ctl = (gu32*)(ws + WS_CTL);
#define SEAM(id) do { if (fused && (id) != LAST_PHASE) { xcd_barrier(bar, F.wave == 0 && lane_id_now() == 0, (unsigned)F.G); if (MK_PROBE == 10) xcd_barrier(bar, F.wave == 0 && lane_id_now() == 0, (unsigned)F.G); } } while (0)
#define SEAMW(id, sync, last) do { if (!split) SEAM(id); else if (last) SEAM(id); else if ((sync) && !is_conv) xcd_barrier(bar2, F.wave == 0 && lane_id_now() == 0, (unsigned)(F.G - NCV)); } while (0)
#define WIN_FRAME do { if (split) { Fp.G = F.G - NCV; Fp.bid = F.bid - NCV; Fp.vcu = (Fp.G % 8 == 0) ? (Fp.bid % 8) * (Fp.G / 8) + Fp.bid / 8 : Fp.bid; } } while (0)
#define REPS(k) ((MK_PROBE) == (k) ? 2 : 1)

#ifndef SKIP_P0
    if (MK_FP8TEST && lo == 0 && F.bid == 0 && F.wave == 0) fp8_selftest(F.ctl, F.lane);
    if (IN(0)) { PHASE_BEGIN for (int rep = 0; rep < REPS(1); ++rep) p0_prologue(Fp, ap, ws, split ? 1 : 0); SEAM(0); }
#endif

    for (int s = 0; s < N_STEPS; ++s) {
        const int pb = 1 + 10 * s;
        const int layer = s == 0 ? 0 : (s == 1 ? 0 : (s <= 3 ? 1 : s - 2));
        const int kind = layer % 3;
        const bool rest = !(s == 0 || s == 2);
#ifndef SKIP_G1
        const bool inw = split && s <= 1;
        if (IN(pb) && inw && is_conv) {
            if (s == 0) { PHASE_BEGIN Fp.G = NCV; p0_prologue(Fp, ap, ws, 2); }
        } else
        if (IN(pb)) {
            PHASE_BEGIN
            if (inw) WIN_FRAME;
            pg8::Gemm g; pg8::EpiProj E; E.ssq_in = nullptr; E.ssq_out = nullptr; E.rope = (const pg8::f32x2*)(ws + WS_ROPE); E.rope_heads = 0u; E.oscale = 1.0f;
            if (s == 0) { g = pg8::Gemm{(const bf16*)(ws + WS_MEMB), (const bf16*)(ws + WS_WKV), NB * MEML, 2048, 1024, 1024}; E.O = (bf16*)(ws + WS_KVMEM); E.ldc = 2048; }
            else if (s == 3) { g = pg8::Gemm{(const bf16*)(ws + WS_PROJ), (const bf16*)(ws + WS_WUQ), T, 1280, 256, 1280}; E.O = (bf16*)(ws + WS_QQ); E.ldc = 1280; E.ssq_in = (const float*)(ws + WS_SSQ); E.rope_heads = 0xFFFFFu; }
            else { const int n = kind == 0 ? 2560 : (kind == 1 ? 1280 : 1536);
                g = pg8::Gemm{(const bf16*)(ws + WS_XB), (const bf16*)(ws + WS_WIN + (size_t)layer * 5 * MiB), T, n, 1024, 1024}; E.O = (bf16*)(ws + WS_PROJ); E.ldc = n;
                if (layer != 0) { g.A = (const bf16*)(ws + WS_XB8); g.K = 512; g.lda = 512; E.oscale = 1.0f / 64.0f; }
                if (kind == 1) { E.ssq_out = (float*)(ws + WS_SSQ); E.rope_heads = 0xF0u | (1u << 16); }
                if (kind == 2) E.rope_heads = 0xFFFFu; }
            pg8::StaticOrder S; S.init(g.M, g.N, Fp.G, (s == 0 && !inw) ? Fp.G - 1 - Fp.bid : Fp.bid); if (s <= 1) S.split = 0;
            if (!(s == 0 || s == 1 || s == 3)) { for (int rep = 0; rep < REPS(2); ++rep) pg8::gemm_phase<pg8::EpiProj, pg8::StaticOrder, true, true, true>(F.lds + RING_OFF, g, S, E, F.wave * 64 + lane_id_now()); }
            else { for (int rep = 0; rep < REPS(2); ++rep) pg8::gemm_phase<pg8::EpiProj, pg8::StaticOrder, true, true, false>(F.lds + RING_OFF, g, S, E, F.wave * 64 + lane_id_now()); }
        }
        if (IN(pb)) { if (inw) SEAMW(pb, s == 1, false); else if (!(s == 0 && fused)) SEAM(pb); }
#endif
        if (s == 3) {
#ifndef SKIP_PS
            if (IN(pb + 1)) { PHASE_BEGIN for (int rep = 0; rep < ((MK_PROBE == 3 || MK_PROBE == 31) ? 2 : 1); ++rep) score_phase(Fp, (const bf16*)(ws + WS_QQ), (const bf16*)(ws + WS_PROJ), (float*)(ws + WS_ACT)); SEAM(pb + 1); }
#endif
#ifndef SKIP_PT
            if (IN(pb + 2)) { PHASE_BEGIN for (int rep = 0; rep < ((MK_PROBE == 3 || MK_PROBE == 32) ? 2 : 1); ++rep) select_phase(Fp, (const float*)(ws + WS_ACT), (unsigned long long*)(ws + WS_MASK)); SEAM(pb + 2); }
#endif
        }
        if (!rest) continue;
#ifndef SKIP_MIX
        if (IN(pb + 3) && !(inw && is_conv)) { PHASE_BEGIN if (inw) WIN_FRAME; for (int rep = 0; rep < ((MK_PROBE == 4 || (MK_PROBE == 41 && kind == 1) || (MK_PROBE == 42 && kind == 2) || (MK_PROBE == 43 && kind == 0)) ? 2 : 1); ++rep) mixer_phase(Fp, ap, ws, layer, kind, s + 8 * rep); }
        if (IN(pb + 3)) { if (inw) SEAMW(pb + 3, true, false); else SEAM(pb + 3); }
#endif
#ifndef SKIP_G2
        if (IN(pb + 4) && !(inw && is_conv)) {
            PHASE_BEGIN
            if (inw) WIN_FRAME;
            pg8::Gemm g{(const bf16*)(ws + WS_CAT), (const bf16*)(ws + WS_WOUT + (size_t)layer * 2 * MiB), T, 1024, 512, 512};
            pg8::EpiProj E; E.O = (bf16*)(ws + WS_Y); E.ldc = 1024; E.ssq_in = nullptr; E.ssq_out = nullptr; E.rope = nullptr; E.rope_heads = 0u; E.oscale = 1.0f / 128.0f;
            pg8::StaticOrder S; S.init(T, 1024, Fp.G, Fp.bid);
            for (int rep = 0; rep < REPS(5); ++rep) pg8::gemm_phase<pg8::EpiProj, pg8::StaticOrder, true, true, true>(F.lds + RING_OFF, g, S, E, F.wave * 64 + lane_id_now());
        }
        if (IN(pb + 4)) { if (inw) SEAMW(pb + 4, true, false); else SEAM(pb + 4); }
#endif
#ifndef SKIP_LN1
        if (IN(pb + 5) && !(inw && is_conv)) {
            PHASE_BEGIN
            if (inw) WIN_FRAME;
            for (int rep = 0; rep < ((MK_PROBE == 6 || MK_PROBE == 61 || MK_PROBE == 62 || MK_PROBE == 63) ? 2 : 1); ++rep)
            ln1_phase(Fp, (const bf16*)(ws + WS_XB), (const bf16*)(ws + WS_Y), ap->in[12] + layer * D, ap->in[13] + layer * D, (bf16*)(ws + WS_QQ),
                      ap->in[14] + (size_t)layer * D * NEXP, ap->in[15] + layer * NEXP, (bf16*)(ws + (rep ? WS_ACT : WS_XP)), Fp.ctl + (rep ? CW_GDUMMY : CW_GCOUNT) + layer * NEXP,
                      (int*)(ws + (rep ? WS_SSQ : WS_ROWS)), (float*)(ws + (rep ? WS_MASK : WS_GATES)), (rep && MK_PROBE == 61) ? 2 : (rep && MK_PROBE == 62) ? 1 : (rep && MK_PROBE == 63) ? 0 : 3);
        }
        if (IN(pb + 5)) { if (inw) SEAMW(pb + 5, true, true); else SEAM(pb + 5); }
#endif
        if (IN(pb + 6) || IN(pb + 7)) {
            LAS int* pref = (LAS int*)(F.lds + L_PREF); LAS int* tiles = (LAS int*)(F.lds + L_TILES);
#ifndef SKIP_G3
            if (IN(pb + 6)) {
                PHASE_BEGIN
                if (Fp.wave == 0) {
                    const int l_ = Fp.lane; const int tl_ = l_ < 32 ? (int)((__hip_atomic_load(Fp.ctl + CW_GCOUNT + layer * NEXP + (l_ & 31), RLX_AGENT) + 255u) >> 8) : 0;
                    int v_ = tl_ * 8;
#pragma unroll
                    for (int d_ = 1; d_ < 32; d_ <<= 1) { const int t_ = __builtin_amdgcn_ds_bpermute(((l_ - d_) & 63) << 2, v_); if (l_ >= d_) v_ += t_; }
                    if (l_ < 32) { tiles[l_] = tl_; pref[l_] = v_ - tl_ * 8; } if (l_ == 31) pref[32] = v_; }
                __syncthreads();
                pg8::Gemm g{(const bf16*)(ws + WS_XP), (const bf16*)(ws + WS_WGU + (size_t)layer * 64 * MiB), NEXP * CAPROWS, NEXP * 2048, 512, 512};
                pg8::EpiSwiglu E{(bf16*)(ws + WS_ACT), ap->in[17] + (size_t)layer * NEXP * 2048};
                pg8::MoeOrder S{pref, tiles, 8, pref[32], F.G, F.vcu};
                for (int rep = 0; rep < REPS(7); ++rep) pg8::gemm_phase<pg8::EpiSwiglu, pg8::MoeOrder, true, true, true>(F.lds + RING_OFF, g, S, E, F.wave * 64 + lane_id_now());
                SEAM(pb + 6);
            }
#endif
#ifndef SKIP_G4
            if (IN(pb + 7)) {
                PHASE_BEGIN
                if (Fp.wave == 0) {
                    const int l_ = Fp.lane; const int tl_ = l_ < 32 ? (int)((__hip_atomic_load(Fp.ctl + CW_GCOUNT + layer * NEXP + (l_ & 31), RLX_AGENT) + 255u) >> 8) : 0;
                    int v_ = tl_ * 4;
#pragma unroll
                    for (int d_ = 1; d_ < 32; d_ <<= 1) { const int t_ = __builtin_amdgcn_ds_bpermute(((l_ - d_) & 63) << 2, v_); if (l_ >= d_) v_ += t_; }
                    if (l_ < 32) { tiles[l_] = tl_; pref[l_] = v_ - tl_ * 4; } if (l_ == 31) pref[32] = v_; }
                __syncthreads();
                pg8::Gemm g{(const bf16*)(ws + WS_ACT), (const bf16*)(ws + WS_WDN + (size_t)layer * 32 * MiB), NEXP * CAPROWS, NEXP * 1024, 512, 512};
                pg8::EpiDown E{(bf16*)(ws + WS_XP), ap->in[19] + (size_t)layer * NEXP * 1024};
                pg8::MoeOrder S{pref, tiles, 4, pref[32], F.G, F.vcu};
                for (int rep = 0; rep < REPS(8); ++rep) pg8::gemm_phase<pg8::EpiDown, pg8::MoeOrder, true, true, true>(F.lds + RING_OFF, g, S, E, F.wave * 64 + lane_id_now());
                SEAM(pb + 7);
            }
#endif
        }
#ifndef SKIP_LN2
        if (IN(pb + 8)) {
            PHASE_BEGIN
            for (int rep = 0; rep < REPS(9); ++rep)
            ln2_phase(Fp, (const bf16*)(ws + WS_QQ), (const bf16*)(ws + WS_XP), (const int*)(ws + WS_ROWS), (const float*)(ws + WS_GATES), ap->in[20] + layer * D, ap->in[21] + layer * D,
                      layer == DEPTH - 1 ? ap->out : (float*)nullptr, (bf16*)(ws + WS_XB), (layer + 1 < DEPTH) ? (unsigned char*)(ws + WS_XB8) : (unsigned char*)nullptr);
            SEAM(pb + 8);
        }
#endif
    }
    if (MK_FP8TEST && hi > LAST_PHASE) {
        const unsigned code = __hip_atomic_load(F.ctl + CW_ERR, RLX_AGENT);
        if (code) { const float v = code == 2u ? 100.f : 10.f;
            for (int row = F.bid * NWAVES + F.wave; row < T; row += F.G * NWAVES) { f32x4* o = (f32x4*)(args.out + (size_t)row * D) + F.lane;
#pragma unroll
                for (int j = 0; j < 4; ++j) o[64 * j] = (f32x4){v, v, v, v}; } }
    }
#undef IN
#undef SEAM
}

extern "C" void kernel_launch(void* const* d_in, const int* in_sizes, int n_in, void* d_out, int out_size, void* d_ws, size_t ws_size, hipStream_t stream) {
    static int grid = 0;
    if (grid == 0) {
        if (n_in != 22 || in_sizes[0] != T * D || out_size != T * D || ws_size < WS_END) { fprintf(stderr, "kernel_launch: unexpected shapes (n_in %d, in0 %d, out %d, ws %zu < %zu); nothing launched\n", n_in, n_in > 0 ? in_sizes[0] : -1, out_size, ws_size, (size_t)WS_END); grid = -1; return; }
        int dev = 0, cus = 0, per_cu = 0;
        if (hipGetDevice(&dev) != hipSuccess || hipDeviceGetAttribute(&cus, hipDeviceAttributeMultiprocessorCount, dev) != hipSuccess) { fprintf(stderr, "kernel_launch: device query failed\n"); grid = -1; return; }
        if (hipFuncSetAttribute((const void*)mk_fwd, hipFuncAttributeMaxDynamicSharedMemorySize, LDS_BYTES) != hipSuccess) { fprintf(stderr, "kernel_launch: hipFuncSetAttribute failed\n"); grid = -1; return; }
        if (hipOccupancyMaxActiveBlocksPerMultiprocessor(&per_cu, (const void*)mk_fwd, NTHREADS, LDS_BYTES) != hipSuccess || per_cu < 1) fprintf(stderr, "kernel_launch: note: occupancy query reports %d workgroups per CU\n", per_cu);
        (void)hipGetLastError();
        grid = cus;
    }
    if (grid < 0) return;
    if (hipMemsetAsync((char*)d_ws + WS_CTL, 0, CTL_ZERO_BYTES, stream) != hipSuccess) { fprintf(stderr, "kernel_launch: hipMemsetAsync failed\n"); return; }
    Args a{};
    for (int i = 0; i < 22; ++i) a.in[i] = (const float*)d_in[i];
    a.out = (float*)d_out; a.ws = (unsigned char*)d_ws;
    unsigned char* ws = (unsigned char*)d_ws;
    { int nj = 0, items = 0;
      auto add = [&](const float* src, int ldw, int K, int col0, int nvalid, int nblk, size_t dst_off, int row0, const float* scale, int f8 = 0, float mul = 1.0f) {
          Job& j = a.jobs[nj++]; j.src = src; j.dst = (bf16*)(ws + dst_off); j.scale = scale; j.ldw = ldw; j.K = K; j.col0 = col0; j.nvalid = nvalid; j.nblk = nblk; j.row0 = row0; j.item0 = items; j.f8 = f8; j.mul = mul; j.pad = 0;
          items += nblk * (K / 128); };
      const float* a_w_in = a.in[2]; const float* b_w_in = a.in[4]; const float* c_w_in = a.in[8];
      add(a_w_in, 2560, 1024, 0, 2560, 10, WS_WIN + 0 * 5 * MiB, 0, nullptr);
      add(a_w_in + (size_t)1024 * 2560, 2560, 1024, 0, 2560, 10, WS_WIN + 3 * 5 * MiB, 0, nullptr, 1, 64.0f);
      add(b_w_in, 1096, 1024, 0, 768, 3, WS_WIN + 1 * 5 * MiB, 0, nullptr, 1, 64.0f);
      add(b_w_in, 1096, 1024, 840, 256, 1, WS_WIN + 1 * 5 * MiB, 768, nullptr, 1, 64.0f);
      add(b_w_in, 1096, 1024, 768, 72, 1, WS_WIN + 1 * 5 * MiB, 1024, nullptr, 1, 64.0f);
      add(c_w_in, 1536, 1024, 0, 1536, 6, WS_WIN + 2 * 5 * MiB, 0, nullptr, 1, 64.0f);
      for (int l = 0; l < 4; ++l) add(a.in[10] + (size_t)l * 1024 * 1024, 1024, 1024, 0, 1024, 4, WS_WOUT + (size_t)l * 2 * MiB, 0, nullptr, 1, 128.0f);
      for (int l = 0; l < 4; ++l) add(a.in[11] + (size_t)l * 1024 * 512, 512, 1024, 0, 512, 2, WS_WKV, 512 * l, nullptr);
      add(a.in[6], 768, 256, 0, 768, 3, WS_WUQ, 0, a.in[5]);
      add(a.in[7], 512, 256, 0, 512, 2, WS_WUQ, 768, a.in[5]);
      a.njob_items = items; }
    a.pad = 0;
#if MK_MULTI
    for (int id = 0; id <= LAST_PHASE; ++id) {
        if (!phase_exists(id)) continue;
        a.ph_lo = id; a.ph_hi = id + 1;
        hipLaunchKernelGGL(mk_fwd, dim3(grid), dim3(NTHREADS), LDS_BYTES, stream, a);
    }
#else
    a.ph_lo = 0; a.ph_hi = LAST_PHASE + 1;
    hipLaunchKernelGGL(mk_fwd, dim3(grid), dim3(NTHREADS), LDS_BYTES, stream, a);
#endif
    const hipError_t le = hipPeekAtLastError();
    if (le != hipSuccess) fprintf(stderr, "kernel_launch: launch failed: %s (grid %d)\n", hipGetErrorName(le), grid);
}
```

```cpp
#include <hip/hip_runtime.h>
#include <cstdio>
#include <cstdint>
#include <cmath>

#ifndef MK_MULTI
#define MK_MULTI 0
#endif
#ifndef MK_SPLIT
#define MK_SPLIT 0
#endif
#ifndef MK_CHECK
#define MK_CHECK 0
#endif

namespace pg8 {
#define PG8_LAS __attribute__((address_space(3)))
typedef unsigned short bf16_t;
typedef short bf16x8 __attribute__((ext_vector_type(8)));
typedef float f32x4 __attribute__((ext_vector_type(4)));
typedef unsigned u32x4 __attribute__((ext_vector_type(4)));
typedef int i32x8 __attribute__((ext_vector_type(8)));
typedef short bf16x16 __attribute__((ext_vector_type(16)));
typedef unsigned u32x2 __attribute__((ext_vector_type(2)));
constexpr int BM = 256, BK = 64, HALF = 128, HTB = HALF * BK * 2  , STAGE_BYTES = 8 * HTB, NXCD = 8, WGM = 8;

__host__ __device__ __forceinline__ int lds_byte(int r, int c) { const int st = (r >> 4) * 2 + (c >> 5), rr = r & 15, cc = c & 31, ob = rr * 64 + cc * 2; return st * 1024 + (ob ^ (((ob >> 9) & 1) << 5)); }
__host__ __device__ __forceinline__ void stage_rc(int b, int& R, int& C) { const int st = b / 1024, sb = b % 1024, swz = sb ^ (((sb >> 9) & 1) << 5); R = (st >> 1) * 16 + swz / 64; C = (st & 1) * 32 + (swz % 64) / 2; }
__host__ __device__ __forceinline__ int perm32(int rho) { const int n = rho >> 4, i = rho & 15; return 8 * (i >> 2) + 4 * n + (i & 3); }

struct Unit { int pm, pn, hs; };
struct Gemm { const bf16_t* A; const bf16_t* Bt; int M, N, K, lda; };

struct StaticOrder {
    int nM, nN, nwg, G, c, split;
    __host__ __device__ void init(int M, int N, int G_, int c_) { nM = M / BM; nN = N / BM; nwg = nM * nN; G = G_; c = c_; split = 1; }
    __host__ __device__ bool next(int i, Unit& u) const {
        const int nfull = nwg / G, rem = nwg - nfull * G; int L = i * G + c; u.hs = 0;
        if (split && i == nfull && rem > 0 && 2 * rem <= G) { if (c >= 2 * rem) return false; L = nfull * G + (c >> 1); u.hs = 1 + (c & 1); }
        if (L >= nwg) return false;
        int wgid = L; { const int q = nwg / NXCD, r = nwg % NXCD, xcd = wgid % NXCD, off = wgid / NXCD; wgid = (xcd < r ? xcd * (q + 1) : r * (q + 1) + (xcd - r) * q) + off; }
        const int nig = WGM * nN, gid = wgid / nig, fm = gid * WGM, gsz = (nM - fm) < WGM ? (nM - fm) : WGM;
        u.pm = fm + ((wgid % nig) % gsz); u.pn = (wgid % nig) / gsz; return true;
    }
    __device__ __forceinline__ void a_ready(const Unit&) const {}
    __device__ __forceinline__ void done(const Unit&) const {}
};

typedef float f32x2 __attribute__((ext_vector_type(2)));
__device__ __forceinline__ float shx16(float v, int lane, int m) { return __int_as_float(__builtin_amdgcn_ds_bpermute((lane ^ m) << 2, __float_as_int(v))); }
typedef __bf16 bf16x2_t __attribute__((ext_vector_type(2)));
__device__ __forceinline__ unsigned pk4_fp8(float a, float b, float c, float d) { int w = __builtin_amdgcn_cvt_pk_fp8_f32(a, b, 0, false); w = __builtin_amdgcn_cvt_pk_fp8_f32(c, d, w, true); return (unsigned)w; }
__device__ __forceinline__ unsigned cvt_pk_bf16(float lo, float hi) { f32x2 v = {lo, hi}; bf16x2_t b = __builtin_convertvector(v, bf16x2_t); return __builtin_bit_cast(unsigned, b); }

struct EpiProj {
    static constexpr bool PERM = true, AFTER_DRAIN = false, BIAS_LDS = false; static constexpr int NSTORE = 16;
    bf16_t* O; int ldc; const float* ssq_in; float* ssq_out; const f32x2* rope; unsigned rope_heads; float oscale;
    __device__ __forceinline__ void operator()(const f32x4 (&acc)[2][2][4][2], const Unit& u, int wr, int wc, int fr, int fq) const {
        const int row0 = u.pm * BM + (u.hs == 2 ? HALF : 0) + wr * 64 + fr, col0 = u.pn * BM + wc * 32 + 8 * fq;
        const bool do_ssq = (ssq_out != nullptr) && (u.pn == 0);
        const __amdgpu_buffer_rsrc_t ors = __builtin_amdgcn_make_buffer_rsrc((void*)O, 0, 0x7fffffff, 0x00020000);
        const bool any_rope = rope_heads != 0u;
        f32x4 sq_n = {0.f, 0.f, 0.f, 0.f}, cs_n[4];
#pragma unroll
        for (int q = 0; q < 4; ++q) cs_n[q] = (f32x4){0.f, 0.f, 0.f, 0.f};
#define EPI_ROWLOADS(ROW) do { if (ssq_in) sq_n = *(const f32x4*)(ssq_in + (size_t)(ROW) * 4); \
            if (any_rope) { const f32x4* cs_ = (const f32x4*)(rope + (size_t)((ROW) & 4095) * 8); cs_n[0] = cs_[0]; cs_n[1] = cs_[1]; cs_n[2] = cs_[2]; cs_n[3] = cs_[3]; } } while (0)
        EPI_ROWLOADS(row0);
#pragma unroll
        for (int ai = 0; ai < 2; ++ai) if (ai == 0 || u.hs == 0)
#pragma unroll
            for (int m = 0; m < 4; ++m) {
                const int row = row0 + ai * HALF + m * 16;
                const f32x4 s = sq_n, c01 = cs_n[0], c23 = cs_n[1], c45 = cs_n[2], c67 = cs_n[3];
                if (!(ai == 1 && m == 3)) { const int rown = row0 + (m == 3 ? HALF : ai * HALF + (m + 1) * 16); EPI_ROWLOADS(rown); }
                float rs = 1.f;
                if (ssq_in) rs = 1.0f / sqrtf(((s[0] + s[1]) + (s[2] + s[3])) * (1.f / 256.f) + 1e-5f);
                float ss = 0.f;
#pragma unroll
                for (int bj = 0; bj < 2; ++bj) {
                    f32x4 v0 = acc[ai][bj][m][0] * oscale, v1 = acc[ai][bj][m][1] * oscale;
                    if (do_ssq) ss += ((v0[0] * v0[0] + v0[1] * v0[1]) + (v0[2] * v0[2] + v0[3] * v0[3])) + ((v1[0] * v1[0] + v1[1] * v1[1]) + (v1[2] * v1[2] + v1[3] * v1[3]));
                    v0 = v0 * rs; v1 = v1 * rs;
                    const int head = (u.pn * BM + bj * HALF + wc * 32) >> 6;
                    if (((rope_heads >> head) & 1u) && !(wc & 1)) {
                        f32x4 o0, o1;
#pragma unroll
                        for (int j = 0; j < 4; ++j) { o0[j] = shx16(v0[j], fr + 16 * fq, 16); o1[j] = shx16(v1[j], fr + 16 * fq, 16); }
                        if (fq < 2) {
                            const float sg = fq == 0 ? -1.f : 1.f;
                            v0[0] = v0[0] * c01[0] + sg * o0[0] * c01[1]; v0[1] = v0[1] * c01[2] + sg * o0[1] * c01[3];
                            v0[2] = v0[2] * c23[0] + sg * o0[2] * c23[1]; v0[3] = v0[3] * c23[2] + sg * o0[3] * c23[3];
                            v1[0] = v1[0] * c45[0] + sg * o1[0] * c45[1]; v1[1] = v1[1] * c45[2] + sg * o1[1] * c45[3];
                            v1[2] = v1[2] * c67[0] + sg * o1[2] * c67[1]; v1[3] = v1[3] * c67[2] + sg * o1[3] * c67[3];
                        }
                    }
                    u32x4 w; w.x = cvt_pk_bf16(v0[0], v0[1]); w.y = cvt_pk_bf16(v0[2], v0[3]); w.z = cvt_pk_bf16(v1[0], v1[1]); w.w = cvt_pk_bf16(v1[2], v1[3]);
                    __builtin_amdgcn_raw_buffer_store_b128(w, ors, (row * ldc + col0 + bj * HALF) * 2, 0, 0);
                }
                if (do_ssq) { ss += shx16(ss, fr + 16 * fq, 16); ss += shx16(ss, fr + 16 * fq, 32); if (fq == 0) ssq_out[(size_t)row * 4 + wc] = ss; }
            }
#undef EPI_ROWLOADS
    }
};
struct EpiSwiglu {
    static constexpr bool PERM = true, AFTER_DRAIN = false, BIAS_LDS = true; static constexpr int NSTORE = 8;
    bf16_t* O; const float* bias;
    static constexpr float WSC = 1.0f / 64.0f;
    __device__ __forceinline__ void stage_bias(const Unit& u, PG8_LAS void* dst, int lane) const {
        const __amdgpu_buffer_rsrc_t brs = __builtin_amdgcn_make_buffer_rsrc((void*)bias, 0, 32 * 2048 * 4, 0x00020000);
        const int e = u.pn >> 3, t = u.pn & 7;
        __builtin_amdgcn_raw_ptr_buffer_load_lds(brs, dst, 16, (lane & 31) * 16 + (lane >> 5) * 4096, (e * 2048 + t * 128) * 4, 0, 0);
    }
    __device__ __forceinline__ void operator()(const f32x4 (&acc)[2][2][4][2], const Unit& u, int wr, int wc, int fr, int fq, const PG8_LAS float* bl) const {
        const int t = u.pn & 7;
        const int row0 = u.pm * BM + (u.hs == 2 ? HALF : 0) + wr * 64 + fr, jl = wc * 32 + 8 * fq, j0 = t * 128 + jl;
        const f32x4 bg0 = *(const PG8_LAS f32x4*)(bl + jl), bg1 = *(const PG8_LAS f32x4*)(bl + jl + 4), bu0 = *(const PG8_LAS f32x4*)(bl + 128 + jl), bu1 = *(const PG8_LAS f32x4*)(bl + 128 + jl + 4);
#pragma unroll
        for (int ai = 0; ai < 2; ++ai) if (ai == 0 || u.hs == 0)
#pragma unroll
            for (int m = 0; m < 4; ++m) {
                const int row = row0 + ai * HALF + m * 16;
                float r[8];
#pragma unroll
                for (int n = 0; n < 2; ++n) {
                    const f32x4 g4 = acc[ai][0][m][n] * WSC + (n ? bg1 : bg0), u4 = acc[ai][1][m][n] * WSC + (n ? bu1 : bu0);
#pragma unroll
                    for (int j = 0; j < 4; ++j) {
                        const float g = fminf(g4[j], 7.0f), up = fminf(fmaxf(u4[j], -7.0f), 7.0f);
                        const float sg = __builtin_amdgcn_rcpf(1.0f + __builtin_amdgcn_exp2f(g * (-1.702f * 1.4426950408889634f)));
                        r[n * 4 + j] = (up + 1.0f) * g * sg;
                    }
                }
                u32x2 w; w.x = pk4_fp8(r[0], r[1], r[2], r[3]); w.y = pk4_fp8(r[4], r[5], r[6], r[7]);
                *(u32x2*)((unsigned char*)O + (size_t)row * 1024 + j0) = w;
            }
    }
};
struct EpiDown {
    static constexpr bool PERM = true, AFTER_DRAIN = false, BIAS_LDS = true; static constexpr int NSTORE = 16;
    bf16_t* O; const float* bias;
    __device__ __forceinline__ void stage_bias(const Unit& u, PG8_LAS void* dst, int lane) const {
        const __amdgpu_buffer_rsrc_t brs = __builtin_amdgcn_make_buffer_rsrc((void*)bias, 0, 32 * 1024 * 4, 0x00020000);
        const int e = u.pn >> 2, t = u.pn & 3;
        __builtin_amdgcn_raw_ptr_buffer_load_lds(brs, dst, 16, lane * 16, (e * 1024 + t * 256) * 4, 0, 0);
    }
    __device__ __forceinline__ void operator()(const f32x4 (&acc)[2][2][4][2], const Unit& u, int wr, int wc, int fr, int fq, const PG8_LAS float* bl) const {
        const int t = u.pn & 3;
        const int row0 = u.pm * BM + (u.hs == 2 ? HALF : 0) + wr * 64 + fr, cl = wc * 32 + 8 * fq, col0 = t * BM + cl;
        f32x4 bv[2][2];
#pragma unroll
        for (int bj = 0; bj < 2; ++bj)
#pragma unroll
            for (int n = 0; n < 2; ++n) bv[bj][n] = *(const PG8_LAS f32x4*)(bl + cl + bj * HALF + 4 * n);
#pragma unroll
        for (int ai = 0; ai < 2; ++ai) if (ai == 0 || u.hs == 0)
#pragma unroll
            for (int m = 0; m < 4; ++m) { unsigned char* rowp = (unsigned char*)O + (size_t)(row0 + ai * HALF + m * 16) * 1024 + col0;
#pragma unroll
                for (int bj = 0; bj < 2; ++bj) { const f32x4 v0 = (acc[ai][bj][m][0] * (1.0f / 128.0f) + bv[bj][0]) * 16.0f, v1 = (acc[ai][bj][m][1] * (1.0f / 128.0f) + bv[bj][1]) * 16.0f;
                    u32x2 w; w.x = pk4_fp8(v0[0], v0[1], v0[2], v0[3]); w.y = pk4_fp8(v1[0], v1[1], v1[2], v1[3]);
                    *(u32x2*)(rowp + bj * HALF) = w; } }
    }
};
struct MoeOrder {
    const PG8_LAS int* pref; const PG8_LAS int* tiles; int ntn, total, G, vcu;
    __device__ __forceinline__ bool next(int i, Unit& u) const {
        const int nfull = total / G, rem = total - nfull * G; int L = i * G + vcu; u.hs = 0;
        if (i == nfull && rem > 0 && 2 * rem <= G) { if (vcu >= 2 * rem) return false; L = nfull * G + (vcu >> 1); u.hs = 1 + (vcu & 1); }
        if (L >= total) return false;
        int e = 0;
        for (int k = 1; k < 32; ++k) e += (pref[k] <= L) ? 1 : 0;
        const int r = L - pref[e], te = tiles[e];
        const int grp = te * 4, ntq = r / grp, r2 = r - ntq * grp, mt = r2 >> 2, ntl = r2 & 3;
        u.pm = __builtin_amdgcn_readfirstlane(e * 64 + mt); u.pn = __builtin_amdgcn_readfirstlane(e * ntn + ntq * 4 + ntl); return true;
    }
    __device__ __forceinline__ void a_ready(const Unit&) const {}
    __device__ __forceinline__ void done(const Unit&) const {}
};

template <class Epi, class Sched, bool ALIGN_EPI = false, bool SP2 = false, bool FP8 = false>
__device__ __forceinline__ void gemm_phase(PG8_LAS unsigned char* lds, const Gemm g, const Sched& S, const Epi& E, const int tid_in) {
    const int tid_ = tid_in;
    const int tid = tid_, wid = __builtin_amdgcn_readfirstlane(tid >> 6), lane = tid & 63, wr = wid >> 2, wc = wid & 3, fr = lane & 15, fq = lane >> 4;
    const int K = g.K, nt = K / BK;
    unsigned voffA[2], voffB[2];
#pragma unroll
    for (int i = 0; i < 2; ++i) { int R, C; stage_rc(tid * 16 + i * 8192, R, C); const int Rb = Epi::PERM ? ((R & ~31) + perm32(R & 31)) : R;
        voffA[i] = (unsigned)(R * g.lda + C) * 2u; voffB[i] = (unsigned)(Rb * K + C) * 2u; }
    const unsigned kstep = (unsigned)(BK * 2);
    const unsigned hstepA = (unsigned)HALF * g.lda * 2, hstepB = (unsigned)HALF * K * 2;
    const unsigned tstepA = 2 * hstepA, tstepB = 2 * hstepB;
    const unsigned ldsw = (unsigned)wid * 1024u;
    const int aoff = lds_byte(wr * 64 + fr, fq * 8), boff = lds_byte(wc * 32 + fr, fq * 8);
#define PG8_SA(b, h) (((b) * 2 + (h)) * HTB)
#define PG8_SB(b, h) ((4 + (b) * 2 + (h)) * HTB)
    const __amdgpu_buffer_rsrc_t rA = __builtin_amdgcn_make_buffer_rsrc((void*)g.A, 0, 0x7fffffff, 0x00020000), rB = __builtin_amdgcn_make_buffer_rsrc((void*)g.Bt, 0, 0x7fffffff, 0x00020000);
#define PG8_STAGE(bufoff, soff, voff, rs) do { _Pragma("unroll") for (int _i = 0; _i < 2; ++_i) \
        __builtin_amdgcn_raw_ptr_buffer_load_lds(rs, (PG8_LAS void*)(lds + (bufoff) + ldsw + _i * 8192), 16, (int)(voff)[_i], (int)(soff), 0, 0); } while (0)
#define PG8_LD2(P) __builtin_shufflevector(*(const PG8_LAS bf16x8*)(P), *(const PG8_LAS bf16x8*)((P) + 1024), 0, 1, 2, 3, 4, 5, 6, 7, 8, 9, 10, 11, 12, 13, 14, 15)
#define PG8_LDA(dst, b, h) do { _Pragma("unroll") for (int m = 0; m < 4; ++m) dst[m] = PG8_LD2(lds + PG8_SA(b, h) + aoff + m * 2048); } while (0)
#define PG8_LDB(dst, b, h) do { _Pragma("unroll") for (int n = 0; n < 2; ++n) dst[n] = PG8_LD2(lds + PG8_SB(b, h) + boff + n * 2048); } while (0)
#define PG8_LO(X) __builtin_shufflevector((X), (X), 0, 1, 2, 3, 4, 5, 6, 7)
#define PG8_HI(X) __builtin_shufflevector((X), (X), 8, 9, 10, 11, 12, 13, 14, 15)
#define PG8_MMA(ai, bj, At, Bt) do { __builtin_amdgcn_s_setprio(1); if constexpr (FP8) { _Pragma("unroll") for (int m = 0; m < 4; ++m) _Pragma("unroll") for (int n = 0; n < 2; ++n) \
        acc[ai][bj][m][n] = __builtin_amdgcn_mfma_scale_f32_16x16x128_f8f6f4(__builtin_bit_cast(i32x8, Bt[n]), __builtin_bit_cast(i32x8, At[m]), acc[ai][bj][m][n], 0, 0, 0, 0x7f7f7f7f, 0, 0x7f7f7f7f); \
        asm volatile("" : "+v"(acc[ai][bj][0][0]), "+v"(acc[ai][bj][0][1]), "+v"(acc[ai][bj][1][0]), "+v"(acc[ai][bj][1][1]), "+v"(acc[ai][bj][2][0]), "+v"(acc[ai][bj][2][1]), "+v"(acc[ai][bj][3][0]), "+v"(acc[ai][bj][3][1]));   } else { \
        _Pragma("unroll") for (int m = 0; m < 4; ++m) _Pragma("unroll") for (int n = 0; n < 2; ++n) { \
        acc[ai][bj][m][n] = __builtin_amdgcn_mfma_f32_16x16x32_bf16(PG8_LO(Bt[n]), PG8_LO(At[m]), acc[ai][bj][m][n], 0, 0, 0); \
        acc[ai][bj][m][n] = __builtin_amdgcn_mfma_f32_16x16x32_bf16(PG8_HI(Bt[n]), PG8_HI(At[m]), acc[ai][bj][m][n], 0, 0, 0); } } __builtin_amdgcn_s_setprio(0); } while (0)
#define PG8_WAIT_V(n) asm volatile("s_waitcnt vmcnt(" #n ")" ::: "memory")
#define PG8_WAIT_L(n) asm volatile("s_waitcnt lgkmcnt(" #n ")" ::: "memory")
#define PG8_WAIT_V8S do { if (t != 0 || pst == 0) PG8_WAIT_V(8); else if (pst == Epi::NSTORE) asm volatile("s_waitcnt vmcnt(%0)" :: "n"(8 + Epi::NSTORE) : "memory"); else asm volatile("s_waitcnt vmcnt(%0)" :: "n"(8 + Epi::NSTORE / 2) : "memory"); } while (0)
#define PG8_BAR __builtin_amdgcn_s_barrier()
#define PG8_SCHED __builtin_amdgcn_sched_barrier(0)
    Unit cur, nxt; int ui = 0, pst = 0;
    if (!S.next(0, cur)) return;
    f32x4 acc[2][2][4][2];
    float z0_ = 0.f; asm volatile("" : "+v"(z0_));
#pragma unroll
    for (int a = 0; a < 2; ++a)
#pragma unroll
        for (int b = 0; b < 2; ++b)
#pragma unroll
            for (int m = 0; m < 4; ++m)
#pragma unroll
                for (int n = 0; n < 2; ++n) acc[a][b][m][n] = (f32x4){z0_, z0_, z0_, z0_};
    bf16x16 At[4], B0[2], B1[2];
    unsigned cA = (unsigned)cur.pm * tstepA + (cur.hs == 2 ? hstepA : 0u), cB = (unsigned)cur.pn * tstepB;
    S.a_ready(cur);
    if constexpr (SP2) {
        PG8_STAGE(PG8_SB(0, 0), cB, voffB, rB); PG8_STAGE(PG8_SB(0, 1), cB + hstepB, voffB, rB); PG8_STAGE(PG8_SA(0, 0), cA, voffA, rA); PG8_STAGE(PG8_SA(0, 1), cA + hstepA, voffA, rA);
        if (wr == 1) PG8_BAR;
        PG8_WAIT_V(2); PG8_BAR;
        PG8_STAGE(PG8_SB(1, 0), cB + kstep, voffB, rB); PG8_STAGE(PG8_SA(1, 0), cA + kstep, voffA, rA); PG8_STAGE(PG8_SB(1, 1), cB + hstepB + kstep, voffB, rB);
        PG8_WAIT_V(6); PG8_BAR;
    } else {
        PG8_STAGE(PG8_SB(0, 0), cB, voffB, rB); PG8_STAGE(PG8_SA(0, 0), cA, voffA, rA); PG8_STAGE(PG8_SB(0, 1), cB + hstepB, voffB, rB); PG8_STAGE(PG8_SA(0, 1), cA + hstepA, voffA, rA);
        if (wr == 1) PG8_BAR;
        PG8_WAIT_V(4); PG8_BAR;
        PG8_STAGE(PG8_SB(1, 0), cB + kstep, voffB, rB); PG8_STAGE(PG8_SA(1, 0), cA + kstep, voffA, rA); PG8_STAGE(PG8_SB(1, 1), cB + hstepB + kstep, voffB, rB);
        PG8_WAIT_V(6); PG8_BAR;
    }
    for (;;) {
        const bool has_next = S.next(ui + 1, nxt);
        if constexpr (Epi::BIAS_LDS) { if (wid == 0) { int lb_; asm volatile("v_mbcnt_lo_u32_b32 %0, -1, 0\n\tv_mbcnt_hi_u32_b32 %0, -1, %0" : "=v"(lb_)); E.stage_bias(cur, (PG8_LAS void*)(lds + STAGE_BYTES + (ui & 1) * 1024), lb_); } }
        const unsigned nA = has_next ? (unsigned)nxt.pm * tstepA + (nxt.hs == 2 ? hstepA : 0u) : cA, nB = has_next ? (unsigned)nxt.pn * tstepB : cB;
        const bool chalf = cur.hs != 0;
        for (int t = 0; t < nt; t += 2) {
            const bool last = (t == nt - 2);
            const unsigned a1 = cA + (unsigned)(t + 1) * kstep;
            const unsigned a2 = last ? nA : cA + (unsigned)(t + 2) * kstep, b2 = last ? nB : cB + (unsigned)(t + 2) * kstep;
            const unsigned a3 = a2 + kstep, b3 = b2 + kstep;
            if (last && has_next) S.a_ready(nxt);
            if constexpr (SP2) {
            PG8_LDB(B0, 0, 0); PG8_LDB(B1, 0, 1); PG8_SCHED; PG8_LDA(At, 0, 0); PG8_STAGE(PG8_SA(1, 1), a1 + hstepA, voffA, rA);
            PG8_WAIT_V8S; PG8_WAIT_L(0); PG8_BAR; PG8_MMA(0, 0, At, B0); PG8_MMA(0, 1, At, B1); PG8_BAR; PG8_SCHED;
            PG8_LDA(At, 0, 1); PG8_STAGE(PG8_SB(0, 0), b2, voffB, rB); PG8_STAGE(PG8_SB(0, 1), b2 + hstepB, voffB, rB); PG8_STAGE(PG8_SA(0, 0), a2, voffA, rA);
            PG8_WAIT_V8S; PG8_WAIT_L(0); PG8_BAR; if (!chalf) { PG8_MMA(1, 0, At, B0); PG8_MMA(1, 1, At, B1); } PG8_BAR; PG8_SCHED;
            PG8_LDB(B0, 1, 0); PG8_LDB(B1, 1, 1); PG8_SCHED; PG8_LDA(At, 1, 0); PG8_STAGE(PG8_SA(0, 1), a2 + hstepA, voffA, rA);
            PG8_WAIT_V(8); PG8_WAIT_L(0); PG8_BAR; PG8_MMA(0, 0, At, B0); PG8_MMA(0, 1, At, B1); PG8_BAR; PG8_SCHED;
            PG8_LDA(At, 1, 1); PG8_STAGE(PG8_SB(1, 0), b3, voffB, rB); PG8_STAGE(PG8_SB(1, 1), b3 + hstepB, voffB, rB); PG8_STAGE(PG8_SA(1, 0), a3, voffA, rA);
            PG8_WAIT_V(8); PG8_WAIT_L(0); PG8_BAR; if (!chalf) { PG8_MMA(1, 0, At, B0); PG8_MMA(1, 1, At, B1); } PG8_BAR; PG8_SCHED;
            } else {
            PG8_LDB(B0, 0, 0); PG8_SCHED; PG8_LDA(At, 0, 0); PG8_STAGE(PG8_SA(1, 1), a1 + hstepA, voffA, rA);
            PG8_WAIT_L(8); PG8_BAR; PG8_WAIT_L(0); PG8_MMA(0, 0, At, B0); PG8_BAR; PG8_SCHED;
            PG8_LDB(B1, 0, 1); PG8_STAGE(PG8_SB(0, 0), b2, voffB, rB);
            PG8_BAR; PG8_WAIT_L(0); PG8_MMA(0, 1, At, B1); PG8_BAR;
            PG8_LDA(At, 0, 1); PG8_STAGE(PG8_SA(0, 0), a2, voffA, rA);
            PG8_BAR; PG8_WAIT_L(0); PG8_MMA(1, 0, At, B0); PG8_BAR; PG8_SCHED;
            PG8_STAGE(PG8_SB(0, 1), b2 + hstepB, voffB, rB);
            PG8_WAIT_V(6); PG8_BAR; PG8_MMA(1, 1, At, B1); PG8_BAR;
            PG8_LDB(B0, 1, 0); PG8_SCHED; PG8_LDA(At, 1, 0); PG8_STAGE(PG8_SA(0, 1), a2 + hstepA, voffA, rA);
            PG8_WAIT_L(8); PG8_BAR; PG8_WAIT_L(0); PG8_MMA(0, 0, At, B0); PG8_BAR; PG8_SCHED;
            PG8_LDB(B1, 1, 1); PG8_STAGE(PG8_SB(1, 0), b3, voffB, rB);
            PG8_BAR; PG8_WAIT_L(0); PG8_MMA(0, 1, At, B1); PG8_BAR;
            PG8_LDA(At, 1, 1); PG8_STAGE(PG8_SA(1, 0), a3, voffA, rA);
            PG8_BAR; PG8_WAIT_L(0); PG8_MMA(1, 0, At, B0); PG8_BAR; PG8_SCHED;
            PG8_STAGE(PG8_SB(1, 1), b3 + hstepB, voffB, rB);
            PG8_WAIT_V(6); PG8_BAR; PG8_MMA(1, 1, At, B1); PG8_BAR;
            }
        }
        if constexpr (ALIGN_EPI) { if (wr == 0) PG8_BAR; }
        if constexpr (!Epi::AFTER_DRAIN) { int l_; asm volatile("v_mbcnt_lo_u32_b32 %0, -1, 0\n\tv_mbcnt_hi_u32_b32 %0, -1, %0" : "=v"(l_)); if constexpr (Epi::BIAS_LDS) E(acc, cur, wr, wc, l_ & 15, l_ >> 4, (const PG8_LAS float*)(lds + STAGE_BYTES + (ui & 1) * 1024)); else E(acc, cur, wr, wc, l_ & 15, l_ >> 4); S.done(cur); }
        if (!has_next) break;
        asm volatile("" : "+v"(z0_));
#pragma unroll
        for (int a = 0; a < 2; ++a)
#pragma unroll
            for (int b = 0; b < 2; ++b)
#pragma unroll
                for (int m = 0; m < 4; ++m)
#pragma unroll
                    for (int n = 0; n < 2; ++n) acc[a][b][m][n] = (f32x4){z0_, z0_, z0_, z0_};
        pst = cur.hs ? Epi::NSTORE / 2 : Epi::NSTORE; cur = nxt; cA = nA; cB = nB; ++ui;
        if constexpr (ALIGN_EPI) { if (wr == 1) PG8_BAR; }
    }
    PG8_WAIT_V(0);
    if constexpr (!ALIGN_EPI) { if (wr == 0) PG8_BAR; }
    PG8_BAR;
    if constexpr (Epi::AFTER_DRAIN) { E.fused(acc, cur, wr, wc, fr, fq, lds, wid, lane); S.done(cur); }
#undef PG8_SA
#undef PG8_SB
#undef PG8_STAGE
#undef PG8_LDA
#undef PG8_LDB
#undef PG8_MMA
#undef PG8_LD2
#undef PG8_LO
#undef PG8_HI
#undef PG8_WAIT_V
#undef PG8_WAIT_L
#undef PG8_WAIT_V8S
#undef PG8_BAR
#undef PG8_SCHED
}
}

constexpr int NB = 4, SEQ = 4096, T = NB * SEQ, D = 1024, DEPTH = 4, NEXP = 32, DEXP = 1024, MEML = 256;
constexpr int CAPROWS = 16384;
constexpr float LN_EPS = 1e-5f, ALPHA = 1.681792830507429f;
constexpr float LOG2E = 1.4426950408889634f, C2 = 0.125f * 1.4426950408889634f;
constexpr float NEG_BIG = -1.0e30f;
constexpr float NEG_RAW = -0x1p100f;
constexpr int NWAVES = 8, NTHREADS = 512;

constexpr size_t MiB = 1u << 20;
constexpr size_t WS_CTL = 0, CTL_ZERO_BYTES = 65536;
constexpr size_t WS_ROPE = 1 * MiB;
constexpr size_t WS_WUQ = 2 * MiB;
constexpr size_t WS_MEMB = 3 * MiB;
constexpr size_t WS_KVMEM = 5 * MiB;
constexpr size_t WS_WKV = 9 * MiB;
constexpr size_t WS_WOUT = 13 * MiB;
constexpr size_t WS_WIN = 21 * MiB;
constexpr size_t WS_SSQ = 41 * MiB;
constexpr size_t WS_ROWS = 42 * MiB;
constexpr size_t WS_GATES = 43 * MiB;
constexpr size_t WS_MASK = 44 * MiB;
constexpr size_t WS_XB = 52 * MiB;
constexpr size_t WS_CAT = 84 * MiB;
constexpr size_t WS_Y = 116 * MiB;
constexpr size_t WS_QQ = 148 * MiB;
constexpr size_t WS_PROJ = 188 * MiB;
constexpr size_t WS_XB8 = 268 * MiB;
constexpr size_t WS_XA = 268 * MiB;
constexpr size_t WS_XM = 332 * MiB;
constexpr size_t WS_WGU = 400 * MiB;
constexpr size_t WS_WDN = 912 * MiB;
constexpr size_t WS_XP = 1168 * MiB;
constexpr size_t WS_ACT = 2192 * MiB;
constexpr size_t WS_END = 3216 * MiB;
constexpr int CW_TMO = 0, CW_ERR = 2;
constexpr int CW_BAR = 4096;
constexpr int CW_QHEAD = 8192;
constexpr int CW_GCOUNT = 9216;
constexpr int CW_BAR2 = 12288;
constexpr int CW_GDUMMY = 9472;
static_assert((CW_BAR2 + 3456) * 4 <= (int)CTL_ZERO_BYTES && (CW_GDUMMY + 128) * 4 <= (int)CTL_ZERO_BYTES, "CTL words inside the memset region");

constexpr int RING_OFF = 0, RING_BYTES = 131072;
constexpr int LDSCTL_OFF = 143360;
constexpr int L_XB = LDSCTL_OFF + 0;
constexpr int L_Q = LDSCTL_OFF + 16;
constexpr int L_XB2 = LDSCTL_OFF + 32;
constexpr int L_PREF = LDSCTL_OFF + 64;
constexpr int L_TILES = LDSCTL_OFF + 256;
constexpr int L_CNT = LDSCTL_OFF + 384;
constexpr int L_BASE = LDSCTL_OFF + 512;
constexpr int L_ROUTE = LDSCTL_OFF + 1024;
constexpr int LDS_BYTES = 147456;

#define GAS __attribute__((address_space(1)))
#define LAS __attribute__((address_space(3)))
typedef unsigned short bf16;
typedef unsigned u32x4 __attribute__((ext_vector_type(4)));
typedef unsigned u32x2 __attribute__((ext_vector_type(2)));
typedef float f32x4 __attribute__((ext_vector_type(4)));
typedef float f32x2 __attribute__((ext_vector_type(2)));
typedef float f32x16 __attribute__((ext_vector_type(16)));
typedef short bf16x8 __attribute__((ext_vector_type(8)));
typedef short s16x4 __attribute__((ext_vector_type(4)));
typedef short v4i16_t __attribute__((ext_vector_type(4)));
typedef GAS unsigned gu32;
#define RLX_AGENT __ATOMIC_RELAXED, __HIP_MEMORY_SCOPE_AGENT
__device__ __forceinline__ unsigned pk2(float lo, float hi) { return pg8::cvt_pk_bf16(lo, hi); }
__device__ __forceinline__ float bf2f(bf16 b) { return __uint_as_float((unsigned)b << 16); }
__device__ __forceinline__ float bflo(unsigned w) { return __uint_as_float(w << 16); }
__device__ __forceinline__ float bfhi(unsigned w) { return __uint_as_float(w & 0xffff0000u); }
__device__ __forceinline__ int crow(int r, int hi) { return (r & 3) + 8 * (r >> 2) + 4 * hi; }
__device__ __forceinline__ float swapmax(float m) { auto rr = __builtin_amdgcn_permlane32_swap(__float_as_uint(m), __float_as_uint(m), false, false); return fmaxf(__uint_as_float(rr[0]), __uint_as_float(rr[1])); }
__device__ __forceinline__ float swapsum(float m) { auto rr = __builtin_amdgcn_permlane32_swap(__float_as_uint(m), __float_as_uint(m), false, false); return __uint_as_float(rr[0]) + __uint_as_float(rr[1]); }
__device__ __forceinline__ int lane_id_now() { int l; asm volatile("v_mbcnt_lo_u32_b32 %0, -1, 0\n\tv_mbcnt_hi_u32_b32 %0, -1, %0" : "=v"(l)); return l; }
__device__ __forceinline__ float shx(float v, int m) { return __int_as_float(__builtin_amdgcn_ds_bpermute((lane_id_now() ^ m) << 2, __float_as_int(v))); }
__device__ __forceinline__ int shxi(int v, int m) { return __builtin_amdgcn_ds_bpermute((lane_id_now() ^ m) << 2, v); }
__device__ __forceinline__ int shli(int v, int src) { return __builtin_amdgcn_ds_bpermute(src << 2, v); }
__device__ __forceinline__ float wave_sum(float v) {
#define WS_DPP(CTRL) v += __int_as_float(__builtin_amdgcn_update_dpp(0, __float_as_int(v), (CTRL), 0xF, 0xF, false))
    WS_DPP(0xB1); WS_DPP(0x4E); WS_DPP(0x141); WS_DPP(0x140);
#undef WS_DPP
    const float r0 = __int_as_float(__builtin_amdgcn_readlane(__float_as_int(v), 0)), r1 = __int_as_float(__builtin_amdgcn_readlane(__float_as_int(v), 16));
    const float r2 = __int_as_float(__builtin_amdgcn_readlane(__float_as_int(v), 32)), r3 = __int_as_float(__builtin_amdgcn_readlane(__float_as_int(v), 48));
    return (r0 + r1) + (r2 + r3);
}

#define XB_TMO      128
#define XB_XCNT(j)  (256  + 64 * (j))
#define XB_XSUB(j)  (1280 + 64 * (j))
#define XB_XGEN(j)  (2304 + 64 * (j))
#define XB_TOP      3328
#define XB_TOPGEN   3392
#define XCD_BAR_WORDS 3456
#define XB_SPIN_CAP (1u << 18)

__device__ __forceinline__ unsigned xb_ld(unsigned* p)              { return __hip_atomic_load(p, __ATOMIC_RELAXED, __HIP_MEMORY_SCOPE_AGENT); }
__device__ __forceinline__ unsigned xb_add(unsigned* p, unsigned v) { return __hip_atomic_fetch_add(p, v, __ATOMIC_RELAXED, __HIP_MEMORY_SCOPE_AGENT); }
__device__ __forceinline__ unsigned xb_xcc_id() { return (unsigned)__builtin_amdgcn_s_getreg((3 << 11) | 20) & 0xFu; }
#define XB_SPIN(cond, bar) do { unsigned _sp = 0; while (cond) { __builtin_amdgcn_s_sleep(1); \
    if ((++_sp & 255u) == 0u) { if (xb_ld(&(bar)[XB_TMO])) break; if (_sp > XB_SPIN_CAP) { atomicAdd(&(bar)[XB_TMO], 1u); break; } } } } while (0)

struct XcdBarrier {
    unsigned* bar; unsigned x;
    volatile LAS unsigned* st;
};

__device__ __forceinline__ XcdBarrier xcd_barrier_post(unsigned* bar, volatile LAS unsigned* st) {
    XcdBarrier b; b.bar = bar; b.x = xb_xcc_id(); b.st = st;
    if (threadIdx.x == 0) (void)xb_add(&bar[XB_XCNT(b.x)], 1u);
    return b;
}
__device__ __forceinline__ void xcd_barrier_complete(unsigned* bar, unsigned x, unsigned& nloc, unsigned& nx, const unsigned G) {
    unsigned sum, cnt, mine, sp = 0u;
    for (;;) {
        sum = 0u; cnt = 0u; mine = 0u;
#pragma unroll
        for (unsigned j = 0; j < 16; ++j) { const unsigned c = xb_ld(&bar[XB_XCNT(j)]); sum += c; cnt += (c > 0u) ? 1u : 0u; mine = (j == x) ? c : mine; }
        if (sum == G) break;
        __builtin_amdgcn_s_sleep(1);
        if ((++sp & 255u) == 0u) { if (xb_ld(&bar[XB_TMO])) break; if (sp > XB_SPIN_CAP) { atomicAdd(&bar[XB_TMO], 1u); break; } }
    }
    nloc = mine > 0u ? mine : 1u; nx = cnt > 0u ? cnt : 1u;
}

__device__ __noinline__ void xcd_barrier_ni(unsigned* bar_, unsigned x_, unsigned st_off, bool leader_thread, unsigned G_) {
    XcdBarrier b; b.bar = bar_; b.x = x_; b.st = (volatile LAS unsigned*)(uintptr_t)st_off;
    asm volatile("s_waitcnt vmcnt(0)" ::: "memory");
    __syncthreads();
    if (leader_thread) {
        unsigned* bar = b.bar;
        __builtin_amdgcn_s_waitcnt(0);
        unsigned nloc = b.st[0], nx = b.st[1];
        if (nloc == 0u) { xcd_barrier_complete(bar, b.x, nloc, nx, G_); b.st[0] = nloc; b.st[1] = nx; }
        const unsigned old = xb_add(&bar[XB_XSUB(b.x)], 1u);
        const unsigned gen = old / nloc;
        if (old + 1u == (gen + 1u) * nloc) {
            __builtin_amdgcn_fence(__ATOMIC_RELEASE, "agent");
            asm volatile("s_waitcnt vmcnt(0)" ::: "memory");
            const unsigned og = xb_add(&bar[XB_TOP], 1u);
            const unsigned tg = og / nx;
            if (og + 1u == (tg + 1u) * nx) xb_add(&bar[XB_TOPGEN], 1u);
            else XB_SPIN(xb_ld(&bar[XB_TOPGEN]) == tg, bar);
            __builtin_amdgcn_fence(__ATOMIC_ACQUIRE, "agent");
            xb_add(&bar[XB_XGEN(b.x)], 1u);
            asm volatile("s_waitcnt vmcnt(0)" ::: "memory");
        } else {
            XB_SPIN(xb_ld(&bar[XB_XGEN(b.x)]) == gen, bar);
            __builtin_amdgcn_fence(__ATOMIC_ACQUIRE, "agent");
            asm volatile("s_waitcnt vmcnt(0)" ::: "memory");
        }
    }
    __syncthreads();
}
__device__ __forceinline__ void xcd_barrier(const XcdBarrier& b, bool leader_thread, unsigned G) { xcd_barrier_ni(b.bar, b.x, (unsigned)(uintptr_t)b.st, leader_thread, G); }

struct Frame {
    LAS unsigned char* lds;
    gu32* ctl;
    int tid, lane, wave, bid, G, vcu;
};
struct Job { const float* src; bf16* dst; const float* scale; int ldw, K, col0, nvalid, nblk, row0, item0, f8; float mul; int pad; };
constexpr int NJOBS = 16;
struct Args {
    const float* in[22]; float* out; unsigned char* ws; Job jobs[NJOBS];
    int njob_items, ph_lo, ph_hi, pad;
};
typedef const __attribute__((address_space(4))) Args* ArgsP;

struct TrItem { const float* src; const float* scale; bf16* dst; int ldw, k0, colbase, nvalid, perm, dstK, drow0, f8; float mul; };
__device__ __forceinline__ void tr_load(f32x4 (&v)[16], const TrItem& I, int lane, int wid) {
#pragma unroll
    for (int rr = 0; rr < 16; ++rr) {
        const int k = rr * 8 + wid, n = 4 * lane;
        const float* srow = I.src + (size_t)(I.k0 + k) * I.ldw + I.colbase;
        const int col = (I.perm && n >= 128) ? n + 896 : n;
        if (n + 3 < I.nvalid) v[rr] = __builtin_nontemporal_load((const f32x4*)(srow + col));
        else { f32x4 t; t[0] = (n < I.nvalid) ? srow[col] : 0.f; t[1] = (n + 1 < I.nvalid) ? srow[col + 1] : 0.f; t[2] = (n + 2 < I.nvalid) ? srow[col + 2] : 0.f; t[3] = 0.f; v[rr] = t; }
    }
}
__device__ __forceinline__ void tr_to_lds(const f32x4 (&v)[16], LAS float* scr, const TrItem& I, int lane, int wid) {
#pragma unroll
    for (int rr = 0; rr < 16; ++rr) {
        const int k = rr * 8 + wid;
        const float sc = I.scale ? I.scale[I.k0 + k] * I.mul : I.mul;
        *(LAS f32x4*)(scr + k * 256 + 4 * (lane ^ ((k >> 3) & 15))) = v[rr] * sc;
    }
}
__device__ __forceinline__ void tr_store(const LAS float* scr, const TrItem& I, int lane, int wid) {
#pragma unroll
    for (int q = 0; q < 8; ++q) {
        const int n = wid * 32 + q * 4 + (lane >> 4), a = lane & 15;
        const LAS float* s = scr + (8 * a) * 256 + 4 * ((n >> 2) ^ a) + (n & 3);
        if (I.f8) { u32x2 o; o.x = pg8::pk4_fp8(s[0], s[256], s[2 * 256], s[3 * 256]); o.y = pg8::pk4_fp8(s[4 * 256], s[5 * 256], s[6 * 256], s[7 * 256]);
            __builtin_nontemporal_store(o, (u32x2*)((unsigned char*)I.dst + (size_t)(I.drow0 + n) * I.dstK + I.k0 + 8 * a)); }
        else { u32x4 o; o.x = pk2(s[0], s[256]); o.y = pk2(s[2 * 256], s[3 * 256]); o.z = pk2(s[4 * 256], s[5 * 256]); o.w = pk2(s[6 * 256], s[7 * 256]);
            *(u32x4*)(I.dst + (size_t)(I.drow0 + n) * I.dstK + I.k0 + 8 * a) = o; }
    }
}
__device__ __forceinline__ void sincos_d(double x, float& c, float& s) {
    const double TWO_PI = 6.283185307179586476925, INV_2PI = 0.15915494309189533577;
    const double r = x - TWO_PI * rint(x * INV_2PI), r2 = r * r;
    double sn = 1.0, cs = 1.0;
#pragma unroll
    for (int k = 14; k >= 1; --k) { sn = 1.0 - sn * r2 / (double)((2 * k) * (2 * k + 1)); cs = 1.0 - cs * r2 / (double)((2 * k - 1) * (2 * k)); }
    s = (float)(sn * r); c = (float)cs;
}
constexpr int MOE_ITEMS = DEPTH * NEXP * 96, MOE_ITEMS_LAYER = NEXP * 96;
#ifndef MK_CVT_LAYERS_P0
#define MK_CVT_LAYERS_P0 4
#endif
__device__ __forceinline__ TrItem tr_decode(ArgsP A, unsigned char* ws, int it) {
    TrItem I;
    if (it < MOE_ITEMS) {
        const int le = it / 96, r = it % 96; I.scale = nullptr; I.nvalid = 256; I.dstK = 1024; I.f8 = 1;
        if (r < 64) { const int kb = r >> 3, nb = r & 7; I.src = A->in[16] + (size_t)le * (1024 * 2048); I.ldw = 2048; I.k0 = kb * 128; I.colbase = nb * 128; I.perm = 1;
            I.dst = (bf16*)(ws + WS_WGU + (size_t)le * (2048 * 1024)); I.drow0 = nb * 256; I.mul = 64.0f; }
        else { const int r2 = r - 64, kb = r2 >> 2, nb = r2 & 3; I.src = A->in[18] + (size_t)le * (1024 * 1024); I.ldw = 1024; I.k0 = kb * 128; I.colbase = nb * 256; I.perm = 0;
            I.dst = (bf16*)(ws + WS_WDN + (size_t)le * (1024 * 1024)); I.drow0 = nb * 256; I.mul = 128.0f; }
    } else {
        const int ji = it - MOE_ITEMS; int j = 0;
#pragma unroll
        for (int q = 1; q < NJOBS; ++q) j += (A->jobs[q].item0 <= ji) ? 1 : 0;
        const int K = A->jobs[j].K, r = ji - A->jobs[j].item0, nkb = K >> 7, kb = r % nkb, nb = r / nkb;
        int nv = A->jobs[j].nvalid - nb * 256; nv = nv < 0 ? 0 : (nv > 256 ? 256 : nv);
        I.src = A->jobs[j].src; I.scale = A->jobs[j].scale; I.dst = A->jobs[j].dst; I.ldw = A->jobs[j].ldw; I.k0 = kb * 128; I.colbase = A->jobs[j].col0 + nb * 256; I.nvalid = nv; I.perm = 0;
        I.dstK = K; I.drow0 = A->jobs[j].row0 + nb * 256; I.f8 = A->jobs[j].f8; I.mul = A->jobs[j].mul;
    }
    return I;
}
__device__ __forceinline__ void tr_run(Frame& F, ArgsP A, unsigned char* ws, int j0, int step, int j1, int split, int gap) {
    LAS float* scr = (LAS float*)(F.lds + RING_OFF);
#define TR_ITEM(jj) tr_decode(A, ws, (jj) < split ? (jj) : (jj) + gap)
    if (j0 < j1) {
        f32x4 vA[16], vB[16];
        TrItem ia = TR_ITEM(j0), ib = ia;
        tr_load(vA, ia, F.lane, F.wave);
        if (j0 + step < j1) { ib = TR_ITEM(j0 + step); tr_load(vB, ib, F.lane, F.wave); }
        for (int j = j0; j < j1; j += 2 * step) {
            tr_to_lds(vA, scr, ia, F.lane, F.wave);
            __syncthreads();
            const TrItem ca = ia;
            if (j + 2 * step < j1) { ia = TR_ITEM(j + 2 * step); tr_load(vA, ia, F.lane, F.wave); }
            tr_store(scr, ca, F.lane, F.wave);
            __syncthreads();
            if (j + step < j1) {
                tr_to_lds(vB, scr, ib, F.lane, F.wave);
                __syncthreads();
                const TrItem cb = ib;
                if (j + 3 * step < j1) { ib = TR_ITEM(j + 3 * step); tr_load(vB, ib, F.lane, F.wave); }
                tr_store(scr, cb, F.lane, F.wave);
                __syncthreads();
            }
        }
    }
#undef TR_ITEM
}
__device__ __forceinline__ void p0_prologue(Frame& F, ArgsP A, unsigned char* ws, const int part) {
    constexpr int NP0 = MK_CVT_LAYERS_P0 * MOE_ITEMS_LAYER;
    const int total = NP0 + A->njob_items;
    const int it_lo = (part == 1) ? NP0 : 0, it_hi = (part == 2) ? NP0 : total;
    tr_run(F, A, ws, it_lo + F.bid, F.G, it_hi, NP0, MOE_ITEMS - NP0);
    if (part == 2) return;
    const size_t gt = (size_t)F.bid * NTHREADS + F.tid, NT = (size_t)F.G * NTHREADS;
    { const float* x = A->in[0]; bf16* xb = (bf16*)(ws + WS_XB);
      for (size_t i = gt; i < (size_t)T * D / 8; i += 4 * NT) {
          f32x4 a[4], b[4];
#pragma unroll
          for (int k = 0; k < 4; ++k) if (i + k * NT < (size_t)T * D / 8) { a[k] = *(const f32x4*)(x + (i + k * NT) * 8); b[k] = *(const f32x4*)(x + (i + k * NT) * 8 + 4); }
#pragma unroll
          for (int k = 0; k < 4; ++k) if (i + k * NT < (size_t)T * D / 8) { u32x4 o; o.x = pk2(a[k][0], a[k][1]); o.y = pk2(a[k][2], a[k][3]); o.z = pk2(b[k][0], b[k][1]); o.w = pk2(b[k][2], b[k][3]); *(u32x4*)(xb + (i + k * NT) * 8) = o; } }
      const float* mm = A->in[1]; bf16* mb = (bf16*)(ws + WS_MEMB);
      for (size_t i = gt; i < (size_t)NB * MEML * D / 8; i += NT) { const f32x4 a = *(const f32x4*)(mm + i * 8), b = *(const f32x4*)(mm + i * 8 + 4);
          u32x4 o; o.x = pk2(a[0], a[1]); o.y = pk2(a[2], a[3]); o.z = pk2(b[0], b[1]); o.w = pk2(b[2], b[3]); *(u32x4*)(mb + i * 8) = o; } }
    { f32x2* rt = (f32x2*)(ws + WS_ROPE);
      for (size_t i = gt; i < (size_t)SEQ * 8; i += NT) { const int pos = (int)(i >> 3), k = (int)(i & 7);
          const double inv = k == 0 ? 1.0 : k == 1 ? 0.19392274474868576 : k == 2 ? 0.03760603093086393 : k == 3 ? 0.007292664737217109 : k == 4 ? 0.001414213562373095 : k == 5 ? 0.0002742481756762073 : k == 6 ? 5.318295896944988e-05 : 1.031338537721246e-05;
          float c, s; sincos_d((double)pos * inv, c, s); rt[i] = (f32x2){c, s}; } }
}

struct AttnP {
    const bf16* Q; const bf16* K; const bf16* V; bf16* O; const unsigned long long* mask;
    int ldq, ldk, ldv, ldo, qrow0, krow0, t_lo, t_hi, qpos0, mode, has_sink, o8; float sink2;
};
constexpr int AT_K0 = 0, AT_KSZ = 64 * 144, AT_V0 = 2 * AT_KSZ, AT_VSZ = 8192;
__device__ __forceinline__ s16x4 vtr(const LAS unsigned char* p) { return __builtin_bit_cast(s16x4, __builtin_amdgcn_ds_read_tr16_b64_v4i16((LAS v4i16_t*)p)); }
__device__ __forceinline__ void attn_unit(const Frame& F, const AttnP& P) {
    const int tid = F.tid, lane = F.lane, wid = F.wave, r32 = lane & 31, hi = lane >> 5;
    LAS unsigned char* lds = F.lds + RING_OFF;
    const int skey = tid >> 3, sc = tid & 7;
    const int kdst = skey * 144 + sc * 16;
    const int vdst = (sc >> 2) * 4096 + (skey >> 4) * 1024 + (skey & 15) * 64 + (sc & 3) * 16;
    const bf16* kg = P.K + (size_t)(P.krow0 + skey) * P.ldk + sc * 8;
    const bf16* vg = P.V + (size_t)(P.krow0 + skey) * P.ldv + sc * 8;
    const int qrow = P.qrow0 + wid * 32 + r32;
    bf16x8 qr[4];
#pragma unroll
    for (int d0 = 0; d0 < 4; ++d0) qr[d0] = *(const bf16x8*)(P.Q + (size_t)qrow * P.ldq + d0 * 16 + hi * 8);
    const int qmin = P.qpos0 + wid * 32, qmax = qmin + 31, qpos = qmin + r32;
    float m = P.has_sink ? P.sink2 : NEG_BIG;
    f32x16 o0 = {}, o1 = {}, lacc;
#pragma unroll
    for (int r = 0; r < 16; ++r) lacc[r] = P.has_sink ? 1.f : 0.f;
    const bf16x8 ones8 = (bf16x8){0x3f80, 0x3f80, 0x3f80, 0x3f80, 0x3f80, 0x3f80, 0x3f80, 0x3f80};
    const int vp0 = ((lane >> 4) & 1) * 32 + (lane & 3) * 8 + (4 * hi + ((lane & 15) >> 2)) * 64;
    u32x4 kreg = *(const u32x4*)(kg + (size_t)P.t_lo * 64 * P.ldk), vreg = *(const u32x4*)(vg + (size_t)P.t_lo * 64 * P.ldv);
    const unsigned long long* mrow = P.mode == 2 ? P.mask + (size_t)(wid * 32 + r32) * 64 : nullptr;
    unsigned long long mcur = 0ull, mnxt = P.mode == 2 ? mrow[P.t_lo] : 0ull;
    *(LAS u32x4*)(lds + AT_K0 + kdst) = kreg; *(LAS u32x4*)(lds + AT_V0 + vdst) = vreg;
    __syncthreads();
    for (int t = P.t_lo; t < P.t_hi; ++t) {
        const int cur = (t - P.t_lo) & 1;
        const bool more = (t + 1 < P.t_hi);
        mcur = mnxt;
        if (more) { kreg = *(const u32x4*)(kg + (size_t)(t + 1) * 64 * P.ldk); vreg = *(const u32x4*)(vg + (size_t)(t + 1) * 64 * P.ldv); if (P.mode == 2) mnxt = mrow[t + 1]; }
        bool active = true;
        if (P.mode == 1) active = (64 * t + 63 >= qmin - 127) && (64 * t <= qmax);
        if (P.mode == 2) active = (64 * t <= qmax);
        if (active) {
            const LAS unsigned char* Kb = lds + AT_K0 + cur * AT_KSZ; const LAS unsigned char* Vb = lds + AT_V0 + cur * AT_VSZ;
            f32x16 p0 = {}, p1 = {};
#pragma unroll
            for (int d0 = 0; d0 < 4; ++d0) {
                const bf16x8 a0 = *(const LAS bf16x8*)(Kb + r32 * 144 + (2 * d0 + hi) * 16);
                const bf16x8 a1 = *(const LAS bf16x8*)(Kb + (r32 + 32) * 144 + (2 * d0 + hi) * 16);
                p0 = __builtin_amdgcn_mfma_f32_32x32x16_bf16(a0, qr[d0], p0, 0, 0, 0);
                p1 = __builtin_amdgcn_mfma_f32_32x32x16_bf16(a1, qr[d0], p1, 0, 0, 0);
            }
            float mx = fmaxf(p0[0], p1[0]);
#pragma unroll
            for (int r = 1; r < 16; ++r) mx = fmaxf(fmaxf(mx, p0[r]), p1[r]);
            mx = swapmax(mx) * C2;
            const float mnew = fmaxf(m, mx), alpha = __builtin_amdgcn_exp2f(m - mnew);
            m = mnew;
#pragma unroll
            for (int r = 0; r < 16; r += 2) {
                f32x2 a_ = {p0[r], p0[r + 1]}, b_ = {p1[r], p1[r + 1]}; const f32x2 c2_ = {C2, C2}, nm_ = {-mnew, -mnew};
                a_ = __builtin_elementwise_fma(a_, c2_, nm_); b_ = __builtin_elementwise_fma(b_, c2_, nm_);
                p0[r] = __builtin_amdgcn_exp2f(a_[0]); p0[r + 1] = __builtin_amdgcn_exp2f(a_[1]); p1[r] = __builtin_amdgcn_exp2f(b_[0]); p1[r + 1] = __builtin_amdgcn_exp2f(b_[1]); }
            if (P.mode == 1) {
                const int rel = qpos - 64 * t - 4 * hi;
#pragma unroll
                for (int r = 0; r < 16; ++r) { const int c = (r & 3) + 8 * (r >> 2);
                    p0[r] = ((unsigned)(rel - c) < 128u) ? p0[r] : 0.f; p1[r] = ((unsigned)(rel - c - 32) < 128u) ? p1[r] : 0.f; }
            } else if (P.mode == 2) {
                const unsigned long long w = mcur >> (4 * hi);
                const int wl = (int)(unsigned)w, wh = (int)(unsigned)(w >> 32);
#pragma unroll
                for (int r = 0; r < 16; ++r) { const int c = (r & 3) + 8 * (r >> 2);
                    int d0_ = __builtin_amdgcn_sbfe(wl, c, 1), d1_ = __builtin_amdgcn_sbfe(wh, c, 1); asm("" : "+v"(d0_), "+v"(d1_));
                    p0[r] = __uint_as_float(__float_as_uint(p0[r]) & (unsigned)d0_); p1[r] = __uint_as_float(__float_as_uint(p1[r]) & (unsigned)d1_); }
            }
            if (__any(alpha != 1.0f)) {
#pragma unroll
                for (int r = 0; r < 16; ++r) { o0[r] *= alpha; o1[r] *= alpha; lacc[r] *= alpha; }
            }
            bf16x8 pf[4];
            { u32x4 w;
              w.x = pk2(p0[0], p0[1]); w.y = pk2(p0[2], p0[3]); w.z = pk2(p0[4], p0[5]); w.w = pk2(p0[6], p0[7]); pf[0] = __builtin_bit_cast(bf16x8, w);
              w.x = pk2(p0[8], p0[9]); w.y = pk2(p0[10], p0[11]); w.z = pk2(p0[12], p0[13]); w.w = pk2(p0[14], p0[15]); pf[1] = __builtin_bit_cast(bf16x8, w);
              w.x = pk2(p1[0], p1[1]); w.y = pk2(p1[2], p1[3]); w.z = pk2(p1[4], p1[5]); w.w = pk2(p1[6], p1[7]); pf[2] = __builtin_bit_cast(bf16x8, w);
              w.x = pk2(p1[8], p1[9]); w.y = pk2(p1[10], p1[11]); w.z = pk2(p1[12], p1[13]); w.w = pk2(p1[14], p1[15]); pf[3] = __builtin_bit_cast(bf16x8, w); }
#pragma unroll
            for (int ks = 0; ks < 4; ++ks) {
                const s16x4 a_lo = vtr(Vb + vp0 + ks * 1024), a_hi = vtr(Vb + vp0 + ks * 1024 + 512);
                const s16x4 b_lo = vtr(Vb + vp0 + 4096 + ks * 1024), b_hi = vtr(Vb + vp0 + 4096 + ks * 1024 + 512);
                const bf16x8 va = (bf16x8){a_lo[0], a_lo[1], a_lo[2], a_lo[3], a_hi[0], a_hi[1], a_hi[2], a_hi[3]};
                const bf16x8 vb = (bf16x8){b_lo[0], b_lo[1], b_lo[2], b_lo[3], b_hi[0], b_hi[1], b_hi[2], b_hi[3]};
                o0 = __builtin_amdgcn_mfma_f32_32x32x16_bf16(va, pf[ks], o0, 0, 0, 0);
                o1 = __builtin_amdgcn_mfma_f32_32x32x16_bf16(vb, pf[ks], o1, 0, 0, 0);
                lacc = __builtin_amdgcn_mfma_f32_32x32x16_bf16(ones8, pf[ks], lacc, 0, 0, 0);
            }
        }
        if (more) { *(LAS u32x4*)(lds + AT_K0 + (cur ^ 1) * AT_KSZ + kdst) = kreg; *(LAS u32x4*)(lds + AT_V0 + (cur ^ 1) * AT_VSZ + vdst) = vreg; }
        __syncthreads();
    }
    const float inv = 1.0f / lacc[0];
    if (P.o8) {
        unsigned char* orow8 = (unsigned char*)P.O + (size_t)qrow * P.ldo + 4 * hi;
#pragma unroll
        for (int g = 0; g < 4; ++g) {
            *(unsigned*)(orow8 + 8 * g) = pg8::pk4_fp8(o0[4 * g] * inv, o0[4 * g + 1] * inv, o0[4 * g + 2] * inv, o0[4 * g + 3] * inv);
            *(unsigned*)(orow8 + 32 + 8 * g) = pg8::pk4_fp8(o1[4 * g] * inv, o1[4 * g + 1] * inv, o1[4 * g + 2] * inv, o1[4 * g + 3] * inv);
        }
        return;
    }
    bf16* orow = P.O + (size_t)qrow * P.ldo + 4 * hi;
#pragma unroll
    for (int g = 0; g < 4; ++g) {
        u32x2 w0, w1;
        w0.x = pk2(o0[4 * g] * inv, o0[4 * g + 1] * inv); w0.y = pk2(o0[4 * g + 2] * inv, o0[4 * g + 3] * inv);
        w1.x = pk2(o1[4 * g] * inv, o1[4 * g + 1] * inv); w1.y = pk2(o1[4 * g + 2] * inv, o1[4 * g + 3] * inv);
        *(u32x2*)(orow + 8 * g) = w0; *(u32x2*)(orow + 32 + 8 * g) = w1;
    }
}

__device__ __forceinline__ void conv_item(const bf16* PROJ, const float* cw, bf16* CAT, int idx) {
    const int chunk = idx % 96, run = idx / 96, c0 = chunk * 8, t0 = run * 16;
    float w0[8], w1[8], w2[8];
#pragma unroll
    for (int j = 0; j < 8; ++j) { w0[j] = cw[c0 + j]; w1[j] = cw[768 + c0 + j]; w2[j] = cw[1536 + c0 + j]; }
    float z1[8], z2[8];
#pragma unroll
    for (int j = 0; j < 8; ++j) { z1[j] = 0.f; z2[j] = 0.f; }
    if ((t0 & (SEQ - 1)) != 0) {
#pragma unroll
        for (int back = 2; back >= 1; --back) {
            const bf16* row = PROJ + (size_t)(t0 - back) * 2560;
            const u32x4 uu = *(const u32x4*)(row + c0), cc = *(const u32x4*)(row + 1536 + c0);
            float z[8];
            z[0] = bflo(uu.x) * bflo(cc.x); z[1] = bfhi(uu.x) * bfhi(cc.x); z[2] = bflo(uu.y) * bflo(cc.y); z[3] = bfhi(uu.y) * bfhi(cc.y);
            z[4] = bflo(uu.z) * bflo(cc.z); z[5] = bfhi(uu.z) * bfhi(cc.z); z[6] = bflo(uu.w) * bflo(cc.w); z[7] = bfhi(uu.w) * bfhi(cc.w);
#pragma unroll
            for (int j = 0; j < 8; ++j) { if (back == 2) z2[j] = z[j]; else z1[j] = z[j]; }
        }
    }
    u32x4 in_[2][4][3];
#define CONV_LOADG(G, S) do { _Pragma("unroll") for (int k = 0; k < 4; ++k) { const bf16* row = PROJ + (size_t)(t0 + 4 * (G) + k) * 2560; \
        in_[S][k][0] = *(const u32x4*)(row + c0); in_[S][k][1] = *(const u32x4*)(row + 768 + c0); in_[S][k][2] = *(const u32x4*)(row + 1536 + c0); } } while (0)
    CONV_LOADG(0, 0);
#pragma unroll
    for (int g = 0; g < 4; ++g) {
        if (g < 3) CONV_LOADG(g + 1, (g + 1) & 1);
#pragma unroll
        for (int k = 0; k < 4; ++k) {
            const int i = 4 * g + k;
            const u32x4 uu = in_[g & 1][k][0], bb = in_[g & 1][k][1], cc = in_[g & 1][k][2];
            float z[8], b[8], r[8];
            z[0] = bflo(uu.x) * bflo(cc.x); z[1] = bfhi(uu.x) * bfhi(cc.x); z[2] = bflo(uu.y) * bflo(cc.y); z[3] = bfhi(uu.y) * bfhi(cc.y);
            z[4] = bflo(uu.z) * bflo(cc.z); z[5] = bfhi(uu.z) * bfhi(cc.z); z[6] = bflo(uu.w) * bflo(cc.w); z[7] = bfhi(uu.w) * bfhi(cc.w);
            b[0] = bflo(bb.x); b[1] = bfhi(bb.x); b[2] = bflo(bb.y); b[3] = bfhi(bb.y); b[4] = bflo(bb.z); b[5] = bfhi(bb.z); b[6] = bflo(bb.w); b[7] = bfhi(bb.w);
#pragma unroll
            for (int j = 0; j < 8; ++j) { r[j] = b[j] * ((w0[j] * z2[j] + w1[j] * z1[j]) + w2[j] * z[j]); z2[j] = z1[j]; z1[j] = z[j]; }
            u32x4 o; o.x = pk2(r[0], r[1]); o.y = pk2(r[2], r[3]); o.z = pk2(r[4], r[5]); o.w = pk2(r[6], r[7]);
            (void)o; u32x2 o8_; o8_.x = pg8::pk4_fp8(r[0], r[1], r[2], r[3]); o8_.y = pg8::pk4_fp8(r[4], r[5], r[6], r[7]); *(u32x2*)((unsigned char*)CAT + (size_t)(t0 + i) * 1024 + c0) = o8_;
        }
    }
#undef CONV_LOADG
}

__device__ __forceinline__ void mixer_phase(Frame& F, ArgsP A, unsigned char* ws, int layer, int kind, int qidx) {
    const bf16* PROJ = (const bf16*)(ws + WS_PROJ); bf16* CAT = (bf16*)(ws + WS_CAT); const bf16* KVM = (const bf16*)(ws + WS_KVMEM) + layer * 512;
    const int nproj = kind == 0 ? 2560 : (kind == 1 ? 1280 : 1536), qm_off = kind == 0 ? 2304 : (kind == 1 ? 768 : 1280);
    const int n_main = kind == 0 ? 0 : 768, n_mem = 256, n_conv = kind == 0 ? 192 : 0;
    constexpr int CVT_PER = 12, N_CVT = (DEPTH - MK_CVT_LAYERS_P0) * MOE_ITEMS_LAYER / CVT_PER;
    const int n_cvt = (kind == 1) ? N_CVT : 0;
    const int total = n_main + n_mem + n_conv + n_cvt;
    volatile LAS unsigned* qw = (volatile LAS unsigned*)(F.lds + L_Q);
    for (;;) {
        if (F.tid == 0) *qw = __hip_atomic_fetch_add(F.ctl + CW_QHEAD + 64 * qidx, 1u, RLX_AGENT);
        __syncthreads();
        int u = (int)*qw;
        __syncthreads();
        if (u >= total) break;
        if (n_cvt) {
            if (u < 3 * n_cvt) { if (u % 3 == 2) { const int c = u / 3; tr_run(F, A, ws, MK_CVT_LAYERS_P0 * MOE_ITEMS_LAYER + c * CVT_PER, 1, MK_CVT_LAYERS_P0 * MOE_ITEMS_LAYER + c * CVT_PER + CVT_PER, MOE_ITEMS, 0); continue; } u = (u / 3) * 2 + u % 3; }
            else u -= n_cvt;
        }
        if (u < n_main) {
            AttnP P;
            if (kind == 1) {
                const int qt = 15 - u / 48, rem = u % 48, b = rem / 12, h = rem % 12, g = h / 3;
                P.Q = (const bf16*)(ws + WS_QQ) + h * 64; P.ldq = 1280; P.K = PROJ + 256 + g * 64; P.ldk = 1280; P.V = PROJ + 512 + g * 64; P.ldv = 1280;
                P.O = (bf16*)((unsigned char*)CAT + h * 64); P.ldo = 1024; P.o8 = 1; P.qrow0 = b * SEQ + qt * 256; P.krow0 = b * SEQ; P.t_lo = 0; P.t_hi = qt * 4 + 4; P.qpos0 = qt * 256; P.mode = 2;
                P.mask = (const unsigned long long*)(ws + WS_MASK) + (size_t)P.qrow0 * 64; P.has_sink = 0; P.sink2 = 0.f;
            } else {
                const int b = u / 192, h = (u / 16) % 12, qt = u % 16, g = h / 3;
                P.Q = PROJ + h * 64; P.ldq = 1536; P.K = PROJ + 768 + g * 64; P.ldk = 1536; P.V = PROJ + 1024 + g * 64; P.ldv = 1536;
                P.O = (bf16*)((unsigned char*)CAT + h * 64); P.ldo = 1024; P.o8 = 1; P.qrow0 = b * SEQ + qt * 256; P.krow0 = b * SEQ; P.qpos0 = qt * 256;
                P.t_lo = qt == 0 ? 0 : (qt * 256 - 128) / 64; P.t_hi = qt * 4 + 4; P.mode = 1; P.mask = nullptr; P.has_sink = 1; P.sink2 = A->in[9][h] * LOG2E;
            }
            attn_unit(F, P);
        } else if (u < n_main + n_mem) {
            const int v = u - n_main, b = v / 64, h = (v / 16) % 4, qt = v % 16;
            AttnP P;
            P.Q = PROJ + qm_off + h * 64; P.ldq = nproj; P.K = KVM + h * 64; P.ldk = 2048; P.V = KVM + 256 + h * 64; P.ldv = 2048;
            P.o8 = 1; P.O = P.o8 ? (bf16*)((unsigned char*)CAT + 768 + h * 64) : CAT + 768 + h * 64; P.ldo = 1024; P.qrow0 = b * SEQ + qt * 256; P.krow0 = b * MEML; P.t_lo = 0; P.t_hi = 4; P.qpos0 = qt * 256; P.mode = 0; P.mask = nullptr; P.has_sink = 0; P.sink2 = 0.f;
            attn_unit(F, P);
        } else {
            const int v = u - n_main - n_mem;
            conv_item(PROJ, A->in[3] + (size_t)(layer == 0 ? 0 : 1) * 3 * 768, CAT, v * NTHREADS + F.tid);
        }
    }
}

__device__ __forceinline__ void score_phase(Frame& F, const bf16* QQ, const bf16* PROJ, float* SC) {
    const int lane = F.lane, r32 = lane & 31, hi = lane >> 5;
    LAS float* wtab = (LAS float*)(F.lds + RING_OFF + F.wave * 1024);
    constexpr float WSCALE = 0.04419417382415922f;
    constexpr int PER_B = 576;
    const __amdgpu_buffer_rsrc_t scrs = __builtin_amdgcn_make_buffer_rsrc((void*)SC, 0, T * SEQ * 4, 0x00020000);
    for (int wu = F.bid * NWAVES + F.wave; wu < NB * PER_B; wu += F.G * NWAVES) {
        const int b = wu / PER_B, idx = PER_B - 1 - wu % PER_B;
        int g = 0;
        for (int k = 1; k < 8; ++k) g += (8 * k * (k + 1) <= idx) ? 1 : 0;
        const int r = idx - 8 * g * (g + 1), qb = 16 * g + r / (g + 1), c = r % (g + 1);
        const int kb_lo = 16 * c, kb_hi = (16 * c + 16 < qb + 1) ? 16 * c + 16 : qb + 1;
        const int t0 = b * SEQ + 32 * qb;
#pragma unroll
        for (int k = 0; k < 4; ++k) { const int i4 = lane * 4 + k, h = i4 >> 5, hh = (i4 >> 4) & 1, reg = i4 & 15;
            wtab[i4] = bf2f(PROJ[(size_t)(t0 + crow(reg, hh)) * 1280 + 1088 + h]) * WSCALE; }
        bf16x8 qA[8][4];
#pragma unroll
        for (int h = 0; h < 8; ++h)
#pragma unroll
            for (int st = 0; st < 4; ++st) qA[h][st] = *(const bf16x8*)(QQ + (size_t)(t0 + r32) * 1280 + 768 + h * 64 + st * 16 + hi * 8);
        const bf16* kbase = PROJ + (size_t)(b * SEQ + r32) * 1280 + 1024 + hi * 8;
        bf16x8 kA[4], kBf[4];
#pragma unroll
        for (int st = 0; st < 4; ++st) kA[st] = *(const bf16x8*)(kbase + (size_t)(32 * kb_lo) * 1280 + st * 16);
#define PS_BLOCK(KF, KB) do { f32x16 acc = {}; \
            _Pragma("unroll") for (int h = 0; h < 8; ++h) { f32x16 dd = {}; \
                _Pragma("unroll") for (int st = 0; st < 4; ++st) dd = __builtin_amdgcn_mfma_f32_32x32x16_bf16(qA[h][st], KF[st], dd, 0, 0, 0); \
                const LAS f32x4* wp = (const LAS f32x4*)(wtab + (h * 2 + hi) * 16); const f32x4 w0 = wp[0], w1 = wp[1], w2 = wp[2], w3 = wp[3]; \
                _Pragma("unroll") for (int q = 0; q < 4; ++q) { acc[q] = fmaf(w0[q], fmaxf(dd[q], 0.f), acc[q]); acc[4 + q] = fmaf(w1[q], fmaxf(dd[4 + q], 0.f), acc[4 + q]); \
                    acc[8 + q] = fmaf(w2[q], fmaxf(dd[8 + q], 0.f), acc[8 + q]); acc[12 + q] = fmaf(w3[q], fmaxf(dd[12 + q], 0.f), acc[12 + q]); } \
                if (h & 1) __builtin_amdgcn_sched_barrier(0); } \
            _Pragma("unroll") for (int reg = 0; reg < 16; ++reg) __builtin_amdgcn_raw_buffer_store_b32(__float_as_uint(acc[reg]), scrs, (4 * hi * SEQ + r32) * 4, ((t0 + (reg & 3) + 8 * (reg >> 2)) * SEQ + 32 * (KB)) * 4, 0); } while (0)
        for (int kb = kb_lo; kb < kb_hi; kb += 2) {
            __builtin_amdgcn_sched_barrier(0);
            if (kb + 1 < kb_hi) {
#pragma unroll
                for (int st = 0; st < 4; ++st) kBf[st] = *(const bf16x8*)(kbase + (size_t)(32 * (kb + 1)) * 1280 + st * 16);
            }
            __builtin_amdgcn_sched_barrier(0);
            PS_BLOCK(kA, kb);
            __builtin_amdgcn_sched_barrier(0);
            if (kb + 1 < kb_hi) {
                if (kb + 2 < kb_hi) {
#pragma unroll
                    for (int st = 0; st < 4; ++st) kA[st] = *(const bf16x8*)(kbase + (size_t)(32 * (kb + 2)) * 1280 + st * 16);
                }
                __builtin_amdgcn_sched_barrier(0);
                PS_BLOCK(kBf, kb + 1);
            }
        }
#undef PS_BLOCK
    }
}
__device__ __forceinline__ void select_phase(Frame& F, const float* SC, unsigned long long* MASK) {
    const int qstride = F.G * NWAVES;
    unsigned raw[64];
#define SEL_LOAD(qq) do { const int pos_ = (qq) & (SEQ - 1); if ((qq) < T && pos_ >= 256) { int ln_ = lane_id_now(); const int ni_ = (pos_ >> 6) + 1; const float* row_ = SC + (size_t)(qq) * SEQ; \
        _Pragma("unroll") for (int gq = 0; gq < 4; ++gq) if (ni_ > 16 * gq) { _Pragma("unroll") for (int i = 16 * gq; i < 16 * gq + 16; ++i) { const int s_ = 64 * i + ln_; raw[i] = __float_as_uint(row_[s_ <= pos_ ? s_ : pos_]); } } } } while (0)
    int q0_ = F.bid * NWAVES + F.wave;
    SEL_LOAD(q0_);
    for (int q = q0_; q < T; q += qstride) {
        int lane = F.lane; asm volatile("" : "+v"(lane));
        const int pos = q & (SEQ - 1);
        unsigned long long myword = 0ull;
        if (pos < 256) {
            const int lo = 64 * lane;
            myword = (lo > pos) ? 0ull : ((pos - lo >= 63) ? ~0ull : ((1ull << (pos - lo + 1)) - 1ull));
            SEL_LOAD(q + qstride);
        } else {
            const int ni = (pos >> 6) + 1;
            unsigned key[64];
#pragma unroll
            for (int i = 0; i < 64; ++i) key[i] = 0u;
#pragma unroll
            for (int gq = 0; gq < 4; ++gq) if (ni > 16 * gq) {
#pragma unroll
                for (int i = 16 * gq; i < 16 * gq + 16; ++i) { const int s = 64 * i + lane; unsigned bts = raw[i]; if (bts == 0x80000000u) bts = 0u;
                    const unsigned kk = (bts & 0x80000000u) ? ~bts : (bts | 0x80000000u); key[i] = (s <= pos) ? kk : 0u; } }
            SEL_LOAD(q + qstride);
            auto count_ge = [&](const unsigned Tp) -> int {
                int cA = 0, cB = 0, cC = 0, cD = 0;
#pragma unroll
                for (int gq = 0; gq < 4; ++gq) if (ni > 16 * gq) {
                    unsigned long long m0_, m1_, m2_, m3_;
                    asm("v_cmp_le_u32_e64 %4, %8, %9\n\tv_cmp_le_u32_e64 %5, %8, %10\n\tv_cmp_le_u32_e64 %6, %8, %11\n\tv_cmp_le_u32_e64 %7, %8, %12\n\tv_addc_co_u32_e64 %0, %4, 0, %0, %4\n\tv_addc_co_u32_e64 %1, %5, 0, %1, %5\n\tv_addc_co_u32_e64 %2, %6, 0, %2, %6\n\tv_addc_co_u32_e64 %3, %7, 0, %3, %7\n\tv_cmp_le_u32_e64 %4, %8, %13\n\tv_cmp_le_u32_e64 %5, %8, %14\n\tv_cmp_le_u32_e64 %6, %8, %15\n\tv_cmp_le_u32_e64 %7, %8, %16\n\tv_addc_co_u32_e64 %0, %4, 0, %0, %4\n\tv_addc_co_u32_e64 %1, %5, 0, %1, %5\n\tv_addc_co_u32_e64 %2, %6, 0, %2, %6\n\tv_addc_co_u32_e64 %3, %7, 0, %3, %7\n\tv_cmp_le_u32_e64 %4, %8, %17\n\tv_cmp_le_u32_e64 %5, %8, %18\n\tv_cmp_le_u32_e64 %6, %8, %19\n\tv_cmp_le_u32_e64 %7, %8, %20\n\tv_addc_co_u32_e64 %0, %4, 0, %0, %4\n\tv_addc_co_u32_e64 %1, %5, 0, %1, %5\n\tv_addc_co_u32_e64 %2, %6, 0, %2, %6\n\tv_addc_co_u32_e64 %3, %7, 0, %3, %7\n\tv_cmp_le_u32_e64 %4, %8, %21\n\tv_cmp_le_u32_e64 %5, %8, %22\n\tv_cmp_le_u32_e64 %6, %8, %23\n\tv_cmp_le_u32_e64 %7, %8, %24\n\tv_addc_co_u32_e64 %0, %4, 0, %0, %4\n\tv_addc_co_u32_e64 %1, %5, 0, %1, %5\n\tv_addc_co_u32_e64 %2, %6, 0, %2, %6\n\tv_addc_co_u32_e64 %3, %7, 0, %3, %7"
                        : "+v"(cA), "+v"(cB), "+v"(cC), "+v"(cD), "=&s"(m0_), "=&s"(m1_), "=&s"(m2_), "=&s"(m3_) : "s"(Tp), "v"(key[16 * gq + 0]), "v"(key[16 * gq + 1]), "v"(key[16 * gq + 2]), "v"(key[16 * gq + 3]), "v"(key[16 * gq + 4]), "v"(key[16 * gq + 5]), "v"(key[16 * gq + 6]), "v"(key[16 * gq + 7]), "v"(key[16 * gq + 8]), "v"(key[16 * gq + 9]), "v"(key[16 * gq + 10]), "v"(key[16 * gq + 11]), "v"(key[16 * gq + 12]), "v"(key[16 * gq + 13]), "v"(key[16 * gq + 14]), "v"(key[16 * gq + 15])); }
                const int cl = (cA + cB) + (cC + cD);
                int c = 0;
#pragma unroll
                for (int bb = 0; bb < 7; ++bb) c += __popcll(__ballot((cl >> bb) & 1)) << bb;
                return c; };
            unsigned kmx = 0u;
#pragma unroll
            for (int i = 0; i < 64; ++i) kmx = key[i] > kmx ? key[i] : kmx;
#pragma unroll
            for (int o = 1; o < 64; o <<= 1) { const unsigned ov = (unsigned)shxi((int)kmx, o); kmx = ov > kmx ? ov : kmx; }
            kmx = (unsigned)__builtin_amdgcn_readfirstlane((int)kmx);
            unsigned lo = 0u, hi = kmx + 1u; int clo = pos + 1, chi = 0;
            if (kmx > 0x82000000u) { const unsigned l2 = (kmx & 0xff800000u) - 0x02000000u; const int c2 = count_ge(l2); if (c2 >= 256) { lo = l2; clo = c2; } else { hi = l2; chi = c2; } }
            float flo = (float)clo - 255.5f, fhi = (float)chi - 255.5f; int side = 0;
            for (int it = 0; it < 96; ++it) {
                if (clo == 256 || hi - lo <= 1u) break;
                const unsigned span = hi - lo;
                unsigned mid;
                if (it % 3 == 2) mid = lo + (span >> 1);
                else { const float tt = flo / (flo - fhi); unsigned d = (unsigned)((float)span * tt); d = d < 1u ? 1u : (d > span - 1u ? span - 1u : d); mid = lo + d; }
                mid = (unsigned)__builtin_amdgcn_readfirstlane((int)mid);
                const int c = count_ge(mid);
                if (c >= 256) { lo = mid; clo = c; flo = (float)c - 255.5f; if (side == 1) fhi *= 0.5f; side = 1; }
                else { hi = mid; chi = c; fhi = (float)c - 255.5f; if (side == -1) flo *= 0.5f; side = -1; }
            }
            const unsigned Tk = lo; const int cT = clo;
            int need = 256, base = 0;
            if (cT != 256) {
                int cl = 0;
#pragma unroll
                for (int i = 0; i < 64; ++i) cl += (key[i] > Tk) ? 1 : 0;
                int cgt = 0;
#pragma unroll
                for (int bb = 0; bb < 7; ++bb) cgt += __popcll(__ballot((cl >> bb) & 1)) << bb;
                need = 256 - cgt;
            }
            int wlo = 0, whi = 0;
            if (cT == 256) {
#pragma unroll
                for (int i = 0; i < 64; ++i) { const unsigned long long wsel = __ballot(key[i] >= Tk);
                    asm("s_nop 4\n\tv_writelane_b32 %0, %2, %4\n\tv_writelane_b32 %1, %3, %4" : "+v"(wlo), "+v"(whi) : "s"((int)(unsigned)wsel), "s"((int)(unsigned)(wsel >> 32)), "n"(i)); }
            } else {
                const unsigned long long ltmask = (1ull << lane) - 1ull;
#pragma unroll
                for (int i = 0; i < 64; ++i) {
                    const unsigned long long eq = __ballot(key[i] == Tk); const int rank = base + __popcll(eq & ltmask);
                    const bool sel = (key[i] > Tk) || (key[i] == Tk && rank < need); base += __popcll(eq);
                    const unsigned long long wsel = __ballot(sel);
                    asm("s_nop 4\n\tv_writelane_b32 %0, %2, %4\n\tv_writelane_b32 %1, %3, %4" : "+v"(wlo), "+v"(whi) : "s"((int)(unsigned)wsel), "s"((int)(unsigned)(wsel >> 32)), "n"(i));
                }
            }
            myword = ((unsigned long long)(unsigned)whi << 32) | (unsigned long long)(unsigned)wlo;
        }
        MASK[(size_t)q * 64 + lane] = myword;
    }
}

#undef SEL_LOAD
__device__ __forceinline__ void ln1_phase(Frame& F, const bf16* xres, const bf16* Y, const float* g1, const float* b1, bf16* XMB, const float* rw, const float* rb,
                                          bf16* XP, gu32* gcount, int* ROWS, float* GATES, const int pmode = 3) {
    const int lane = F.lane, wid = F.wave, tid = F.tid;
    float ALPHA_ = ALPHA; asm volatile("" : "+v"(ALPHA_));
    LAS float* x32 = (LAS float*)(F.lds + RING_OFF);
    volatile LAS unsigned* cnt = (volatile LAS unsigned*)(F.lds + L_CNT); volatile LAS unsigned* base = (volatile LAS unsigned*)(F.lds + L_BASE);
    LAS int* route = (LAS int*)(F.lds + L_ROUTE);
    const int e = lane & 31, half = lane >> 5;
    const float rbe = rb[e];
    const __amdgpu_buffer_rsrc_t xrs_ = __builtin_amdgcn_make_buffer_rsrc((void*)xres, 0, T * D * 2, 0x00020000), yrs_ = __builtin_amdgcn_make_buffer_rsrc((void*)Y, 0, T * D * 2, 0x00020000);
    for (int chunk = F.bid; chunk < T / 64; chunk += F.G) {
        if (tid < 32) cnt[tid] = 0u;
        __syncthreads();
        u32x2 rxn[4][4], ryn[4][4];
#define LN1_LOAD(B) do { _Pragma("unroll") for (int rr = 0; rr < 4; ++rr) { const int ro_ = (chunk * 64 + wid * 8 + (B) * 4 + rr) * (D * 2);       \
            _Pragma("unroll") for (int j = 0; j < 4; ++j) { rxn[rr][j] = __builtin_bit_cast(u32x2, __builtin_amdgcn_raw_buffer_load_b64(xrs_, lane * 8, ro_ + 512 * j, 0)); ryn[rr][j] = __builtin_bit_cast(u32x2, __builtin_amdgcn_raw_buffer_load_b64(yrs_, lane * 8, ro_ + 512 * j, 0)); } } } while (0)
        LN1_LOAD(0);
#pragma unroll 1
        for (int batch = 0; batch < 2; ++batch) {
            const int lrow0 = wid * 8 + batch * 4, row0 = chunk * 64 + lrow0;
            u32x2 rx[4][4], ry[4][4];
#pragma unroll
            for (int rr = 0; rr < 4; ++rr)
#pragma unroll
                for (int j = 0; j < 4; ++j) { rx[rr][j] = rxn[rr][j]; ry[rr][j] = ryn[rr][j]; }
            if (batch == 0) LN1_LOAD(1);
            float xv[4][16], mean_[4], rstd_[4];
#pragma unroll
            for (int rr = 0; rr < 4; ++rr) { float s = 0.f;
#pragma unroll
                for (int j = 0; j < 4; ++j) { const u32x2 xx = rx[rr][j], yy = ry[rr][j];
                    xv[rr][4 * j] = ALPHA_ * bflo(xx.x) + bflo(yy.x); xv[rr][4 * j + 1] = ALPHA_ * bfhi(xx.x) + bfhi(yy.x); xv[rr][4 * j + 2] = ALPHA_ * bflo(xx.y) + bflo(yy.y); xv[rr][4 * j + 3] = ALPHA_ * bfhi(xx.y) + bfhi(yy.y);
                    s += (xv[rr][4 * j] + xv[rr][4 * j + 1]) + (xv[rr][4 * j + 2] + xv[rr][4 * j + 3]); }
                mean_[rr] = s; }
#pragma unroll
            for (int rr = 0; rr < 4; ++rr) mean_[rr] = wave_sum(mean_[rr]);
#pragma unroll
            for (int rr = 0; rr < 4; ++rr) { mean_[rr] *= (1.f / D); float s2 = 0.f;
#pragma unroll
                for (int k = 0; k < 16; ++k) { xv[rr][k] -= mean_[rr]; s2 += xv[rr][k] * xv[rr][k]; }
                rstd_[rr] = s2; }
            __builtin_amdgcn_sched_barrier(0);
            f32x4 gg_[4], bb_[4];
#pragma unroll
            for (int j = 0; j < 4; ++j) { gg_[j] = __builtin_bit_cast(f32x4, __builtin_amdgcn_raw_buffer_load_b128(__builtin_amdgcn_make_buffer_rsrc((void*)g1, 0, D * 4, 0x00020000), lane * 16, j * 1024, 0)); bb_[j] = __builtin_bit_cast(f32x4, __builtin_amdgcn_raw_buffer_load_b128(__builtin_amdgcn_make_buffer_rsrc((void*)b1, 0, D * 4, 0x00020000), lane * 16, j * 1024, 0)); }
            __builtin_amdgcn_sched_barrier(0);
#pragma unroll
            for (int rr = 0; rr < 4; ++rr) rstd_[rr] = wave_sum(rstd_[rr]);
#pragma unroll
            for (int rr = 0; rr < 4; ++rr) { const float rstd = 1.0f / sqrtf(rstd_[rr] * (1.f / D) + LN_EPS);
#pragma unroll
                for (int j = 0; j < 4; ++j) { const f32x4 gg = gg_[j], bb = bb_[j];
                    f32x4 o;
#pragma unroll
                    for (int k = 0; k < 4; ++k) o[k] = xv[rr][4 * j + k] * rstd * gg[k] + bb[k];
                    u32x2 pb; pb.x = pk2(o[0], o[1]); pb.y = pk2(o[2], o[3]);
                    *(u32x2*)(XMB + (size_t)(row0 + rr) * D + 4 * lane + 256 * j) = pb;
                    *(LAS f32x4*)(x32 + (wid * 4 + rr) * 1028 + 4 * lane + 256 * j) = o; } }
            float a0 = 0.f, a1 = 0.f, a2 = 0.f, a3 = 0.f;
            float wA[32], wB[32];
            const __amdgpu_buffer_rsrc_t wrs = __builtin_amdgcn_make_buffer_rsrc((void*)rw, 0, D * NEXP * 4, 0x00020000);
            const int wvo = ((wid * 128 + half * 4) * 32 + e) * 4;
            __builtin_amdgcn_sched_barrier(0);
            if (pmode & 1) {
#pragma unroll
                for (int i = 0; i < 8; ++i)
#pragma unroll
                    for (int t = 0; t < 4; ++t) wA[4 * i + t] = __uint_as_float(__builtin_amdgcn_raw_buffer_load_b32(wrs, wvo, (8 * i + t) * 128, 0));
            }
            __builtin_amdgcn_sched_barrier(0);
            __syncthreads();
            if (pmode & 1) {
                f32x16 pacc, pacc1;
#pragma unroll
                for (int r = 0; r < 16; ++r) { pacc[r] = 0.f; pacc1[r] = 0.f; }
                const LAS float* xa = x32 + (lane & 31) * 1028 + wid * 128 + half * 4;
                f32x4 xq[16];
#pragma unroll
                for (int i = 0; i < 8; ++i) xq[i] = *(const LAS f32x4*)(xa + 8 * i);
#pragma unroll
                for (int i = 0; i < 8; ++i)
#pragma unroll
                    for (int t = 0; t < 4; ++t) wB[4 * i + t] = __uint_as_float(__builtin_amdgcn_raw_buffer_load_b32(wrs, wvo, (64 + 8 * i + t) * 128, 0));
#pragma unroll
                for (int i = 0; i < 8; ++i) {
                    pacc = __builtin_amdgcn_mfma_f32_32x32x2f32(xq[i][0], wA[4 * i + 0], pacc, 0, 0, 0); pacc1 = __builtin_amdgcn_mfma_f32_32x32x2f32(xq[i][1], wA[4 * i + 1], pacc1, 0, 0, 0);
                    pacc = __builtin_amdgcn_mfma_f32_32x32x2f32(xq[i][2], wA[4 * i + 2], pacc, 0, 0, 0); pacc1 = __builtin_amdgcn_mfma_f32_32x32x2f32(xq[i][3], wA[4 * i + 3], pacc1, 0, 0, 0); }
                __builtin_amdgcn_sched_barrier(0);
#pragma unroll
                for (int i = 8; i < 16; ++i) xq[i] = *(const LAS f32x4*)(xa + 8 * i);
#pragma unroll
                for (int i = 0; i < 8; ++i) {
                    pacc = __builtin_amdgcn_mfma_f32_32x32x2f32(xq[8 + i][0], wB[4 * i + 0], pacc, 0, 0, 0); pacc1 = __builtin_amdgcn_mfma_f32_32x32x2f32(xq[8 + i][1], wB[4 * i + 1], pacc1, 0, 0, 0);
                    pacc = __builtin_amdgcn_mfma_f32_32x32x2f32(xq[8 + i][2], wB[4 * i + 2], pacc, 0, 0, 0); pacc1 = __builtin_amdgcn_mfma_f32_32x32x2f32(xq[8 + i][3], wB[4 * i + 3], pacc1, 0, 0, 0); }
#pragma unroll
                for (int r = 0; r < 16; ++r) pacc[r] += pacc1[r];
                __syncthreads();
                LAS float* pw = x32 + wid * 1024 + e;
#pragma unroll
                for (int r = 0; r < 16; ++r) pw[crow(r, half) * 32] = pacc[r];
                __syncthreads();
                const LAS float* pr = x32 + (half * 4) * 1024 + (wid * 4) * 32 + e;
#pragma unroll
                for (int q = 0; q < 4; ++q) { a0 += pr[q * 1024]; a1 += pr[q * 1024 + 32]; a2 += pr[q * 1024 + 64]; a3 += pr[q * 1024 + 96]; }
            } else { __syncthreads(); __syncthreads(); }
            __syncthreads();
            float lg[4]; lg[0] = a0 + shx(a0, 32) + rbe; lg[1] = a1 + shx(a1, 32) + rbe; lg[2] = a2 + shx(a2, 32) + rbe; lg[3] = a3 + shx(a3, 32) + rbe;
            float selv[4][4]; int seli[4][4];
#pragma unroll
            for (int rr = 0; rr < 4; ++rr) {
                float v = lg[rr];
#pragma unroll
                for (int k = 0; k < 4; ++k) {
                    float bv = v; int bi = e;
#pragma unroll
                    for (int msk = 1; msk < 32; msk <<= 1) { const float ov = shx(bv, msk); const int oi = shxi(bi, msk); if (ov > bv || (ov == bv && oi < bi)) { bv = ov; bi = oi; } }
                    selv[rr][k] = bv; seli[rr][k] = bi;
                    if (bi == e) v = -INFINITY;
                }
            }
            if (lane < 16) {
                const int rr = lane >> 2, k = lane & 3;
                float sv[4]; int si[4];
#pragma unroll
                for (int q = 0; q < 4; ++q) { sv[q] = rr == 0 ? selv[0][q] : rr == 1 ? selv[1][q] : rr == 2 ? selv[2][q] : selv[3][q]; si[q] = rr == 0 ? seli[0][q] : rr == 1 ? seli[1][q] : rr == 2 ? seli[2][q] : seli[3][q]; }
                const float ex1 = __expf(sv[1] - sv[0]), ex2 = __expf(sv[2] - sv[0]), ex3 = __expf(sv[3] - sv[0]);
                const float isum = 1.0f / (1.0f + ex1 + ex2 + ex3);
                const int me = k == 0 ? si[0] : k == 1 ? si[1] : k == 2 ? si[2] : si[3];
                const float mg = (k == 0 ? 1.0f : k == 1 ? ex1 : k == 2 ? ex2 : ex3) * isum;
                const int mr = (int)__hip_atomic_fetch_add((LAS unsigned*)(F.lds + L_CNT) + me, 1u, __ATOMIC_RELAXED, __HIP_MEMORY_SCOPE_WORKGROUP);
                LAS int* rt = route + ((lrow0 + rr) * 4 + k) * 3;
                rt[0] = me; rt[1] = mr; rt[2] = __float_as_int(mg);
            }
        }
        __syncthreads();
        if (wid == 0) { const int l_ = lane_id_now(); if (l_ < 32) base[l_] = __hip_atomic_fetch_add(gcount + l_, cnt[l_], RLX_AGENT); }
        __syncthreads();
#pragma unroll 1
        for (int batch = 0; batch < 2; ++batch) {
            const int lrow0 = wid * 8 + batch * 4, row0 = chunk * 64 + lrow0;
            u32x4 sa[4], sb[4];
#pragma unroll
            for (int rr = 0; rr < 4; ++rr) { const bf16* src = XMB + (size_t)(row0 + rr) * D; sa[rr] = *(const u32x4*)(src + lane * 16); sb[rr] = *(const u32x4*)(src + lane * 16 + 8); }
            int vrow = 0;
            if (lane < 16) { const int rr = lane >> 2, k = lane & 3; const LAS int* rt = route + ((lrow0 + rr) * 4 + k) * 3; const int me = rt[0];
                vrow = me * CAPROWS + (int)base[me] + rt[1]; ROWS[(size_t)(row0 + rr) * 4 + k] = vrow; GATES[(size_t)(row0 + rr) * 4 + k] = __int_as_float(rt[2]); }
            if (pmode & 2) {
#pragma unroll
                for (int rr = 0; rr < 4; ++rr) {
                    const u32x4 a = sa[rr], b = sb[rr];
                    u32x4 o; o.x = pg8::pk4_fp8(bflo(a.x), bfhi(a.x), bflo(a.y), bfhi(a.y)); o.y = pg8::pk4_fp8(bflo(a.z), bfhi(a.z), bflo(a.w), bfhi(a.w));
                    o.z = pg8::pk4_fp8(bflo(b.x), bfhi(b.x), bflo(b.y), bfhi(b.y)); o.w = pg8::pk4_fp8(bflo(b.z), bfhi(b.z), bflo(b.w), bfhi(b.w));
#pragma unroll
                    for (int k = 0; k < 4; ++k) { const int vr = shli(vrow, rr * 4 + k); unsigned char* dst = (unsigned char*)XP + (size_t)vr * D;
                        __builtin_nontemporal_store(o, (u32x4*)(dst + lane * 16)); }
                }
            }
        }
        __syncthreads();
    }
}
#undef LN1_LOAD
__device__ __forceinline__ void ln2_phase(Frame& F, const bf16* XMB, const bf16* YP, const int* ROWS, const float* GATES, const float* g2, const float* b2, float* out, bf16* XB, unsigned char* XB8) {
    const int lane = F.lane;
    float ALPHA_ = ALPHA; asm volatile("" : "+v"(ALPHA_));
    const int rstride = F.G * NWAVES, row_first = F.bid * NWAVES + F.wave;
    const unsigned char* yp8 = (const unsigned char*)YP;
    int ix0 = 0, ix1 = 0, ix2 = 0, ix3 = 0; f32x4 gtn = {0.f, 0.f, 0.f, 0.f};
    u32x2 xbn[4]; int qn[4][4]; f32x4 gtc = {0.f, 0.f, 0.f, 0.f};
#define LN2_IDX(R) do { if ((R) < T) { ix0 = ROWS[(size_t)(R) * 4]; ix1 = ROWS[(size_t)(R) * 4 + 1]; ix2 = ROWS[(size_t)(R) * 4 + 2]; ix3 = ROWS[(size_t)(R) * 4 + 3]; gtn = *(const f32x4*)(GATES + (size_t)(R) * 4); } } while (0)
#define LN2_DATA(R) do { if ((R) < T) { gtc = gtn; _Pragma("unroll") for (int j = 0; j < 4; ++j) { const int c = 4 * lane + 256 * j; xbn[j] = *(const u32x2*)(XMB + (size_t)(R) * D + c); \
        qn[j][0] = *(const int*)(yp8 + (size_t)ix0 * D + c); qn[j][1] = *(const int*)(yp8 + (size_t)ix1 * D + c); qn[j][2] = *(const int*)(yp8 + (size_t)ix2 * D + c); qn[j][3] = *(const int*)(yp8 + (size_t)ix3 * D + c); } } } while (0)
    f32x4 gg_[4], bb_[4];
#pragma unroll
    for (int j = 0; j < 4; ++j) { gg_[j] = *(const f32x4*)(g2 + 4 * lane + 256 * j); bb_[j] = *(const f32x4*)(b2 + 4 * lane + 256 * j); }
    LN2_IDX(row_first);
    LN2_DATA(row_first);
    LN2_IDX(row_first + rstride);
    for (int row = row_first; row < T; row += rstride) {
        u32x2 xbc[4]; int qc[4][4]; const f32x4 gt = gtc;
#pragma unroll
        for (int j = 0; j < 4; ++j) { xbc[j] = xbn[j]; qc[j][0] = qn[j][0]; qc[j][1] = qn[j][1]; qc[j][2] = qn[j][2]; qc[j][3] = qn[j][3]; }
        LN2_DATA(row + rstride);
        LN2_IDX(row + 2 * rstride);
        float v[16]; float s = 0.f;
#pragma unroll
        for (int j = 0; j < 4; ++j) {
            const u32x2 xb_ = xbc[j]; const f32x4 xx = {bflo(xb_.x), bfhi(xb_.x), bflo(xb_.y), bfhi(xb_.y)};
            const int q0 = qc[j][0], q1 = qc[j][1], q2 = qc[j][2], q3 = qc[j][3];
            const f32x2 a0 = __builtin_amdgcn_cvt_pk_f32_fp8(q0, false), b0 = __builtin_amdgcn_cvt_pk_f32_fp8(q0, true), a1 = __builtin_amdgcn_cvt_pk_f32_fp8(q1, false), b1 = __builtin_amdgcn_cvt_pk_f32_fp8(q1, true);
            const f32x2 a2 = __builtin_amdgcn_cvt_pk_f32_fp8(q2, false), b2_ = __builtin_amdgcn_cvt_pk_f32_fp8(q2, true), a3 = __builtin_amdgcn_cvt_pk_f32_fp8(q3, false), b3 = __builtin_amdgcn_cvt_pk_f32_fp8(q3, true);
            const float g0 = gt[0] * (1.0f / 16.0f), g1 = gt[1] * (1.0f / 16.0f), g2_ = gt[2] * (1.0f / 16.0f), g3 = gt[3] * (1.0f / 16.0f);
            v[4 * j]     = ALPHA_ * xx[0] + ((g0 * a0[0] + g1 * a1[0]) + (g2_ * a2[0] + g3 * a3[0]));
            v[4 * j + 1] = ALPHA_ * xx[1] + ((g0 * a0[1] + g1 * a1[1]) + (g2_ * a2[1] + g3 * a3[1]));
            v[4 * j + 2] = ALPHA_ * xx[2] + ((g0 * b0[0] + g1 * b1[0]) + (g2_ * b2_[0] + g3 * b3[0]));
            v[4 * j + 3] = ALPHA_ * xx[3] + ((g0 * b0[1] + g1 * b1[1]) + (g2_ * b2_[1] + g3 * b3[1]));
            s += (v[4 * j] + v[4 * j + 1]) + (v[4 * j + 2] + v[4 * j + 3]); }
        const float mean = wave_sum(s) * (1.f / D); float s2 = 0.f;
#pragma unroll
        for (int k = 0; k < 16; ++k) { v[k] -= mean; s2 += v[k] * v[k]; }
        const float rstd = 1.0f / sqrtf(wave_sum(s2) * (1.f / D) + LN_EPS);
#pragma unroll
        for (int j = 0; j < 4; ++j) { const int c = 4 * lane + 256 * j; const f32x4 gg = gg_[j], bb = bb_[j];
            f32x4 o;
#pragma unroll
            for (int k = 0; k < 4; ++k) o[k] = v[4 * j + k] * rstd * gg[k] + bb[k];
            if (out) *(f32x4*)(out + (size_t)row * D + c) = o;
            u32x2 pb; pb.x = pk2(o[0], o[1]); pb.y = pk2(o[2], o[3]); *(u32x2*)(XB + (size_t)row * D + c) = pb;
            if (XB8) *(unsigned*)(XB8 + (size_t)row * D + c) = pg8::pk4_fp8(o[0], o[1], o[2], o[3]); }
    }
}
#undef LN2_IDX
#undef LN2_DATA

#ifndef MK_FP8TEST
#define MK_FP8TEST 0
#endif
typedef int i32x8 __attribute__((ext_vector_type(8)));
__device__ __forceinline__ int t8_val(int which, int rc, int g, int j) { unsigned h = (unsigned)(which * 7919 + rc * 104729 + g * 1299709 + j * 15485863 + 12345); h ^= h >> 13; h *= 0x5bd1e995u; h ^= h >> 15; return (int)(h % 9u) - 4; }
__device__ __forceinline__ void fp8_selftest(gu32* ctl, int lane) {
    const int rc = lane & 15, g = lane >> 4;
    i32x8 a, b;
#pragma unroll
    for (int w = 0; w < 8; ++w) {
        int wa = __builtin_amdgcn_cvt_pk_fp8_f32((float)t8_val(0, rc, g, 4 * w), (float)t8_val(0, rc, g, 4 * w + 1), 0, false);
        wa = __builtin_amdgcn_cvt_pk_fp8_f32((float)t8_val(0, rc, g, 4 * w + 2), (float)t8_val(0, rc, g, 4 * w + 3), wa, true);
        int wb = __builtin_amdgcn_cvt_pk_fp8_f32((float)t8_val(1, rc, g, 4 * w), (float)t8_val(1, rc, g, 4 * w + 1), 0, false);
        wb = __builtin_amdgcn_cvt_pk_fp8_f32((float)t8_val(1, rc, g, 4 * w + 2), (float)t8_val(1, rc, g, 4 * w + 3), wb, true);
        a[w] = wa; b[w] = wb;
    }
    f32x4 c = {0.f, 0.f, 0.f, 0.f};
    c = __builtin_amdgcn_mfma_scale_f32_16x16x128_f8f6f4(a, b, c, 0, 0, 0, 0x7f7f7f7f, 0, 0x7f7f7f7f);
    int bad = 0, scaled = 0;
#pragma unroll
    for (int reg = 0; reg < 4; ++reg) {
        const int row = 4 * (lane >> 4) + reg, col = lane & 15; int e = 0;
        for (int gg = 0; gg < 4; ++gg) for (int j = 0; j < 32; ++j) e += t8_val(0, row, gg, j) * t8_val(1, col, gg, j);
        if (c[reg] != (float)e) { bad = 1; if (e != 0 && (c[reg] == (float)e * 0.5f || c[reg] == (float)e * 2.0f || c[reg] == (float)e * 0.25f || c[reg] == (float)e * 4.0f)) scaled = 1; }
    }
    const unsigned long long mb = __ballot(bad), ms = __ballot(bad && scaled);
    if (lane == 0 && mb) __hip_atomic_store(ctl + CW_ERR, (mb == ms) ? 2u : 1u, RLX_AGENT);
}

constexpr int N_STEPS = 6, LAST_PHASE = 1 + 10 * 5 + 8;
__host__ __device__ constexpr bool phase_exists(int id) {
    if (id == 0) return true;
    if (id < 1 || id > LAST_PHASE) return false;
    const int s = (id - 1) / 10, p = (id - 1) % 10;
    if (p == 0) return true;
    if (p == 9) return false;
    if (s == 0 || s == 2) return false;
    if (p == 1 || p == 2) return s == 3;
    return true;
}
__global__ void __launch_bounds__(NTHREADS, 2) mk_fwd(Args args) {
    extern __shared__ __attribute__((aligned(16))) unsigned char lds_raw[];
    Frame F;
    F.lds = (LAS unsigned char*)lds_raw;
    F.tid = threadIdx.x; F.lane = F.tid & 63; F.wave = __builtin_amdgcn_readfirstlane(F.tid >> 6);
    F.bid = blockIdx.x; F.G = gridDim.x; F.vcu = (F.G % 8 == 0) ? (F.bid % 8) * (F.G / 8) + F.bid / 8 : F.bid;
    F.ctl = (gu32*)(args.ws + WS_CTL);
    const int lo = args.ph_lo, hi = args.ph_hi;
    const bool fused = (hi - lo) > 1;
    for (int u = F.tid; u < (LDS_BYTES - LDSCTL_OFF) / 4; u += NTHREADS) ((LAS unsigned*)(F.lds + LDSCTL_OFF))[u] = 0u;
    __syncthreads();
    XcdBarrier bar; bar.bar = (unsigned*)(F.ctl + CW_BAR); bar.x = 0; bar.st = nullptr;
    if (fused) bar = xcd_barrier_post((unsigned*)(F.ctl + CW_BAR), (volatile LAS unsigned*)(F.lds + L_XB));
    const bool split = fused && MK_SPLIT && (F.G % 16 == 0) && lo == 0 && hi > 16;
    const int NCV = split ? F.G / 2 : 0;
    const bool is_conv = split && F.bid < NCV;
    XcdBarrier bar2; bar2.bar = (unsigned*)(F.ctl + CW_BAR2); bar2.x = 0; bar2.st = nullptr;
    if (split && !is_conv) bar2 = xcd_barrier_post((unsigned*)(F.ctl + CW_BAR2), (volatile LAS unsigned*)(F.lds + L_XB2));
#ifndef MK_PROBE
#define MK_PROBE 0
#endif
#define IN(id) (lo <= (id) && (id) < hi)
#define PHASE_BEGIN ArgsP ap = (ArgsP)__builtin_amdgcn_kernarg_segment_ptr(); asm volatile("" : "+s"(ap)); GAS unsigned char* wsg_ = (GAS unsigned char*)ap->ws; asm volatile("" : "+s"(wsg_)); unsigned char* ws = (unsigned char*)wsg_; Frame Fp = F; { const int l_ = lane_id_now(); Fp.lane = l_; Fp.tid = F.wave * 64 + l_; } Fp.ctl = (gu32*)(ws + WS_CTL);
#define SEAM(id) do { if (fused && (id) != LAST_PHASE) { xcd_barrier(bar, F.wave == 0 && lane_id_now() == 0, (unsigned)F.G); if (MK_PROBE == 10) xcd_barrier(bar, F.wave == 0 && lane_id_now() == 0, (unsigned)F.G); } } while (0)
#define SEAMW(id, sync, last) do { if (!split) SEAM(id); else if (last) SEAM(id); else if ((sync) && !is_conv) xcd_barrier(bar2, F.wave == 0 && lane_id_now() == 0, (unsigned)(F.G - NCV)); } while (0)
#define WIN_FRAME do { if (split) { Fp.G = F.G - NCV; Fp.bid = F.bid - NCV; Fp.vcu = (Fp.G % 8 == 0) ? (Fp.bid % 8) * (Fp.G / 8) + Fp.bid / 8 : Fp.bid; } } while (0)
#define REPS(k) ((MK_PROBE) == (k) ? 2 : 1)

#ifndef SKIP_P0
    if (MK_FP8TEST && lo == 0 && F.bid == 0 && F.wave == 0) fp8_selftest(F.ctl, F.lane);
    if (IN(0)) { PHASE_BEGIN for (int rep = 0; rep < REPS(1); ++rep) p0_prologue(Fp, ap, ws, split ? 1 : 0); SEAM(0); }
#endif

    for (int s = 0; s < N_STEPS; ++s) {
        const int pb = 1 + 10 * s;
        const int layer = s == 0 ? 0 : (s == 1 ? 0 : (s <= 3 ? 1 : s - 2));
        const int kind = layer % 3;
        const bool rest = !(s == 0 || s == 2);
#ifndef SKIP_G1
        const bool inw = split && s <= 1;
        if (IN(pb) && inw && is_conv) {
            if (s == 0) { PHASE_BEGIN Fp.G = NCV; p0_prologue(Fp, ap, ws, 2); }
        } else
        if (IN(pb)) {
            PHASE_BEGIN
            if (inw) WIN_FRAME;
            pg8::Gemm g; pg8::EpiProj E; E.ssq_in = nullptr; E.ssq_out = nullptr; E.rope = (const pg8::f32x2*)(ws + WS_ROPE); E.rope_heads = 0u; E.oscale = 1.0f;
            if (s == 0) { g = pg8::Gemm{(const bf16*)(ws + WS_MEMB), (const bf16*)(ws + WS_WKV), NB * MEML, 2048, 1024, 1024}; E.O = (bf16*)(ws + WS_KVMEM); E.ldc = 2048; }
            else if (s == 3) { g = pg8::Gemm{(const bf16*)(ws + WS_PROJ), (const bf16*)(ws + WS_WUQ), T, 1280, 256, 1280}; E.O = (bf16*)(ws + WS_QQ); E.ldc = 1280; E.ssq_in = (const float*)(ws + WS_SSQ); E.rope_heads = 0xFFFFFu; }
            else { const int n = kind == 0 ? 2560 : (kind == 1 ? 1280 : 1536);
                g = pg8::Gemm{(const bf16*)(ws + WS_XB), (const bf16*)(ws + WS_WIN + (size_t)layer * 5 * MiB), T, n, 1024, 1024}; E.O = (bf16*)(ws + WS_PROJ); E.ldc = n;
                if (layer != 0) { g.A = (const bf16*)(ws + WS_XB8); g.K = 512; g.lda = 512; E.oscale = 1.0f / 64.0f; }
                if (kind == 1) { E.ssq_out = (float*)(ws + WS_SSQ); E.rope_heads = 0xF0u | (1u << 16); }
                if (kind == 2) E.rope_heads = 0xFFFFu; }
            pg8::StaticOrder S; S.init(g.M, g.N, Fp.G, (s == 0 && !inw) ? Fp.G - 1 - Fp.bid : Fp.bid); if (s <= 1) S.split = 0;
            if (!(s == 0 || s == 1 || s == 3)) { for (int rep = 0; rep < REPS(2); ++rep) pg8::gemm_phase<pg8::EpiProj, pg8::StaticOrder, true, true, true>(F.lds + RING_OFF, g, S, E, F.wave * 64 + lane_id_now()); }
            else { for (int rep = 0; rep < REPS(2); ++rep) pg8::gemm_phase<pg8::EpiProj, pg8::StaticOrder, true, true, false>(F.lds + RING_OFF, g, S, E, F.wave * 64 + lane_id_now()); }
        }
        if (IN(pb)) { if (inw) SEAMW(pb, s == 1, false); else if (!(s == 0 && fused)) SEAM(pb); }
#endif
        if (s == 3) {
#ifndef SKIP_PS
            if (IN(pb + 1)) { PHASE_BEGIN for (int rep = 0; rep < ((MK_PROBE == 3 || MK_PROBE == 31) ? 2 : 1); ++rep) score_phase(Fp, (const bf16*)(ws + WS_QQ), (const bf16*)(ws + WS_PROJ), (float*)(ws + WS_ACT)); SEAM(pb + 1); }
#endif
#ifndef SKIP_PT
            if (IN(pb + 2)) { PHASE_BEGIN for (int rep = 0; rep < ((MK_PROBE == 3 || MK_PROBE == 32) ? 2 : 1); ++rep) select_phase(Fp, (const float*)(ws + WS_ACT), (unsigned long long*)(ws + WS_MASK)); SEAM(pb + 2); }
#endif
        }
        if (!rest) continue;
#ifndef SKIP_MIX
        if (IN(pb + 3) && !(inw && is_conv)) { PHASE_BEGIN if (inw) WIN_FRAME; for (int rep = 0; rep < ((MK_PROBE == 4 || (MK_PROBE == 41 && kind == 1) || (MK_PROBE == 42 && kind == 2) || (MK_PROBE == 43 && kind == 0)) ? 2 : 1); ++rep) mixer_phase(Fp, ap, ws, layer, kind, s + 8 * rep); }
        if (IN(pb + 3)) { if (inw) SEAMW(pb + 3, true, false); else SEAM(pb + 3); }
#endif
#ifndef SKIP_G2
        if (IN(pb + 4) && !(inw && is_conv)) {
            PHASE_BEGIN
            if (inw) WIN_FRAME;
            pg8::Gemm g{(const bf16*)(ws + WS_CAT), (const bf16*)(ws + WS_WOUT + (size_t)layer * 2 * MiB), T, 1024, 512, 512};
            pg8::EpiProj E; E.O = (bf16*)(ws + WS_Y); E.ldc = 1024; E.ssq_in = nullptr; E.ssq_out = nullptr; E.rope = nullptr; E.rope_heads = 0u; E.oscale = 1.0f / 128.0f;
            pg8::StaticOrder S; S.init(T, 1024, Fp.G, Fp.bid);
            for (int rep = 0; rep < REPS(5); ++rep) pg8::gemm_phase<pg8::EpiProj, pg8::StaticOrder, true, true, true>(F.lds + RING_OFF, g, S, E, F.wave * 64 + lane_id_now());
        }
        if (IN(pb + 4)) { if (inw) SEAMW(pb + 4, true, false); else SEAM(pb + 4); }
#endif
#ifndef SKIP_LN1
        if (IN(pb + 5) && !(inw && is_conv)) {
            PHASE_BEGIN
            if (inw) WIN_FRAME;
            for (int rep = 0; rep < ((MK_PROBE == 6 || MK_PROBE == 61 || MK_PROBE == 62 || MK_PROBE == 63) ? 2 : 1); ++rep)
            ln1_phase(Fp, (const bf16*)(ws + WS_XB), (const bf16*)(ws + WS_Y), ap->in[12] + layer * D, ap->in[13] + layer * D, (bf16*)(ws + WS_QQ),
                      ap->in[14] + (size_t)layer * D * NEXP, ap->in[15] + layer * NEXP, (bf16*)(ws + (rep ? WS_ACT : WS_XP)), Fp.ctl + (rep ? CW_GDUMMY : CW_GCOUNT) + layer * NEXP,
                      (int*)(ws + (rep ? WS_SSQ : WS_ROWS)), (float*)(ws + (rep ? WS_MASK : WS_GATES)), (rep && MK_PROBE == 61) ? 2 : (rep && MK_PROBE == 62) ? 1 : (rep && MK_PROBE == 63) ? 0 : 3);
        }
        if (IN(pb + 5)) { if (inw) SEAMW(pb + 5, true, true); else SEAM(pb + 5); }
#endif
        if (IN(pb + 6) || IN(pb + 7)) {
            LAS int* pref = (LAS int*)(F.lds + L_PREF); LAS int* tiles = (LAS int*)(F.lds + L_TILES);
#ifndef SKIP_G3
            if (IN(pb + 6)) {
                PHASE_BEGIN
                if (Fp.wave == 0) {
                    const int l_ = Fp.lane; const int tl_ = l_ < 32 ? (int)((__hip_atomic_load(Fp.ctl + CW_GCOUNT + layer * NEXP + (l_ & 31), RLX_AGENT) + 255u) >> 8) : 0;
                    int v_ = tl_ * 8;
#pragma unroll
                    for (int d_ = 1; d_ < 32; d_ <<= 1) { const int t_ = __builtin_amdgcn_ds_bpermute(((l_ - d_) & 63) << 2, v_); if (l_ >= d_) v_ += t_; }
                    if (l_ < 32) { tiles[l_] = tl_; pref[l_] = v_ - tl_ * 8; } if (l_ == 31) pref[32] = v_; }
                __syncthreads();
                pg8::Gemm g{(const bf16*)(ws + WS_XP), (const bf16*)(ws + WS_WGU + (size_t)layer * 64 * MiB), NEXP * CAPROWS, NEXP * 2048, 512, 512};
                pg8::EpiSwiglu E{(bf16*)(ws + WS_ACT), ap->in[17] + (size_t)layer * NEXP * 2048};
                pg8::MoeOrder S{pref, tiles, 8, pref[32], F.G, F.vcu};
                for (int rep = 0; rep < REPS(7); ++rep) pg8::gemm_phase<pg8::EpiSwiglu, pg8::MoeOrder, true, true, true>(F.lds + RING_OFF, g, S, E, F.wave * 64 + lane_id_now());
                SEAM(pb + 6);
            }
#endif
#ifndef SKIP_G4
            if (IN(pb + 7)) {
                PHASE_BEGIN
                if (Fp.wave == 0) {
                    const int l_ = Fp.lane; const int tl_ = l_ < 32 ? (int)((__hip_atomic_load(Fp.ctl + CW_GCOUNT + layer * NEXP + (l_ & 31), RLX_AGENT) + 255u) >> 8) : 0;
                    int v_ = tl_ * 4;
#pragma unroll
                    for (int d_ = 1; d_ < 32; d_ <<= 1) { const int t_ = __builtin_amdgcn_ds_bpermute(((l_ - d_) & 63) << 2, v_); if (l_ >= d_) v_ += t_; }
                    if (l_ < 32) { tiles[l_] = tl_; pref[l_] = v_ - tl_ * 4; } if (l_ == 31) pref[32] = v_; }
                __syncthreads();
                pg8::Gemm g{(const bf16*)(ws + WS_ACT), (const bf16*)(ws + WS_WDN + (size_t)layer * 32 * MiB), NEXP * CAPROWS, NEXP * 1024, 512, 512};
                pg8::EpiDown E{(bf16*)(ws + WS_XP), ap->in[19] + (size_t)layer * NEXP * 1024};
                pg8::MoeOrder S{pref, tiles, 4, pref[32], F.G, F.vcu};
                for (int rep = 0; rep < REPS(8); ++rep) pg8::gemm_phase<pg8::EpiDown, pg8::MoeOrder, true, true, true>(F.lds + RING_OFF, g, S, E, F.wave * 64 + lane_id_now());
                SEAM(pb + 7);
            }
#endif
        }
#ifndef SKIP_LN2
        if (IN(pb + 8)) {
            PHASE_BEGIN
            for (int rep = 0; rep < REPS(9); ++rep)
            ln2_phase(Fp, (const bf16*)(ws + WS_QQ), (const bf16*)(ws + WS_XP), (const int*)(ws + WS_ROWS), (const float*)(ws + WS_GATES), ap->in[20] + layer * D, ap->in[21] + layer * D,
                      layer == DEPTH - 1 ? ap->out : (float*)nullptr, (bf16*)(ws + WS_XB), (layer + 1 < DEPTH) ? (unsigned char*)(ws + WS_XB8) : (unsigned char*)nullptr);
            SEAM(pb + 8);
        }
#endif
    }
    if (MK_FP8TEST && hi > LAST_PHASE) {
        const unsigned code = __hip_atomic_load(F.ctl + CW_ERR, RLX_AGENT);
        if (code) { const float v = code == 2u ? 100.f : 10.f;
            for (int row = F.bid * NWAVES + F.wave; row < T; row += F.G * NWAVES) { f32x4* o = (f32x4*)(args.out + (size_t)row * D) + F.lane;
#pragma unroll
                for (int j = 0; j < 4; ++j) o[64 * j] = (f32x4){v, v, v, v}; } }
    }
#undef IN
#undef SEAM
}

extern "C" void kernel_launch(void* const* d_in, const int* in_sizes, int n_in, void* d_out, int out_size, void* d_ws, size_t ws_size, hipStream_t stream) {
    static int grid = 0;
    if (grid == 0) {
        if (n_in != 22 || in_sizes[0] != T * D || out_size != T * D || ws_size < WS_END) { fprintf(stderr, "kernel_launch: unexpected shapes (n_in %d, in0 %d, out %d, ws %zu < %zu); nothing launched\n", n_in, n_in > 0 ? in_sizes[0] : -1, out_size, ws_size, (size_t)WS_END); grid = -1; return; }
        int dev = 0, cus = 0, per_cu = 0;
        if (hipGetDevice(&dev) != hipSuccess || hipDeviceGetAttribute(&cus, hipDeviceAttributeMultiprocessorCount, dev) != hipSuccess) { fprintf(stderr, "kernel_launch: device query failed\n"); grid = -1; return; }
        if (hipFuncSetAttribute((const void*)mk_fwd, hipFuncAttributeMaxDynamicSharedMemorySize, LDS_BYTES) != hipSuccess) { fprintf(stderr, "kernel_launch: hipFuncSetAttribute failed\n"); grid = -1; return; }
        if (hipOccupancyMaxActiveBlocksPerMultiprocessor(&per_cu, (const void*)mk_fwd, NTHREADS, LDS_BYTES) != hipSuccess || per_cu < 1) fprintf(stderr, "kernel_launch: note: occupancy query reports %d workgroups per CU\n", per_cu);
        (void)hipGetLastError();
        grid = cus;
    }
    if (grid < 0) return;
    if (hipMemsetAsync((char*)d_ws + WS_CTL, 0, CTL_ZERO_BYTES, stream) != hipSuccess) { fprintf(stderr, "kernel_launch: hipMemsetAsync failed\n"); return; }
    Args a{};
    for (int i = 0; i < 22; ++i) a.in[i] = (const float*)d_in[i];
    a.out = (float*)d_out; a.ws = (unsigned char*)d_ws;
    unsigned char* ws = (unsigned char*)d_ws;
    { int nj = 0, items = 0;
      auto add = [&](const float* src, int ldw, int K, int col0, int nvalid, int nblk, size_t dst_off, int row0, const float* scale, int f8 = 0, float mul = 1.0f) {
          Job& j = a.jobs[nj++]; j.src = src; j.dst = (bf16*)(ws + dst_off); j.scale = scale; j.ldw = ldw; j.K = K; j.col0 = col0; j.nvalid = nvalid; j.nblk = nblk; j.row0 = row0; j.item0 = items; j.f8 = f8; j.mul = mul; j.pad = 0;
          items += nblk * (K / 128); };
      const float* a_w_in = a.in[2]; const float* b_w_in = a.in[4]; const float* c_w_in = a.in[8];
      add(a_w_in, 2560, 1024, 0, 2560, 10, WS_WIN + 0 * 5 * MiB, 0, nullptr);
      add(a_w_in + (size_t)1024 * 2560, 2560, 1024, 0, 2560, 10, WS_WIN + 3 * 5 * MiB, 0, nullptr, 1, 64.0f);
      add(b_w_in, 1096, 1024, 0, 768, 3, WS_WIN + 1 * 5 * MiB, 0, nullptr, 1, 64.0f);
      add(b_w_in, 1096, 1024, 840, 256, 1, WS_WIN + 1 * 5 * MiB, 768, nullptr, 1, 64.0f);
      add(b_w_in, 1096, 1024, 768, 72, 1, WS_WIN + 1 * 5 * MiB, 1024, nullptr, 1, 64.0f);
      add(c_w_in, 1536, 1024, 0, 1536, 6, WS_WIN + 2 * 5 * MiB, 0, nullptr, 1, 64.0f);
      for (int l = 0; l < 4; ++l) add(a.in[10] + (size_t)l * 1024 * 1024, 1024, 1024, 0, 1024, 4, WS_WOUT + (size_t)l * 2 * MiB, 0, nullptr, 1, 128.0f);
      for (int l = 0; l < 4; ++l) add(a.in[11] + (size_t)l * 1024 * 512, 512, 1024, 0, 512, 2, WS_WKV, 512 * l, nullptr);
      add(a.in[6], 768, 256, 0, 768, 3, WS_WUQ, 0, a.in[5]);
      add(a.in[7], 512, 256, 0, 512, 2, WS_WUQ, 768, a.in[5]);
      a.njob_items = items; }
    a.pad = 0;
#if MK_MULTI
    for (int id = 0; id <= LAST_PHASE; ++id) {
        if (!phase_exists(id)) continue;
        a.ph_lo = id; a.ph_hi = id + 1;
        hipLaunchKernelGGL(mk_fwd, dim3(grid), dim3(NTHREADS), LDS_BYTES, stream, a);
    }
#else
    a.ph_lo = 0; a.ph_hi = LAST_PHASE + 1;
    hipLaunchKernelGGL(mk_fwd, dim3(grid), dim3(NTHREADS), LDS_BYTES, stream, a);
#endif
    const hipError_t le = hipPeekAtLastError();
    if (le != hipSuccess) fprintf(stderr, "kernel_launch: launch failed: %s (grid %d)\n", hipGetErrorName(le), grid);
}
```

```cpp
#include <hip/hip_runtime.h>
#include <cstdio>
#include <cstdint>
#include <cmath>

#ifndef MK_MULTI
#define MK_MULTI 0
#endif
#ifndef MK_SPLIT
#define MK_SPLIT 0
#endif
#ifndef MK_CHECK
#define MK_CHECK 0
#endif

namespace pg8 {
#define PG8_LAS __attribute__((address_space(3)))
typedef unsigned short bf16_t;
typedef short bf16x8 __attribute__((ext_vector_type(8)));
typedef float f32x4 __attribute__((ext_vector_type(4)));
typedef unsigned u32x4 __attribute__((ext_vector_type(4)));
typedef int i32x8 __attribute__((ext_vector_type(8)));
typedef short bf16x16 __attribute__((ext_vector_type(16)));
typedef unsigned u32x2 __attribute__((ext_vector_type(2)));
constexpr int BM = 256, BK = 64, HALF = 128, HTB = HALF * BK * 2  , STAGE_BYTES = 8 * HTB, NXCD = 8, WGM = 8;

__host__ __device__ __forceinline__ int lds_byte(int r, int c) { const int st = (r >> 4) * 2 + (c >> 5), rr = r & 15, cc = c & 31, ob = rr * 64 + cc * 2; return st * 1024 + (ob ^ (((ob >> 9) & 1) << 5)); }
__host__ __device__ __forceinline__ void stage_rc(int b, int& R, int& C) { const int st = b / 1024, sb = b % 1024, swz = sb ^ (((sb >> 9) & 1) << 5); R = (st >> 1) * 16 + swz / 64; C = (st & 1) * 32 + (swz % 64) / 2; }
__host__ __device__ __forceinline__ int perm32(int rho) { const int n = rho >> 4, i = rho & 15; return 8 * (i >> 2) + 4 * n + (i & 3); }

struct Unit { int pm, pn, hs; };
struct Gemm { const bf16_t* A; const bf16_t* Bt; int M, N, K, lda; };

struct StaticOrder {
    int nM, nN, nwg, G, c, split;
    __host__ __device__ void init(int M, int N, int G_, int c_) { nM = M / BM; nN = N / BM; nwg = nM * nN; G = G_; c = c_; split = 1; }
    __host__ __device__ bool next(int i, Unit& u) const {
        const int nfull = nwg / G, rem = nwg - nfull * G; int L = i * G + c; u.hs = 0;
        if (split && i == nfull && rem > 0 && 2 * rem <= G) { if (c >= 2 * rem) return false; L = nfull * G + (c >> 1); u.hs = 1 + (c & 1); }
        if (L >= nwg) return false;
        int wgid = L; { const int q = nwg / NXCD, r = nwg % NXCD, xcd = wgid % NXCD, off = wgid / NXCD; wgid = (xcd < r ? xcd * (q + 1) : r * (q + 1) + (xcd - r) * q) + off; }
        const int nig = WGM * nN, gid = wgid / nig, fm = gid * WGM, gsz = (nM - fm) < WGM ? (nM - fm) : WGM;
        u.pm = fm + ((wgid % nig) % gsz); u.pn = (wgid % nig) / gsz; return true;
    }
    __device__ __forceinline__ void a_ready(const Unit&) const {}
    __device__ __forceinline__ void done(const Unit&) const {}
};

typedef float f32x2 __attribute__((ext_vector_type(2)));
__device__ __forceinline__ float shx16(float v, int lane, int m) { return __int_as_float(__builtin_amdgcn_ds_bpermute((lane ^ m) << 2, __float_as_int(v))); }
typedef __bf16 bf16x2_t __attribute__((ext_vector_type(2)));
__device__ __forceinline__ unsigned pk4_fp8(float a, float b, float c, float d) { int w = __builtin_amdgcn_cvt_pk_fp8_f32(a, b, 0, false); w = __builtin_amdgcn_cvt_pk_fp8_f32(c, d, w, true); return (unsigned)w; }
__device__ __forceinline__ unsigned cvt_pk_bf16(float lo, float hi) { f32x2 v = {lo, hi}; bf16x2_t b = __builtin_convertvector(v, bf16x2_t); return __builtin_bit_cast(unsigned, b); }

struct EpiProj {
    static constexpr bool PERM = true, AFTER_DRAIN = false, BIAS_LDS = false; static constexpr int NSTORE = 16;
    bf16_t* O; int ldc; const float* ssq_in; float* ssq_out; const f32x2* rope; unsigned rope_heads; float oscale;
    __device__ __forceinline__ void operator()(const f32x4 (&acc)[2][2][4][2], const Unit& u, int wr, int wc, int fr, int fq) const {
        const int row0 = u.pm * BM + (u.hs == 2 ? HALF : 0) + wr * 64 + fr, col0 = u.pn * BM + wc * 32 + 8 * fq;
        const bool do_ssq = (ssq_out != nullptr) && (u.pn == 0);
        const __amdgpu_buffer_rsrc_t ors = __builtin_amdgcn_make_buffer_rsrc((void*)O, 0, 0x7fffffff, 0x00020000);
        const bool any_rope = rope_heads != 0u;
        f32x4 sq_n = {0.f, 0.f, 0.f, 0.f}, cs_n[4];
#pragma unroll
        for (int q = 0; q < 4; ++q) cs_n[q] = (f32x4){0.f, 0.f, 0.f, 0.f};
#define EPI_ROWLOADS(ROW) do { if (ssq_in) sq_n = *(const f32x4*)(ssq_in + (size_t)(ROW) * 4); \
            if (any_rope) { const f32x4* cs_ = (const f32x4*)(rope + (size_t)((ROW) & 4095) * 8); cs_n[0] = cs_[0]; cs_n[1] = cs_[1]; cs_n[2] = cs_[2]; cs_n[3] = cs_[3]; } } while (0)
        EPI_ROWLOADS(row0);
#pragma unroll
        for (int ai = 0; ai < 2; ++ai) if (ai == 0 || u.hs == 0)
#pragma unroll
            for (int m = 0; m < 4; ++m) {
                const int row = row0 + ai * HALF + m * 16;
                const f32x4 s = sq_n, c01 = cs_n[0], c23 = cs_n[1], c45 = cs_n[2], c67 = cs_n[3];
                if (!(ai == 1 && m == 3)) { const int rown = row0 + (m == 3 ? HALF : ai * HALF + (m + 1) * 16); EPI_ROWLOADS(rown); }
                float rs = 1.f;
                if (ssq_in) rs = 1.0f / sqrtf(((s[0] + s[1]) + (s[2] + s[3])) * (1.f / 256.f) + 1e-5f);
                float ss = 0.f;
#pragma unroll
                for (int bj = 0; bj < 2; ++bj) {
                    f32x4 v0 = acc[ai][bj][m][0] * oscale, v1 = acc[ai][bj][m][1] * oscale;
                    if (do_ssq) ss += ((v0[0] * v0[0] + v0[1] * v0[1]) + (v0[2] * v0[2] + v0[3] * v0[3])) + ((v1[0] * v1[0] + v1[1] * v1[1]) + (v1[2] * v1[2] + v1[3] * v1[3]));
                    v0 = v0 * rs; v1 = v1 * rs;
                    const int head = (u.pn * BM + bj * HALF + wc * 32) >> 6;
                    if (((rope_heads >> head) & 1u) && !(wc & 1)) {
                        f32x4 o0, o1;
#pragma unroll
                        for (int j = 0; j < 4; ++j) { o0[j] = shx16(v0[j], fr + 16 * fq, 16); o1[j] = shx16(v1[j], fr + 16 * fq, 16); }
                        if (fq < 2) {
                            const float sg = fq == 0 ? -1.f : 1.f;
                            v0[0] = v0[0] * c01[0] + sg * o0[0] * c01[1]; v0[1] = v0[1] * c01[2] + sg * o0[1] * c01[3];
                            v0[2] = v0[2] * c23[0] + sg * o0[2] * c23[1]; v0[3] = v0[3] * c23[2] + sg * o0[3] * c23[3];
                            v1[0] = v1[0] * c45[0] + sg * o1[0] * c45[1]; v1[1] = v1[1] * c45[2] + sg * o1[1] * c45[3];
                            v1[2] = v1[2] * c67[0] + sg * o1[2] * c67[1]; v1[3] = v1[3] * c67[2] + sg * o1[3] * c67[3];
                        }
                    }
                    u32x4 w; w.x = cvt_pk_bf16(v0[0], v0[1]); w.y = cvt_pk_bf16(v0[2], v0[3]); w.z = cvt_pk_bf16(v1[0], v1[1]); w.w = cvt_pk_bf16(v1[2], v1[3]);
                    __builtin_amdgcn_raw_buffer_store_b128(w, ors, (row * ldc + col0 + bj * HALF) * 2, 0, 0);
                }
                if (do_ssq) { ss += shx16(ss, fr + 16 * fq, 16); ss += shx16(ss, fr + 16 * fq, 32); if (fq == 0) ssq_out[(size_t)row * 4 + wc] = ss; }
            }
#undef EPI_ROWLOADS
    }
};
struct EpiSwiglu {
    static constexpr bool PERM = true, AFTER_DRAIN = false, BIAS_LDS = true; static constexpr int NSTORE = 8;
    bf16_t* O; const float* bias;
    static constexpr float WSC = 1.0f / 64.0f;
    __device__ __forceinline__ void stage_bias(const Unit& u, PG8_LAS void* dst, int lane) const {
        const __amdgpu_buffer_rsrc_t brs = __builtin_amdgcn_make_buffer_rsrc((void*)bias, 0, 32 * 2048 * 4, 0x00020000);
        const int e = u.pn >> 3, t = u.pn & 7;
        __builtin_amdgcn_raw_ptr_buffer_load_lds(brs, dst, 16, (lane & 31) * 16 + (lane >> 5) * 4096, (e * 2048 + t * 128) * 4, 0, 0);
    }
    __device__ __forceinline__ void operator()(const f32x4 (&acc)[2][2][4][2], const Unit& u, int wr, int wc, int fr, int fq, const PG8_LAS float* bl) const {
        const int t = u.pn & 7;
        const int row0 = u.pm * BM + (u.hs == 2 ? HALF : 0) + wr * 64 + fr, jl = wc * 32 + 8 * fq, j0 = t * 128 + jl;
        const f32x4 bg0 = *(const PG8_LAS f32x4*)(bl + jl), bg1 = *(const PG8_LAS f32x4*)(bl + jl + 4), bu0 = *(const PG8_LAS f32x4*)(bl + 128 + jl), bu1 = *(const PG8_LAS f32x4*)(bl + 128 + jl + 4);
#pragma unroll
        for (int ai = 0; ai < 2; ++ai) if (ai == 0 || u.hs == 0)
#pragma unroll
            for (int m = 0; m < 4; ++m) {
                const int row = row0 + ai * HALF + m * 16;
                float r[8];
#pragma unroll
                for (int n = 0; n < 2; ++n) {
                    const f32x4 g4 = acc[ai][0][m][n] * WSC + (n ? bg1 : bg0), u4 = acc[ai][1][m][n] * WSC + (n ? bu1 : bu0);
#pragma unroll
                    for (int j = 0; j < 4; ++j) {
                        const float g = fminf(g4[j], 7.0f), up = fminf(fmaxf(u4[j], -7.0f), 7.0f);
                        const float sg = __builtin_amdgcn_rcpf(1.0f + __builtin_amdgcn_exp2f(g * (-1.702f * 1.4426950408889634f)));
                        r[n * 4 + j] = (up + 1.0f) * g * sg;
                    }
                }
                u32x2 w; w.x = pk4_fp8(r[0], r[1], r[2], r[3]); w.y = pk4_fp8(r[4], r[5], r[6], r[7]);
                *(u32x2*)((unsigned char*)O + (size_t)row * 1024 + j0) = w;
            }
    }
};
struct EpiDown {
    static constexpr bool PERM = true, AFTER_DRAIN = false, BIAS_LDS = true; static constexpr int NSTORE = 16;
    bf16_t* O; const float* bias;
    __device__ __forceinline__ void stage_bias(const Unit& u, PG8_LAS void* dst, int lane) const {
        const __amdgpu_buffer_rsrc_t brs = __builtin_amdgcn_make_buffer_rsrc((void*)bias, 0, 32 * 1024 * 4, 0x00020000);
        const int e = u.pn >> 2, t = u.pn & 3;
        __builtin_amdgcn_raw_ptr_buffer_load_lds(brs, dst, 16, lane * 16, (e * 1024 + t * 256) * 4, 0, 0);
    }
    __device__ __forceinline__ void operator()(const f32x4 (&acc)[2][2][4][2], const Unit& u, int wr, int wc, int fr, int fq, const PG8_LAS float* bl) const {
        const int t = u.pn & 3;
        const int row0 = u.pm * BM + (u.hs == 2 ? HALF : 0) + wr * 64 + fr, cl = wc * 32 + 8 * fq, col0 = t * BM + cl;
        f32x4 bv[2][2];
#pragma unroll
        for (int bj = 0; bj < 2; ++bj)
#pragma unroll
            for (int n = 0; n < 2; ++n) bv[bj][n] = *(const PG8_LAS f32x4*)(bl + cl + bj * HALF + 4 * n);
#pragma unroll
        for (int ai = 0; ai < 2; ++ai) if (ai == 0 || u.hs == 0)
#pragma unroll
            for (int m = 0; m < 4; ++m) { unsigned char* rowp = (unsigned char*)O + (size_t)(row0 + ai * HALF + m * 16) * 1024 + col0;
#pragma unroll
                for (int bj = 0; bj < 2; ++bj) { const f32x4 v0 = (acc[ai][bj][m][0] * (1.0f / 128.0f) + bv[bj][0]) * 16.0f, v1 = (acc[ai][bj][m][1] * (1.0f / 128.0f) + bv[bj][1]) * 16.0f;
                    u32x2 w; w.x = pk4_fp8(v0[0], v0[1], v0[2], v0[3]); w.y = pk4_fp8(v1[0], v1[1], v1[2], v1[3]);
                    *(u32x2*)(rowp + bj * HALF) = w; } }
    }
};
struct MoeOrder {
    const PG8_LAS int* pref; const PG8_LAS int* tiles; int ntn, total, G, vcu;
    __device__ __forceinline__ bool next(int i, Unit& u) const {
        const int nfull = total / G, rem = total - nfull * G; int L = i * G + vcu; u.hs = 0;
        if (i == nfull && rem > 0 && 2 * rem <= G) { if (vcu >= 2 * rem) return false; L = nfull * G + (vcu >> 1); u.hs = 1 + (vcu & 1); }
        if (L >= total) return false;
        int e = 0;
        for (int k = 1; k < 32; ++k) e += (pref[k] <= L) ? 1 : 0;
        const int r = L - pref[e], te = tiles[e];
        const int grp = te * 4, ntq = r / grp, r2 = r - ntq * grp, mt = r2 >> 2, ntl = r2 & 3;
        u.pm = __builtin_amdgcn_readfirstlane(e * 64 + mt); u.pn = __builtin_amdgcn_readfirstlane(e * ntn + ntq * 4 + ntl); return true;
    }
    __device__ __forceinline__ void a_ready(const Unit&) const {}
    __device__ __forceinline__ void done(const Unit&) const {}
};

template <class Epi, class Sched, bool ALIGN_EPI = false, bool SP2 = false, bool FP8 = false>
__device__ __forceinline__ void gemm_phase(PG8_LAS unsigned char* lds, const Gemm g, const Sched& S, const Epi& E, const int tid_in) {
    const int tid_ = tid_in;
    const int tid = tid_, wid = __builtin_amdgcn_readfirstlane(tid >> 6), lane = tid & 63, wr = wid >> 2, wc = wid & 3, fr = lane & 15, fq = lane >> 4;
    const int K = g.K, nt = K / BK;
    unsigned voffA[2], voffB[2];
#pragma unroll
    for (int i = 0; i < 2; ++i) { int R, C; stage_rc(tid * 16 + i * 8192, R, C); const int Rb = Epi::PERM ? ((R & ~31) + perm32(R & 31)) : R;
        voffA[i] = (unsigned)(R * g.lda + C) * 2u; voffB[i] = (unsigned)(Rb * K + C) * 2u; }
    const unsigned kstep = (unsigned)(BK * 2);
    const unsigned hstepA = (unsigned)HALF * g.lda * 2, hstepB = (unsigned)HALF * K * 2;
    const unsigned tstepA = 2 * hstepA, tstepB = 2 * hstepB;
    const unsigned ldsw = (unsigned)wid * 1024u;
    const int aoff = lds_byte(wr * 64 + fr, fq * 8), boff = lds_byte(wc * 32 + fr, fq * 8);
#define PG8_SA(b, h) (((b) * 2 + (h)) * HTB)
#define PG8_SB(b, h) ((4 + (b) * 2 + (h)) * HTB)
    const __amdgpu_buffer_rsrc_t rA = __builtin_amdgcn_make_buffer_rsrc((void*)g.A, 0, 0x7fffffff, 0x00020000), rB = __builtin_amdgcn_make_buffer_rsrc((void*)g.Bt, 0, 0x7fffffff, 0x00020000);
#define PG8_STAGE(bufoff, soff, voff, rs) do { _Pragma("unroll") for (int _i = 0; _i < 2; ++_i) \
        __builtin_amdgcn_raw_ptr_buffer_load_lds(rs, (PG8_LAS void*)(lds + (bufoff) + ldsw + _i * 8192), 16, (int)(voff)[_i], (int)(soff), 0, 0); } while (0)
#define PG8_LD2(P) __builtin_shufflevector(*(const PG8_LAS bf16x8*)(P), *(const PG8_LAS bf16x8*)((P) + 1024), 0, 1, 2, 3, 4, 5, 6, 7, 8, 9, 10, 11, 12, 13, 14, 15)
#define PG8_LDA(dst, b, h) do { _Pragma("unroll") for (int m = 0; m < 4; ++m) dst[m] = PG8_LD2(lds + PG8_SA(b, h) + aoff + m * 2048); } while (0)
#define PG8_LDB(dst, b, h) do { _Pragma("unroll") for (int n = 0; n < 2; ++n) dst[n] = PG8_LD2(lds + PG8_SB(b, h) + boff + n * 2048); } while (0)
#define PG8_LO(X) __builtin_shufflevector((X), (X), 0, 1, 2, 3, 4, 5, 6, 7)
#define PG8_HI(X) __builtin_shufflevector((X), (X), 8, 9, 10, 11, 12, 13, 14, 15)
#define PG8_MMA(ai, bj, At, Bt) do { __builtin_amdgcn_s_setprio(1); if constexpr (FP8) { _Pragma("unroll") for (int m = 0; m < 4; ++m) _Pragma("unroll") for (int n = 0; n < 2; ++n) \
        acc[ai][bj][m][n] = __builtin_amdgcn_mfma_scale_f32_16x16x128_f8f6f4(__builtin_bit_cast(i32x8, Bt[n]), __builtin_bit_cast(i32x8, At[m]), acc[ai][bj][m][n], 0, 0, 0, 0x7f7f7f7f, 0, 0x7f7f7f7f); \
        asm volatile("" : "+v"(acc[ai][bj][0][0]), "+v"(acc[ai][bj][0][1]), "+v"(acc[ai][bj][1][0]), "+v"(acc[ai][bj][1][1]), "+v"(acc[ai][bj][2][0]), "+v"(acc[ai][bj][2][1]), "+v"(acc[ai][bj][3][0]), "+v"(acc[ai][bj][3][1]));   } else { \
        _Pragma("unroll") for (int m = 0; m < 4; ++m) _Pragma("unroll") for (int n = 0; n < 2; ++n) { \
        acc[ai][bj][m][n] = __builtin_amdgcn_mfma_f32_16x16x32_bf16(PG8_LO(Bt[n]), PG8_LO(At[m]), acc[ai][bj][m][n], 0, 0, 0); \
        acc[ai][bj][m][n] = __builtin_amdgcn_mfma_f32_16x16x32_bf16(PG8_HI(Bt[n]), PG8_HI(At[m]), acc[ai][bj][m][n], 0, 0, 0); } } __builtin_amdgcn_s_setprio(0); } while (0)
#define PG8_WAIT_V(n) asm volatile("s_waitcnt vmcnt(" #n ")" ::: "memory")
#define PG8_WAIT_L(n) asm volatile("s_waitcnt lgkmcnt(" #n ")" ::: "memory")
#define PG8_WAIT_V8S do { if (t != 0 || pst == 0) PG8_WAIT_V(8); else if (pst == Epi::NSTORE) asm volatile("s_waitcnt vmcnt(%0)" :: "n"(8 + Epi::NSTORE) : "memory"); else asm volatile("s_waitcnt vmcnt(%0)" :: "n"(8 + Epi::NSTORE / 2) : "memory"); } while (0)
#define PG8_BAR __builtin_amdgcn_s_barrier()
#define PG8_SCHED __builtin_amdgcn_sched_barrier(0)
    Unit cur, nxt; int ui = 0, pst = 0;
    if (!S.next(0, cur)) return;
    f32x4 acc[2][2][4][2];
    float z0_ = 0.f; asm volatile("" : "+v"(z0_));
#pragma unroll
    for (int a = 0; a < 2; ++a)
#pragma unroll
        for (int b = 0; b < 2; ++b)
#pragma unroll
            for (int m = 0; m < 4; ++m)
#pragma unroll
                for (int n = 0; n < 2; ++n) acc[a][b][m][n] = (f32x4){z0_, z0_, z0_, z0_};
    bf16x16 At[4], B0[2], B1[2];
    unsigned cA = (unsigned)cur.pm * tstepA + (cur.hs == 2 ? hstepA : 0u), cB = (unsigned)cur.pn * tstepB;
    S.a_ready(cur);
    if constexpr (SP2) {
        PG8_STAGE(PG8_SB(0, 0), cB, voffB, rB); PG8_STAGE(PG8_SB(0, 1), cB + hstepB, voffB, rB); PG8_STAGE(PG8_SA(0, 0), cA, voffA, rA); PG8_STAGE(PG8_SA(0, 1), cA + hstepA, voffA, rA);
        if (wr == 1) PG8_BAR;
        PG8_WAIT_V(2); PG8_BAR;
        PG8_STAGE(PG8_SB(1, 0), cB + kstep, voffB, rB); PG8_STAGE(PG8_SA(1, 0), cA + kstep, voffA, rA); PG8_STAGE(PG8_SB(1, 1), cB + hstepB + kstep, voffB, rB);
        PG8_WAIT_V(6); PG8_BAR;
    } else {
        PG8_STAGE(PG8_SB(0, 0), cB, voffB, rB); PG8_STAGE(PG8_SA(0, 0), cA, voffA, rA); PG8_STAGE(PG8_SB(0, 1), cB + hstepB, voffB, rB); PG8_STAGE(PG8_SA(0, 1), cA + hstepA, voffA, rA);
        if (wr == 1) PG8_BAR;
        PG8_WAIT_V(4); PG8_BAR;
        PG8_STAGE(PG8_SB(1, 0), cB + kstep, voffB, rB); PG8_STAGE(PG8_SA(1, 0), cA + kstep, voffA, rA); PG8_STAGE(PG8_SB(1, 1), cB + hstepB + kstep, voffB, rB);
        PG8_WAIT_V(6); PG8_BAR;
    }
    for (;;) {
        const bool has_next = S.next(ui + 1, nxt);
        if constexpr (Epi::BIAS_LDS) { if (wid == 0) { int lb_; asm volatile("v_mbcnt_lo_u32_b32 %0, -1, 0\n\tv_mbcnt_hi_u32_b32 %0, -1, %0" : "=v"(lb_)); E.stage_bias(cur, (PG8_LAS void*)(lds + STAGE_BYTES + (ui & 1) * 1024), lb_); } }
        const unsigned nA = has_next ? (unsigned)nxt.pm * tstepA + (nxt.hs == 2 ? hstepA : 0u) : cA, nB = has_next ? (unsigned)nxt.pn * tstepB : cB;
        const bool chalf = cur.hs != 0;
        for (int t = 0; t < nt; t += 2) {
            const bool last = (t == nt - 2);
            const unsigned a1 = cA + (unsigned)(t + 1) * kstep;
            const unsigned a2 = last ? nA : cA + (unsigned)(t + 2) * kstep, b2 = last ? nB : cB + (unsigned)(t + 2) * kstep;
            const unsigned a3 = a2 + kstep, b3 = b2 + kstep;
            if (last && has_next) S.a_ready(nxt);
            if constexpr (SP2) {
            PG8_LDB(B0, 0, 0); PG8_LDB(B1, 0, 1); PG8_SCHED; PG8_LDA(At, 0, 0); PG8_STAGE(PG8_SA(1, 1), a1 + hstepA, voffA, rA);
            PG8_WAIT_V8S; PG8_WAIT_L(0); PG8_BAR; PG8_MMA(0, 0, At, B0); PG8_MMA(0, 1, At, B1); PG8_BAR; PG8_SCHED;
            PG8_LDA(At, 0, 1); PG8_STAGE(PG8_SB(0, 0), b2, voffB, rB); PG8_STAGE(PG8_SB(0, 1), b2 + hstepB, voffB, rB); PG8_STAGE(PG8_SA(0, 0), a2, voffA, rA);
            PG8_WAIT_V8S; PG8_WAIT_L(0); PG8_BAR; if (!chalf) { PG8_MMA(1, 0, At, B0); PG8_MMA(1, 1, At, B1); } PG8_BAR; PG8_SCHED;
            PG8_LDB(B0, 1, 0); PG8_LDB(B1, 1, 1); PG8_SCHED; PG8_LDA(At, 1, 0); PG8_STAGE(PG8_SA(0, 1), a2 + hstepA, voffA, rA);
            PG8_WAIT_V(8); PG8_WAIT_L(0); PG8_BAR; PG8_MMA(0, 0, At, B0); PG8_MMA(0, 1, At, B1); PG8_BAR; PG8_SCHED;
            PG8_LDA(At, 1, 1); PG8_STAGE(PG8_SB(1, 0), b3, voffB, rB); PG8_STAGE(PG8_SB(1, 1), b3 + hstepB, voffB, rB); PG8_STAGE(PG8_SA(1, 0), a3, voffA, rA);
            PG8_WAIT_V(8); PG8_WAIT_L(0); PG8_BAR; if (!chalf) { PG8_MMA(1, 0, At, B0); PG8_MMA(1, 1, At, B1); } PG8_BAR; PG8_SCHED;
            } else {
            PG8_LDB(B0, 0, 0); PG8_SCHED; PG8_LDA(At, 0, 0); PG8_STAGE(PG8_SA(1, 1), a1 + hstepA, voffA, rA);
            PG8_WAIT_L(8); PG8_BAR; PG8_WAIT_L(0); PG8_MMA(0, 0, At, B0); PG8_BAR; PG8_SCHED;
            PG8_LDB(B1, 0, 1); PG8_STAGE(PG8_SB(0, 0), b2, voffB, rB);
            PG8_BAR; PG8_WAIT_L(0); PG8_MMA(0, 1, At, B1); PG8_BAR;
            PG8_LDA(At, 0, 1); PG8_STAGE(PG8_SA(0, 0), a2, voffA, rA);
            PG8_BAR; PG8_WAIT_L(0); PG8_MMA(1, 0, At, B0); PG8_BAR; PG8_SCHED;
            PG8_STAGE(PG8_SB(0, 1), b2 + hstepB, voffB, rB);
            PG8_WAIT_V(6); PG8_BAR; PG8_MMA(1, 1, At, B1); PG8_BAR;
            PG8_LDB(B0, 1, 0); PG8_SCHED; PG8_LDA(At, 1, 0); PG8_STAGE(PG8_SA(0, 1), a2 + hstepA, voffA, rA);
            PG8_WAIT_L(8); PG8_BAR; PG8_WAIT_L(0); PG8_MMA(0, 0, At, B0); PG8_BAR; PG8_SCHED;
            PG8_LDB(B1, 1, 1); PG8_STAGE(PG8_SB(1, 0), b3, voffB, rB);
            PG8_BAR; PG8_WAIT_L(0); PG8_MMA(0, 1, At, B1); PG8_BAR;
            PG8_LDA(At, 1, 1); PG8_STAGE(PG8_SA(1, 0), a3, voffA, rA);
            PG8_BAR; PG8_WAIT_L(0); PG8_MMA(1, 0, At, B0); PG8_BAR; PG8_SCHED;
            PG8_STAGE(PG8_SB(1, 1), b3 + hstepB, voffB, rB);
            PG8_WAIT_V(6); PG8_BAR; PG8_MMA(1, 1, At, B1); PG8_BAR;
            }
        }
        if constexpr (ALIGN_EPI) { if (wr == 0) PG8_BAR; }
        if constexpr (!Epi::AFTER_DRAIN) { int l_; asm volatile("v_mbcnt_lo_u32_b32 %0, -1, 0\n\tv_mbcnt_hi_u32_b32 %0, -1, %0" : "=v"(l_)); if constexpr (Epi::BIAS_LDS) E(acc, cur, wr, wc, l_ & 15, l_ >> 4, (const PG8_LAS float*)(lds + STAGE_BYTES + (ui & 1) * 1024)); else E(acc, cur, wr, wc, l_ & 15, l_ >> 4); S.done(cur); }
        if (!has_next) break;
        asm volatile("" : "+v"(z0_));
#pragma unroll
        for (int a = 0; a < 2; ++a)
#pragma unroll
            for (int b = 0; b < 2; ++b)
#pragma unroll
                for (int m = 0; m < 4; ++m)
#pragma unroll
                    for (int n = 0; n < 2; ++n) acc[a][b][m][n] = (f32x4){z0_, z0_, z0_, z0_};
        pst = cur.hs ? Epi::NSTORE / 2 : Epi::NSTORE; cur = nxt; cA = nA; cB = nB; ++ui;
        if constexpr (ALIGN_EPI) { if (wr == 1) PG8_BAR; }
    }
    PG8_WAIT_V(0);
    if constexpr (!ALIGN_EPI) { if (wr == 0) PG8_BAR; }
    PG8_BAR;
    if constexpr (Epi::AFTER_DRAIN) { E.fused(acc, cur, wr, wc, fr, fq, lds, wid, lane); S.done(cur); }
#undef PG8_SA
#undef PG8_SB
#undef PG8_STAGE
#undef PG8_LDA
#undef PG8_LDB
#undef PG8_MMA
#undef PG8_LD2
#undef PG8_LO
#undef PG8_HI
#undef PG8_WAIT_V
#undef PG8_WAIT_L
#undef PG8_WAIT_V8S
#undef PG8_BAR
#undef PG8_SCHED
}
}

constexpr int NB = 4, SEQ = 4096, T = NB * SEQ, D = 1024, DEPTH = 4, NEXP = 32, DEXP = 1024, MEML = 256;
constexpr int CAPROWS = 16384;
constexpr float LN_EPS = 1e-5f, ALPHA = 1.681792830507429f;
constexpr float LOG2E = 1.4426950408889634f, C2 = 0.125f * 1.4426950408889634f;
constexpr float NEG_BIG = -1.0e30f;
constexpr float NEG_RAW = -0x1p100f;
constexpr int NWAVES = 8, NTHREADS = 512;

constexpr size_t MiB = 1u << 20;
constexpr size_t WS_CTL = 0, CTL_ZERO_BYTES = 65536;
constexpr size_t WS_ROPE = 1 * MiB;
constexpr size_t WS_WUQ = 2 * MiB;
constexpr size_t WS_MEMB = 3 * MiB;
constexpr size_t WS_KVMEM = 5 * MiB;
constexpr size_t WS_WKV = 9 * MiB;
constexpr size_t WS_WOUT = 13 * MiB;
constexpr size_t WS_WIN = 21 * MiB;
constexpr size_t WS_SSQ = 41 * MiB;
constexpr size_t WS_ROWS = 42 * MiB;
constexpr size_t WS_GATES = 43 * MiB;
constexpr size_t WS_MASK = 44 * MiB;
constexpr size_t WS_XB = 52 * MiB;
constexpr size_t WS_CAT = 84 * MiB;
constexpr size_t WS_Y = 116 * MiB;
constexpr size_t WS_QQ = 148 * MiB;
constexpr size_t WS_PROJ = 188 * MiB;
constexpr size_t WS_XB8 = 268 * MiB;
constexpr size_t WS_XA = 268 * MiB;
constexpr size_t WS_XM = 332 * MiB;
constexpr size_t WS_WGU = 400 * MiB;
constexpr size_t WS_WDN = 912 * MiB;
constexpr size_t WS_XP = 1168 * MiB;
constexpr size_t WS_ACT = 2192 * MiB;
constexpr size_t WS_END = 3216 * MiB;
constexpr int CW_TMO = 0, CW_ERR = 2;
constexpr int CW_BAR = 4096;
constexpr int CW_QHEAD = 8192;
constexpr int CW_GCOUNT = 9216;
constexpr int CW_BAR2 = 12288;
constexpr int CW_GDUMMY = 9472;
static_assert((CW_BAR2 + 3456) * 4 <= (int)CTL_ZERO_BYTES && (CW_GDUMMY + 128) * 4 <= (int)CTL_ZERO_BYTES, "CTL words inside the memset region");

constexpr int RING_OFF = 0, RING_BYTES = 131072;
constexpr int LDSCTL_OFF = 143360;
constexpr int L_XB = LDSCTL_OFF + 0;
constexpr int L_Q = LDSCTL_OFF + 16;
constexpr int L_XB2 = LDSCTL_OFF + 32;
constexpr int L_PREF = LDSCTL_OFF + 64;
constexpr int L_TILES = LDSCTL_OFF + 256;
constexpr int L_CNT = LDSCTL_OFF + 384;
constexpr int L_BASE = LDSCTL_OFF + 512;
constexpr int L_ROUTE = LDSCTL_OFF + 1024;
constexpr int LDS_BYTES = 147456;

#define GAS __attribute__((address_space(1)))
#define LAS __attribute__((address_space(3)))
typedef unsigned short bf16;
typedef unsigned u32x4 __attribute__((ext_vector_type(4)));
typedef unsigned u32x2 __attribute__((ext_vector_type(2)));
typedef float f32x4 __attribute__((ext_vector_type(4)));
typedef float f32x2 __attribute__((ext_vector_type(2)));
typedef float f32x16 __attribute__((ext_vector_type(16)));
typedef short bf16x8 __attribute__((ext_vector_type(8)));
typedef short s16x4 __attribute__((ext_vector_type(4)));
typedef short v4i16_t __attribute__((ext_vector_type(4)));
typedef GAS unsigned gu32;
#define RLX_AGENT __ATOMIC_RELAXED, __HIP_MEMORY_SCOPE_AGENT
__device__ __forceinline__ unsigned pk2(float lo, float hi) { return pg8::cvt_pk_bf16(lo, hi); }
__device__ __forceinline__ float bf2f(bf16 b) { return __uint_as_float((unsigned)b << 16); }
__device__ __forceinline__ float bflo(unsigned w) { return __uint_as_float(w << 16); }
__device__ __forceinline__ float bfhi(unsigned w) { return __uint_as_float(w & 0xffff0000u); }
__device__ __forceinline__ int crow(int r, int hi) { return (r & 3) + 8 * (r >> 2) + 4 * hi; }
__device__ __forceinline__ float swapmax(float m) { auto rr = __builtin_amdgcn_permlane32_swap(__float_as_uint(m), __float_as_uint(m), false, false); return fmaxf(__uint_as_float(rr[0]), __uint_as_float(rr[1])); }
__device__ __forceinline__ float swapsum(float m) { auto rr = __builtin_amdgcn_permlane32_swap(__float_as_uint(m), __float_as_uint(m), false, false); return __uint_as_float(rr[0]) + __uint_as_float(rr[1]); }
__device__ __forceinline__ int lane_id_now() { int l; asm volatile("v_mbcnt_lo_u32_b32 %0, -1, 0\n\tv_mbcnt_hi_u32_b32 %0, -1, %0" : "=v"(l)); return l; }
__device__ __forceinline__ float shx(float v, int m) { return __int_as_float(__builtin_amdgcn_ds_bpermute((lane_id_now() ^ m) << 2, __float_as_int(v))); }
__device__ __forceinline__ int shxi(int v, int m) { return __builtin_amdgcn_ds_bpermute((lane_id_now() ^ m) << 2, v); }
__device__ __forceinline__ int shli(int v, int src) { return __builtin_amdgcn_ds_bpermute(src << 2, v); }
__device__ __forceinline__ float wave_sum(float v) {
#define WS_DPP(CTRL) v += __int_as_float(__builtin_amdgcn_update_dpp(0, __float_as_int(v), (CTRL), 0xF, 0xF, false))
    WS_DPP(0xB1); WS_DPP(0x4E); WS_DPP(0x141); WS_DPP(0x140);
#undef WS_DPP
    const float r0 = __int_as_float(__builtin_amdgcn_readlane(__float_as_int(v), 0)), r1 = __int_as_float(__builtin_amdgcn_readlane(__float_as_int(v), 16));
    const float r2 = __int_as_float(__builtin_amdgcn_readlane(__float_as_int(v), 32)), r3 = __int_as_float(__builtin_amdgcn_readlane(__float_as_int(v), 48));
    return (r0 + r1) + (r2 + r3);
}

#define XB_TMO      128
#define XB_XCNT(j)  (256  + 64 * (j))
#define XB_XSUB(j)  (1280 + 64 * (j))
#define XB_XGEN(j)  (2304 + 64 * (j))
#define XB_TOP      3328
#define XB_TOPGEN   3392
#define XCD_BAR_WORDS 3456
#define XB_SPIN_CAP (1u << 18)

__device__ __forceinline__ unsigned xb_ld(unsigned* p)              { return __hip_atomic_load(p, __ATOMIC_RELAXED, __HIP_MEMORY_SCOPE_AGENT); }
__device__ __forceinline__ unsigned xb_add(unsigned* p, unsigned v) { return __hip_atomic_fetch_add(p, v, __ATOMIC_RELAXED, __HIP_MEMORY_SCOPE_AGENT); }
__device__ __forceinline__ unsigned xb_xcc_id() { return (unsigned)__builtin_amdgcn_s_getreg((3 << 11) | 20) & 0xFu; }
#define XB_SPIN(cond, bar) do { unsigned _sp = 0; while (cond) { __builtin_amdgcn_s_sleep(1); \
    if ((++_sp & 255u) == 0u) { if (xb_ld(&(bar)[XB_TMO])) break; if (_sp > XB_SPIN_CAP) { atomicAdd(&(bar)[XB_TMO], 1u); break; } } } } while (0)

struct XcdBarrier {
    unsigned* bar; unsigned x;
    volatile LAS unsigned* st;
};

__device__ __forceinline__ XcdBarrier xcd_barrier_post(unsigned* bar, volatile LAS unsigned* st) {
    XcdBarrier b; b.bar = bar; b.x = xb_xcc_id(); b.st = st;
    if (threadIdx.x == 0) (void)xb_add(&bar[XB_XCNT(b.x)], 1u);
    return b;
}
__device__ __forceinline__ void xcd_barrier_complete(unsigned* bar, unsigned x, unsigned& nloc, unsigned& nx, const unsigned G) {
    unsigned sum, cnt, mine, sp = 0u;
    for (;;) {
        sum = 0u; cnt = 0u; mine = 0u;
#pragma unroll
        for (unsigned j = 0; j < 16; ++j) { const unsigned c = xb_ld(&bar[XB_XCNT(j)]); sum += c; cnt += (c > 0u) ? 1u : 0u; mine = (j == x) ? c : mine; }
        if (sum == G) break;
        __builtin_amdgcn_s_sleep(1);
        if ((++sp & 255u) == 0u) { if (xb_ld(&bar[XB_TMO])) break; if (sp > XB_SPIN_CAP) { atomicAdd(&bar[XB_TMO], 1u); break; } }
    }
    nloc = mine > 0u ? mine : 1u; nx = cnt > 0u ? cnt : 1u;
}

__device__ __noinline__ void xcd_barrier_ni(unsigned* bar_, unsigned x_, unsigned st_off, bool leader_thread, unsigned G_) {
    XcdBarrier b; b.bar = bar_; b.x = x_; b.st = (volatile LAS unsigned*)(uintptr_t)st_off;
    asm volatile("s_waitcnt vmcnt(0)" ::: "memory");
    __syncthreads();
    if (leader_thread) {
        unsigned* bar = b.bar;
        __builtin_amdgcn_s_waitcnt(0);
        unsigned nloc = b.st[0], nx = b.st[1];
        if (nloc == 0u) { xcd_barrier_complete(bar, b.x, nloc, nx, G_); b.st[0] = nloc; b.st[1] = nx; }
        const unsigned old = xb_add(&bar[XB_XSUB(b.x)], 1u);
        const unsigned gen = old / nloc;
        if (old + 1u == (gen + 1u) * nloc) {
            __builtin_amdgcn_fence(__ATOMIC_RELEASE, "agent");
            asm volatile("s_waitcnt vmcnt(0)" ::: "memory");
            const unsigned og = xb_add(&bar[XB_TOP], 1u);
            const unsigned tg = og / nx;
            if (og + 1u == (tg + 1u) * nx) xb_add(&bar[XB_TOPGEN], 1u);
            else XB_SPIN(xb_ld(&bar[XB_TOPGEN]) == tg, bar);
            __builtin_amdgcn_fence(__ATOMIC_ACQUIRE, "agent");
            xb_add(&bar[XB_XGEN(b.x)], 1u);
            asm volatile("s_waitcnt vmcnt(0)" ::: "memory");
        } else {
            XB_SPIN(xb_ld(&bar[XB_XGEN(b.x)]) == gen, bar);
            __builtin_amdgcn_fence(__ATOMIC_ACQUIRE, "agent");
            asm volatile("s_waitcnt vmcnt(0)" ::: "memory");
        }
    }
    __syncthreads();
}
__device__ __forceinline__ void xcd_barrier(const XcdBarrier& b, bool leader_thread, unsigned G) { xcd_barrier_ni(b.bar, b.x, (unsigned)(uintptr_t)b.st, leader_thread, G); }

struct Frame {
    LAS unsigned char* lds;
    gu32* ctl;
    int tid, lane, wave, bid, G, vcu;
};
struct Job { const float* src; bf16* dst; const float* scale; int ldw, K, col0, nvalid, nblk, row0, item0, f8; float mul; int pad; };
constexpr int NJOBS = 16;
struct Args {
    const float* in[22]; float* out; unsigned char* ws; Job jobs[NJOBS];
    int njob_items, ph_lo, ph_hi, pad;
};
typedef const __attribute__((address_space(4))) Args* ArgsP;

struct TrItem { const float* src; const float* scale; bf16* dst; int ldw, k0, colbase, nvalid, perm, dstK, drow0, f8; float mul; };
__device__ __forceinline__ void tr_load(f32x4 (&v)[16], const TrItem& I, int lane, int wid) {
#pragma unroll
    for (int rr = 0; rr < 16; ++rr) {
        const int k = rr * 8 + wid, n = 4 * lane;
        const float* srow = I.src + (size_t)(I.k0 + k) * I.ldw + I.colbase;
        const int col = (I.perm && n >= 128) ? n + 896 : n;
        if (n + 3 < I.nvalid) v[rr] = __builtin_nontemporal_load((const f32x4*)(srow + col));
        else { f32x4 t; t[0] = (n < I.nvalid) ? srow[col] : 0.f; t[1] = (n + 1 < I.nvalid) ? srow[col + 1] : 0.f; t[2] = (n + 2 < I.nvalid) ? srow[col + 2] : 0.f; t[3] = 0.f; v[rr] = t; }
    }
}
__device__ __forceinline__ void tr_to_lds(const f32x4 (&v)[16], LAS float* scr, const TrItem& I, int lane, int wid) {
#pragma unroll
    for (int rr = 0; rr < 16; ++rr) {
        const int k = rr * 8 + wid;
        const float sc = I.scale ? I.scale[I.k0 + k] * I.mul : I.mul;
        *(LAS f32x4*)(scr + k * 256 + 4 * (lane ^ ((k >> 3) & 15))) = v[rr] * sc;
    }
}
__device__ __forceinline__ void tr_store(const LAS float* scr, const TrItem& I, int lane, int wid) {
#pragma unroll
    for (int q = 0; q < 8; ++q) {
        const int n = wid * 32 + q * 4 + (lane >> 4), a = lane & 15;
        const LAS float* s = scr + (8 * a) * 256 + 4 * ((n >> 2) ^ a) + (n & 3);
        if (I.f8) { u32x2 o; o.x = pg8::pk4_fp8(s[0], s[256], s[2 * 256], s[3 * 256]); o.y = pg8::pk4_fp8(s[4 * 256], s[5 * 256], s[6 * 256], s[7 * 256]);
            __builtin_nontemporal_store(o, (u32x2*)((unsigned char*)I.dst + (size_t)(I.drow0 + n) * I.dstK + I.k0 + 8 * a)); }
        else { u32x4 o; o.x = pk2(s[0], s[256]); o.y = pk2(s[2 * 256], s[3 * 256]); o.z = pk2(s[4 * 256], s[5 * 256]); o.w = pk2(s[6 * 256], s[7 * 256]);
            *(u32x4*)(I.dst + (size_t)(I.drow0 + n) * I.dstK + I.k0 + 8 * a) = o; }
    }
}
__device__ __forceinline__ void sincos_d(double x, float& c, float& s) {
    const double TWO_PI = 6.283185307179586476925, INV_2PI = 0.15915494309189533577;
    const double r = x - TWO_PI * rint(x * INV_2PI), r2 = r * r;
    double sn = 1.0, cs = 1.0;
#pragma unroll
    for (int k = 14; k >= 1; --k) { sn = 1.0 - sn * r2 / (double)((2 * k) * (2 * k + 1)); cs = 1.0 - cs * r2 / (double)((2 * k - 1) * (2 * k)); }
    s = (float)(sn * r); c = (float)cs;
}
constexpr int MOE_ITEMS = DEPTH * NEXP * 96, MOE_ITEMS_LAYER = NEXP * 96;
#ifndef MK_CVT_LAYERS_P0
#define MK_CVT_LAYERS_P0 4
#endif
__device__ __forceinline__ TrItem tr_decode(ArgsP A, unsigned char* ws, int it) {
    TrItem I;
    if (it < MOE_ITEMS) {
        const int le = it / 96, r = it % 96; I.scale = nullptr; I.nvalid = 256; I.dstK = 1024; I.f8 = 1;
        if (r < 64) { const int kb = r >> 3, nb = r & 7; I.src = A->in[16] + (size_t)le * (1024 * 2048); I.ldw = 2048; I.k0 = kb * 128; I.colbase = nb * 128; I.perm = 1;
            I.dst = (bf16*)(ws + WS_WGU + (size_t)le * (2048 * 1024)); I.drow0 = nb * 256; I.mul = 64.0f; }
        else { const int r2 = r - 64, kb = r2 >> 2, nb = r2 & 3; I.src = A->in[18] + (size_t)le * (1024 * 1024); I.ldw = 1024; I.k0 = kb * 128; I.colbase = nb * 256; I.perm = 0;
            I.dst = (bf16*)(ws + WS_WDN + (size_t)le * (1024 * 1024)); I.drow0 = nb * 256; I.mul = 128.0f; }
    } else {
        const int ji = it - MOE_ITEMS; int j = 0;
#pragma unroll
        for (int q = 1; q < NJOBS; ++q) j += (A->jobs[q].item0 <= ji) ? 1 : 0;
        const int K = A->jobs[j].K, r = ji - A->jobs[j].item0, nkb = K >> 7, kb = r % nkb, nb = r / nkb;
        int nv = A->jobs[j].nvalid - nb * 256; nv = nv < 0 ? 0 : (nv > 256 ? 256 : nv);
        I.src = A->jobs[j].src; I.scale = A->jobs[j].scale; I.dst = A->jobs[j].dst; I.ldw = A->jobs[j].ldw; I.k0 = kb * 128; I.colbase = A->jobs[j].col0 + nb * 256; I.nvalid = nv; I.perm = 0;
        I.dstK = K; I.drow0 = A->jobs[j].row0 + nb * 256; I.f8 = A->jobs[j].f8; I.mul = A->jobs[j].mul;
    }
    return I;
}
__device__ __forceinline__ void tr_run(Frame& F, ArgsP A, unsigned char* ws, int j0, int step, int j1, int split, int gap) {
    LAS float* scr = (LAS float*)(F.lds + RING_OFF);
#define TR_ITEM(jj) tr_decode(A, ws, (jj) < split ? (jj) : (jj) + gap)
    if (j0 < j1) {
        f32x4 vA[16], vB[16];
        TrItem ia = TR_ITEM(j0), ib = ia;
        tr_load(vA, ia, F.lane, F.wave);
        if (j0 + step < j1) { ib = TR_ITEM(j0 + step); tr_load(vB, ib, F.lane, F.wave); }
        for (int j = j0; j < j1; j += 2 * step) {
            tr_to_lds(vA, scr, ia, F.lane, F.wave);
            __syncthreads();
            const TrItem ca = ia;
            if (j + 2 * step < j1) { ia = TR_ITEM(j + 2 * step); tr_load(vA, ia, F.lane, F.wave); }
            tr_store(scr, ca, F.lane, F.wave);
            __syncthreads();
            if (j + step < j1) {
                tr_to_lds(vB, scr, ib, F.lane, F.wave);
                __syncthreads();
                const TrItem cb = ib;
                if (j + 3 * step < j1) { ib = TR_ITEM(j + 3 * step); tr_load(vB, ib, F.lane, F.wave); }
                tr_store(scr, cb, F.lane, F.wave);
                __syncthreads();
            }
        }
    }
#undef TR_ITEM
}
__device__ __forceinline__ void p0_prologue(Frame& F, ArgsP A, unsigned char* ws, const int part) {
    constexpr int NP0 = MK_CVT_LAYERS_P0 * MOE_ITEMS_LAYER;
    const int total = NP0 + A->njob_items;
    const int it_lo = (part == 1) ? NP0 : 0, it_hi = (part == 2) ? NP0 : total;
    tr_run(F, A, ws, it_lo + F.bid, F.G, it_hi, NP0, MOE_ITEMS - NP0);
    if (part == 2) return;
    const size_t gt = (size_t)F.bid * NTHREADS + F.tid, NT = (size_t)F.G * NTHREADS;
    { const float* x = A->in[0]; bf16* xb = (bf16*)(ws + WS_XB);
      for (size_t i = gt; i < (size_t)T * D / 8; i += 4 * NT) {
          f32x4 a[4], b[4];
#pragma unroll
          for (int k = 0; k < 4; ++k) if (i + k * NT < (size_t)T * D / 8) { a[k] = *(const f32x4*)(x + (i + k * NT) * 8); b[k] = *(const f32x4*)(x + (i + k * NT) * 8 + 4); }
#pragma unroll
          for (int k = 0; k < 4; ++k) if (i + k * NT < (size_t)T * D / 8) { u32x4 o; o.x = pk2(a[k][0], a[k][1]); o.y = pk2(a[k][2], a[k][3]); o.z = pk2(b[k][0], b[k][1]); o.w = pk2(b[k][2], b[k][3]); *(u32x4*)(xb + (i + k * NT) * 8) = o; } }
      const float* mm = A->in[1]; bf16* mb = (bf16*)(ws + WS_MEMB);
      for (size_t i = gt; i < (size_t)NB * MEML * D / 8; i += NT) { const f32x4 a = *(const f32x4*)(mm + i * 8), b = *(const f32x4*)(mm + i * 8 + 4);
          u32x4 o; o.x = pk2(a[0], a[1]); o.y = pk2(a[2], a[3]); o.z = pk2(b[0], b[1]); o.w = pk2(b[2], b[3]); *(u32x4*)(mb + i * 8) = o; } }
    { f32x2* rt = (f32x2*)(ws + WS_ROPE);
      for (size_t i = gt; i < (size_t)SEQ * 8; i += NT) { const int pos = (int)(i >> 3), k = (int)(i & 7);
          const double inv = k == 0 ? 1.0 : k == 1 ? 0.19392274474868576 : k == 2 ? 0.03760603093086393 : k == 3 ? 0.007292664737217109 : k == 4 ? 0.001414213562373095 : k == 5 ? 0.0002742481756762073 : k == 6 ? 5.318295896944988e-05 : 1.031338537721246e-05;
          float c, s; sincos_d((double)pos * inv, c, s); rt[i] = (f32x2){c, s}; } }
}

struct AttnP {
    const bf16* Q; const bf16* K; const bf16* V; bf16* O; const unsigned long long* mask;
    int ldq, ldk, ldv, ldo, qrow0, krow0, t_lo, t_hi, qpos0, mode, has_sink, o8; float sink2;
};
constexpr int AT_K0 = 0, AT_KSZ = 64 * 144, AT_V0 = 2 * AT_KSZ, AT_VSZ = 8192;
__device__ __forceinline__ s16x4 vtr(const LAS unsigned char* p) { return __builtin_bit_cast(s16x4, __builtin_amdgcn_ds_read_tr16_b64_v4i16((LAS v4i16_t*)p)); }
__device__ __forceinline__ void attn_unit(const Frame& F, const AttnP& P) {
    const int tid = F.tid, lane = F.lane, wid = F.wave, r32 = lane & 31, hi = lane >> 5;
    LAS unsigned char* lds = F.lds + RING_OFF;
    const int skey = tid >> 3, sc = tid & 7;
    const int kdst = skey * 144 + sc * 16;
    const int vdst = (sc >> 2) * 4096 + (skey >> 4) * 1024 + (skey & 15) * 64 + (sc & 3) * 16;
    const bf16* kg = P.K + (size_t)(P.krow0 + skey) * P.ldk + sc * 8;
    const bf16* vg = P.V + (size_t)(P.krow0 + skey) * P.ldv + sc * 8;
    const int qrow = P.qrow0 + wid * 32 + r32;
    bf16x8 qr[4];
#pragma unroll
    for (int d0 = 0; d0 < 4; ++d0) qr[d0] = *(const bf16x8*)(P.Q + (size_t)qrow * P.ldq + d0 * 16 + hi * 8);
    const int qmin = P.qpos0 + wid * 32, qmax = qmin + 31, qpos = qmin + r32;
    float m = P.has_sink ? P.sink2 : NEG_BIG;
    f32x16 o0 = {}, o1 = {}, lacc;
#pragma unroll
    for (int r = 0; r < 16; ++r) lacc[r] = P.has_sink ? 1.f : 0.f;
    const bf16x8 ones8 = (bf16x8){0x3f80, 0x3f80, 0x3f80, 0x3f80, 0x3f80, 0x3f80, 0x3f80, 0x3f80};
    const int vp0 = ((lane >> 4) & 1) * 32 + (lane & 3) * 8 + (4 * hi + ((lane & 15) >> 2)) * 64;
    u32x4 kreg = *(const u32x4*)(kg + (size_t)P.t_lo * 64 * P.ldk), vreg = *(const u32x4*)(vg + (size_t)P.t_lo * 64 * P.ldv);
    const unsigned long long* mrow = P.mode == 2 ? P.mask + (size_t)(wid * 32 + r32) * 64 : nullptr;
    unsigned long long mcur = 0ull, mnxt = P.mode == 2 ? mrow[P.t_lo] : 0ull;
    *(LAS u32x4*)(lds + AT_K0 + kdst) = kreg; *(LAS u32x4*)(lds + AT_V0 + vdst) = vreg;
    __syncthreads();
    for (int t = P.t_lo; t < P.t_hi; ++t) {
        const int cur = (t - P.t_lo) & 1;
        const bool more = (t + 1 < P.t_hi);
        mcur = mnxt;
        if (more) { kreg = *(const u32x4*)(kg + (size_t)(t + 1) * 64 * P.ldk); vreg = *(const u32x4*)(vg + (size_t)(t + 1) * 64 * P.ldv); if (P.mode == 2) mnxt = mrow[t + 1]; }
        bool active = true;
        if (P.mode == 1) active = (64 * t + 63 >= qmin - 127) && (64 * t <= qmax);
        if (P.mode == 2) active = (64 * t <= qmax);
        if (active) {
            const LAS unsigned char* Kb = lds + AT_K0 + cur * AT_KSZ; const LAS unsigned char* Vb = lds + AT_V0 + cur * AT_VSZ;
            f32x16 p0 = {}, p1 = {};
#pragma unroll
            for (int d0 = 0; d0 < 4; ++d0) {
                const bf16x8 a0 = *(const LAS bf16x8*)(Kb + r32 * 144 + (2 * d0 + hi) * 16);
                const bf16x8 a1 = *(const LAS bf16x8*)(Kb + (r32 + 32) * 144 + (2 * d0 + hi) * 16);
                p0 = __builtin_amdgcn_mfma_f32_32x32x16_bf16(a0, qr[d0], p0, 0, 0, 0);
                p1 = __builtin_amdgcn_mfma_f32_32x32x16_bf16(a1, qr[d0], p1, 0, 0, 0);
            }
            float mx = fmaxf(p0[0], p1[0]);
#pragma unroll
            for (int r = 1; r < 16; ++r) mx = fmaxf(fmaxf(mx, p0[r]), p1[r]);
            mx = swapmax(mx) * C2;
            const float mnew = fmaxf(m, mx), alpha = __builtin_amdgcn_exp2f(m - mnew);
            m = mnew;
#pragma unroll
            for (int r = 0; r < 16; r += 2) {
                f32x2 a_ = {p0[r], p0[r + 1]}, b_ = {p1[r], p1[r + 1]}; const f32x2 c2_ = {C2, C2}, nm_ = {-mnew, -mnew};
                a_ = __builtin_elementwise_fma(a_, c2_, nm_); b_ = __builtin_elementwise_fma(b_, c2_, nm_);
                p0[r] = __builtin_amdgcn_exp2f(a_[0]); p0[r + 1] = __builtin_amdgcn_exp2f(a_[1]); p1[r] = __builtin_amdgcn_exp2f(b_[0]); p1[r + 1] = __builtin_amdgcn_exp2f(b_[1]); }
            if (P.mode == 1) {
                const int rel = qpos - 64 * t - 4 * hi;
#pragma unroll
                for (int r = 0; r < 16; ++r) { const int c = (r & 3) + 8 * (r >> 2);
                    p0[r] = ((unsigned)(rel - c) < 128u) ? p0[r] : 0.f; p1[r] = ((unsigned)(rel - c - 32) < 128u) ? p1[r] : 0.f; }
            } else if (P.mode == 2) {
                const unsigned long long w = mcur >> (4 * hi);
                const int wl = (int)(unsigned)w, wh = (int)(unsigned)(w >> 32);
#pragma unroll
                for (int r = 0; r < 16; ++r) { const int c = (r & 3) + 8 * (r >> 2);
                    int d0_ = __builtin_amdgcn_sbfe(wl, c, 1), d1_ = __builtin_amdgcn_sbfe(wh, c, 1); asm("" : "+v"(d0_), "+v"(d1_));
                    p0[r] = __uint_as_float(__float_as_uint(p0[r]) & (unsigned)d0_); p1[r] = __uint_as_float(__float_as_uint(p1[r]) & (unsigned)d1_); }
            }
            if (__any(alpha != 1.0f)) {
#pragma unroll
                for (int r = 0; r < 16; ++r) { o0[r] *= alpha; o1[r] *= alpha; lacc[r] *= alpha; }
            }
            bf16x8 pf[4];
            { u32x4 w;
              w.x = pk2(p0[0], p0[1]); w.y = pk2(p0[2], p0[3]); w.z = pk2(p0[4], p0[5]); w.w = pk2(p0[6], p0[7]); pf[0] = __builtin_bit_cast(bf16x8, w);
              w.x = pk2(p0[8], p0[9]); w.y = pk2(p0[10], p0[11]); w.z = pk2(p0[12], p0[13]); w.w = pk2(p0[14], p0[15]); pf[1] = __builtin_bit_cast(bf16x8, w);
              w.x = pk2(p1[0], p1[1]); w.y = pk2(p1[2], p1[3]); w.z = pk2(p1[4], p1[5]); w.w = pk2(p1[6], p1[7]); pf[2] = __builtin_bit_cast(bf16x8, w);
              w.x = pk2(p1[8], p1[9]); w.y = pk2(p1[10], p1[11]); w.z = pk2(p1[12], p1[13]); w.w = pk2(p1[14], p1[15]); pf[3] = __builtin_bit_cast(bf16x8, w); }
#pragma unroll
            for (int ks = 0; ks < 4; ++ks) {
                const s16x4 a_lo = vtr(Vb + vp0 + ks * 1024), a_hi = vtr(Vb + vp0 + ks * 1024 + 512);
                const s16x4 b_lo = vtr(Vb + vp0 + 4096 + ks * 1024), b_hi = vtr(Vb + vp0 + 4096 + ks * 1024 + 512);
                const bf16x8 va = (bf16x8){a_lo[0], a_lo[1], a_lo[2], a_lo[3], a_hi[0], a_hi[1], a_hi[2], a_hi[3]};
                const bf16x8 vb = (bf16x8){b_lo[0], b_lo[1], b_lo[2], b_lo[3], b_hi[0], b_hi[1], b_hi[2], b_hi[3]};
                o0 = __builtin_amdgcn_mfma_f32_32x32x16_bf16(va, pf[ks], o0, 0, 0, 0);
                o1 = __builtin_amdgcn_mfma_f32_32x32x16_bf16(vb, pf[ks], o1, 0, 0, 0);
                lacc = __builtin_amdgcn_mfma_f32_32x32x16_bf16(ones8, pf[ks], lacc, 0, 0, 0);
            }
        }
        if (more) { *(LAS u32x4*)(lds + AT_K0 + (cur ^ 1) * AT_KSZ + kdst) = kreg; *(LAS u32x4*)(lds + AT_V0 + (cur ^ 1) * AT_VSZ + vdst) = vreg; }
        __syncthreads();
    }
    const float inv = 1.0f / lacc[0];
    if (P.o8) {
        unsigned char* orow8 = (unsigned char*)P.O + (size_t)qrow * P.ldo + 4 * hi;
#pragma unroll
        for (int g = 0; g < 4; ++g) {
            *(unsigned*)(orow8 + 8 * g) = pg8::pk4_fp8(o0[4 * g] * inv, o0[4 * g + 1] * inv, o0[4 * g + 2] * inv, o0[4 * g + 3] * inv);
            *(unsigned*)(orow8 + 32 + 8 * g) = pg8::pk4_fp8(o1[4 * g] * inv, o1[4 * g + 1] * inv, o1[4 * g + 2] * inv, o1[4 * g + 3] * inv);
        }
        return;
    }
    bf16* orow = P.O + (size_t)qrow * P.ldo + 4 * hi;
#pragma unroll
    for (int g = 0; g < 4; ++g) {
        u32x2 w0, w1;
        w0.x = pk2(o0[4 * g] * inv, o0[4 * g + 1] * inv); w0.y = pk2(o0[4 * g + 2] * inv, o0[4 * g + 3] * inv);
        w1.x = pk2(o1[4 * g] * inv, o1[4 * g + 1] * inv); w1.y = pk2(o1[4 * g + 2] * inv, o1[4 * g + 3] * inv);
        *(u32x2*)(orow + 8 * g) = w0; *(u32x2*)(orow + 32 + 8 * g) = w1;
    }
}

__device__ __forceinline__ void conv_item(const bf16* PROJ, const float* cw, bf16* CAT, int idx) {
    const int chunk = idx % 96, run = idx / 96, c0 = chunk * 8, t0 = run * 16;
    float w0[8], w1[8], w2[8];
#pragma unroll
    for (int j = 0; j < 8; ++j) { w0[j] = cw[c0 + j]; w1[j] = cw[768 + c0 + j]; w2[j] = cw[1536 + c0 + j]; }
    float z1[8], z2[8];
#pragma unroll
    for (int j = 0; j < 8; ++j) { z1[j] = 0.f; z2[j] = 0.f; }
    if ((t0 & (SEQ - 1)) != 0) {
#pragma unroll
        for (int back = 2; back >= 1; --back) {
            const bf16* row = PROJ + (size_t)(t0 - back) * 2560;
            const u32x4 uu = *(const u32x4*)(row + c0), cc = *(const u32x4*)(row + 1536 + c0);
            float z[8];
            z[0] = bflo(uu.x) * bflo(cc.x); z[1] = bfhi(uu.x) * bfhi(cc.x); z[2] = bflo(uu.y) * bflo(cc.y); z[3] = bfhi(uu.y) * bfhi(cc.y);
            z[4] = bflo(uu.z) * bflo(cc.z); z[5] = bfhi(uu.z) * bfhi(cc.z); z[6] = bflo(uu.w) * bflo(cc.w); z[7] = bfhi(uu.w) * bfhi(cc.w);
#pragma unroll
            for (int j = 0; j < 8; ++j) { if (back == 2) z2[j] = z[j]; else z1[j] = z[j]; }
        }
    }
    u32x4 in_[2][4][3];
#define CONV_LOADG(G, S) do { _Pragma("unroll") for (int k = 0; k < 4; ++k) { const bf16* row = PROJ + (size_t)(t0 + 4 * (G) + k) * 2560; \
        in_[S][k][0] = *(const u32x4*)(row + c0); in_[S][k][1] = *(const u32x4*)(row + 768 + c0); in_[S][k][2] = *(const u32x4*)(row + 1536 + c0); } } while (0)
    CONV_LOADG(0, 0);
#pragma unroll
    for (int g = 0; g < 4; ++g) {
        if (g < 3) CONV_LOADG(g + 1, (g + 1) & 1);
#pragma unroll
        for (int k = 0; k < 4; ++k) {
            const int i = 4 * g + k;
            const u32x4 uu = in_[g & 1][k][0], bb = in_[g & 1][k][1], cc = in_[g & 1][k][2];
            float z[8], b[8], r[8];
            z[0] = bflo(uu.x) * bflo(cc.x); z[1] = bfhi(uu.x) * bfhi(cc.x); z[2] = bflo(uu.y) * bflo(cc.y); z[3] = bfhi(uu.y) * bfhi(cc.y);
            z[4] = bflo(uu.z) * bflo(cc.z); z[5] = bfhi(uu.z) * bfhi(cc.z); z[6] = bflo(uu.w) * bflo(cc.w); z[7] = bfhi(uu.w) * bfhi(cc.w);
            b[0] = bflo(bb.x); b[1] = bfhi(bb.x); b[2] = bflo(bb.y); b[3] = bfhi(bb.y); b[4] = bflo(bb.z); b[5] = bfhi(bb.z); b[6] = bflo(bb.w); b[7] = bfhi(bb.w);
#pragma unroll
            for (int j = 0; j < 8; ++j) { r[j] = b[j] * ((w0[j] * z2[j] + w1[j] * z1[j]) + w2[j] * z[j]); z2[j] = z1[j]; z1[j] = z[j]; }
            u32x4 o; o.x = pk2(r[0], r[1]); o.y = pk2(r[2], r[3]); o.z = pk2(r[4], r[5]); o.w = pk2(r[6], r[7]);
            (void)o; u32x2 o8_; o8_.x = pg8::pk4_fp8(r[0], r[1], r[2], r[3]); o8_.y = pg8::pk4_fp8(r[4], r[5], r[6], r[7]); *(u32x2*)((unsigned char*)CAT + (size_t)(t0 + i) * 1024 + c0) = o8_;
        }
    }
#undef CONV_LOADG
}

__device__ __forceinline__ void mixer_phase(Frame& F, ArgsP A, unsigned char* ws, int layer, int kind, int qidx) {
    const bf16* PROJ = (const bf16*)(ws + WS_PROJ); bf16* CAT = (bf16*)(ws + WS_CAT); const bf16* KVM = (const bf16*)(ws + WS_KVMEM) + layer * 512;
    const int nproj = kind == 0 ? 2560 : (kind == 1 ? 1280 : 1536), qm_off = kind == 0 ? 2304 : (kind == 1 ? 768 : 1280);
    const int n_main = kind == 0 ? 0 : 768, n_mem = 256, n_conv = kind == 0 ? 192 : 0;
    constexpr int CVT_PER = 12, N_CVT = (DEPTH - MK_CVT_LAYERS_P0) * MOE_ITEMS_LAYER / CVT_PER;
    const int n_cvt = (kind == 1) ? N_CVT : 0;
    const int total = n_main + n_mem + n_conv + n_cvt;
    volatile LAS unsigned* qw = (volatile LAS unsigned*)(F.lds + L_Q);
    for (;;) {
        if (F.tid == 0) *qw = __hip_atomic_fetch_add(F.ctl + CW_QHEAD + 64 * qidx, 1u, RLX_AGENT);
        __syncthreads();
        int u = (int)*qw;
        __syncthreads();
        if (u >= total) break;
        if (n_cvt) {
            if (u < 3 * n_cvt) { if (u % 3 == 2) { const int c = u / 3; tr_run(F, A, ws, MK_CVT_LAYERS_P0 * MOE_ITEMS_LAYER + c * CVT_PER, 1, MK_CVT_LAYERS_P0 * MOE_ITEMS_LAYER + c * CVT_PER + CVT_PER, MOE_ITEMS, 0); continue; } u = (u / 3) * 2 + u % 3; }
            else u -= n_cvt;
        }
        if (u < n_main) {
            AttnP P;
            if (kind == 1) {
                const int qt = 15 - u / 48, rem = u % 48, b = rem / 12, h = rem % 12, g = h / 3;
                P.Q = (const bf16*)(ws + WS_QQ) + h * 64; P.ldq = 1280; P.K = PROJ + 256 + g * 64; P.ldk = 1280; P.V = PROJ + 512 + g * 64; P.ldv = 1280;
                P.O = (bf16*)((unsigned char*)CAT + h * 64); P.ldo = 1024; P.o8 = 1; P.qrow0 = b * SEQ + qt * 256; P.krow0 = b * SEQ; P.t_lo = 0; P.t_hi = qt * 4 + 4; P.qpos0 = qt * 256; P.mode = 2;
                P.mask = (const unsigned long long*)(ws + WS_MASK) + (size_t)P.qrow0 * 64; P.has_sink = 0; P.sink2 = 0.f;
            } else {
                const int b = u / 192, h = (u / 16) % 12, qt = u % 16, g = h / 3;
                P.Q = PROJ + h * 64; P.ldq = 1536; P.K = PROJ + 768 + g * 64; P.ldk = 1536; P.V = PROJ + 1024 + g * 64; P.ldv = 1536;
                P.O = (bf16*)((unsigned char*)CAT + h * 64); P.ldo = 1024; P.o8 = 1; P.qrow0 = b * SEQ + qt * 256; P.krow0 = b * SEQ; P.qpos0 = qt * 256;
                P.t_lo = qt == 0 ? 0 : (qt * 256 - 128) / 64; P.t_hi = qt * 4 + 4; P.mode = 1; P.mask = nullptr; P.has_sink = 1; P.sink2 = A->in[9][h] * LOG2E;
            }
            attn_unit(F, P);
        } else if (u < n_main + n_mem) {
            const int v = u - n_main, b = v / 64, h = (v / 16) % 4, qt = v % 16;
            AttnP P;
            P.Q = PROJ + qm_off + h * 64; P.ldq = nproj; P.K = KVM + h * 64; P.ldk = 2048; P.V = KVM + 256 + h * 64; P.ldv = 2048;
            P.o8 = 1; P.O = P.o8 ? (bf16*)((unsigned char*)CAT + 768 + h * 64) : CAT + 768 + h * 64; P.ldo = 1024; P.qrow0 = b * SEQ + qt * 256; P.krow0 = b * MEML; P.t_lo = 0; P.t_hi = 4; P.qpos0 = qt * 256; P.mode = 0; P.mask = nullptr; P.has_sink = 0; P.sink2 = 0.f;
            attn_unit(F, P);
        } else {
            const int v = u - n_main - n_mem;
            conv_item(PROJ, A->in[3] + (size_t)(layer == 0 ? 0 : 1) * 3 * 768, CAT, v * NTHREADS + F.tid);
        }
    }
}

__device__ __forceinline__ void score_phase(Frame& F, const bf16* QQ, const bf16* PROJ, float* SC) {
    const int lane = F.lane, r32 = lane & 31, hi = lane >> 5;
    LAS float* wtab = (LAS float*)(F.lds + RING_OFF + F.wave * 1024);
    constexpr float WSCALE = 0.04419417382415922f;
    constexpr int PER_B = 576;
    const __amdgpu_buffer_rsrc_t scrs = __builtin_amdgcn_make_buffer_rsrc((void*)SC, 0, T * SEQ * 4, 0x00020000);
    for (int wu = F.bid * NWAVES + F.wave; wu < NB * PER_B; wu += F.G * NWAVES) {
        const int b = wu / PER_B, idx = PER_B - 1 - wu % PER_B;
        int g = 0;
        for (int k = 1; k < 8; ++k) g += (8 * k * (k + 1) <= idx) ? 1 : 0;
        const int r = idx - 8 * g * (g + 1), qb = 16 * g + r / (g + 1), c = r % (g + 1);
        const int kb_lo = 16 * c, kb_hi = (16 * c + 16 < qb + 1) ? 16 * c + 16 : qb + 1;
        const int t0 = b * SEQ + 32 * qb;
#pragma unroll
        for (int k = 0; k < 4; ++k) { const int i4 = lane * 4 + k, h = i4 >> 5, hh = (i4 >> 4) & 1, reg = i4 & 15;
            wtab[i4] = bf2f(PROJ[(size_t)(t0 + crow(reg, hh)) * 1280 + 1088 + h]) * WSCALE; }
        bf16x8 qA[8][4];
#pragma unroll
        for (int h = 0; h < 8; ++h)
#pragma unroll
            for (int st = 0; st < 4; ++st) qA[h][st] = *(const bf16x8*)(QQ + (size_t)(t0 + r32) * 1280 + 768 + h * 64 + st * 16 + hi * 8);
        const bf16* kbase = PROJ + (size_t)(b * SEQ + r32) * 1280 + 1024 + hi * 8;
        bf16x8 kA[4], kBf[4];
#pragma unroll
        for (int st = 0; st < 4; ++st) kA[st] = *(const bf16x8*)(kbase + (size_t)(32 * kb_lo) * 1280 + st * 16);
#define PS_BLOCK(KF, KB) do { f32x16 acc = {}; \
            _Pragma("unroll") for (int h = 0; h < 8; ++h) { f32x16 dd = {}; \
                _Pragma("unroll") for (int st = 0; st < 4; ++st) dd = __builtin_amdgcn_mfma_f32_32x32x16_bf16(qA[h][st], KF[st], dd, 0, 0, 0); \
                const LAS f32x4* wp = (const LAS f32x4*)(wtab + (h * 2 + hi) * 16); const f32x4 w0 = wp[0], w1 = wp[1], w2 = wp[2], w3 = wp[3]; \
                _Pragma("unroll") for (int q = 0; q < 4; ++q) { acc[q] = fmaf(w0[q], fmaxf(dd[q], 0.f), acc[q]); acc[4 + q] = fmaf(w1[q], fmaxf(dd[4 + q], 0.f), acc[4 + q]); \
                    acc[8 + q] = fmaf(w2[q], fmaxf(dd[8 + q], 0.f), acc[8 + q]); acc[12 + q] = fmaf(w3[q], fmaxf(dd[12 + q], 0.f), acc[12 + q]); } \
                if (h & 1) __builtin_amdgcn_sched_barrier(0); } \
            _Pragma("unroll") for (int reg = 0; reg < 16; ++reg) __builtin_amdgcn_raw_buffer_store_b32(__float_as_uint(acc[reg]), scrs, (4 * hi * SEQ + r32) * 4, ((t0 + (reg & 3) + 8 * (reg >> 2)) * SEQ + 32 * (KB)) * 4, 0); } while (0)
        for (int kb = kb_lo; kb < kb_hi; kb += 2) {
            __builtin_amdgcn_sched_barrier(0);
            if (kb + 1 < kb_hi) {
#pragma unroll
                for (int st = 0; st < 4; ++st) kBf[st] = *(const bf16x8*)(kbase + (size_t)(32 * (kb + 1)) * 1280 + st * 16);
            }
            __builtin_amdgcn_sched_barrier(0);
            PS_BLOCK(kA, kb);
            __builtin_amdgcn_sched_barrier(0);
            if (kb + 1 < kb_hi) {
                if (kb + 2 < kb_hi) {
#pragma unroll
                    for (int st = 0; st < 4; ++st) kA[st] = *(const bf16x8*)(kbase + (size_t)(32 * (kb + 2)) * 1280 + st * 16);
                }
                __builtin_amdgcn_sched_barrier(0);
                PS_BLOCK(kBf, kb + 1);
            }
        }
#undef PS_BLOCK
    }
}
__device__ __forceinline__ void select_phase(Frame& F, const float* SC, unsigned long long* MASK) {
    const int qstride = F.G * NWAVES;
    unsigned raw[64];
#define SEL_LOAD(qq) do { const int pos_ = (qq) & (SEQ - 1); if ((qq) < T && pos_ >= 256) { int ln_ = lane_id_now(); const int ni_ = (pos_ >> 6) + 1; const float* row_ = SC + (size_t)(qq) * SEQ; \
        _Pragma("unroll") for (int gq = 0; gq < 4; ++gq) if (ni_ > 16 * gq) { _Pragma("unroll") for (int i = 16 * gq; i < 16 * gq + 16; ++i) { const int s_ = 64 * i + ln_; raw[i] = __float_as_uint(__builtin_nontemporal_load(row_ + (s_ <= pos_ ? s_ : pos_))); } } } } while (0)
    int q0_ = F.bid * NWAVES + F.wave;
    SEL_LOAD(q0_);
    for (int q = q0_; q < T; q += qstride) {
        int lane = F.lane; asm volatile("" : "+v"(lane));
        const int pos = q & (SEQ - 1);
        unsigned long long myword = 0ull;
        if (pos < 256) {
            const int lo = 64 * lane;
            myword = (lo > pos) ? 0ull : ((pos - lo >= 63) ? ~0ull : ((1ull << (pos - lo + 1)) - 1ull));
            SEL_LOAD(q + qstride);
        } else {
            const int ni = (pos >> 6) + 1;
            unsigned key[64];
#pragma unroll
            for (int i = 0; i < 64; ++i) key[i] = 0u;
#pragma unroll
            for (int gq = 0; gq < 4; ++gq) if (ni > 16 * gq) {
#pragma unroll
                for (int i = 16 * gq; i < 16 * gq + 16; ++i) { const int s = 64 * i + lane; unsigned bts = raw[i]; if (bts == 0x80000000u) bts = 0u;
                    const unsigned kk = (bts & 0x80000000u) ? ~bts : (bts | 0x80000000u); key[i] = (s <= pos) ? kk : 0u; } }
            SEL_LOAD(q + qstride);
            auto count_ge = [&](const unsigned Tp) -> int {
                int cA = 0, cB = 0, cC = 0, cD = 0;
#pragma unroll
                for (int gq = 0; gq < 4; ++gq) if (ni > 16 * gq) {
                    unsigned long long m0_, m1_, m2_, m3_;
                    asm("v_cmp_le_u32_e64 %4, %8, %9\n\tv_cmp_le_u32_e64 %5, %8, %10\n\tv_cmp_le_u32_e64 %6, %8, %11\n\tv_cmp_le_u32_e64 %7, %8, %12\n\tv_addc_co_u32_e64 %0, %4, 0, %0, %4\n\tv_addc_co_u32_e64 %1, %5, 0, %1, %5\n\tv_addc_co_u32_e64 %2, %6, 0, %2, %6\n\tv_addc_co_u32_e64 %3, %7, 0, %3, %7\n\tv_cmp_le_u32_e64 %4, %8, %13\n\tv_cmp_le_u32_e64 %5, %8, %14\n\tv_cmp_le_u32_e64 %6, %8, %15\n\tv_cmp_le_u32_e64 %7, %8, %16\n\tv_addc_co_u32_e64 %0, %4, 0, %0, %4\n\tv_addc_co_u32_e64 %1, %5, 0, %1, %5\n\tv_addc_co_u32_e64 %2, %6, 0, %2, %6\n\tv_addc_co_u32_e64 %3, %7, 0, %3, %7\n\tv_cmp_le_u32_e64 %4, %8, %17\n\tv_cmp_le_u32_e64 %5, %8, %18\n\tv_cmp_le_u32_e64 %6, %8, %19\n\tv_cmp_le_u32_e64 %7, %8, %20\n\tv_addc_co_u32_e64 %0, %4, 0, %0, %4\n\tv_addc_co_u32_e64 %1, %5, 0, %1, %5\n\tv_addc_co_u32_e64 %2, %6, 0, %2, %6\n\tv_addc_co_u32_e64 %3, %7, 0, %3, %7\n\tv_cmp_le_u32_e64 %4, %8, %21\n\tv_cmp_le_u32_e64 %5, %8, %22\n\tv_cmp_le_u32_e64 %6, %8, %23\n\tv_cmp_le_u32_e64 %7, %8, %24\n\tv_addc_co_u32_e64 %0, %4, 0, %0, %4\n\tv_addc_co_u32_e64 %1, %5, 0, %1, %5\n\tv_addc_co_u32_e64 %2, %6, 0, %2, %6\n\tv_addc_co_u32_e64 %3, %7, 0, %3, %7"
                        : "+v"(cA), "+v"(cB), "+v"(cC), "+v"(cD), "=&s"(m0_), "=&s"(m1_), "=&s"(m2_), "=&s"(m3_) : "s"(Tp), "v"(key[16 * gq + 0]), "v"(key[16 * gq + 1]), "v"(key[16 * gq + 2]), "v"(key[16 * gq + 3]), "v"(key[16 * gq + 4]), "v"(key[16 * gq + 5]), "v"(key[16 * gq + 6]), "v"(key[16 * gq + 7]), "v"(key[16 * gq + 8]), "v"(key[16 * gq + 9]), "v"(key[16 * gq + 10]), "v"(key[16 * gq + 11]), "v"(key[16 * gq + 12]), "v"(key[16 * gq + 13]), "v"(key[16 * gq + 14]), "v"(key[16 * gq + 15])); }
                const int cl = (cA + cB) + (cC + cD);
                int c = 0;
#pragma unroll
                for (int bb = 0; bb < 7; ++bb) c += __popcll(__ballot((cl >> bb) & 1)) << bb;
                return c; };
            unsigned kmx = 0u;
#pragma unroll
            for (int i = 0; i < 64; ++i) kmx = key[i] > kmx ? key[i] : kmx;
#pragma unroll
            for (int o = 1; o < 64; o <<= 1) { const unsigned ov = (unsigned)shxi((int)kmx, o); kmx = ov > kmx ? ov : kmx; }
            kmx = (unsigned)__builtin_amdgcn_readfirstlane((int)kmx);
            unsigned lo = 0u, hi = kmx + 1u; int clo = pos + 1, chi = 0;
            if (kmx > 0x82000000u) { const unsigned l2 = (kmx & 0xff800000u) - 0x02000000u; const int c2 = count_ge(l2); if (c2 >= 256) { lo = l2; clo = c2; } else { hi = l2; chi = c2; } }
            float flo = (float)clo - 255.5f, fhi = (float)chi - 255.5f; int side = 0;
            for (int it = 0; it < 96; ++it) {
                if (clo == 256 || hi - lo <= 1u) break;
                const unsigned span = hi - lo;
                unsigned mid;
                if (it % 3 == 2) mid = lo + (span >> 1);
                else { const float tt = flo / (flo - fhi); unsigned d = (unsigned)((float)span * tt); d = d < 1u ? 1u : (d > span - 1u ? span - 1u : d); mid = lo + d; }
                mid = (unsigned)__builtin_amdgcn_readfirstlane((int)mid);
                const int c = count_ge(mid);
                if (c >= 256) { lo = mid; clo = c; flo = (float)c - 255.5f; if (side == 1) fhi *= 0.5f; side = 1; }
                else { hi = mid; chi = c; fhi = (float)c - 255.5f; if (side == -1) flo *= 0.5f; side = -1; }
            }
            const unsigned Tk = lo; const int cT = clo;
            int need = 256, base = 0;
            if (cT != 256) {
                int cl = 0;
#pragma unroll
                for (int i = 0; i < 64; ++i) cl += (key[i] > Tk) ? 1 : 0;
                int cgt = 0;
#pragma unroll
                for (int bb = 0; bb < 7; ++bb) cgt += __popcll(__ballot((cl >> bb) & 1)) << bb;
                need = 256 - cgt;
            }
            int wlo = 0, whi = 0;
            if (cT == 256) {
#pragma unroll
                for (int i = 0; i < 64; ++i) { const unsigned long long wsel = __ballot(key[i] >= Tk);
                    asm("s_nop 4\n\tv_writelane_b32 %0, %2, %4\n\tv_writelane_b32 %1, %3, %4" : "+v"(wlo), "+v"(whi) : "s"((int)(unsigned)wsel), "s"((int)(unsigned)(wsel >> 32)), "n"(i)); }
            } else {
                const unsigned long long ltmask = (1ull << lane) - 1ull;
#pragma unroll
                for (int i = 0; i < 64; ++i) {
                    const unsigned long long eq = __ballot(key[i] == Tk); const int rank = base + __popcll(eq & ltmask);
                    const bool sel = (key[i] > Tk) || (key[i] == Tk && rank < need); base += __popcll(eq);
                    const unsigned long long wsel = __ballot(sel);
                    asm("s_nop 4\n\tv_writelane_b32 %0, %2, %4\n\tv_writelane_b32 %1, %3, %4" : "+v"(wlo), "+v"(whi) : "s"((int)(unsigned)wsel), "s"((int)(unsigned)(wsel >> 32)), "n"(i));
                }
            }
            myword = ((unsigned long long)(unsigned)whi << 32) | (unsigned long long)(unsigned)wlo;
        }
        MASK[(size_t)q * 64 + lane] = myword;
    }
}

#undef SEL_LOAD
__device__ __forceinline__ void ln1_phase(Frame& F, const bf16* xres, const bf16* Y, const float* g1, const float* b1, bf16* XMB, const float* rw, const float* rb,
                                          bf16* XP, gu32* gcount, int* ROWS, float* GATES, const int pmode = 3) {
    const int lane = F.lane, wid = F.wave, tid = F.tid;
    float ALPHA_ = ALPHA; asm volatile("" : "+v"(ALPHA_));
    LAS float* x32 = (LAS float*)(F.lds + RING_OFF);
    volatile LAS unsigned* cnt = (volatile LAS unsigned*)(F.lds + L_CNT); volatile LAS unsigned* base = (volatile LAS unsigned*)(F.lds + L_BASE);
    LAS int* route = (LAS int*)(F.lds + L_ROUTE);
    const int e = lane & 31, half = lane >> 5;
    const float rbe = rb[e];
    const __amdgpu_buffer_rsrc_t xrs_ = __builtin_amdgcn_make_buffer_rsrc((void*)xres, 0, T * D * 2, 0x00020000), yrs_ = __builtin_amdgcn_make_buffer_rsrc((void*)Y, 0, T * D * 2, 0x00020000);
    for (int chunk = F.bid; chunk < T / 64; chunk += F.G) {
        if (tid < 32) cnt[tid] = 0u;
        __syncthreads();
        u32x2 rxn[4][4], ryn[4][4];
#define LN1_LOAD(B) do { _Pragma("unroll") for (int rr = 0; rr < 4; ++rr) { const int ro_ = (chunk * 64 + wid * 8 + (B) * 4 + rr) * (D * 2);       \
            _Pragma("unroll") for (int j = 0; j < 4; ++j) { rxn[rr][j] = __builtin_bit_cast(u32x2, __builtin_amdgcn_raw_buffer_load_b64(xrs_, lane * 8, ro_ + 512 * j, 2)); ryn[rr][j] = __builtin_bit_cast(u32x2, __builtin_amdgcn_raw_buffer_load_b64(yrs_, lane * 8, ro_ + 512 * j, 2)); } } } while (0)
        LN1_LOAD(0);
#pragma unroll 1
        for (int batch = 0; batch < 2; ++batch) {
            const int lrow0 = wid * 8 + batch * 4, row0 = chunk * 64 + lrow0;
            u32x2 rx[4][4], ry[4][4];
#pragma unroll
            for (int rr = 0; rr < 4; ++rr)
#pragma unroll
                for (int j = 0; j < 4; ++j) { rx[rr][j] = rxn[rr][j]; ry[rr][j] = ryn[rr][j]; }
            if (batch == 0) LN1_LOAD(1);
            float xv[4][16], mean_[4], rstd_[4];
#pragma unroll
            for (int rr = 0; rr < 4; ++rr) { float s = 0.f;
#pragma unroll
                for (int j = 0; j < 4; ++j) { const u32x2 xx = rx[rr][j], yy = ry[rr][j];
                    xv[rr][4 * j] = ALPHA_ * bflo(xx.x) + bflo(yy.x); xv[rr][4 * j + 1] = ALPHA_ * bfhi(xx.x) + bfhi(yy.x); xv[rr][4 * j + 2] = ALPHA_ * bflo(xx.y) + bflo(yy.y); xv[rr][4 * j + 3] = ALPHA_ * bfhi(xx.y) + bfhi(yy.y);
                    s += (xv[rr][4 * j] + xv[rr][4 * j + 1]) + (xv[rr][4 * j + 2] + xv[rr][4 * j + 3]); }
                mean_[rr] = s; }
#pragma unroll
            for (int rr = 0; rr < 4; ++rr) mean_[rr] = wave_sum(mean_[rr]);
#pragma unroll
            for (int rr = 0; rr < 4; ++rr) { mean_[rr] *= (1.f / D); float s2 = 0.f;
#pragma unroll
                for (int k = 0; k < 16; ++k) { xv[rr][k] -= mean_[rr]; s2 += xv[rr][k] * xv[rr][k]; }
                rstd_[rr] = s2; }
            __builtin_amdgcn_sched_barrier(0);
            f32x4 gg_[4], bb_[4];
#pragma unroll
            for (int j = 0; j < 4; ++j) { gg_[j] = __builtin_bit_cast(f32x4, __builtin_amdgcn_raw_buffer_load_b128(__builtin_amdgcn_make_buffer_rsrc((void*)g1, 0, D * 4, 0x00020000), lane * 16, j * 1024, 0)); bb_[j] = __builtin_bit_cast(f32x4, __builtin_amdgcn_raw_buffer_load_b128(__builtin_amdgcn_make_buffer_rsrc((void*)b1, 0, D * 4, 0x00020000), lane * 16, j * 1024, 0)); }
            __builtin_amdgcn_sched_barrier(0);
#pragma unroll
            for (int rr = 0; rr < 4; ++rr) rstd_[rr] = wave_sum(rstd_[rr]);
#pragma unroll
            for (int rr = 0; rr < 4; ++rr) { const float rstd = 1.0f / sqrtf(rstd_[rr] * (1.f / D) + LN_EPS);
#pragma unroll
                for (int j = 0; j < 4; ++j) { const f32x4 gg = gg_[j], bb = bb_[j];
                    f32x4 o;
#pragma unroll
                    for (int k = 0; k < 4; ++k) o[k] = xv[rr][4 * j + k] * rstd * gg[k] + bb[k];
                    u32x2 pb; pb.x = pk2(o[0], o[1]); pb.y = pk2(o[2], o[3]);
                    *(u32x2*)(XMB + (size_t)(row0 + rr) * D + 4 * lane + 256 * j) = pb;
                    *(LAS f32x4*)(x32 + (wid * 4 + rr) * 1028 + 4 * lane + 256 * j) = o; } }
            float a0 = 0.f, a1 = 0.f, a2 = 0.f, a3 = 0.f;
            float wA[32], wB[32];
            const __amdgpu_buffer_rsrc_t wrs = __builtin_amdgcn_make_buffer_rsrc((void*)rw, 0, D * NEXP * 4, 0x00020000);
            const int wvo = ((wid * 128 + half * 4) * 32 + e) * 4;
            __builtin_amdgcn_sched_barrier(0);
            if (pmode & 1) {
#pragma unroll
                for (int i = 0; i < 8; ++i)
#pragma unroll
                    for (int t = 0; t < 4; ++t) wA[4 * i + t] = __uint_as_float(__builtin_amdgcn_raw_buffer_load_b32(wrs, wvo, (8 * i + t) * 128, 0));
            }
            __builtin_amdgcn_sched_barrier(0);
            __syncthreads();
            if (pmode & 1) {
                f32x16 pacc, pacc1;
#pragma unroll
                for (int r = 0; r < 16; ++r) { pacc[r] = 0.f; pacc1[r] = 0.f; }
                const LAS float* xa = x32 + (lane & 31) * 1028 + wid * 128 + half * 4;
                f32x4 xq[16];
#pragma unroll
                for (int i = 0; i < 8; ++i) xq[i] = *(const LAS f32x4*)(xa + 8 * i);
#pragma unroll
                for (int i = 0; i < 8; ++i)
#pragma unroll
                    for (int t = 0; t < 4; ++t) wB[4 * i + t] = __uint_as_float(__builtin_amdgcn_raw_buffer_load_b32(wrs, wvo, (64 + 8 * i + t) * 128, 0));
#pragma unroll
                for (int i = 0; i < 8; ++i) {
                    pacc = __builtin_amdgcn_mfma_f32_32x32x2f32(xq[i][0], wA[4 * i + 0], pacc, 0, 0, 0); pacc1 = __builtin_amdgcn_mfma_f32_32x32x2f32(xq[i][1], wA[4 * i + 1], pacc1, 0, 0, 0);
                    pacc = __builtin_amdgcn_mfma_f32_32x32x2f32(xq[i][2], wA[4 * i + 2], pacc, 0, 0, 0); pacc1 = __builtin_amdgcn_mfma_f32_32x32x2f32(xq[i][3], wA[4 * i + 3], pacc1, 0, 0, 0); }
                __builtin_amdgcn_sched_barrier(0);
#pragma unroll
                for (int i = 8; i < 16; ++i) xq[i] = *(const LAS f32x4*)(xa + 8 * i);
#pragma unroll
                for (int i = 0; i < 8; ++i) {
                    pacc = __builtin_amdgcn_mfma_f32_32x32x2f32(xq[8 + i][0], wB[4 * i + 0], pacc, 0, 0, 0); pacc1 = __builtin_amdgcn_mfma_f32_32x32x2f32(xq[8 + i][1], wB[4 * i + 1], pacc1, 0, 0, 0);
                    pacc = __builtin_amdgcn_mfma_f32_32x32x2f32(xq[8 + i][2], wB[4 * i + 2], pacc, 0, 0, 0); pacc1 = __builtin_amdgcn_mfma_f32_32x32x2f32(xq[8 + i][3], wB[4 * i + 3], pacc1, 0, 0, 0); }
#pragma unroll
                for (int r = 0; r < 16; ++r) pacc[r] += pacc1[r];
                __syncthreads();
                LAS float* pw = x32 + wid * 1024 + e;
#pragma unroll
                for (int r = 0; r < 16; ++r) pw[crow(r, half) * 32] = pacc[r];
                __syncthreads();
                const LAS float* pr = x32 + (half * 4) * 1024 + (wid * 4) * 32 + e;
#pragma unroll
                for (int q = 0; q < 4; ++q) { a0 += pr[q * 1024]; a1 += pr[q * 1024 + 32]; a2 += pr[q * 1024 + 64]; a3 += pr[q * 1024 + 96]; }
            } else { __syncthreads(); __syncthreads(); }
            __syncthreads();
            float lg[4]; lg[0] = a0 + shx(a0, 32) + rbe; lg[1] = a1 + shx(a1, 32) + rbe; lg[2] = a2 + shx(a2, 32) + rbe; lg[3] = a3 + shx(a3, 32) + rbe;
            float selv[4][4]; int seli[4][4];
#pragma unroll
            for (int rr = 0; rr < 4; ++rr) {
                float v = lg[rr];
#pragma unroll
                for (int k = 0; k < 4; ++k) {
                    float bv = v; int bi = e;
#pragma unroll
                    for (int msk = 1; msk < 32; msk <<= 1) { const float ov = shx(bv, msk); const int oi = shxi(bi, msk); if (ov > bv || (ov == bv && oi < bi)) { bv = ov; bi = oi; } }
                    selv[rr][k] = bv; seli[rr][k] = bi;
                    if (bi == e) v = -INFINITY;
                }
            }
            if (lane < 16) {
                const int rr = lane >> 2, k = lane & 3;
                float sv[4]; int si[4];
#pragma unroll
                for (int q = 0; q < 4; ++q) { sv[q] = rr == 0 ? selv[0][q] : rr == 1 ? selv[1][q] : rr == 2 ? selv[2][q] : selv[3][q]; si[q] = rr == 0 ? seli[0][q] : rr == 1 ? seli[1][q] : rr == 2 ? seli[2][q] : seli[3][q]; }
                const float ex1 = __expf(sv[1] - sv[0]), ex2 = __expf(sv[2] - sv[0]), ex3 = __expf(sv[3] - sv[0]);
                const float isum = 1.0f / (1.0f + ex1 + ex2 + ex3);
                const int me = k == 0 ? si[0] : k == 1 ? si[1] : k == 2 ? si[2] : si[3];
                const float mg = (k == 0 ? 1.0f : k == 1 ? ex1 : k == 2 ? ex2 : ex3) * isum;
                const int mr = (int)__hip_atomic_fetch_add((LAS unsigned*)(F.lds + L_CNT) + me, 1u, __ATOMIC_RELAXED, __HIP_MEMORY_SCOPE_WORKGROUP);
                LAS int* rt = route + ((lrow0 + rr) * 4 + k) * 3;
                rt[0] = me; rt[1] = mr; rt[2] = __float_as_int(mg);
            }
        }
        __syncthreads();
        if (wid == 0) { const int l_ = lane_id_now(); if (l_ < 32) base[l_] = __hip_atomic_fetch_add(gcount + l_, cnt[l_], RLX_AGENT); }
        __syncthreads();
#pragma unroll 1
        for (int batch = 0; batch < 2; ++batch) {
            const int lrow0 = wid * 8 + batch * 4, row0 = chunk * 64 + lrow0;
            u32x4 sa[4], sb[4];
#pragma unroll
            for (int rr = 0; rr < 4; ++rr) { const bf16* src = XMB + (size_t)(row0 + rr) * D; sa[rr] = *(const u32x4*)(src + lane * 16); sb[rr] = *(const u32x4*)(src + lane * 16 + 8); }
            int vrow = 0;
            if (lane < 16) { const int rr = lane >> 2, k = lane & 3; const LAS int* rt = route + ((lrow0 + rr) * 4 + k) * 3; const int me = rt[0];
                vrow = me * CAPROWS + (int)base[me] + rt[1]; ROWS[(size_t)(row0 + rr) * 4 + k] = vrow; GATES[(size_t)(row0 + rr) * 4 + k] = __int_as_float(rt[2]); }
            if (pmode & 2) {
#pragma unroll
                for (int rr = 0; rr < 4; ++rr) {
                    const u32x4 a = sa[rr], b = sb[rr];
                    u32x4 o; o.x = pg8::pk4_fp8(bflo(a.x), bfhi(a.x), bflo(a.y), bfhi(a.y)); o.y = pg8::pk4_fp8(bflo(a.z), bfhi(a.z), bflo(a.w), bfhi(a.w));
                    o.z = pg8::pk4_fp8(bflo(b.x), bfhi(b.x), bflo(b.y), bfhi(b.y)); o.w = pg8::pk4_fp8(bflo(b.z), bfhi(b.z), bflo(b.w), bfhi(b.w));
#pragma unroll
                    for (int k = 0; k < 4; ++k) { const int vr = shli(vrow, rr * 4 + k); unsigned char* dst = (unsigned char*)XP + (size_t)vr * D;
                        __builtin_nontemporal_store(o, (u32x4*)(dst + lane * 16)); }
                }
            }
        }
        __syncthreads();
    }
}
#undef LN1_LOAD
__device__ __forceinline__ void ln2_phase(Frame& F, const bf16* XMB, const bf16* YP, const int* ROWS, const float* GATES, const float* g2, const float* b2, float* out, bf16* XB, unsigned char* XB8) {
    const int lane = F.lane;
    float ALPHA_ = ALPHA; asm volatile("" : "+v"(ALPHA_));
    const int rstride = F.G * NWAVES, row_first = F.bid * NWAVES + F.wave;
    const unsigned char* yp8 = (const unsigned char*)YP;
    int ix0 = 0, ix1 = 0, ix2 = 0, ix3 = 0; f32x4 gtn = {0.f, 0.f, 0.f, 0.f};
    u32x2 xbn[4]; int qn[4][4]; f32x4 gtc = {0.f, 0.f, 0.f, 0.f};
#define LN2_IDX(R) do { if ((R) < T) { ix0 = ROWS[(size_t)(R) * 4]; ix1 = ROWS[(size_t)(R) * 4 + 1]; ix2 = ROWS[(size_t)(R) * 4 + 2]; ix3 = ROWS[(size_t)(R) * 4 + 3]; gtn = *(const f32x4*)(GATES + (size_t)(R) * 4); } } while (0)
#define LN2_DATA(R) do { if ((R) < T) { gtc = gtn; _Pragma("unroll") for (int j = 0; j < 4; ++j) { const int c = 4 * lane + 256 * j; xbn[j] = *(const u32x2*)(XMB + (size_t)(R) * D + c); \
        qn[j][0] = *(const int*)(yp8 + (size_t)ix0 * D + c); qn[j][1] = *(const int*)(yp8 + (size_t)ix1 * D + c); qn[j][2] = *(const int*)(yp8 + (size_t)ix2 * D + c); qn[j][3] = *(const int*)(yp8 + (size_t)ix3 * D + c); } } } while (0)
    f32x4 gg_[4], bb_[4];
#pragma unroll
    for (int j = 0; j < 4; ++j) { gg_[j] = *(const f32x4*)(g2 + 4 * lane + 256 * j); bb_[j] = *(const f32x4*)(b2 + 4 * lane + 256 * j); }
    LN2_IDX(row_first);
    LN2_DATA(row_first);
    LN2_IDX(row_first + rstride);
    for (int row = row_first; row < T; row += rstride) {
        u32x2 xbc[4]; int qc[4][4]; const f32x4 gt = gtc;
#pragma unroll
        for (int j = 0; j < 4; ++j) { xbc[j] = xbn[j]; qc[j][0] = qn[j][0]; qc[j][1] = qn[j][1]; qc[j][2] = qn[j][2]; qc[j][3] = qn[j][3]; }
        LN2_DATA(row + rstride);
        LN2_IDX(row + 2 * rstride);
        float v[16]; float s = 0.f;
#pragma unroll
        for (int j = 0; j < 4; ++j) {
            const u32x2 xb_ = xbc[j]; const f32x4 xx = {bflo(xb_.x), bfhi(xb_.x), bflo(xb_.y), bfhi(xb_.y)};
            const int q0 = qc[j][0], q1 = qc[j][1], q2 = qc[j][2], q3 = qc[j][3];
            const f32x2 a0 = __builtin_amdgcn_cvt_pk_f32_fp8(q0, false), b0 = __builtin_amdgcn_cvt_pk_f32_fp8(q0, true), a1 = __builtin_amdgcn_cvt_pk_f32_fp8(q1, false), b1 = __builtin_amdgcn_cvt_pk_f32_fp8(q1, true);
            const f32x2 a2 = __builtin_amdgcn_cvt_pk_f32_fp8(q2, false), b2_ = __builtin_amdgcn_cvt_pk_f32_fp8(q2, true), a3 = __builtin_amdgcn_cvt_pk_f32_fp8(q3, false), b3 = __builtin_amdgcn_cvt_pk_f32_fp8(q3, true);
            const float g0 = gt[0] * (1.0f / 16.0f), g1 = gt[1] * (1.0f / 16.0f), g2_ = gt[2] * (1.0f / 16.0f), g3 = gt[3] * (1.0f / 16.0f);
            v[4 * j]     = ALPHA_ * xx[0] + ((g0 * a0[0] + g1 * a1[0]) + (g2_ * a2[0] + g3 * a3[0]));
            v[4 * j + 1] = ALPHA_ * xx[1] + ((g0 * a0[1] + g1 * a1[1]) + (g2_ * a2[1] + g3 * a3[1]));
            v[4 * j + 2] = ALPHA_ * xx[2] + ((g0 * b0[0] + g1 * b1[0]) + (g2_ * b2_[0] + g3 * b3[0]));
            v[4 * j + 3] = ALPHA_ * xx[3] + ((g0 * b0[1] + g1 * b1[1]) + (g2_ * b2_[1] + g3 * b3[1]));
            s += (v[4 * j] + v[4 * j + 1]) + (v[4 * j + 2] + v[4 * j + 3]); }
        const float mean = wave_sum(s) * (1.f / D); float s2 = 0.f;
#pragma unroll
        for (int k = 0; k < 16; ++k) { v[k] -= mean; s2 += v[k] * v[k]; }
        const float rstd = 1.0f / sqrtf(wave_sum(s2) * (1.f / D) + LN_EPS);
#pragma unroll
        for (int j = 0; j < 4; ++j) { const int c = 4 * lane + 256 * j; const f32x4 gg = gg_[j], bb = bb_[j];
            f32x4 o;
#pragma unroll
            for (int k = 0; k < 4; ++k) o[k] = v[4 * j + k] * rstd * gg[k] + bb[k];
            if (out) *(f32x4*)(out + (size_t)row * D + c) = o;
            u32x2 pb; pb.x = pk2(o[0], o[1]); pb.y = pk2(o[2], o[3]); *(u32x2*)(XB + (size_t)row * D + c) = pb;
            if (XB8) *(unsigned*)(XB8 + (size_t)row * D + c) = pg8::pk4_fp8(o[0], o[1], o[2], o[3]); }
    }
}
#undef LN2_IDX
#undef LN2_DATA

#ifndef MK_FP8TEST
#define MK_FP8TEST 0
#endif
typedef int i32x8 __attribute__((ext_vector_type(8)));
__device__ __forceinline__ int t8_val(int which, int rc, int g, int j) { unsigned h = (unsigned)(which * 7919 + rc * 104729 + g * 1299709 + j * 15485863 + 12345); h ^= h >> 13; h *= 0x5bd1e995u; h ^= h >> 15; return (int)(h % 9u) - 4; }
__device__ __forceinline__ void fp8_selftest(gu32* ctl, int lane) {
    const int rc = lane & 15, g = lane >> 4;
    i32x8 a, b;
#pragma unroll
    for (int w = 0; w < 8; ++w) {
        int wa = __builtin_amdgcn_cvt_pk_fp8_f32((float)t8_val(0, rc, g, 4 * w), (float)t8_val(0, rc, g, 4 * w + 1), 0, false);
        wa = __builtin_amdgcn_cvt_pk_fp8_f32((float)t8_val(0, rc, g, 4 * w + 2), (float)t8_val(0, rc, g, 4 * w + 3), wa, true);
        int wb = __builtin_amdgcn_cvt_pk_fp8_f32((float)t8_val(1, rc, g, 4 * w), (float)t8_val(1, rc, g, 4 * w + 1), 0, false);
        wb = __builtin_amdgcn_cvt_pk_fp8_f32((float)t8_val(1, rc, g, 4 * w + 2), (float)t8_val(1, rc, g, 4 * w + 3), wb, true);
        a[w] = wa; b[w] = wb;
    }
    f32x4 c = {0.f, 0.f, 0.f, 0.f};
    c = __builtin_amdgcn_mfma_scale_f32_16x16x128_f8f6f4(a, b, c, 0, 0, 0, 0x7f7f7f7f, 0, 0x7f7f7f7f);
    int bad = 0, scaled = 0;
#pragma unroll
    for (int reg = 0; reg < 4; ++reg) {
        const int row = 4 * (lane >> 4) + reg, col = lane & 15; int e = 0;
        for (int gg = 0; gg < 4; ++gg) for (int j = 0; j < 32; ++j) e += t8_val(0, row, gg, j) * t8_val(1, col, gg, j);
        if (c[reg] != (float)e) { bad = 1; if (e != 0 && (c[reg] == (float)e * 0.5f || c[reg] == (float)e * 2.0f || c[reg] == (float)e * 0.25f || c[reg] == (float)e * 4.0f)) scaled = 1; }
    }
    const unsigned long long mb = __ballot(bad), ms = __ballot(bad && scaled);
    if (lane == 0 && mb) __hip_atomic_store(ctl + CW_ERR, (mb == ms) ? 2u : 1u, RLX_AGENT);
}

constexpr int N_STEPS = 6, LAST_PHASE = 1 + 10 * 5 + 8;
__host__ __device__ constexpr bool phase_exists(int id) {
    if (id == 0) return true;
    if (id < 1 || id > LAST_PHASE) return false;
    const int s = (id - 1) / 10, p = (id - 1) % 10;
    if (p == 0) return true;
    if (p == 9) return false;
    if (s == 0 || s == 2) return false;
    if (p == 1 || p == 2) return s == 3;
    return true;
}
__global__ void __launch_bounds__(NTHREADS, 2) mk_fwd(Args args) {
    extern __shared__ __attribute__((aligned(16))) unsigned char lds_raw[];
    Frame F;
    F.lds = (LAS unsigned char*)lds_raw;
    F.tid = threadIdx.x; F.lane = F.tid & 63; F.wave = __builtin_amdgcn_readfirstlane(F.tid >> 6);
    F.bid = blockIdx.x; F.G = gridDim.x; F.vcu = (F.G % 8 == 0) ? (F.bid % 8) * (F.G / 8) + F.bid / 8 : F.bid;
    F.ctl = (gu32*)(args.ws + WS_CTL);
    const int lo = args.ph_lo, hi = args.ph_hi;
    const bool fused = (hi - lo) > 1;
    for (int u = F.tid; u < (LDS_BYTES - LDSCTL_OFF) / 4; u += NTHREADS) ((LAS unsigned*)(F.lds + LDSCTL_OFF))[u] = 0u;
    __syncthreads();
    XcdBarrier bar; bar.bar = (unsigned*)(F.ctl + CW_BAR); bar.x = 0; bar.st = nullptr;
    if (fused) bar = xcd_barrier_post((unsigned*)(F.ctl + CW_BAR), (volatile LAS unsigned*)(F.lds + L_XB));
    const bool split = fused && MK_SPLIT && (F.G % 16 == 0) && lo == 0 && hi > 16;
    const int NCV = split ? F.G / 2 : 0;
    const bool is_conv = split && F.bid < NCV;
    XcdBarrier bar2; bar2.bar = (unsigned*)(F.ctl + CW_BAR2); bar2.x = 0; bar2.st = nullptr;
    if (split && !is_conv) bar2 = xcd_barrier_post((unsigned*)(F.ctl + CW_BAR2), (volatile LAS unsigned*)(F.lds + L_XB2));
#ifndef MK_PROBE
#define MK_PROBE 0
#endif
#define IN(id) (lo <= (id) && (id) < hi)
#define PHASE_BEGIN ArgsP ap = (ArgsP)__builtin_amdgcn_kernarg_segment_ptr(); asm volatile("" : "+s"(ap)); GAS unsigned char* wsg_ = (GAS unsigned char*)ap->ws; asm volatile("" : "+s"(wsg_)); unsigned char* ws = (unsigned char*)wsg_; Frame Fp = F; { const int l_ = lane_id_now(); Fp.lane = l_; Fp.tid = F.wave * 64 + l_; } Fp.ctl = (gu32*)(ws + WS_CTL);
#define SEAM(id) do { if (fused && (id) != LAST_PHASE) { xcd_barrier(bar, F.wave == 0 && lane_id_now() == 0, (unsigned)F.G); if (MK_PROBE == 10) xcd_barrier(bar, F.wave == 0 && lane_id_now() == 0, (unsigned)F.G); } } while (0)
#define SEAMW(id, sync, last) do { if (!split) SEAM(id); else if (last) SEAM(id); else if ((sync) && !is_conv) xcd_barrier(bar2, F.wave == 0 && lane_id_now() == 0, (unsigned)(F.G - NCV)); } while (0)
#define WIN_FRAME do { if (split) { Fp.G = F.G - NCV; Fp.bid = F.bid - NCV; Fp.vcu = (Fp.G % 8 == 0) ? (Fp.bid % 8) * (Fp.G / 8) + Fp.bid / 8 : Fp.bid; } } while (0)
#define REPS(k) ((MK_PROBE) == (k) ? 2 : 1)

#ifndef SKIP_P0
    if (MK_FP8TEST && lo == 0 && F.bid == 0 && F.wave == 0) fp8_selftest(F.ctl, F.lane);
    if (IN(0)) { PHASE_BEGIN for (int rep = 0; rep < REPS(1); ++rep) p0_prologue(Fp, ap, ws, split ? 1 : 0); SEAM(0); }
#endif

    for (int s = 0; s < N_STEPS; ++s) {
        const int pb = 1 + 10 * s;
        const int layer = s == 0 ? 0 : (s == 1 ? 0 : (s <= 3 ? 1 : s - 2));
        const int kind = layer % 3;
        const bool rest = !(s == 0 || s == 2);
#ifndef SKIP_G1
        const bool inw = split && s <= 1;
        if (IN(pb) && inw && is_conv) {
            if (s == 0) { PHASE_BEGIN Fp.G = NCV; p0_prologue(Fp, ap, ws, 2); }
        } else
        if (IN(pb)) {
            PHASE_BEGIN
            if (inw) WIN_FRAME;
            pg8::Gemm g; pg8::EpiProj E; E.ssq_in = nullptr; E.ssq_out = nullptr; E.rope = (const pg8::f32x2*)(ws + WS_ROPE); E.rope_heads = 0u; E.oscale = 1.0f;
            if (s == 0) { g = pg8::Gemm{(const bf16*)(ws + WS_MEMB), (const bf16*)(ws + WS_WKV), NB * MEML, 2048, 1024, 1024}; E.O = (bf16*)(ws + WS_KVMEM); E.ldc = 2048; }
            else if (s == 3) { g = pg8::Gemm{(const bf16*)(ws + WS_PROJ), (const bf16*)(ws + WS_WUQ), T, 1280, 256, 1280}; E.O = (bf16*)(ws + WS_QQ); E.ldc = 1280; E.ssq_in = (const float*)(ws + WS_SSQ); E.rope_heads = 0xFFFFFu; }
            else { const int n = kind == 0 ? 2560 : (kind == 1 ? 1280 : 1536);
                g = pg8::Gemm{(const bf16*)(ws + WS_XB), (const bf16*)(ws + WS_WIN + (size_t)layer * 5 * MiB), T, n, 1024, 1024}; E.O = (bf16*)(ws + WS_PROJ); E.ldc = n;
                if (layer != 0) { g.A = (const bf16*)(ws + WS_XB8); g.K = 512; g.lda = 512; E.oscale = 1.0f / 64.0f; }
                if (kind == 1) { E.ssq_out = (float*)(ws + WS_SSQ); E.rope_heads = 0xF0u | (1u << 16); }
                if (kind == 2) E.rope_heads = 0xFFFFu; }
            pg8::StaticOrder S; S.init(g.M, g.N, Fp.G, (s == 0 && !inw) ? Fp.G - 1 - Fp.bid : Fp.bid); if (s <= 1) S.split = 0;
            if (!(s == 0 || s == 1 || s == 3)) { for (int rep = 0; rep < REPS(2); ++rep) pg8::gemm_phase<pg8::EpiProj, pg8::StaticOrder, true, true, true>(F.lds + RING_OFF, g, S, E, F.wave * 64 + lane_id_now()); }
            else { for (int rep = 0; rep < REPS(2); ++rep) pg8::gemm_phase<pg8::EpiProj, pg8::StaticOrder, true, true, false>(F.lds + RING_OFF, g, S, E, F.wave * 64 + lane_id_now()); }
        }
        if (IN(pb)) { if (inw) SEAMW(pb, s == 1, false); else if (!(s == 0 && fused)) SEAM(pb); }
#endif
        if (s == 3) {
#ifndef SKIP_PS
            if (IN(pb + 1)) { PHASE_BEGIN for (int rep = 0; rep < ((MK_PROBE == 3 || MK_PROBE == 31) ? 2 : 1); ++rep) score_phase(Fp, (const bf16*)(ws + WS_QQ), (const bf16*)(ws + WS_PROJ), (float*)(ws + WS_ACT)); SEAM(pb + 1); }
#endif
#ifndef SKIP_PT
            if (IN(pb + 2)) { PHASE_BEGIN for (int rep = 0; rep < ((MK_PROBE == 3 || MK_PROBE == 32) ? 2 : 1); ++rep) select_phase(Fp, (const float*)(ws + WS_ACT), (unsigned long long*)(ws + WS_MASK)); SEAM(pb + 2); }
#endif
        }
        if (!rest) continue;
#ifndef SKIP_MIX
        if (IN(pb + 3) && !(inw && is_conv)) { PHASE_BEGIN if (inw) WIN_FRAME; for (int rep = 0; rep < ((MK_PROBE == 4 || (MK_PROBE == 41 && kind == 1) || (MK_PROBE == 42 && kind == 2) || (MK_PROBE == 43 && kind == 0)) ? 2 : 1); ++rep) mixer_phase(Fp, ap, ws, layer, kind, s + 8 * rep); }
        if (IN(pb + 3)) { if (inw) SEAMW(pb + 3, true, false); else SEAM(pb + 3); }
#endif
#ifndef SKIP_G2
        if (IN(pb + 4) && !(inw && is_conv)) {
            PHASE_BEGIN
            if (inw) WIN_FRAME;
            pg8::Gemm g{(const bf16*)(ws + WS_CAT), (const bf16*)(ws + WS_WOUT + (size_t)layer * 2 * MiB), T, 1024, 512, 512};
            pg8::EpiProj E; E.O = (bf16*)(ws + WS_Y); E.ldc = 1024; E.ssq_in = nullptr; E.ssq_out = nullptr; E.rope = nullptr; E.rope_heads = 0u; E.oscale = 1.0f / 128.0f;
            pg8::StaticOrder S; S.init(T, 1024, Fp.G, Fp.bid);
            for (int rep = 0; rep < REPS(5); ++rep) pg8::gemm_phase<pg8::EpiProj, pg8::StaticOrder, true, true, true>(F.lds + RING_OFF, g, S, E, F.wave * 64 + lane_id_now());
        }
        if (IN(pb + 4)) { if (inw) SEAMW(pb + 4, true, false); else SEAM(pb + 4); }
#endif
#ifndef SKIP_LN1
        if (IN(pb + 5) && !(inw && is_conv)) {
            PHASE_BEGIN
            if (inw) WIN_FRAME;
            for (int rep = 0; rep < ((MK_PROBE == 6 || MK_PROBE == 61 || MK_PROBE == 62 || MK_PROBE == 63) ? 2 : 1); ++rep)
            ln1_phase(Fp, (const bf16*)(ws + WS_XB), (const bf16*)(ws + WS_Y), ap->in[12] + layer * D, ap->in[13] + layer * D, (bf16*)(ws + WS_QQ),
                      ap->in[14] + (size_t)layer * D * NEXP, ap->in[15] + layer * NEXP, (bf16*)(ws + (rep ? WS_ACT : WS_XP)), Fp.ctl + (rep ? CW_GDUMMY : CW_GCOUNT) + layer * NEXP,
                      (int*)(ws + (rep ? WS_SSQ : WS_ROWS)), (float*)(ws + (rep ? WS_MASK : WS_GATES)), (rep && MK_PROBE == 61) ? 2 : (rep && MK_PROBE == 62) ? 1 : (rep && MK_PROBE == 63) ? 0 : 3);
        }
        if (IN(pb + 5)) { if (inw) SEAMW(pb + 5, true, true); else SEAM(pb + 5); }
#endif
        if (IN(pb + 6) || IN(pb + 7)) {
            LAS int* pref = (LAS int*)(F.lds + L_PREF); LAS int* tiles = (LAS int*)(F.lds + L_TILES);
#ifndef SKIP_G3
            if (IN(pb + 6)) {
                PHASE_BEGIN
                if (Fp.wave == 0) {
                    const int l_ = Fp.lane; const int tl_ = l_ < 32 ? (int)((__hip_atomic_load(Fp.ctl + CW_GCOUNT + layer * NEXP + (l_ & 31), RLX_AGENT) + 255u) >> 8) : 0;
                    int v_ = tl_ * 8;
#pragma unroll
                    for (int d_ = 1; d_ < 32; d_ <<= 1) { const int t_ = __builtin_amdgcn_ds_bpermute(((l_ - d_) & 63) << 2, v_); if (l_ >= d_) v_ += t_; }
                    if (l_ < 32) { tiles[l_] = tl_; pref[l_] = v_ - tl_ * 8; } if (l_ == 31) pref[32] = v_; }
                __syncthreads();
                pg8::Gemm g{(const bf16*)(ws + WS_XP), (const bf16*)(ws + WS_WGU + (size_t)layer * 64 * MiB), NEXP * CAPROWS, NEXP * 2048, 512, 512};
                pg8::EpiSwiglu E{(bf16*)(ws + WS_ACT), ap->in[17] + (size_t)layer * NEXP * 2048};
                pg8::MoeOrder S{pref, tiles, 8, pref[32], F.G, F.vcu};
                for (int rep = 0; rep < REPS(7); ++rep) pg8::gemm_phase<pg8::EpiSwiglu, pg8::MoeOrder, true, true, true>(F.lds + RING_OFF, g, S, E, F.wave * 64 + lane_id_now());
                SEAM(pb + 6);
            }
#endif
#ifndef SKIP_G4
            if (IN(pb + 7)) {
                PHASE_BEGIN
                if (Fp.wave == 0) {
                    const int l_ = Fp.lane; const int tl_ = l_ < 32 ? (int)((__hip_atomic_load(Fp.ctl + CW_GCOUNT + layer * NEXP + (l_ & 31), RLX_AGENT) + 255u) >> 8) : 0;
                    int v_ = tl_ * 4;
#pragma unroll
                    for (int d_ = 1; d_ < 32; d_ <<= 1) { const int t_ = __builtin_amdgcn_ds_bpermute(((l_ - d_) & 63) << 2, v_); if (l_ >= d_) v_ += t_; }
                    if (l_ < 32) { tiles[l_] = tl_; pref[l_] = v_ - tl_ * 4; } if (l_ == 31) pref[32] = v_; }
                __syncthreads();
                pg8::Gemm g{(const bf16*)(ws + WS_ACT), (const bf16*)(ws + WS_WDN + (size_t)layer * 32 * MiB), NEXP * CAPROWS, NEXP * 1024, 512, 512};
                pg8::EpiDown E{(bf16*)(ws + WS_XP), ap->in[19] + (size_t)layer * NEXP * 1024};
                pg8::MoeOrder S{pref, tiles, 4, pref[32], F.G, F.vcu};
                for (int rep = 0; rep < REPS(8); ++rep) pg8::gemm_phase<pg8::EpiDown, pg8::MoeOrder, true, true, true>(F.lds + RING_OFF, g, S, E, F.wave * 64 + lane_id_now());
                SEAM(pb + 7);
            }
#endif
        }
#ifndef SKIP_LN2
        if (IN(pb + 8)) {
            PHASE_BEGIN
            for (int rep = 0; rep < REPS(9); ++rep)
            ln2_phase(Fp, (const bf16*)(ws + WS_QQ), (const bf16*)(ws + WS_XP), (const int*)(ws + WS_ROWS), (const float*)(ws + WS_GATES), ap->in[20] + layer * D, ap->in[21] + layer * D,
                      layer == DEPTH - 1 ? ap->out : (float*)nullptr, (bf16*)(ws + WS_XB), (layer + 1 < DEPTH) ? (unsigned char*)(ws + WS_XB8) : (unsigned char*)nullptr);
            SEAM(pb + 8);
        }
#endif
    }
    if (MK_FP8TEST && hi > LAST_PHASE) {
        const unsigned code = __hip_atomic_load(F.ctl + CW_ERR, RLX_AGENT);
        if (code) { const float v = code == 2u ? 100.f : 10.f;
            for (int row = F.bid * NWAVES + F.wave; row < T; row += F.G * NWAVES) { f32x4* o = (f32x4*)(args.out + (size_t)row * D) + F.lane;
#pragma unroll
                for (int j = 0; j < 4; ++j) o[64 * j] = (f32x4){v, v, v, v}; } }
    }
#undef IN
#undef SEAM
}

extern "C" void kernel_launch(void* const* d_in, const int* in_sizes, int n_in, void* d_out, int out_size, void* d_ws, size_t ws_size, hipStream_t stream) {
    static int grid = 0;
    if (grid == 0) {
        if (n_in != 22 || in_sizes[0] != T * D || out_size != T * D || ws_size < WS_END) { fprintf(stderr, "kernel_launch: unexpected shapes (n_in %d, in0 %d, out %d, ws %zu < %zu); nothing launched\n", n_in, n_in > 0 ? in_sizes[0] : -1, out_size, ws_size, (size_t)WS_END); grid = -1; return; }
        int dev = 0, cus = 0, per_cu = 0;
        if (hipGetDevice(&dev) != hipSuccess || hipDeviceGetAttribute(&cus, hipDeviceAttributeMultiprocessorCount, dev) != hipSuccess) { fprintf(stderr, "kernel_launch: device query failed\n"); grid = -1; return; }
        if (hipFuncSetAttribute((const void*)mk_fwd, hipFuncAttributeMaxDynamicSharedMemorySize, LDS_BYTES) != hipSuccess) { fprintf(stderr, "kernel_launch: hipFuncSetAttribute failed\n"); grid = -1; return; }
        if (hipOccupancyMaxActiveBlocksPerMultiprocessor(&per_cu, (const void*)mk_fwd, NTHREADS, LDS_BYTES) != hipSuccess || per_cu < 1) fprintf(stderr, "kernel_launch: note: occupancy query reports %d workgroups per CU\n", per_cu);
        (void)hipGetLastError();
        grid = cus;
    }
    if (grid < 0) return;
    if (hipMemsetAsync((char*)d_ws + WS_CTL, 0, CTL_ZERO_BYTES, stream) != hipSuccess) { fprintf(stderr, "kernel_launch: hipMemsetAsync failed\n"); return; }
    Args a{};
    for (int i = 0; i < 22; ++i) a.in[i] = (const float*)d_in[i];
    a.out = (float*)d_out; a.ws = (unsigned char*)d_ws;
    unsigned char* ws = (unsigned char*)d_ws;
    { int nj = 0, items = 0;
      auto add = [&](const float* src, int ldw, int K, int col0, int nvalid, int nblk, size_t dst_off, int row0, const float* scale, int f8 = 0, float mul = 1.0f) {
          Job& j = a.jobs[nj++]; j.src = src; j.dst = (bf16*)(ws + dst_off); j.scale = scale; j.ldw = ldw; j.K = K; j.col0 = col0; j.nvalid = nvalid; j.nblk = nblk; j.row0 = row0; j.item0 = items; j.f8 = f8; j.mul = mul; j.pad = 0;
          items += nblk * (K / 128); };
      const float* a_w_in = a.in[2]; const float* b_w_in = a.in[4]; const float* c_w_in = a.in[8];
      add(a_w_in, 2560, 1024, 0, 2560, 10, WS_WIN + 0 * 5 * MiB, 0, nullptr);
      add(a_w_in + (size_t)1024 * 2560, 2560, 1024, 0, 2560, 10, WS_WIN + 3 * 5 * MiB, 0, nullptr, 1, 64.0f);
      add(b_w_in, 1096, 1024, 0, 768, 3, WS_WIN + 1 * 5 * MiB, 0, nullptr, 1, 64.0f);
      add(b_w_in, 1096, 1024, 840, 256, 1, WS_WIN + 1 * 5 * MiB, 768, nullptr, 1, 64.0f);
      add(b_w_in, 1096, 1024, 768, 72, 1, WS_WIN + 1 * 5 * MiB, 1024, nullptr, 1, 64.0f);
      add(c_w_in, 1536, 1024, 0, 1536, 6, WS_WIN + 2 * 5 * MiB, 0, nullptr, 1, 64.0f);
      for (int l = 0; l < 4; ++l) add(a.in[10] + (size_t)l * 1024 * 1024, 1024, 1024, 0, 1024, 4, WS_WOUT + (size_t)l * 2 * MiB, 0, nullptr, 1, 128.0f);
      for (int l = 0; l < 4; ++l) add(a.in[11] + (size_t)l * 1024 * 512, 512, 1024, 0, 512, 2, WS_WKV, 512 * l, nullptr);
      add(a.in[6], 768, 256, 0, 768, 3, WS_WUQ, 0, a.in[5]);
      add(a.in[7], 512, 256, 0, 512, 2, WS_WUQ, 768, a.in[5]);
      a.njob_items = items; }
    a.pad = 0;
#if MK_MULTI
    for (int id = 0; id <= LAST_PHASE; ++id) {
        if (!phase_exists(id)) continue;
        a.ph_lo = id; a.ph_hi = id + 1;
        hipLaunchKernelGGL(mk_fwd, dim3(grid), dim3(NTHREADS), LDS_BYTES, stream, a);
    }
#else
    a.ph_lo = 0; a.ph_hi = LAST_PHASE + 1;
    hipLaunchKernelGGL(mk_fwd, dim3(grid), dim3(NTHREADS), LDS_BYTES, stream, a);
#endif
    const hipError_t le = hipPeekAtLastError();
    if (le != hipSuccess) fprintf(stderr, "kernel_launch: launch failed: %s (grid %d)\n", hipGetErrorName(le), grid);
}
```

```cpp
#include <hip/hip_runtime.h>
#include <cstdio>
#include <cstdint>
#include <cmath>

#ifndef MK_MULTI
#define MK_MULTI 0
#endif
#ifndef MK_SPLIT
#define MK_SPLIT 0
#endif
#ifndef MK_CHECK
#define MK_CHECK 0
#endif

namespace pg8 {
#define PG8_LAS __attribute__((address_space(3)))
typedef unsigned short bf16_t;
typedef short bf16x8 __attribute__((ext_vector_type(8)));
typedef float f32x4 __attribute__((ext_vector_type(4)));
typedef unsigned u32x4 __attribute__((ext_vector_type(4)));
typedef int i32x8 __attribute__((ext_vector_type(8)));
typedef short bf16x16 __attribute__((ext_vector_type(16)));
typedef unsigned u32x2 __attribute__((ext_vector_type(2)));
constexpr int BM = 256, BK = 64, HALF = 128, HTB = HALF * BK * 2  , STAGE_BYTES = 8 * HTB, NXCD = 8, WGM = 8;

__host__ __device__ __forceinline__ int lds_byte(int r, int c) { const int st = (r >> 4) * 2 + (c >> 5), rr = r & 15, cc = c & 31, ob = rr * 64 + cc * 2; return st * 1024 + (ob ^ (((ob >> 9) & 1) << 5)); }
__host__ __device__ __forceinline__ void stage_rc(int b, int& R, int& C) { const int st = b / 1024, sb = b % 1024, swz = sb ^ (((sb >> 9) & 1) << 5); R = (st >> 1) * 16 + swz / 64; C = (st & 1) * 32 + (swz % 64) / 2; }
__host__ __device__ __forceinline__ int perm32(int rho) { const int n = rho >> 4, i = rho & 15; return 8 * (i >> 2) + 4 * n + (i & 3); }

struct Unit { int pm, pn, hs; };
struct Gemm { const bf16_t* A; const bf16_t* Bt; int M, N, K, lda; };

struct StaticOrder {
    int nM, nN, nwg, G, c, split;
    __host__ __device__ void init(int M, int N, int G_, int c_) { nM = M / BM; nN = N / BM; nwg = nM * nN; G = G_; c = c_; split = 1; }
    __host__ __device__ bool next(int i, Unit& u) const {
        const int nfull = nwg / G, rem = nwg - nfull * G; int L = i * G + c; u.hs = 0;
        if (split && i == nfull && rem > 0 && 2 * rem <= G) { if (c >= 2 * rem) return false; L = nfull * G + (c >> 1); u.hs = 1 + (c & 1); }
        if (L >= nwg) return false;
        int wgid = L; { const int q = nwg / NXCD, r = nwg % NXCD, xcd = wgid % NXCD, off = wgid / NXCD; wgid = (xcd < r ? xcd * (q + 1) : r * (q + 1) + (xcd - r) * q) + off; }
        const int nig = WGM * nN, gid = wgid / nig, fm = gid * WGM, gsz = (nM - fm) < WGM ? (nM - fm) : WGM;
        u.pm = fm + ((wgid % nig) % gsz); u.pn = (wgid % nig) / gsz; return true;
    }
    __device__ __forceinline__ void a_ready(const Unit&) const {}
    __device__ __forceinline__ void done(const Unit&) const {}
};

typedef float f32x2 __attribute__((ext_vector_type(2)));
__device__ __forceinline__ float shx16(float v, int lane, int m) { return __int_as_float(__builtin_amdgcn_ds_bpermute((lane ^ m) << 2, __float_as_int(v))); }
typedef __bf16 bf16x2_t __attribute__((ext_vector_type(2)));
__device__ __forceinline__ unsigned pk4_fp8(float a, float b, float c, float d) { int w = __builtin_amdgcn_cvt_pk_fp8_f32(a, b, 0, false); w = __builtin_amdgcn_cvt_pk_fp8_f32(c, d, w, true); return (unsigned)w; }
__device__ __forceinline__ unsigned cvt_pk_bf16(float lo, float hi) { f32x2 v = {lo, hi}; bf16x2_t b = __builtin_convertvector(v, bf16x2_t); return __builtin_bit_cast(unsigned, b); }

struct EpiProj {
    static constexpr bool PERM = true, AFTER_DRAIN = false, BIAS_LDS = false; static constexpr int NSTORE = 16;
    bf16_t* O; int ldc; const float* ssq_in; float* ssq_out; const f32x2* rope; unsigned rope_heads; float oscale;
    __device__ __forceinline__ void operator()(const f32x4 (&acc)[2][2][4][2], const Unit& u, int wr, int wc, int fr, int fq) const {
        if (ssq_in != nullptr || rope_heads != 0u) run<true>(acc, u, wr, wc, fr, fq); else run<false>(acc, u, wr, wc, fr, fq);
    }
    template <bool LOADS>
    __device__ __forceinline__ void run(const f32x4 (&acc)[2][2][4][2], const Unit& u, int wr, int wc, int fr, int fq) const {
        const int row0 = u.pm * BM + (u.hs == 2 ? HALF : 0) + wr * 64 + fr, col0 = u.pn * BM + wc * 32 + 8 * fq;
        const bool do_ssq = (ssq_out != nullptr) && (u.pn == 0);
        const __amdgpu_buffer_rsrc_t ors = __builtin_amdgcn_make_buffer_rsrc((void*)O, 0, 0x7fffffff, 0x00020000);
        const bool any_rope = rope_heads != 0u;
        f32x4 sq_n = {0.f, 0.f, 0.f, 0.f}, cs_n[4];
#pragma unroll
        for (int q = 0; q < 4; ++q) cs_n[q] = (f32x4){0.f, 0.f, 0.f, 0.f};
        const float* sqp_ = ssq_in ? ssq_in : (const float*)rope;
#define EPI_ROWLOADS(ROW) do { if constexpr (LOADS) { sq_n = *(const f32x4*)(sqp_ + (size_t)(ROW) * 4); \
            const f32x4* cs_ = (const f32x4*)(rope + (size_t)((ROW) & 4095) * 8); cs_n[0] = cs_[0]; cs_n[1] = cs_[1]; cs_n[2] = cs_[2]; cs_n[3] = cs_[3]; } } while (0)
        EPI_ROWLOADS(row0);
#pragma unroll
        for (int ai = 0; ai < 2; ++ai) if (ai == 0 || u.hs == 0)
#pragma unroll
            for (int m = 0; m < 4; ++m) {
                const int row = row0 + ai * HALF + m * 16;
                const f32x4 s = sq_n, c01 = cs_n[0], c23 = cs_n[1], c45 = cs_n[2], c67 = cs_n[3];
                if (!(ai == 1 && m == 3)) { const int rown = row0 + (m == 3 ? HALF : ai * HALF + (m + 1) * 16); EPI_ROWLOADS(rown); }
                float rs = 1.f;
                if (ssq_in) rs = 1.0f / sqrtf(((s[0] + s[1]) + (s[2] + s[3])) * (1.f / 256.f) + 1e-5f);
                float ss = 0.f;
#pragma unroll
                for (int bj = 0; bj < 2; ++bj) {
                    f32x4 v0 = acc[ai][bj][m][0] * oscale, v1 = acc[ai][bj][m][1] * oscale;
                    if (do_ssq) ss += ((v0[0] * v0[0] + v0[1] * v0[1]) + (v0[2] * v0[2] + v0[3] * v0[3])) + ((v1[0] * v1[0] + v1[1] * v1[1]) + (v1[2] * v1[2] + v1[3] * v1[3]));
                    v0 = v0 * rs; v1 = v1 * rs;
                    const int head = (u.pn * BM + bj * HALF + wc * 32) >> 6;
                    if (((rope_heads >> head) & 1u) && !(wc & 1)) {
                        f32x4 o0, o1;
#pragma unroll
                        for (int j = 0; j < 4; ++j) { o0[j] = shx16(v0[j], fr + 16 * fq, 16); o1[j] = shx16(v1[j], fr + 16 * fq, 16); }
                        if (fq < 2) {
                            const float sg = fq == 0 ? -1.f : 1.f;
                            v0[0] = v0[0] * c01[0] + sg * o0[0] * c01[1]; v0[1] = v0[1] * c01[2] + sg * o0[1] * c01[3];
                            v0[2] = v0[2] * c23[0] + sg * o0[2] * c23[1]; v0[3] = v0[3] * c23[2] + sg * o0[3] * c23[3];
                            v1[0] = v1[0] * c45[0] + sg * o1[0] * c45[1]; v1[1] = v1[1] * c45[2] + sg * o1[1] * c45[3];
                            v1[2] = v1[2] * c67[0] + sg * o1[2] * c67[1]; v1[3] = v1[3] * c67[2] + sg * o1[3] * c67[3];
                        }
                    }
                    u32x4 w; w.x = cvt_pk_bf16(v0[0], v0[1]); w.y = cvt_pk_bf16(v0[2], v0[3]); w.z = cvt_pk_bf16(v1[0], v1[1]); w.w = cvt_pk_bf16(v1[2], v1[3]);
                    __builtin_amdgcn_raw_buffer_store_b128(w, ors, (row * ldc + col0 + bj * HALF) * 2, 0, 0);
                }
                if (do_ssq) { ss += shx16(ss, fr + 16 * fq, 16); ss += shx16(ss, fr + 16 * fq, 32); if (fq == 0) ssq_out[(size_t)row * 4 + wc] = ss; }
            }
#undef EPI_ROWLOADS
    }
};
struct EpiSwiglu {
    static constexpr bool PERM = true, AFTER_DRAIN = false, BIAS_LDS = true; static constexpr int NSTORE = 8;
    bf16_t* O; const float* bias;
    static constexpr float WSC = 1.0f / 64.0f;
    __device__ __forceinline__ void stage_bias(const Unit& u, PG8_LAS void* dst, int lane) const {
        const __amdgpu_buffer_rsrc_t brs = __builtin_amdgcn_make_buffer_rsrc((void*)bias, 0, 32 * 2048 * 4, 0x00020000);
        const int e = u.pn >> 3, t = u.pn & 7;
        __builtin_amdgcn_raw_ptr_buffer_load_lds(brs, dst, 16, (lane & 31) * 16 + (lane >> 5) * 4096, (e * 2048 + t * 128) * 4, 0, 0);
    }
    __device__ __forceinline__ void operator()(const f32x4 (&acc)[2][2][4][2], const Unit& u, int wr, int wc, int fr, int fq, const PG8_LAS float* bl) const {
        const int t = u.pn & 7;
        const int row0 = u.pm * BM + (u.hs == 2 ? HALF : 0) + wr * 64 + fr, jl = wc * 32 + 8 * fq, j0 = t * 128 + jl;
        const f32x4 bg0 = *(const PG8_LAS f32x4*)(bl + jl), bg1 = *(const PG8_LAS f32x4*)(bl + jl + 4), bu0 = *(const PG8_LAS f32x4*)(bl + 128 + jl), bu1 = *(const PG8_LAS f32x4*)(bl + 128 + jl + 4);
#pragma unroll
        for (int ai = 0; ai < 2; ++ai) if (ai == 0 || u.hs == 0)
#pragma unroll
            for (int m = 0; m < 4; ++m) {
                const int row = row0 + ai * HALF + m * 16;
                float r[8];
#pragma unroll
                for (int n = 0; n < 2; ++n) {
                    const f32x4 g4 = acc[ai][0][m][n] * WSC + (n ? bg1 : bg0), u4 = acc[ai][1][m][n] * WSC + (n ? bu1 : bu0);
#pragma unroll
                    for (int j = 0; j < 4; ++j) {
                        const float g = fminf(g4[j], 7.0f), up = fminf(fmaxf(u4[j], -7.0f), 7.0f);
                        const float sg = __builtin_amdgcn_rcpf(1.0f + __builtin_amdgcn_exp2f(g * (-1.702f * 1.4426950408889634f)));
                        r[n * 4 + j] = (up + 1.0f) * g * sg;
                    }
                }
                u32x2 w; w.x = pk4_fp8(r[0], r[1], r[2], r[3]); w.y = pk4_fp8(r[4], r[5], r[6], r[7]);
                *(u32x2*)((unsigned char*)O + (size_t)row * 1024 + j0) = w;
            }
    }
};
struct EpiDown {
    static constexpr bool PERM = true, AFTER_DRAIN = false, BIAS_LDS = true; static constexpr int NSTORE = 16;
    bf16_t* O; const float* bias;
    __device__ __forceinline__ void stage_bias(const Unit& u, PG8_LAS void* dst, int lane) const {
        const __amdgpu_buffer_rsrc_t brs = __builtin_amdgcn_make_buffer_rsrc((void*)bias, 0, 32 * 1024 * 4, 0x00020000);
        const int e = u.pn >> 2, t = u.pn & 3;
        __builtin_amdgcn_raw_ptr_buffer_load_lds(brs, dst, 16, lane * 16, (e * 1024 + t * 256) * 4, 0, 0);
    }
    __device__ __forceinline__ void operator()(const f32x4 (&acc)[2][2][4][2], const Unit& u, int wr, int wc, int fr, int fq, const PG8_LAS float* bl) const {
        const int t = u.pn & 3;
        const int row0 = u.pm * BM + (u.hs == 2 ? HALF : 0) + wr * 64 + fr, cl = wc * 32 + 8 * fq, col0 = t * BM + cl;
        f32x4 bv[2][2];
#pragma unroll
        for (int bj = 0; bj < 2; ++bj)
#pragma unroll
            for (int n = 0; n < 2; ++n) bv[bj][n] = *(const PG8_LAS f32x4*)(bl + cl + bj * HALF + 4 * n);
#pragma unroll
        for (int ai = 0; ai < 2; ++ai) if (ai == 0 || u.hs == 0)
#pragma unroll
            for (int m = 0; m < 4; ++m) { unsigned char* rowp = (unsigned char*)O + (size_t)(row0 + ai * HALF + m * 16) * 1024 + col0;
#pragma unroll
                for (int bj = 0; bj < 2; ++bj) { const f32x4 v0 = (acc[ai][bj][m][0] * (1.0f / 128.0f) + bv[bj][0]) * 16.0f, v1 = (acc[ai][bj][m][1] * (1.0f / 128.0f) + bv[bj][1]) * 16.0f;
                    u32x2 w; w.x = pk4_fp8(v0[0], v0[1], v0[2], v0[3]); w.y = pk4_fp8(v1[0], v1[1], v1[2], v1[3]);
                    *(u32x2*)(rowp + bj * HALF) = w; } }
    }
};
struct MoeOrder {
    const PG8_LAS int* pref; const PG8_LAS int* tiles; int ntn, total, G, vcu;
    __device__ __forceinline__ bool next(int i, Unit& u) const {
        const int nfull = total / G, rem = total - nfull * G; int L = i * G + vcu; u.hs = 0;
        if (i == nfull && rem > 0 && 2 * rem <= G) { if (vcu >= 2 * rem) return false; L = nfull * G + (vcu >> 1); u.hs = 1 + (vcu & 1); }
        if (L >= total) return false;
        int e = 0;
        for (int k = 1; k < 32; ++k) e += (pref[k] <= L) ? 1 : 0;
        const int r = L - pref[e], te = tiles[e];
        const int grp = te * 4, ntq = r / grp, r2 = r - ntq * grp, mt = r2 >> 2, ntl = r2 & 3;
        u.pm = __builtin_amdgcn_readfirstlane(e * 64 + mt); u.pn = __builtin_amdgcn_readfirstlane(e * ntn + ntq * 4 + ntl); return true;
    }
    __device__ __forceinline__ void a_ready(const Unit&) const {}
    __device__ __forceinline__ void done(const Unit&) const {}
};

template <class Epi, class Sched, bool ALIGN_EPI = false, bool SP2 = false, bool FP8 = false>
__device__ __forceinline__ void gemm_phase(PG8_LAS unsigned char* lds, const Gemm g, const Sched& S, const Epi& E, const int tid_in) {
    const int tid_ = tid_in;
    const int tid = tid_, wid = __builtin_amdgcn_readfirstlane(tid >> 6), lane = tid & 63, wr = wid >> 2, wc = wid & 3, fr = lane & 15, fq = lane >> 4;
    const int K = g.K, nt = K / BK;
    unsigned voffA[2], voffB[2];
#pragma unroll
    for (int i = 0; i < 2; ++i) { int R, C; stage_rc(tid * 16 + i * 8192, R, C); const int Rb = Epi::PERM ? ((R & ~31) + perm32(R & 31)) : R;
        voffA[i] = (unsigned)(R * g.lda + C) * 2u; voffB[i] = (unsigned)(Rb * K + C) * 2u; }
    const unsigned kstep = (unsigned)(BK * 2);
    const unsigned hstepA = (unsigned)HALF * g.lda * 2, hstepB = (unsigned)HALF * K * 2;
    const unsigned tstepA = 2 * hstepA, tstepB = 2 * hstepB;
    const unsigned ldsw = (unsigned)wid * 1024u;
    const int aoff = lds_byte(wr * 64 + fr, fq * 8), boff = lds_byte(wc * 32 + fr, fq * 8);
#define PG8_SA(b, h) (((b) * 2 + (h)) * HTB)
#define PG8_SB(b, h) ((4 + (b) * 2 + (h)) * HTB)
    const __amdgpu_buffer_rsrc_t rA = __builtin_amdgcn_make_buffer_rsrc((void*)g.A, 0, 0x7fffffff, 0x00020000), rB = __builtin_amdgcn_make_buffer_rsrc((void*)g.Bt, 0, 0x7fffffff, 0x00020000);
#define PG8_STAGE(bufoff, soff, voff, rs) do { _Pragma("unroll") for (int _i = 0; _i < 2; ++_i) \
        __builtin_amdgcn_raw_ptr_buffer_load_lds(rs, (PG8_LAS void*)(lds + (bufoff) + ldsw + _i * 8192), 16, (int)(voff)[_i], (int)(soff), 0, 0); } while (0)
#define PG8_LD2(P) __builtin_shufflevector(*(const PG8_LAS bf16x8*)(P), *(const PG8_LAS bf16x8*)((P) + 1024), 0, 1, 2, 3, 4, 5, 6, 7, 8, 9, 10, 11, 12, 13, 14, 15)
#define PG8_LDA(dst, b, h) do { _Pragma("unroll") for (int m = 0; m < 4; ++m) dst[m] = PG8_LD2(lds + PG8_SA(b, h) + aoff + m * 2048); } while (0)
#define PG8_LDB(dst, b, h) do { _Pragma("unroll") for (int n = 0; n < 2; ++n) dst[n] = PG8_LD2(lds + PG8_SB(b, h) + boff + n * 2048); } while (0)
#define PG8_LO(X) __builtin_shufflevector((X), (X), 0, 1, 2, 3, 4, 5, 6, 7)
#define PG8_HI(X) __builtin_shufflevector((X), (X), 8, 9, 10, 11, 12, 13, 14, 15)
#define PG8_MMA(ai, bj, At, Bt) do { __builtin_amdgcn_s_setprio(1); if constexpr (FP8) { _Pragma("unroll") for (int m = 0; m < 4; ++m) _Pragma("unroll") for (int n = 0; n < 2; ++n) \
        acc[ai][bj][m][n] = __builtin_amdgcn_mfma_scale_f32_16x16x128_f8f6f4(__builtin_bit_cast(i32x8, Bt[n]), __builtin_bit_cast(i32x8, At[m]), acc[ai][bj][m][n], 0, 0, 0, 0x7f7f7f7f, 0, 0x7f7f7f7f); \
        asm volatile("" : "+v"(acc[ai][bj][0][0]), "+v"(acc[ai][bj][0][1]), "+v"(acc[ai][bj][1][0]), "+v"(acc[ai][bj][1][1]), "+v"(acc[ai][bj][2][0]), "+v"(acc[ai][bj][2][1]), "+v"(acc[ai][bj][3][0]), "+v"(acc[ai][bj][3][1]));   } else { \
        _Pragma("unroll") for (int m = 0; m < 4; ++m) _Pragma("unroll") for (int n = 0; n < 2; ++n) { \
        acc[ai][bj][m][n] = __builtin_amdgcn_mfma_f32_16x16x32_bf16(PG8_LO(Bt[n]), PG8_LO(At[m]), acc[ai][bj][m][n], 0, 0, 0); \
        acc[ai][bj][m][n] = __builtin_amdgcn_mfma_f32_16x16x32_bf16(PG8_HI(Bt[n]), PG8_HI(At[m]), acc[ai][bj][m][n], 0, 0, 0); } } __builtin_amdgcn_s_setprio(0); } while (0)
#define PG8_WAIT_V(n) asm volatile("s_waitcnt vmcnt(" #n ")" ::: "memory")
#define PG8_WAIT_L(n) asm volatile("s_waitcnt lgkmcnt(" #n ")" ::: "memory")
#define PG8_WAIT_V8S do { if (t != 0 || pst == 0) PG8_WAIT_V(8); else if (pst == Epi::NSTORE) asm volatile("s_waitcnt vmcnt(%0)" :: "n"(8 + Epi::NSTORE) : "memory"); else asm volatile("s_waitcnt vmcnt(%0)" :: "n"(8 + Epi::NSTORE / 2) : "memory"); } while (0)
#define PG8_BAR __builtin_amdgcn_s_barrier()
#define PG8_SCHED __builtin_amdgcn_sched_barrier(0)
    Unit cur, nxt; int ui = 0, pst = 0;
    if (!S.next(0, cur)) return;
    f32x4 acc[2][2][4][2];
    float z0_ = 0.f; asm volatile("" : "+v"(z0_));
#pragma unroll
    for (int a = 0; a < 2; ++a)
#pragma unroll
        for (int b = 0; b < 2; ++b)
#pragma unroll
            for (int m = 0; m < 4; ++m)
#pragma unroll
                for (int n = 0; n < 2; ++n) acc[a][b][m][n] = (f32x4){z0_, z0_, z0_, z0_};
    bf16x16 At[4], B0[2], B1[2];
    unsigned cA = (unsigned)cur.pm * tstepA + (cur.hs == 2 ? hstepA : 0u), cB = (unsigned)cur.pn * tstepB;
    S.a_ready(cur);
    if constexpr (SP2) {
        PG8_STAGE(PG8_SB(0, 0), cB, voffB, rB); PG8_STAGE(PG8_SB(0, 1), cB + hstepB, voffB, rB); PG8_STAGE(PG8_SA(0, 0), cA, voffA, rA); PG8_STAGE(PG8_SA(0, 1), cA + hstepA, voffA, rA);
        if (wr == 1) PG8_BAR;
        PG8_WAIT_V(2); PG8_BAR;
        PG8_STAGE(PG8_SB(1, 0), cB + kstep, voffB, rB); PG8_STAGE(PG8_SA(1, 0), cA + kstep, voffA, rA); PG8_STAGE(PG8_SB(1, 1), cB + hstepB + kstep, voffB, rB);
        PG8_WAIT_V(6); PG8_BAR;
    } else {
        PG8_STAGE(PG8_SB(0, 0), cB, voffB, rB); PG8_STAGE(PG8_SA(0, 0), cA, voffA, rA); PG8_STAGE(PG8_SB(0, 1), cB + hstepB, voffB, rB); PG8_STAGE(PG8_SA(0, 1), cA + hstepA, voffA, rA);
        if (wr == 1) PG8_BAR;
        PG8_WAIT_V(4); PG8_BAR;
        PG8_STAGE(PG8_SB(1, 0), cB + kstep, voffB, rB); PG8_STAGE(PG8_SA(1, 0), cA + kstep, voffA, rA); PG8_STAGE(PG8_SB(1, 1), cB + hstepB + kstep, voffB, rB);
        PG8_WAIT_V(6); PG8_BAR;
    }
    for (;;) {
        const bool has_next = S.next(ui + 1, nxt);
        if constexpr (Epi::BIAS_LDS) { if (wid == 0) { int lb_; asm volatile("v_mbcnt_lo_u32_b32 %0, -1, 0\n\tv_mbcnt_hi_u32_b32 %0, -1, %0" : "=v"(lb_)); E.stage_bias(cur, (PG8_LAS void*)(lds + STAGE_BYTES + (ui & 1) * 1024), lb_); } }
        const unsigned nA = has_next ? (unsigned)nxt.pm * tstepA + (nxt.hs == 2 ? hstepA : 0u) : cA, nB = has_next ? (unsigned)nxt.pn * tstepB : cB;
        const bool chalf = cur.hs != 0;
        for (int t = 0; t < nt; t += 2) {
            const bool last = (t == nt - 2);
            const unsigned a1 = cA + (unsigned)(t + 1) * kstep;
            const unsigned a2 = last ? nA : cA + (unsigned)(t + 2) * kstep, b2 = last ? nB : cB + (unsigned)(t + 2) * kstep;
            const unsigned a3 = a2 + kstep, b3 = b2 + kstep;
            if (last && has_next) S.a_ready(nxt);
            if constexpr (SP2) {
            PG8_LDB(B0, 0, 0); PG8_LDB(B1, 0, 1); PG8_SCHED; PG8_LDA(At, 0, 0); PG8_STAGE(PG8_SA(1, 1), a1 + hstepA, voffA, rA);
            PG8_WAIT_V8S; PG8_WAIT_L(0); PG8_BAR; PG8_MMA(0, 0, At, B0); PG8_MMA(0, 1, At, B1); PG8_BAR; PG8_SCHED;
            PG8_LDA(At, 0, 1); PG8_STAGE(PG8_SB(0, 0), b2, voffB, rB); PG8_STAGE(PG8_SB(0, 1), b2 + hstepB, voffB, rB); PG8_STAGE(PG8_SA(0, 0), a2, voffA, rA);
            PG8_WAIT_V8S; PG8_WAIT_L(0); PG8_BAR; if (!chalf) { PG8_MMA(1, 0, At, B0); PG8_MMA(1, 1, At, B1); } PG8_BAR; PG8_SCHED;
            PG8_LDB(B0, 1, 0); PG8_LDB(B1, 1, 1); PG8_SCHED; PG8_LDA(At, 1, 0); PG8_STAGE(PG8_SA(0, 1), a2 + hstepA, voffA, rA);
            PG8_WAIT_V(8); PG8_WAIT_L(0); PG8_BAR; PG8_MMA(0, 0, At, B0); PG8_MMA(0, 1, At, B1); PG8_BAR; PG8_SCHED;
            PG8_LDA(At, 1, 1); PG8_STAGE(PG8_SB(1, 0), b3, voffB, rB); PG8_STAGE(PG8_SB(1, 1), b3 + hstepB, voffB, rB); PG8_STAGE(PG8_SA(1, 0), a3, voffA, rA);
            PG8_WAIT_V(8); PG8_WAIT_L(0); PG8_BAR; if (!chalf) { PG8_MMA(1, 0, At, B0); PG8_MMA(1, 1, At, B1); } PG8_BAR; PG8_SCHED;
            } else {
            PG8_LDB(B0, 0, 0); PG8_SCHED; PG8_LDA(At, 0, 0); PG8_STAGE(PG8_SA(1, 1), a1 + hstepA, voffA, rA);
            PG8_WAIT_L(8); PG8_BAR; PG8_WAIT_L(0); PG8_MMA(0, 0, At, B0); PG8_BAR; PG8_SCHED;
            PG8_LDB(B1, 0, 1); PG8_STAGE(PG8_SB(0, 0), b2, voffB, rB);
            PG8_BAR; PG8_WAIT_L(0); PG8_MMA(0, 1, At, B1); PG8_BAR;
            PG8_LDA(At, 0, 1); PG8_STAGE(PG8_SA(0, 0), a2, voffA, rA);
            PG8_BAR; PG8_WAIT_L(0); PG8_MMA(1, 0, At, B0); PG8_BAR; PG8_SCHED;
            PG8_STAGE(PG8_SB(0, 1), b2 + hstepB, voffB, rB);
            PG8_WAIT_V(6); PG8_BAR; PG8_MMA(1, 1, At, B1); PG8_BAR;
            PG8_LDB(B0, 1, 0); PG8_SCHED; PG8_LDA(At, 1, 0); PG8_STAGE(PG8_SA(0, 1), a2 + hstepA, voffA, rA);
            PG8_WAIT_L(8); PG8_BAR; PG8_WAIT_L(0); PG8_MMA(0, 0, At, B0); PG8_BAR; PG8_SCHED;
            PG8_LDB(B1, 1, 1); PG8_STAGE(PG8_SB(1, 0), b3, voffB, rB);
            PG8_BAR; PG8_WAIT_L(0); PG8_MMA(0, 1, At, B1); PG8_BAR;
            PG8_LDA(At, 1, 1); PG8_STAGE(PG8_SA(1, 0), a3, voffA, rA);
            PG8_BAR; PG8_WAIT_L(0); PG8_MMA(1, 0, At, B0); PG8_BAR; PG8_SCHED;
            PG8_STAGE(PG8_SB(1, 1), b3 + hstepB, voffB, rB);
            PG8_WAIT_V(6); PG8_BAR; PG8_MMA(1, 1, At, B1); PG8_BAR;
            }
        }
        if constexpr (ALIGN_EPI) { if (wr == 0) PG8_BAR; }
        if constexpr (!Epi::AFTER_DRAIN) { int l_; asm volatile("v_mbcnt_lo_u32_b32 %0, -1, 0\n\tv_mbcnt_hi_u32_b32 %0, -1, %0" : "=v"(l_)); if constexpr (Epi::BIAS_LDS) E(acc, cur, wr, wc, l_ & 15, l_ >> 4, (const PG8_LAS float*)(lds + STAGE_BYTES + (ui & 1) * 1024)); else E(acc, cur, wr, wc, l_ & 15, l_ >> 4); S.done(cur); }
        if (!has_next) break;
        asm volatile("" : "+v"(z0_));
#pragma unroll
        for (int a = 0; a < 2; ++a)
#pragma unroll
            for (int b = 0; b < 2; ++b)
#pragma unroll
                for (int m = 0; m < 4; ++m)
#pragma unroll
                    for (int n = 0; n < 2; ++n) acc[a][b][m][n] = (f32x4){z0_, z0_, z0_, z0_};
        pst = cur.hs ? Epi::NSTORE / 2 : Epi::NSTORE; cur = nxt; cA = nA; cB = nB; ++ui;
        if constexpr (ALIGN_EPI) { if (wr == 1) PG8_BAR; }
    }
    PG8_WAIT_V(0);
    if constexpr (!ALIGN_EPI) { if (wr == 0) PG8_BAR; }
    PG8_BAR;
    if constexpr (Epi::AFTER_DRAIN) { E.fused(acc, cur, wr, wc, fr, fq, lds, wid, lane); S.done(cur); }
#undef PG8_SA
#undef PG8_SB
#undef PG8_STAGE
#undef PG8_LDA
#undef PG8_LDB
#undef PG8_MMA
#undef PG8_LD2
#undef PG8_LO
#undef PG8_HI
#undef PG8_WAIT_V
#undef PG8_WAIT_L
#undef PG8_WAIT_V8S
#undef PG8_BAR
#undef PG8_SCHED
}
}

constexpr int NB = 4, SEQ = 4096, T = NB * SEQ, D = 1024, DEPTH = 4, NEXP = 32, DEXP = 1024, MEML = 256;
constexpr int CAPROWS = 16384;
constexpr float LN_EPS = 1e-5f, ALPHA = 1.681792830507429f;
constexpr float LOG2E = 1.4426950408889634f, C2 = 0.125f * 1.4426950408889634f;
constexpr float NEG_BIG = -1.0e30f;
constexpr float NEG_RAW = -0x1p100f;
constexpr int NWAVES = 8, NTHREADS = 512;

constexpr size_t MiB = 1u << 20;
constexpr size_t WS_CTL = 0, CTL_ZERO_BYTES = 65536;
constexpr size_t WS_ROPE = 1 * MiB;
constexpr size_t WS_WUQ = 2 * MiB;
constexpr size_t WS_MEMB = 3 * MiB;
constexpr size_t WS_KVMEM = 5 * MiB;
constexpr size_t WS_WKV = 9 * MiB;
constexpr size_t WS_WOUT = 13 * MiB;
constexpr size_t WS_WIN = 21 * MiB;
constexpr size_t WS_SSQ = 41 * MiB;
constexpr size_t WS_ROWS = 42 * MiB;
constexpr size_t WS_GATES = 43 * MiB;
constexpr size_t WS_MASK = 44 * MiB;
constexpr size_t WS_XB = 52 * MiB;
constexpr size_t WS_CAT = 84 * MiB;
constexpr size_t WS_Y = 116 * MiB;
constexpr size_t WS_QQ = 148 * MiB;
constexpr size_t WS_PROJ = 188 * MiB;
constexpr size_t WS_XB8 = 268 * MiB;
constexpr size_t WS_XA = 268 * MiB;
constexpr size_t WS_XM = 332 * MiB;
constexpr size_t WS_WGU = 400 * MiB;
constexpr size_t WS_WDN = 912 * MiB;
constexpr size_t WS_XP = 1168 * MiB;
constexpr size_t WS_ACT = 2192 * MiB;
constexpr size_t WS_END = 3216 * MiB;
constexpr int CW_TMO = 0, CW_ERR = 2;
constexpr int CW_BAR = 4096;
constexpr int CW_QHEAD = 8192;
constexpr int CW_GCOUNT = 9216;
constexpr int CW_BAR2 = 12288;
constexpr int CW_GDUMMY = 9472;
static_assert((CW_BAR2 + 3456) * 4 <= (int)CTL_ZERO_BYTES && (CW_GDUMMY + 128) * 4 <= (int)CTL_ZERO_BYTES, "CTL words inside the memset region");

constexpr int RING_OFF = 0, RING_BYTES = 131072;
constexpr int LDSCTL_OFF = 143360;
constexpr int L_XB = LDSCTL_OFF + 0;
constexpr int L_Q = LDSCTL_OFF + 16;
constexpr int L_XB2 = LDSCTL_OFF + 32;
constexpr int L_PREF = LDSCTL_OFF + 64;
constexpr int L_TILES = LDSCTL_OFF + 256;
constexpr int L_CNT = LDSCTL_OFF + 384;
constexpr int L_BASE = LDSCTL_OFF + 512;
constexpr int L_ROUTE = LDSCTL_OFF + 1024;
constexpr int LDS_BYTES = 147456;

#define GAS __attribute__((address_space(1)))
#define LAS __attribute__((address_space(3)))
typedef unsigned short bf16;
typedef unsigned u32x4 __attribute__((ext_vector_type(4)));
typedef unsigned u32x2 __attribute__((ext_vector_type(2)));
typedef float f32x4 __attribute__((ext_vector_type(4)));
typedef float f32x2 __attribute__((ext_vector_type(2)));
typedef float f32x16 __attribute__((ext_vector_type(16)));
typedef short bf16x8 __attribute__((ext_vector_type(8)));
typedef short s16x4 __attribute__((ext_vector_type(4)));
typedef short v4i16_t __attribute__((ext_vector_type(4)));
typedef GAS unsigned gu32;
#define RLX_AGENT __ATOMIC_RELAXED, __HIP_MEMORY_SCOPE_AGENT
__device__ __forceinline__ unsigned pk2(float lo, float hi) { return pg8::cvt_pk_bf16(lo, hi); }
__device__ __forceinline__ float bf2f(bf16 b) { return __uint_as_float((unsigned)b << 16); }
__device__ __forceinline__ float bflo(unsigned w) { return __uint_as_float(w << 16); }
__device__ __forceinline__ float bfhi(unsigned w) { return __uint_as_float(w & 0xffff0000u); }
__device__ __forceinline__ int crow(int r, int hi) { return (r & 3) + 8 * (r >> 2) + 4 * hi; }
__device__ __forceinline__ float swapmax(float m) { auto rr = __builtin_amdgcn_permlane32_swap(__float_as_uint(m), __float_as_uint(m), false, false); return fmaxf(__uint_as_float(rr[0]), __uint_as_float(rr[1])); }
__device__ __forceinline__ float swapsum(float m) { auto rr = __builtin_amdgcn_permlane32_swap(__float_as_uint(m), __float_as_uint(m), false, false); return __uint_as_float(rr[0]) + __uint_as_float(rr[1]); }
__device__ __forceinline__ int lane_id_now() { int l; asm volatile("v_mbcnt_lo_u32_b32 %0, -1, 0\n\tv_mbcnt_hi_u32_b32 %0, -1, %0" : "=v"(l)); return l; }
__device__ __forceinline__ float shx(float v, int m) { return __int_as_float(__builtin_amdgcn_ds_bpermute((lane_id_now() ^ m) << 2, __float_as_int(v))); }
__device__ __forceinline__ int shxi(int v, int m) { return __builtin_amdgcn_ds_bpermute((lane_id_now() ^ m) << 2, v); }
__device__ __forceinline__ int shli(int v, int src) { return __builtin_amdgcn_ds_bpermute(src << 2, v); }
__device__ __forceinline__ float wave_sum(float v) {
#define WS_DPP(CTRL) v += __int_as_float(__builtin_amdgcn_update_dpp(0, __float_as_int(v), (CTRL), 0xF, 0xF, false))
    WS_DPP(0xB1); WS_DPP(0x4E); WS_DPP(0x141); WS_DPP(0x140);
#undef WS_DPP
    const float r0 = __int_as_float(__builtin_amdgcn_readlane(__float_as_int(v), 0)), r1 = __int_as_float(__builtin_amdgcn_readlane(__float_as_int(v), 16));
    const float r2 = __int_as_float(__builtin_amdgcn_readlane(__float_as_int(v), 32)), r3 = __int_as_float(__builtin_amdgcn_readlane(__float_as_int(v), 48));
    return (r0 + r1) + (r2 + r3);
}

#define XB_TMO      128
#define XB_XCNT(j)  (256  + 64 * (j))
#define XB_XSUB(j)  (1280 + 64 * (j))
#define XB_XGEN(j)  (2304 + 64 * (j))
#define XB_TOP      3328
#define XB_TOPGEN   3392
#define XCD_BAR_WORDS 3456
#define XB_SPIN_CAP (1u << 18)

__device__ __forceinline__ unsigned xb_ld(unsigned* p)              { return __hip_atomic_load(p, __ATOMIC_RELAXED, __HIP_MEMORY_SCOPE_AGENT); }
__device__ __forceinline__ unsigned xb_add(unsigned* p, unsigned v) { return __hip_atomic_fetch_add(p, v, __ATOMIC_RELAXED, __HIP_MEMORY_SCOPE_AGENT); }
__device__ __forceinline__ unsigned xb_xcc_id() { return (unsigned)__builtin_amdgcn_s_getreg((3 << 11) | 20) & 0xFu; }
#define XB_SPIN(cond, bar) do { unsigned _sp = 0; while (cond) { __builtin_amdgcn_s_sleep(1); \
    if ((++_sp & 255u) == 0u) { if (xb_ld(&(bar)[XB_TMO])) break; if (_sp > XB_SPIN_CAP) { atomicAdd(&(bar)[XB_TMO], 1u); break; } } } } while (0)

struct XcdBarrier {
    unsigned* bar; unsigned x;
    volatile LAS unsigned* st;
};

__device__ __forceinline__ XcdBarrier xcd_barrier_post(unsigned* bar, volatile LAS unsigned* st) {
    XcdBarrier b; b.bar = bar; b.x = xb_xcc_id(); b.st = st;
    if (threadIdx.x == 0) (void)xb_add(&bar[XB_XCNT(b.x)], 1u);
    return b;
}
__device__ __forceinline__ void xcd_barrier_complete(unsigned* bar, unsigned x, unsigned& nloc, unsigned& nx, const unsigned G) {
    unsigned sum, cnt, mine, sp = 0u;
    for (;;) {
        sum = 0u; cnt = 0u; mine = 0u;
#pragma unroll
        for (unsigned j = 0; j < 16; ++j) { const unsigned c = xb_ld(&bar[XB_XCNT(j)]); sum += c; cnt += (c > 0u) ? 1u : 0u; mine = (j == x) ? c : mine; }
        if (sum == G) break;
        __builtin_amdgcn_s_sleep(1);
        if ((++sp & 255u) == 0u) { if (xb_ld(&bar[XB_TMO])) break; if (sp > XB_SPIN_CAP) { atomicAdd(&bar[XB_TMO], 1u); break; } }
    }
    nloc = mine > 0u ? mine : 1u; nx = cnt > 0u ? cnt : 1u;
}

__device__ __noinline__ void xcd_barrier_ni(unsigned* bar_, unsigned x_, unsigned st_off, bool leader_thread, unsigned G_) {
    XcdBarrier b; b.bar = bar_; b.x = x_; b.st = (volatile LAS unsigned*)(uintptr_t)st_off;
    asm volatile("s_waitcnt vmcnt(0)" ::: "memory");
    __syncthreads();
    if (leader_thread) {
        unsigned* bar = b.bar;
        __builtin_amdgcn_s_waitcnt(0);
        unsigned nloc = b.st[0], nx = b.st[1];
        if (nloc == 0u) { xcd_barrier_complete(bar, b.x, nloc, nx, G_); b.st[0] = nloc; b.st[1] = nx; }
        const unsigned old = xb_add(&bar[XB_XSUB(b.x)], 1u);
        const unsigned gen = old / nloc;
        if (old + 1u == (gen + 1u) * nloc) {
            __builtin_amdgcn_fence(__ATOMIC_RELEASE, "agent");
            asm volatile("s_waitcnt vmcnt(0)" ::: "memory");
            const unsigned og = xb_add(&bar[XB_TOP], 1u);
            const unsigned tg = og / nx;
            if (og + 1u == (tg + 1u) * nx) xb_add(&bar[XB_TOPGEN], 1u);
            else XB_SPIN(xb_ld(&bar[XB_TOPGEN]) == tg, bar);
            __builtin_amdgcn_fence(__ATOMIC_ACQUIRE, "agent");
            xb_add(&bar[XB_XGEN(b.x)], 1u);
            asm volatile("s_waitcnt vmcnt(0)" ::: "memory");
        } else {
            XB_SPIN(xb_ld(&bar[XB_XGEN(b.x)]) == gen, bar);
            __builtin_amdgcn_fence(__ATOMIC_ACQUIRE, "agent");
            asm volatile("s_waitcnt vmcnt(0)" ::: "memory");
        }
    }
    __syncthreads();
}
__device__ __forceinline__ void xcd_barrier(const XcdBarrier& b, bool leader_thread, unsigned G) { xcd_barrier_ni(b.bar, b.x, (unsigned)(uintptr_t)b.st, leader_thread, G); }

struct Frame {
    LAS unsigned char* lds;
    gu32* ctl;
    int tid, lane, wave, bid, G, vcu;
};
struct Job { const float* src; bf16* dst; const float* scale; int ldw, K, col0, nvalid, nblk, row0, item0, f8; float mul; int pad; };
constexpr int NJOBS = 16;
struct Args {
    const float* in[22]; float* out; unsigned char* ws; Job jobs[NJOBS];
    int njob_items, ph_lo, ph_hi, pad;
};
typedef const __attribute__((address_space(4))) Args* ArgsP;

struct TrItem { const float* src; const float* scale; bf16* dst; int ldw, k0, colbase, nvalid, perm, dstK, drow0, f8; float mul; };
__device__ __forceinline__ void tr_load(f32x4 (&v)[16], const TrItem& I, int lane, int wid) {
#pragma unroll
    for (int rr = 0; rr < 16; ++rr) {
        const int k = rr * 8 + wid, n = 4 * lane;
        const float* srow = I.src + (size_t)(I.k0 + k) * I.ldw + I.colbase;
        const int col = (I.perm && n >= 128) ? n + 896 : n;
        if (n + 3 < I.nvalid) v[rr] = __builtin_nontemporal_load((const f32x4*)(srow + col));
        else { f32x4 t; t[0] = (n < I.nvalid) ? srow[col] : 0.f; t[1] = (n + 1 < I.nvalid) ? srow[col + 1] : 0.f; t[2] = (n + 2 < I.nvalid) ? srow[col + 2] : 0.f; t[3] = 0.f; v[rr] = t; }
    }
}
__device__ __forceinline__ void tr_to_lds(const f32x4 (&v)[16], LAS float* scr, const TrItem& I, int lane, int wid) {
#pragma unroll
    for (int rr = 0; rr < 16; ++rr) {
        const int k = rr * 8 + wid;
        const float sc = I.scale ? I.scale[I.k0 + k] * I.mul : I.mul;
        *(LAS f32x4*)(scr + k * 256 + 4 * (lane ^ ((k >> 3) & 15))) = v[rr] * sc;
    }
}
__device__ __forceinline__ void tr_store(const LAS float* scr, const TrItem& I, int lane, int wid) {
#pragma unroll
    for (int q = 0; q < 8; ++q) {
        const int n = wid * 32 + q * 4 + (lane >> 4), a = lane & 15;
        const LAS float* s = scr + (8 * a) * 256 + 4 * ((n >> 2) ^ a) + (n & 3);
        if (I.f8) { u32x2 o; o.x = pg8::pk4_fp8(s[0], s[256], s[2 * 256], s[3 * 256]); o.y = pg8::pk4_fp8(s[4 * 256], s[5 * 256], s[6 * 256], s[7 * 256]);
            __builtin_nontemporal_store(o, (u32x2*)((unsigned char*)I.dst + (size_t)(I.drow0 + n) * I.dstK + I.k0 + 8 * a)); }
        else { u32x4 o; o.x = pk2(s[0], s[256]); o.y = pk2(s[2 * 256], s[3 * 256]); o.z = pk2(s[4 * 256], s[5 * 256]); o.w = pk2(s[6 * 256], s[7 * 256]);
            *(u32x4*)(I.dst + (size_t)(I.drow0 + n) * I.dstK + I.k0 + 8 * a) = o; }
    }
}
__device__ __forceinline__ void sincos_d(double x, float& c, float& s) {
    const double TWO_PI = 6.283185307179586476925, INV_2PI = 0.15915494309189533577;
    const double r = x - TWO_PI * rint(x * INV_2PI), r2 = r * r;
    double sn = 1.0, cs = 1.0;
#pragma unroll
    for (int k = 14; k >= 1; --k) { sn = 1.0 - sn * r2 / (double)((2 * k) * (2 * k + 1)); cs = 1.0 - cs * r2 / (double)((2 * k - 1) * (2 * k)); }
    s = (float)(sn * r); c = (float)cs;
}
constexpr int MOE_ITEMS = DEPTH * NEXP * 96, MOE_ITEMS_LAYER = NEXP * 96;
#ifndef MK_CVT_LAYERS_P0
#define MK_CVT_LAYERS_P0 4
#endif
__device__ __forceinline__ TrItem tr_decode(ArgsP A, unsigned char* ws, int it) {
    TrItem I;
    if (it < MOE_ITEMS) {
        const int le = it / 96, r = it % 96; I.scale = nullptr; I.nvalid = 256; I.dstK = 1024; I.f8 = 1;
        if (r < 64) { const int kb = r >> 3, nb = r & 7; I.src = A->in[16] + (size_t)le * (1024 * 2048); I.ldw = 2048; I.k0 = kb * 128; I.colbase = nb * 128; I.perm = 1;
            I.dst = (bf16*)(ws + WS_WGU + (size_t)le * (2048 * 1024)); I.drow0 = nb * 256; I.mul = 64.0f; }
        else { const int r2 = r - 64, kb = r2 >> 2, nb = r2 & 3; I.src = A->in[18] + (size_t)le * (1024 * 1024); I.ldw = 1024; I.k0 = kb * 128; I.colbase = nb * 256; I.perm = 0;
            I.dst = (bf16*)(ws + WS_WDN + (size_t)le * (1024 * 1024)); I.drow0 = nb * 256; I.mul = 128.0f; }
    } else {
        const int ji = it - MOE_ITEMS; int j = 0;
#pragma unroll
        for (int q = 1; q < NJOBS; ++q) j += (A->jobs[q].item0 <= ji) ? 1 : 0;
        const int K = A->jobs[j].K, r = ji - A->jobs[j].item0, nkb = K >> 7, kb = r % nkb, nb = r / nkb;
        int nv = A->jobs[j].nvalid - nb * 256; nv = nv < 0 ? 0 : (nv > 256 ? 256 : nv);
        I.src = A->jobs[j].src; I.scale = A->jobs[j].scale; I.dst = A->jobs[j].dst; I.ldw = A->jobs[j].ldw; I.k0 = kb * 128; I.colbase = A->jobs[j].col0 + nb * 256; I.nvalid = nv; I.perm = 0;
        I.dstK = K; I.drow0 = A->jobs[j].row0 + nb * 256; I.f8 = A->jobs[j].f8; I.mul = A->jobs[j].mul;
    }
    return I;
}
__device__ __forceinline__ void tr_run(Frame& F, ArgsP A, unsigned char* ws, int j0, int step, int j1, int split, int gap) {
    LAS float* scr = (LAS float*)(F.lds + RING_OFF);
#define TR_ITEM(jj) tr_decode(A, ws, (jj) < split ? (jj) : (jj) + gap)
    if (j0 < j1) {
        f32x4 vA[16], vB[16];
        TrItem ia = TR_ITEM(j0), ib = ia;
        tr_load(vA, ia, F.lane, F.wave);
        if (j0 + step < j1) { ib = TR_ITEM(j0 + step); tr_load(vB, ib, F.lane, F.wave); }
        for (int j = j0; j < j1; j += 2 * step) {
            tr_to_lds(vA, scr, ia, F.lane, F.wave);
            __syncthreads();
            const TrItem ca = ia;
            if (j + 2 * step < j1) { ia = TR_ITEM(j + 2 * step); tr_load(vA, ia, F.lane, F.wave); }
            tr_store(scr, ca, F.lane, F.wave);
            __syncthreads();
            if (j + step < j1) {
                tr_to_lds(vB, scr, ib, F.lane, F.wave);
                __syncthreads();
                const TrItem cb = ib;
                if (j + 3 * step < j1) { ib = TR_ITEM(j + 3 * step); tr_load(vB, ib, F.lane, F.wave); }
                tr_store(scr, cb, F.lane, F.wave);
                __syncthreads();
            }
        }
    }
#undef TR_ITEM
}
__device__ __forceinline__ void p0_prologue(Frame& F, ArgsP A, unsigned char* ws, const int part) {
    constexpr int NP0 = MK_CVT_LAYERS_P0 * MOE_ITEMS_LAYER;
    const int total = NP0 + A->njob_items;
    const int it_lo = (part == 1) ? NP0 : 0, it_hi = (part == 2) ? NP0 : total;
    tr_run(F, A, ws, it_lo + F.bid, F.G, it_hi, NP0, MOE_ITEMS - NP0);
    if (part == 2) return;
    const size_t gt = (size_t)F.bid * NTHREADS + F.tid, NT = (size_t)F.G * NTHREADS;
    { const float* x = A->in[0]; bf16* xb = (bf16*)(ws + WS_XB);
      for (size_t i = gt; i < (size_t)T * D / 8; i += 4 * NT) {
          f32x4 a[4], b[4];
#pragma unroll
          for (int k = 0; k < 4; ++k) if (i + k * NT < (size_t)T * D / 8) { a[k] = *(const f32x4*)(x + (i + k * NT) * 8); b[k] = *(const f32x4*)(x + (i + k * NT) * 8 + 4); }
#pragma unroll
          for (int k = 0; k < 4; ++k) if (i + k * NT < (size_t)T * D / 8) { u32x4 o; o.x = pk2(a[k][0], a[k][1]); o.y = pk2(a[k][2], a[k][3]); o.z = pk2(b[k][0], b[k][1]); o.w = pk2(b[k][2], b[k][3]); *(u32x4*)(xb + (i + k * NT) * 8) = o; } }
      const float* mm = A->in[1]; bf16* mb = (bf16*)(ws + WS_MEMB);
      for (size_t i = gt; i < (size_t)NB * MEML * D / 8; i += NT) { const f32x4 a = *(const f32x4*)(mm + i * 8), b = *(const f32x4*)(mm + i * 8 + 4);
          u32x4 o; o.x = pk2(a[0], a[1]); o.y = pk2(a[2], a[3]); o.z = pk2(b[0], b[1]); o.w = pk2(b[2], b[3]); *(u32x4*)(mb + i * 8) = o; } }
    { f32x2* rt = (f32x2*)(ws + WS_ROPE);
      for (size_t i = gt; i < (size_t)SEQ * 8; i += NT) { const int pos = (int)(i >> 3), k = (int)(i & 7);
          const double inv = k == 0 ? 1.0 : k == 1 ? 0.19392274474868576 : k == 2 ? 0.03760603093086393 : k == 3 ? 0.007292664737217109 : k == 4 ? 0.001414213562373095 : k == 5 ? 0.0002742481756762073 : k == 6 ? 5.318295896944988e-05 : 1.031338537721246e-05;
          float c, s; sincos_d((double)pos * inv, c, s); rt[i] = (f32x2){c, s}; } }
}

struct AttnP {
    const bf16* Q; const bf16* K; const bf16* V; bf16* O; const unsigned long long* mask;
    int ldq, ldk, ldv, ldo, qrow0, krow0, t_lo, t_hi, qpos0, mode, has_sink, o8; float sink2;
};
constexpr int AT_K0 = 0, AT_KSZ = 64 * 144, AT_V0 = 2 * AT_KSZ, AT_VSZ = 8192;
__device__ __forceinline__ s16x4 vtr(const LAS unsigned char* p) { return __builtin_bit_cast(s16x4, __builtin_amdgcn_ds_read_tr16_b64_v4i16((LAS v4i16_t*)p)); }
__device__ __forceinline__ void attn_unit(const Frame& F, const AttnP& P) {
    const int tid = F.tid, lane = F.lane, wid = F.wave, r32 = lane & 31, hi = lane >> 5;
    LAS unsigned char* lds = F.lds + RING_OFF;
    const int skey = tid >> 3, sc = tid & 7;
    const int kdst = skey * 144 + sc * 16;
    const int vdst = (sc >> 2) * 4096 + (skey >> 4) * 1024 + (skey & 15) * 64 + (sc & 3) * 16;
    const bf16* kg = P.K + (size_t)(P.krow0 + skey) * P.ldk + sc * 8;
    const bf16* vg = P.V + (size_t)(P.krow0 + skey) * P.ldv + sc * 8;
    const int qrow = P.qrow0 + wid * 32 + r32;
    bf16x8 qr[4];
#pragma unroll
    for (int d0 = 0; d0 < 4; ++d0) qr[d0] = *(const bf16x8*)(P.Q + (size_t)qrow * P.ldq + d0 * 16 + hi * 8);
    const int qmin = P.qpos0 + wid * 32, qmax = qmin + 31, qpos = qmin + r32;
    float m = P.has_sink ? P.sink2 : NEG_BIG;
    f32x16 o0 = {}, o1 = {}, lacc;
#pragma unroll
    for (int r = 0; r < 16; ++r) lacc[r] = P.has_sink ? 1.f : 0.f;
    const bf16x8 ones8 = (bf16x8){0x3f80, 0x3f80, 0x3f80, 0x3f80, 0x3f80, 0x3f80, 0x3f80, 0x3f80};
    const int vp0 = ((lane >> 4) & 1) * 32 + (lane & 3) * 8 + (4 * hi + ((lane & 15) >> 2)) * 64;
    u32x4 kreg = *(const u32x4*)(kg + (size_t)P.t_lo * 64 * P.ldk), vreg = *(const u32x4*)(vg + (size_t)P.t_lo * 64 * P.ldv);
    const unsigned long long* mrow = P.mode == 2 ? P.mask + (size_t)(wid * 32 + r32) * 64 : nullptr;
    unsigned long long mcur = 0ull, mnxt = P.mode == 2 ? mrow[P.t_lo] : 0ull;
    *(LAS u32x4*)(lds + AT_K0 + kdst) = kreg; *(LAS u32x4*)(lds + AT_V0 + vdst) = vreg;
    __syncthreads();
    for (int t = P.t_lo; t < P.t_hi; ++t) {
        const int cur = (t - P.t_lo) & 1;
        const bool more = (t + 1 < P.t_hi);
        mcur = mnxt;
        if (more) { kreg = *(const u32x4*)(kg + (size_t)(t + 1) * 64 * P.ldk); vreg = *(const u32x4*)(vg + (size_t)(t + 1) * 64 * P.ldv); if (P.mode == 2) mnxt = mrow[t + 1]; }
        bool active = true;
        if (P.mode == 1) active = (64 * t + 63 >= qmin - 127) && (64 * t <= qmax);
        if (P.mode == 2) active = (64 * t <= qmax);
        if (active) {
            const LAS unsigned char* Kb = lds + AT_K0 + cur * AT_KSZ; const LAS unsigned char* Vb = lds + AT_V0 + cur * AT_VSZ;
            f32x16 p0 = {}, p1 = {};
#pragma unroll
            for (int d0 = 0; d0 < 4; ++d0) {
                const bf16x8 a0 = *(const LAS bf16x8*)(Kb + r32 * 144 + (2 * d0 + hi) * 16);
                const bf16x8 a1 = *(const LAS bf16x8*)(Kb + (r32 + 32) * 144 + (2 * d0 + hi) * 16);
                p0 = __builtin_amdgcn_mfma_f32_32x32x16_bf16(a0, qr[d0], p0, 0, 0, 0);
                p1 = __builtin_amdgcn_mfma_f32_32x32x16_bf16(a1, qr[d0], p1, 0, 0, 0);
            }
            float mx = fmaxf(p0[0], p1[0]);
#pragma unroll
            for (int r = 1; r < 16; ++r) mx = fmaxf(fmaxf(mx, p0[r]), p1[r]);
            mx = swapmax(mx) * C2;
            const float mnew = fmaxf(m, mx), alpha = __builtin_amdgcn_exp2f(m - mnew);
            m = mnew;
#pragma unroll
            for (int r = 0; r < 16; r += 2) {
                f32x2 a_ = {p0[r], p0[r + 1]}, b_ = {p1[r], p1[r + 1]}; const f32x2 c2_ = {C2, C2}, nm_ = {-mnew, -mnew};
                a_ = __builtin_elementwise_fma(a_, c2_, nm_); b_ = __builtin_elementwise_fma(b_, c2_, nm_);
                p0[r] = __builtin_amdgcn_exp2f(a_[0]); p0[r + 1] = __builtin_amdgcn_exp2f(a_[1]); p1[r] = __builtin_amdgcn_exp2f(b_[0]); p1[r + 1] = __builtin_amdgcn_exp2f(b_[1]); }
            if (P.mode == 1) {
                const int rel = qpos - 64 * t - 4 * hi;
#pragma unroll
                for (int r = 0; r < 16; ++r) { const int c = (r & 3) + 8 * (r >> 2);
                    p0[r] = ((unsigned)(rel - c) < 128u) ? p0[r] : 0.f; p1[r] = ((unsigned)(rel - c - 32) < 128u) ? p1[r] : 0.f; }
            } else if (P.mode == 2) {
                const unsigned long long w = mcur >> (4 * hi);
                const int wl = (int)(unsigned)w, wh = (int)(unsigned)(w >> 32);
#pragma unroll
                for (int r = 0; r < 16; ++r) { const int c = (r & 3) + 8 * (r >> 2);
                    int d0_ = __builtin_amdgcn_sbfe(wl, c, 1), d1_ = __builtin_amdgcn_sbfe(wh, c, 1); asm("" : "+v"(d0_), "+v"(d1_));
                    p0[r] = __uint_as_float(__float_as_uint(p0[r]) & (unsigned)d0_); p1[r] = __uint_as_float(__float_as_uint(p1[r]) & (unsigned)d1_); }
            }
            if (__any(alpha != 1.0f)) {
#pragma unroll
                for (int r = 0; r < 16; ++r) { o0[r] *= alpha; o1[r] *= alpha; lacc[r] *= alpha; }
            }
            bf16x8 pf[4];
            { u32x4 w;
              w.x = pk2(p0[0], p0[1]); w.y = pk2(p0[2], p0[3]); w.z = pk2(p0[4], p0[5]); w.w = pk2(p0[6], p0[7]); pf[0] = __builtin_bit_cast(bf16x8, w);
              w.x = pk2(p0[8], p0[9]); w.y = pk2(p0[10], p0[11]); w.z = pk2(p0[12], p0[13]); w.w = pk2(p0[14], p0[15]); pf[1] = __builtin_bit_cast(bf16x8, w);
              w.x = pk2(p1[0], p1[1]); w.y = pk2(p1[2], p1[3]); w.z = pk2(p1[4], p1[5]); w.w = pk2(p1[6], p1[7]); pf[2] = __builtin_bit_cast(bf16x8, w);
              w.x = pk2(p1[8], p1[9]); w.y = pk2(p1[10], p1[11]); w.z = pk2(p1[12], p1[13]); w.w = pk2(p1[14], p1[15]); pf[3] = __builtin_bit_cast(bf16x8, w); }
#pragma unroll
            for (int ks = 0; ks < 4; ++ks) {
                const s16x4 a_lo = vtr(Vb + vp0 + ks * 1024), a_hi = vtr(Vb + vp0 + ks * 1024 + 512);
                const s16x4 b_lo = vtr(Vb + vp0 + 4096 + ks * 1024), b_hi = vtr(Vb + vp0 + 4096 + ks * 1024 + 512);
                const bf16x8 va = (bf16x8){a_lo[0], a_lo[1], a_lo[2], a_lo[3], a_hi[0], a_hi[1], a_hi[2], a_hi[3]};
                const bf16x8 vb = (bf16x8){b_lo[0], b_lo[1], b_lo[2], b_lo[3], b_hi[0], b_hi[1], b_hi[2], b_hi[3]};
                o0 = __builtin_amdgcn_mfma_f32_32x32x16_bf16(va, pf[ks], o0, 0, 0, 0);
                o1 = __builtin_amdgcn_mfma_f32_32x32x16_bf16(vb, pf[ks], o1, 0, 0, 0);
                lacc = __builtin_amdgcn_mfma_f32_32x32x16_bf16(ones8, pf[ks], lacc, 0, 0, 0);
            }
        }
        if (more) { *(LAS u32x4*)(lds + AT_K0 + (cur ^ 1) * AT_KSZ + kdst) = kreg; *(LAS u32x4*)(lds + AT_V0 + (cur ^ 1) * AT_VSZ + vdst) = vreg; }
        __syncthreads();
    }
    const float inv = 1.0f / lacc[0];
    if (P.o8) {
        unsigned char* orow8 = (unsigned char*)P.O + (size_t)qrow * P.ldo + 4 * hi;
#pragma unroll
        for (int g = 0; g < 4; ++g) {
            *(unsigned*)(orow8 + 8 * g) = pg8::pk4_fp8(o0[4 * g] * inv, o0[4 * g + 1] * inv, o0[4 * g + 2] * inv, o0[4 * g + 3] * inv);
            *(unsigned*)(orow8 + 32 + 8 * g) = pg8::pk4_fp8(o1[4 * g] * inv, o1[4 * g + 1] * inv, o1[4 * g + 2] * inv, o1[4 * g + 3] * inv);
        }
        return;
    }
    bf16* orow = P.O + (size_t)qrow * P.ldo + 4 * hi;
#pragma unroll
    for (int g = 0; g < 4; ++g) {
        u32x2 w0, w1;
        w0.x = pk2(o0[4 * g] * inv, o0[4 * g + 1] * inv); w0.y = pk2(o0[4 * g + 2] * inv, o0[4 * g + 3] * inv);
        w1.x = pk2(o1[4 * g] * inv, o1[4 * g + 1] * inv); w1.y = pk2(o1[4 * g + 2] * inv, o1[4 * g + 3] * inv);
        *(u32x2*)(orow + 8 * g) = w0; *(u32x2*)(orow + 32 + 8 * g) = w1;
    }
}

__device__ __forceinline__ void conv_item(const bf16* PROJ, const float* cw, bf16* CAT, int idx) {
    const int chunk = idx % 96, run = idx / 96, c0 = chunk * 8, t0 = run * 16;
    float w0[8], w1[8], w2[8];
#pragma unroll
    for (int j = 0; j < 8; ++j) { w0[j] = cw[c0 + j]; w1[j] = cw[768 + c0 + j]; w2[j] = cw[1536 + c0 + j]; }
    float z1[8], z2[8];
#pragma unroll
    for (int j = 0; j < 8; ++j) { z1[j] = 0.f; z2[j] = 0.f; }
    if ((t0 & (SEQ - 1)) != 0) {
#pragma unroll
        for (int back = 2; back >= 1; --back) {
            const bf16* row = PROJ + (size_t)(t0 - back) * 2560;
            const u32x4 uu = *(const u32x4*)(row + c0), cc = *(const u32x4*)(row + 1536 + c0);
            float z[8];
            z[0] = bflo(uu.x) * bflo(cc.x); z[1] = bfhi(uu.x) * bfhi(cc.x); z[2] = bflo(uu.y) * bflo(cc.y); z[3] = bfhi(uu.y) * bfhi(cc.y);
            z[4] = bflo(uu.z) * bflo(cc.z); z[5] = bfhi(uu.z) * bfhi(cc.z); z[6] = bflo(uu.w) * bflo(cc.w); z[7] = bfhi(uu.w) * bfhi(cc.w);
#pragma unroll
            for (int j = 0; j < 8; ++j) { if (back == 2) z2[j] = z[j]; else z1[j] = z[j]; }
        }
    }
    u32x4 in_[2][4][3];
#define CONV_LOADG(G, S) do { _Pragma("unroll") for (int k = 0; k < 4; ++k) { const bf16* row = PROJ + (size_t)(t0 + 4 * (G) + k) * 2560; \
        in_[S][k][0] = *(const u32x4*)(row + c0); in_[S][k][1] = *(const u32x4*)(row + 768 + c0); in_[S][k][2] = *(const u32x4*)(row + 1536 + c0); } } while (0)
    CONV_LOADG(0, 0);
#pragma unroll
    for (int g = 0; g < 4; ++g) {
        if (g < 3) CONV_LOADG(g + 1, (g + 1) & 1);
#pragma unroll
        for (int k = 0; k < 4; ++k) {
            const int i = 4 * g + k;
            const u32x4 uu = in_[g & 1][k][0], bb = in_[g & 1][k][1], cc = in_[g & 1][k][2];
            float z[8], b[8], r[8];
            z[0] = bflo(uu.x) * bflo(cc.x); z[1] = bfhi(uu.x) * bfhi(cc.x); z[2] = bflo(uu.y) * bflo(cc.y); z[3] = bfhi(uu.y) * bfhi(cc.y);
            z[4] = bflo(uu.z) * bflo(cc.z); z[5] = bfhi(uu.z) * bfhi(cc.z); z[6] = bflo(uu.w) * bflo(cc.w); z[7] = bfhi(uu.w) * bfhi(cc.w);
            b[0] = bflo(bb.x); b[1] = bfhi(bb.x); b[2] = bflo(bb.y); b[3] = bfhi(bb.y); b[4] = bflo(bb.z); b[5] = bfhi(bb.z); b[6] = bflo(bb.w); b[7] = bfhi(bb.w);
#pragma unroll
            for (int j = 0; j < 8; ++j) { r[j] = b[j] * ((w0[j] * z2[j] + w1[j] * z1[j]) + w2[j] * z[j]); z2[j] = z1[j]; z1[j] = z[j]; }
            u32x4 o; o.x = pk2(r[0], r[1]); o.y = pk2(r[2], r[3]); o.z = pk2(r[4], r[5]); o.w = pk2(r[6], r[7]);
            (void)o; u32x2 o8_; o8_.x = pg8::pk4_fp8(r[0], r[1], r[2], r[3]); o8_.y = pg8::pk4_fp8(r[4], r[5], r[6], r[7]); *(u32x2*)((unsigned char*)CAT + (size_t)(t0 + i) * 1024 + c0) = o8_;
        }
    }
#undef CONV_LOADG
}

__device__ __forceinline__ void mixer_phase(Frame& F, ArgsP A, unsigned char* ws, int layer, int kind, int qidx) {
    const bf16* PROJ = (const bf16*)(ws + WS_PROJ); bf16* CAT = (bf16*)(ws + WS_CAT); const bf16* KVM = (const bf16*)(ws + WS_KVMEM) + layer * 512;
    const int nproj = kind == 0 ? 2560 : (kind == 1 ? 1280 : 1536), qm_off = kind == 0 ? 2304 : (kind == 1 ? 768 : 1280);
    const int n_main = kind == 0 ? 0 : 768, n_mem = 256, n_conv = kind == 0 ? 192 : 0;
    constexpr int CVT_PER = 12, N_CVT = (DEPTH - MK_CVT_LAYERS_P0) * MOE_ITEMS_LAYER / CVT_PER;
    const int n_cvt = (kind == 1) ? N_CVT : 0;
    const int total = n_main + n_mem + n_conv + n_cvt;
    volatile LAS unsigned* qw = (volatile LAS unsigned*)(F.lds + L_Q);
    for (;;) {
        if (F.tid == 0) *qw = __hip_atomic_fetch_add(F.ctl + CW_QHEAD + 64 * qidx, 1u, RLX_AGENT);
        __syncthreads();
        int u = (int)*qw;
        __syncthreads();
        if (u >= total) break;
        if (n_cvt) {
            if (u < 3 * n_cvt) { if (u % 3 == 2) { const int c = u / 3; tr_run(F, A, ws, MK_CVT_LAYERS_P0 * MOE_ITEMS_LAYER + c * CVT_PER, 1, MK_CVT_LAYERS_P0 * MOE_ITEMS_LAYER + c * CVT_PER + CVT_PER, MOE_ITEMS, 0); continue; } u = (u / 3) * 2 + u % 3; }
            else u -= n_cvt;
        }
        if (u < n_main) {
            AttnP P;
            if (kind == 1) {
                const int qt = 15 - u / 48, rem = u % 48, b = rem / 12, h = rem % 12, g = h / 3;
                P.Q = (const bf16*)(ws + WS_QQ) + h * 64; P.ldq = 1280; P.K = PROJ + 256 + g * 64; P.ldk = 1280; P.V = PROJ + 512 + g * 64; P.ldv = 1280;
                P.O = (bf16*)((unsigned char*)CAT + h * 64); P.ldo = 1024; P.o8 = 1; P.qrow0 = b * SEQ + qt * 256; P.krow0 = b * SEQ; P.t_lo = 0; P.t_hi = qt * 4 + 4; P.qpos0 = qt * 256; P.mode = 2;
                P.mask = (const unsigned long long*)(ws + WS_MASK) + (size_t)P.qrow0 * 64; P.has_sink = 0; P.sink2 = 0.f;
            } else {
                const int b = u / 192, h = (u / 16) % 12, qt = u % 16, g = h / 3;
                P.Q = PROJ + h * 64; P.ldq = 1536; P.K = PROJ + 768 + g * 64; P.ldk = 1536; P.V = PROJ + 1024 + g * 64; P.ldv = 1536;
                P.O = (bf16*)((unsigned char*)CAT + h * 64); P.ldo = 1024; P.o8 = 1; P.qrow0 = b * SEQ + qt * 256; P.krow0 = b * SEQ; P.qpos0 = qt * 256;
                P.t_lo = qt == 0 ? 0 : (qt * 256 - 128) / 64; P.t_hi = qt * 4 + 4; P.mode = 1; P.mask = nullptr; P.has_sink = 1; P.sink2 = A->in[9][h] * LOG2E;
            }
            attn_unit(F, P);
        } else if (u < n_main + n_mem) {
            const int v = u - n_main, b = v / 64, h = (v / 16) % 4, qt = v % 16;
            AttnP P;
            P.Q = PROJ + qm_off + h * 64; P.ldq = nproj; P.K = KVM + h * 64; P.ldk = 2048; P.V = KVM + 256 + h * 64; P.ldv = 2048;
            P.o8 = 1; P.O = P.o8 ? (bf16*)((unsigned char*)CAT + 768 + h * 64) : CAT + 768 + h * 64; P.ldo = 1024; P.qrow0 = b * SEQ + qt * 256; P.krow0 = b * MEML; P.t_lo = 0; P.t_hi = 4; P.qpos0 = qt * 256; P.mode = 0; P.mask = nullptr; P.has_sink = 0; P.sink2 = 0.f;
            attn_unit(F, P);
        } else {
            const int v = u - n_main - n_mem;
            conv_item(PROJ, A->in[3] + (size_t)(layer == 0 ? 0 : 1) * 3 * 768, CAT, v * NTHREADS + F.tid);
        }
    }
}

__device__ __forceinline__ void score_phase(Frame& F, const bf16* QQ, const bf16* PROJ, float* SC) {
    const int lane = F.lane, r32 = lane & 31, hi = lane >> 5;
    LAS float* wtab = (LAS float*)(F.lds + RING_OFF + F.wave * 1024);
    constexpr float WSCALE = 0.04419417382415922f;
    constexpr int PER_B = 576;
    const __amdgpu_buffer_rsrc_t scrs = __builtin_amdgcn_make_buffer_rsrc((void*)SC, 0, T * SEQ * 4, 0x00020000);
    for (int wu = F.bid * NWAVES + F.wave; wu < NB * PER_B; wu += F.G * NWAVES) {
        const int b = wu / PER_B, idx = PER_B - 1 - wu % PER_B;
        int g = 0;
        for (int k = 1; k < 8; ++k) g += (8 * k * (k + 1) <= idx) ? 1 : 0;
        const int r = idx - 8 * g * (g + 1), qb = 16 * g + r / (g + 1), c = r % (g + 1);
        const int kb_lo = 16 * c, kb_hi = (16 * c + 16 < qb + 1) ? 16 * c + 16 : qb + 1;
        const int t0 = b * SEQ + 32 * qb;
#pragma unroll
        for (int k = 0; k < 4; ++k) { const int i4 = lane * 4 + k, h = i4 >> 5, hh = (i4 >> 4) & 1, reg = i4 & 15;
            wtab[i4] = bf2f(PROJ[(size_t)(t0 + crow(reg, hh)) * 1280 + 1088 + h]) * WSCALE; }
        bf16x8 qA[8][4];
#pragma unroll
        for (int h = 0; h < 8; ++h)
#pragma unroll
            for (int st = 0; st < 4; ++st) qA[h][st] = *(const bf16x8*)(QQ + (size_t)(t0 + r32) * 1280 + 768 + h * 64 + st * 16 + hi * 8);
        const bf16* kbase = PROJ + (size_t)(b * SEQ + r32) * 1280 + 1024 + hi * 8;
        bf16x8 kA[4], kBf[4];
#pragma unroll
        for (int st = 0; st < 4; ++st) kA[st] = *(const bf16x8*)(kbase + (size_t)(32 * kb_lo) * 1280 + st * 16);
#define PS_BLOCK(KF, KB) do { f32x16 acc = {}; \
            _Pragma("unroll") for (int h = 0; h < 8; ++h) { f32x16 dd = {}; \
                _Pragma("unroll") for (int st = 0; st < 4; ++st) dd = __builtin_amdgcn_mfma_f32_32x32x16_bf16(qA[h][st], KF[st], dd, 0, 0, 0); \
                const LAS f32x4* wp = (const LAS f32x4*)(wtab + (h * 2 + hi) * 16); const f32x4 w0 = wp[0], w1 = wp[1], w2 = wp[2], w3 = wp[3]; \
                _Pragma("unroll") for (int q = 0; q < 4; ++q) { acc[q] = fmaf(w0[q], fmaxf(dd[q], 0.f), acc[q]); acc[4 + q] = fmaf(w1[q], fmaxf(dd[4 + q], 0.f), acc[4 + q]); \
                    acc[8 + q] = fmaf(w2[q], fmaxf(dd[8 + q], 0.f), acc[8 + q]); acc[12 + q] = fmaf(w3[q], fmaxf(dd[12 + q], 0.f), acc[12 + q]); } \
                if (h & 1) __builtin_amdgcn_sched_barrier(0); } \
            _Pragma("unroll") for (int reg = 0; reg < 16; ++reg) __builtin_amdgcn_raw_buffer_store_b32(__float_as_uint(acc[reg]), scrs, (4 * hi * SEQ + r32) * 4, ((t0 + (reg & 3) + 8 * (reg >> 2)) * SEQ + 32 * (KB)) * 4, 0); } while (0)
        for (int kb = kb_lo; kb < kb_hi; kb += 2) {
            __builtin_amdgcn_sched_barrier(0);
            if (kb + 1 < kb_hi) {
#pragma unroll
                for (int st = 0; st < 4; ++st) kBf[st] = *(const bf16x8*)(kbase + (size_t)(32 * (kb + 1)) * 1280 + st * 16);
            }
            __builtin_amdgcn_sched_barrier(0);
            PS_BLOCK(kA, kb);
            __builtin_amdgcn_sched_barrier(0);
            if (kb + 1 < kb_hi) {
                if (kb + 2 < kb_hi) {
#pragma unroll
                    for (int st = 0; st < 4; ++st) kA[st] = *(const bf16x8*)(kbase + (size_t)(32 * (kb + 2)) * 1280 + st * 16);
                }
                __builtin_amdgcn_sched_barrier(0);
                PS_BLOCK(kBf, kb + 1);
            }
        }
#undef PS_BLOCK
    }
}
__device__ __forceinline__ void select_phase(Frame& F, const float* SC, unsigned long long* MASK) {
    const int qstride = F.G * NWAVES;
    unsigned raw[64];
#define SEL_LOAD(qq) do { const int pos_ = (qq) & (SEQ - 1); if ((qq) < T && pos_ >= 256) { int ln_ = lane_id_now(); const int ni_ = (pos_ >> 6) + 1; const float* row_ = SC + (size_t)(qq) * SEQ; \
        _Pragma("unroll") for (int gq = 0; gq < 4; ++gq) if (ni_ > 16 * gq) { _Pragma("unroll") for (int i = 16 * gq; i < 16 * gq + 16; ++i) { const int s_ = 64 * i + ln_; raw[i] = __float_as_uint(__builtin_nontemporal_load(row_ + (s_ <= pos_ ? s_ : pos_))); } } } } while (0)
    int q0_ = F.bid * NWAVES + F.wave;
    SEL_LOAD(q0_);
    for (int q = q0_; q < T; q += qstride) {
        int lane = F.lane; asm volatile("" : "+v"(lane));
        const int pos = q & (SEQ - 1);
        unsigned long long myword = 0ull;
        if (pos < 256) {
            const int lo = 64 * lane;
            myword = (lo > pos) ? 0ull : ((pos - lo >= 63) ? ~0ull : ((1ull << (pos - lo + 1)) - 1ull));
            SEL_LOAD(q + qstride);
        } else {
            const int ni = (pos >> 6) + 1;
            unsigned key[64];
#pragma unroll
            for (int i = 0; i < 64; ++i) key[i] = 0u;
#pragma unroll
            for (int gq = 0; gq < 4; ++gq) if (ni > 16 * gq) {
#pragma unroll
                for (int i = 16 * gq; i < 16 * gq + 16; ++i) { const int s = 64 * i + lane; unsigned bts = raw[i]; if (bts == 0x80000000u) bts = 0u;
                    const unsigned kk = (bts & 0x80000000u) ? ~bts : (bts | 0x80000000u); key[i] = (s <= pos) ? kk : 0u; } }
            SEL_LOAD(q + qstride);
            auto count_ge = [&](const unsigned Tp) -> int {
                int cA = 0, cB = 0, cC = 0, cD = 0;
#pragma unroll
                for (int gq = 0; gq < 4; ++gq) if (ni > 16 * gq) {
                    unsigned long long m0_, m1_, m2_, m3_;
                    asm("v_cmp_le_u32_e64 %4, %8, %9\n\tv_cmp_le_u32_e64 %5, %8, %10\n\tv_cmp_le_u32_e64 %6, %8, %11\n\tv_cmp_le_u32_e64 %7, %8, %12\n\tv_addc_co_u32_e64 %0, %4, 0, %0, %4\n\tv_addc_co_u32_e64 %1, %5, 0, %1, %5\n\tv_addc_co_u32_e64 %2, %6, 0, %2, %6\n\tv_addc_co_u32_e64 %3, %7, 0, %3, %7\n\tv_cmp_le_u32_e64 %4, %8, %13\n\tv_cmp_le_u32_e64 %5, %8, %14\n\tv_cmp_le_u32_e64 %6, %8, %15\n\tv_cmp_le_u32_e64 %7, %8, %16\n\tv_addc_co_u32_e64 %0, %4, 0, %0, %4\n\tv_addc_co_u32_e64 %1, %5, 0, %1, %5\n\tv_addc_co_u32_e64 %2, %6, 0, %2, %6\n\tv_addc_co_u32_e64 %3, %7, 0, %3, %7\n\tv_cmp_le_u32_e64 %4, %8, %17\n\tv_cmp_le_u32_e64 %5, %8, %18\n\tv_cmp_le_u32_e64 %6, %8, %19\n\tv_cmp_le_u32_e64 %7, %8, %20\n\tv_addc_co_u32_e64 %0, %4, 0, %0, %4\n\tv_addc_co_u32_e64 %1, %5, 0, %1, %5\n\tv_addc_co_u32_e64 %2, %6, 0, %2, %6\n\tv_addc_co_u32_e64 %3, %7, 0, %3, %7\n\tv_cmp_le_u32_e64 %4, %8, %21\n\tv_cmp_le_u32_e64 %5, %8, %22\n\tv_cmp_le_u32_e64 %6, %8, %23\n\tv_cmp_le_u32_e64 %7, %8, %24\n\tv_addc_co_u32_e64 %0, %4, 0, %0, %4\n\tv_addc_co_u32_e64 %1, %5, 0, %1, %5\n\tv_addc_co_u32_e64 %2, %6, 0, %2, %6\n\tv_addc_co_u32_e64 %3, %7, 0, %3, %7"
                        : "+v"(cA), "+v"(cB), "+v"(cC), "+v"(cD), "=&s"(m0_), "=&s"(m1_), "=&s"(m2_), "=&s"(m3_) : "s"(Tp), "v"(key[16 * gq + 0]), "v"(key[16 * gq + 1]), "v"(key[16 * gq + 2]), "v"(key[16 * gq + 3]), "v"(key[16 * gq + 4]), "v"(key[16 * gq + 5]), "v"(key[16 * gq + 6]), "v"(key[16 * gq + 7]), "v"(key[16 * gq + 8]), "v"(key[16 * gq + 9]), "v"(key[16 * gq + 10]), "v"(key[16 * gq + 11]), "v"(key[16 * gq + 12]), "v"(key[16 * gq + 13]), "v"(key[16 * gq + 14]), "v"(key[16 * gq + 15])); }
                const int cl = (cA + cB) + (cC + cD);
                int c = 0;
#pragma unroll
                for (int bb = 0; bb < 7; ++bb) c += __popcll(__ballot((cl >> bb) & 1)) << bb;
                return c; };
            unsigned kmx = 0u;
#pragma unroll
            for (int i = 0; i < 64; ++i) kmx = key[i] > kmx ? key[i] : kmx;
#pragma unroll
            for (int o = 1; o < 64; o <<= 1) { const unsigned ov = (unsigned)shxi((int)kmx, o); kmx = ov > kmx ? ov : kmx; }
            kmx = (unsigned)__builtin_amdgcn_readfirstlane((int)kmx);
            unsigned lo = 0u, hi = kmx + 1u; int clo = pos + 1, chi = 0;
            if (kmx > 0x82000000u) { const unsigned l2 = (kmx & 0xff800000u) - 0x02000000u; const int c2 = count_ge(l2); if (c2 >= 256) { lo = l2; clo = c2; } else { hi = l2; chi = c2; } }
            float flo = (float)clo - 255.5f, fhi = (float)chi - 255.5f; int side = 0;
            for (int it = 0; it < 96; ++it) {
                if (clo == 256 || hi - lo <= 1u) break;
                const unsigned span = hi - lo;
                unsigned mid;
                if (it % 3 == 2) mid = lo + (span >> 1);
                else { const float tt = flo / (flo - fhi); unsigned d = (unsigned)((float)span * tt); d = d < 1u ? 1u : (d > span - 1u ? span - 1u : d); mid = lo + d; }
                mid = (unsigned)__builtin_amdgcn_readfirstlane((int)mid);
                const int c = count_ge(mid);
                if (c >= 256) { lo = mid; clo = c; flo = (float)c - 255.5f; if (side == 1) fhi *= 0.5f; side = 1; }
                else { hi = mid; chi = c; fhi = (float)c - 255.5f; if (side == -1) flo *= 0.5f; side = -1; }
            }
            const unsigned Tk = lo; const int cT = clo;
            int need = 256, base = 0;
            if (cT != 256) {
                int cl = 0;
#pragma unroll
                for (int i = 0; i < 64; ++i) cl += (key[i] > Tk) ? 1 : 0;
                int cgt = 0;
#pragma unroll
                for (int bb = 0; bb < 7; ++bb) cgt += __popcll(__ballot((cl >> bb) & 1)) << bb;
                need = 256 - cgt;
            }
            int wlo = 0, whi = 0;
            if (cT == 256) {
#pragma unroll
                for (int i = 0; i < 64; ++i) { const unsigned long long wsel = __ballot(key[i] >= Tk);
                    asm("s_nop 4\n\tv_writelane_b32 %0, %2, %4\n\tv_writelane_b32 %1, %3, %4" : "+v"(wlo), "+v"(whi) : "s"((int)(unsigned)wsel), "s"((int)(unsigned)(wsel >> 32)), "n"(i)); }
            } else {
                const unsigned long long ltmask = (1ull << lane) - 1ull;
#pragma unroll
                for (int i = 0; i < 64; ++i) {
                    const unsigned long long eq = __ballot(key[i] == Tk); const int rank = base + __popcll(eq & ltmask);
                    const bool sel = (key[i] > Tk) || (key[i] == Tk && rank < need); base += __popcll(eq);
                    const unsigned long long wsel = __ballot(sel);
                    asm("s_nop 4\n\tv_writelane_b32 %0, %2, %4\n\tv_writelane_b32 %1, %3, %4" : "+v"(wlo), "+v"(whi) : "s"((int)(unsigned)wsel), "s"((int)(unsigned)(wsel >> 32)), "n"(i));
                }
            }
            myword = ((unsigned long long)(unsigned)whi << 32) | (unsigned long long)(unsigned)wlo;
        }
        MASK[(size_t)q * 64 + lane] = myword;
    }
}

#undef SEL_LOAD
__device__ __forceinline__ void ln1_phase(Frame& F, const bf16* xres, const bf16* Y, const float* g1, const float* b1, bf16* XMB, const float* rw, const float* rb,
                                          bf16* XP, gu32* gcount, int* ROWS, float* GATES, const int pmode = 3) {
    const int lane = F.lane, wid = F.wave, tid = F.tid;
    float ALPHA_ = ALPHA; asm volatile("" : "+v"(ALPHA_));
    LAS float* x32 = (LAS float*)(F.lds + RING_OFF);
    volatile LAS unsigned* cnt = (volatile LAS unsigned*)(F.lds + L_CNT); volatile LAS unsigned* base = (volatile LAS unsigned*)(F.lds + L_BASE);
    LAS int* route = (LAS int*)(F.lds + L_ROUTE);
    const int e = lane & 31, half = lane >> 5;
    const float rbe = rb[e];
    const __amdgpu_buffer_rsrc_t xrs_ = __builtin_amdgcn_make_buffer_rsrc((void*)xres, 0, T * D * 2, 0x00020000), yrs_ = __builtin_amdgcn_make_buffer_rsrc((void*)Y, 0, T * D * 2, 0x00020000);
    for (int chunk = F.bid; chunk < T / 64; chunk += F.G) {
        if (tid < 32) cnt[tid] = 0u;
        __syncthreads();
        u32x2 rxn[4][4], ryn[4][4];
#define LN1_LOAD(B) do { _Pragma("unroll") for (int rr = 0; rr < 4; ++rr) { const int ro_ = (chunk * 64 + wid * 8 + (B) * 4 + rr) * (D * 2);       \
            _Pragma("unroll") for (int j = 0; j < 4; ++j) { rxn[rr][j] = __builtin_bit_cast(u32x2, __builtin_amdgcn_raw_buffer_load_b64(xrs_, lane * 8, ro_ + 512 * j, 2)); ryn[rr][j] = __builtin_bit_cast(u32x2, __builtin_amdgcn_raw_buffer_load_b64(yrs_, lane * 8, ro_ + 512 * j, 2)); } } } while (0)
        LN1_LOAD(0);
#pragma unroll 1
        for (int batch = 0; batch < 2; ++batch) {
            const int lrow0 = wid * 8 + batch * 4, row0 = chunk * 64 + lrow0;
            u32x2 rx[4][4], ry[4][4];
#pragma unroll
            for (int rr = 0; rr < 4; ++rr)
#pragma unroll
                for (int j = 0; j < 4; ++j) { rx[rr][j] = rxn[rr][j]; ry[rr][j] = ryn[rr][j]; }
            if (batch == 0) LN1_LOAD(1);
            float xv[4][16], mean_[4], rstd_[4];
#pragma unroll
            for (int rr = 0; rr < 4; ++rr) { float s = 0.f;
#pragma unroll
                for (int j = 0; j < 4; ++j) { const u32x2 xx = rx[rr][j], yy = ry[rr][j];
                    xv[rr][4 * j] = ALPHA_ * bflo(xx.x) + bflo(yy.x); xv[rr][4 * j + 1] = ALPHA_ * bfhi(xx.x) + bfhi(yy.x); xv[rr][4 * j + 2] = ALPHA_ * bflo(xx.y) + bflo(yy.y); xv[rr][4 * j + 3] = ALPHA_ * bfhi(xx.y) + bfhi(yy.y);
                    s += (xv[rr][4 * j] + xv[rr][4 * j + 1]) + (xv[rr][4 * j + 2] + xv[rr][4 * j + 3]); }
                mean_[rr] = s; }
#pragma unroll
            for (int rr = 0; rr < 4; ++rr) mean_[rr] = wave_sum(mean_[rr]);
#pragma unroll
            for (int rr = 0; rr < 4; ++rr) { mean_[rr] *= (1.f / D); float s2 = 0.f;
#pragma unroll
                for (int k = 0; k < 16; ++k) { xv[rr][k] -= mean_[rr]; s2 += xv[rr][k] * xv[rr][k]; }
                rstd_[rr] = s2; }
            __builtin_amdgcn_sched_barrier(0);
            f32x4 gg_[4], bb_[4];
#pragma unroll
            for (int j = 0; j < 4; ++j) { gg_[j] = __builtin_bit_cast(f32x4, __builtin_amdgcn_raw_buffer_load_b128(__builtin_amdgcn_make_buffer_rsrc((void*)g1, 0, D * 4, 0x00020000), lane * 16, j * 1024, 0)); bb_[j] = __builtin_bit_cast(f32x4, __builtin_amdgcn_raw_buffer_load_b128(__builtin_amdgcn_make_buffer_rsrc((void*)b1, 0, D * 4, 0x00020000), lane * 16, j * 1024, 0)); }
            __builtin_amdgcn_sched_barrier(0);
#pragma unroll
            for (int rr = 0; rr < 4; ++rr) rstd_[rr] = wave_sum(rstd_[rr]);
#pragma unroll
            for (int rr = 0; rr < 4; ++rr) { const float rstd = 1.0f / sqrtf(rstd_[rr] * (1.f / D) + LN_EPS);
#pragma unroll
                for (int j = 0; j < 4; ++j) { const f32x4 gg = gg_[j], bb = bb_[j];
                    f32x4 o;
#pragma unroll
                    for (int k = 0; k < 4; ++k) o[k] = xv[rr][4 * j + k] * rstd * gg[k] + bb[k];
                    u32x2 pb; pb.x = pk2(o[0], o[1]); pb.y = pk2(o[2], o[3]);
                    *(u32x2*)(XMB + (size_t)(row0 + rr) * D + 4 * lane + 256 * j) = pb;
                    *(LAS f32x4*)(x32 + (wid * 4 + rr) * 1028 + 4 * lane + 256 * j) = o; } }
            float a0 = 0.f, a1 = 0.f, a2 = 0.f, a3 = 0.f;
            float wA[32], wB[32];
            const __amdgpu_buffer_rsrc_t wrs = __builtin_amdgcn_make_buffer_rsrc((void*)rw, 0, D * NEXP * 4, 0x00020000);
            const int wvo = ((wid * 128 + half * 4) * 32 + e) * 4;
            __builtin_amdgcn_sched_barrier(0);
            if (pmode & 1) {
#pragma unroll
                for (int i = 0; i < 8; ++i)
#pragma unroll
                    for (int t = 0; t < 4; ++t) wA[4 * i + t] = __uint_as_float(__builtin_amdgcn_raw_buffer_load_b32(wrs, wvo, (8 * i + t) * 128, 0));
            }
            __builtin_amdgcn_sched_barrier(0);
            __syncthreads();
            if (pmode & 1) {
                f32x16 pacc, pacc1;
#pragma unroll
                for (int r = 0; r < 16; ++r) { pacc[r] = 0.f; pacc1[r] = 0.f; }
                const LAS float* xa = x32 + (lane & 31) * 1028 + wid * 128 + half * 4;
                f32x4 xq[16];
#pragma unroll
                for (int i = 0; i < 8; ++i) xq[i] = *(const LAS f32x4*)(xa + 8 * i);
#pragma unroll
                for (int i = 0; i < 8; ++i)
#pragma unroll
                    for (int t = 0; t < 4; ++t) wB[4 * i + t] = __uint_as_float(__builtin_amdgcn_raw_buffer_load_b32(wrs, wvo, (64 + 8 * i + t) * 128, 0));
#pragma unroll
                for (int i = 0; i < 8; ++i) {
                    pacc = __builtin_amdgcn_mfma_f32_32x32x2f32(xq[i][0], wA[4 * i + 0], pacc, 0, 0, 0); pacc1 = __builtin_amdgcn_mfma_f32_32x32x2f32(xq[i][1], wA[4 * i + 1], pacc1, 0, 0, 0);
                    pacc = __builtin_amdgcn_mfma_f32_32x32x2f32(xq[i][2], wA[4 * i + 2], pacc, 0, 0, 0); pacc1 = __builtin_amdgcn_mfma_f32_32x32x2f32(xq[i][3], wA[4 * i + 3], pacc1, 0, 0, 0); }
                __builtin_amdgcn_sched_barrier(0);
#pragma unroll
                for (int i = 8; i < 16; ++i) xq[i] = *(const LAS f32x4*)(xa + 8 * i);
#pragma unroll
                for (int i = 0; i < 8; ++i) {
                    pacc = __builtin_amdgcn_mfma_f32_32x32x2f32(xq[8 + i][0], wB[4 * i + 0], pacc, 0, 0, 0); pacc1 = __builtin_amdgcn_mfma_f32_32x32x2f32(xq[8 + i][1], wB[4 * i + 1], pacc1, 0, 0, 0);
                    pacc = __builtin_amdgcn_mfma_f32_32x32x2f32(xq[8 + i][2], wB[4 * i + 2], pacc, 0, 0, 0); pacc1 = __builtin_amdgcn_mfma_f32_32x32x2f32(xq[8 + i][3], wB[4 * i + 3], pacc1, 0, 0, 0); }
#pragma unroll
                for (int r = 0; r < 16; ++r) pacc[r] += pacc1[r];
                __syncthreads();
                LAS float* pw = x32 + wid * 1024 + e;
#pragma unroll
                for (int r = 0; r < 16; ++r) pw[crow(r, half) * 32] = pacc[r];
                __syncthreads();
                const LAS float* pr = x32 + (half * 4) * 1024 + (wid * 4) * 32 + e;
#pragma unroll
                for (int q = 0; q < 4; ++q) { a0 += pr[q * 1024]; a1 += pr[q * 1024 + 32]; a2 += pr[q * 1024 + 64]; a3 += pr[q * 1024 + 96]; }
            } else { __syncthreads(); __syncthreads(); }
            __syncthreads();
            float lg[4]; lg[0] = a0 + shx(a0, 32) + rbe; lg[1] = a1 + shx(a1, 32) + rbe; lg[2] = a2 + shx(a2, 32) + rbe; lg[3] = a3 + shx(a3, 32) + rbe;
            float selv[4][4]; int seli[4][4];
#pragma unroll
            for (int rr = 0; rr < 4; ++rr) {
                float v = lg[rr];
#pragma unroll
                for (int k = 0; k < 4; ++k) {
                    float bv = v; int bi = e;
#pragma unroll
                    for (int msk = 1; msk < 32; msk <<= 1) { const float ov = shx(bv, msk); const int oi = shxi(bi, msk); if (ov > bv || (ov == bv && oi < bi)) { bv = ov; bi = oi; } }
                    selv[rr][k] = bv; seli[rr][k] = bi;
                    if (bi == e) v = -INFINITY;
                }
            }
            if (lane < 16) {
                const int rr = lane >> 2, k = lane & 3;
                float sv[4]; int si[4];
#pragma unroll
                for (int q = 0; q < 4; ++q) { sv[q] = rr == 0 ? selv[0][q] : rr == 1 ? selv[1][q] : rr == 2 ? selv[2][q] : selv[3][q]; si[q] = rr == 0 ? seli[0][q] : rr == 1 ? seli[1][q] : rr == 2 ? seli[2][q] : seli[3][q]; }
                const float ex1 = __expf(sv[1] - sv[0]), ex2 = __expf(sv[2] - sv[0]), ex3 = __expf(sv[3] - sv[0]);
                const float isum = 1.0f / (1.0f + ex1 + ex2 + ex3);
                const int me = k == 0 ? si[0] : k == 1 ? si[1] : k == 2 ? si[2] : si[3];
                const float mg = (k == 0 ? 1.0f : k == 1 ? ex1 : k == 2 ? ex2 : ex3) * isum;
                const int mr = (int)__hip_atomic_fetch_add((LAS unsigned*)(F.lds + L_CNT) + me, 1u, __ATOMIC_RELAXED, __HIP_MEMORY_SCOPE_WORKGROUP);
                LAS int* rt = route + ((lrow0 + rr) * 4 + k) * 3;
                rt[0] = me; rt[1] = mr; rt[2] = __float_as_int(mg);
            }
        }
        __syncthreads();
        if (wid == 0) { const int l_ = lane_id_now(); if (l_ < 32) base[l_] = __hip_atomic_fetch_add(gcount + l_, cnt[l_], RLX_AGENT); }
        __syncthreads();
#pragma unroll 1
        for (int batch = 0; batch < 2; ++batch) {
            const int lrow0 = wid * 8 + batch * 4, row0 = chunk * 64 + lrow0;
            u32x4 sa[4], sb[4];
#pragma unroll
            for (int rr = 0; rr < 4; ++rr) { const bf16* src = XMB + (size_t)(row0 + rr) * D; sa[rr] = *(const u32x4*)(src + lane * 16); sb[rr] = *(const u32x4*)(src + lane * 16 + 8); }
            int vrow = 0;
            if (lane < 16) { const int rr = lane >> 2, k = lane & 3; const LAS int* rt = route + ((lrow0 + rr) * 4 + k) * 3; const int me = rt[0];
                vrow = me * CAPROWS + (int)base[me] + rt[1]; ROWS[(size_t)(row0 + rr) * 4 + k] = vrow; GATES[(size_t)(row0 + rr) * 4 + k] = __int_as_float(rt[2]); }
            if (pmode & 2) {
#pragma unroll
                for (int rr = 0; rr < 4; ++rr) {
                    const u32x4 a = sa[rr], b = sb[rr];
                    u32x4 o; o.x = pg8::pk4_fp8(bflo(a.x), bfhi(a.x), bflo(a.y), bfhi(a.y)); o.y = pg8::pk4_fp8(bflo(a.z), bfhi(a.z), bflo(a.w), bfhi(a.w));
                    o.z = pg8::pk4_fp8(bflo(b.x), bfhi(b.x), bflo(b.y), bfhi(b.y)); o.w = pg8::pk4_fp8(bflo(b.z), bfhi(b.z), bflo(b.w), bfhi(b.w));
#pragma unroll
                    for (int k = 0; k < 4; ++k) { const int vr = shli(vrow, rr * 4 + k); unsigned char* dst = (unsigned char*)XP + (size_t)vr * D;
                        __builtin_nontemporal_store(o, (u32x4*)(dst + lane * 16)); }
                }
            }
        }
        __syncthreads();
    }
}
#undef LN1_LOAD
__device__ __forceinline__ void ln2_phase(Frame& F, const bf16* XMB, const bf16* YP, const int* ROWS, const float* GATES, const float* g2, const float* b2, float* out, bf16* XB, unsigned char* XB8) {
    const int lane = F.lane;
    float ALPHA_ = ALPHA; asm volatile("" : "+v"(ALPHA_));
    const int rstride = F.G * NWAVES, row_first = F.bid * NWAVES + F.wave;
    const unsigned char* yp8 = (const unsigned char*)YP;
    int ix0 = 0, ix1 = 0, ix2 = 0, ix3 = 0; f32x4 gtn = {0.f, 0.f, 0.f, 0.f};
    u32x2 xbn[4]; int qn[4][4]; f32x4 gtc = {0.f, 0.f, 0.f, 0.f};
#define LN2_IDX(R) do { if ((R) < T) { ix0 = ROWS[(size_t)(R) * 4]; ix1 = ROWS[(size_t)(R) * 4 + 1]; ix2 = ROWS[(size_t)(R) * 4 + 2]; ix3 = ROWS[(size_t)(R) * 4 + 3]; gtn = *(const f32x4*)(GATES + (size_t)(R) * 4); } } while (0)
#define LN2_DATA(R) do { if ((R) < T) { gtc = gtn; _Pragma("unroll") for (int j = 0; j < 4; ++j) { const int c = 4 * lane + 256 * j; xbn[j] = *(const u32x2*)(XMB + (size_t)(R) * D + c); \
        qn[j][0] = *(const int*)(yp8 + (size_t)ix0 * D + c); qn[j][1] = *(const int*)(yp8 + (size_t)ix1 * D + c); qn[j][2] = *(const int*)(yp8 + (size_t)ix2 * D + c); qn[j][3] = *(const int*)(yp8 + (size_t)ix3 * D + c); } } } while (0)
    f32x4 gg_[4], bb_[4];
#pragma unroll
    for (int j = 0; j < 4; ++j) { gg_[j] = *(const f32x4*)(g2 + 4 * lane + 256 * j); bb_[j] = *(const f32x4*)(b2 + 4 * lane + 256 * j); }
    LN2_IDX(row_first);
    LN2_DATA(row_first);
    LN2_IDX(row_first + rstride);
    for (int row = row_first; row < T; row += rstride) {
        u32x2 xbc[4]; int qc[4][4]; const f32x4 gt = gtc;
#pragma unroll
        for (int j = 0; j < 4; ++j) { xbc[j] = xbn[j]; qc[j][0] = qn[j][0]; qc[j][1] = qn[j][1]; qc[j][2] = qn[j][2]; qc[j][3] = qn[j][3]; }
        LN2_DATA(row + rstride);
        LN2_IDX(row + 2 * rstride);
        float v[16]; float s = 0.f;
#pragma unroll
        for (int j = 0; j < 4; ++j) {
            const u32x2 xb_ = xbc[j]; const f32x4 xx = {bflo(xb_.x), bfhi(xb_.x), bflo(xb_.y), bfhi(xb_.y)};
            const int q0 = qc[j][0], q1 = qc[j][1], q2 = qc[j][2], q3 = qc[j][3];
            const f32x2 a0 = __builtin_amdgcn_cvt_pk_f32_fp8(q0, false), b0 = __builtin_amdgcn_cvt_pk_f32_fp8(q0, true), a1 = __builtin_amdgcn_cvt_pk_f32_fp8(q1, false), b1 = __builtin_amdgcn_cvt_pk_f32_fp8(q1, true);
            const f32x2 a2 = __builtin_amdgcn_cvt_pk_f32_fp8(q2, false), b2_ = __builtin_amdgcn_cvt_pk_f32_fp8(q2, true), a3 = __builtin_amdgcn_cvt_pk_f32_fp8(q3, false), b3 = __builtin_amdgcn_cvt_pk_f32_fp8(q3, true);
            const float g0 = gt[0] * (1.0f / 16.0f), g1 = gt[1] * (1.0f / 16.0f), g2_ = gt[2] * (1.0f / 16.0f), g3 = gt[3] * (1.0f / 16.0f);
            v[4 * j]     = ALPHA_ * xx[0] + ((g0 * a0[0] + g1 * a1[0]) + (g2_ * a2[0] + g3 * a3[0]));
            v[4 * j + 1] = ALPHA_ * xx[1] + ((g0 * a0[1] + g1 * a1[1]) + (g2_ * a2[1] + g3 * a3[1]));
            v[4 * j + 2] = ALPHA_ * xx[2] + ((g0 * b0[0] + g1 * b1[0]) + (g2_ * b2_[0] + g3 * b3[0]));
            v[4 * j + 3] = ALPHA_ * xx[3] + ((g0 * b0[1] + g1 * b1[1]) + (g2_ * b2_[1] + g3 * b3[1]));
            s += (v[4 * j] + v[4 * j + 1]) + (v[4 * j + 2] + v[4 * j + 3]); }
        const float mean = wave_sum(s) * (1.f / D); float s2 = 0.f;
#pragma unroll
        for (int k = 0; k < 16; ++k) { v[k] -= mean; s2 += v[k] * v[k]; }
        const float rstd = 1.0f / sqrtf(wave_sum(s2) * (1.f / D) + LN_EPS);
#pragma unroll
        for (int j = 0; j < 4; ++j) { const int c = 4 * lane + 256 * j; const f32x4 gg = gg_[j], bb = bb_[j];
            f32x4 o;
#pragma unroll
            for (int k = 0; k < 4; ++k) o[k] = v[4 * j + k] * rstd * gg[k] + bb[k];
            if (out) *(f32x4*)(out + (size_t)row * D + c) = o;
            u32x2 pb; pb.x = pk2(o[0], o[1]); pb.y = pk2(o[2], o[3]); *(u32x2*)(XB + (size_t)row * D + c) = pb;
            if (XB8) *(unsigned*)(XB8 + (size_t)row * D + c) = pg8::pk4_fp8(o[0], o[1], o[2], o[3]); }
    }
}
#undef LN2_IDX
#undef LN2_DATA

#ifndef MK_FP8TEST
#define MK_FP8TEST 0
#endif
typedef int i32x8 __attribute__((ext_vector_type(8)));
__device__ __forceinline__ int t8_val(int which, int rc, int g, int j) { unsigned h = (unsigned)(which * 7919 + rc * 104729 + g * 1299709 + j * 15485863 + 12345); h ^= h >> 13; h *= 0x5bd1e995u; h ^= h >> 15; return (int)(h % 9u) - 4; }
__device__ __forceinline__ void fp8_selftest(gu32* ctl, int lane) {
    const int rc = lane & 15, g = lane >> 4;
    i32x8 a, b;
#pragma unroll
    for (int w = 0; w < 8; ++w) {
        int wa = __builtin_amdgcn_cvt_pk_fp8_f32((float)t8_val(0, rc, g, 4 * w), (float)t8_val(0, rc, g, 4 * w + 1), 0, false);
        wa = __builtin_amdgcn_cvt_pk_fp8_f32((float)t8_val(0, rc, g, 4 * w + 2), (float)t8_val(0, rc, g, 4 * w + 3), wa, true);
        int wb = __builtin_amdgcn_cvt_pk_fp8_f32((float)t8_val(1, rc, g, 4 * w), (float)t8_val(1, rc, g, 4 * w + 1), 0, false);
        wb = __builtin_amdgcn_cvt_pk_fp8_f32((float)t8_val(1, rc, g, 4 * w + 2), (float)t8_val(1, rc, g, 4 * w + 3), wb, true);
        a[w] = wa; b[w] = wb;
    }
    f32x4 c = {0.f, 0.f, 0.f, 0.f};
    c = __builtin_amdgcn_mfma_scale_f32_16x16x128_f8f6f4(a, b, c, 0, 0, 0, 0x7f7f7f7f, 0, 0x7f7f7f7f);
    int bad = 0, scaled = 0;
#pragma unroll
    for (int reg = 0; reg < 4; ++reg) {
        const int row = 4 * (lane >> 4) + reg, col = lane & 15; int e = 0;
        for (int gg = 0; gg < 4; ++gg) for (int j = 0; j < 32; ++j) e += t8_val(0, row, gg, j) * t8_val(1, col, gg, j);
        if (c[reg] != (float)e) { bad = 1; if (e != 0 && (c[reg] == (float)e * 0.5f || c[reg] == (float)e * 2.0f || c[reg] == (float)e * 0.25f || c[reg] == (float)e * 4.0f)) scaled = 1; }
    }
    const unsigned long long mb = __ballot(bad), ms = __ballot(bad && scaled);
    if (lane == 0 && mb) __hip_atomic_store(ctl + CW_ERR, (mb == ms) ? 2u : 1u, RLX_AGENT);
}

constexpr int N_STEPS = 6, LAST_PHASE = 1 + 10 * 5 + 8;
__host__ __device__ constexpr bool phase_exists(int id) {
    if (id == 0) return true;
    if (id < 1 || id > LAST_PHASE) return false;
    const int s = (id - 1) / 10, p = (id - 1) % 10;
    if (p == 0) return true;
    if (p == 9) return false;
    if (s == 0 || s == 2) return false;
    if (p == 1 || p == 2) return s == 3;
    return true;
}
__global__ void __launch_bounds__(NTHREADS, 2) mk_fwd(Args args) {
    extern __shared__ __attribute__((aligned(16))) unsigned char lds_raw[];
    Frame F;
    F.lds = (LAS unsigned char*)lds_raw;
    F.tid = threadIdx.x; F.lane = F.tid & 63; F.wave = __builtin_amdgcn_readfirstlane(F.tid >> 6);
    F.bid = blockIdx.x; F.G = gridDim.x; F.vcu = (F.G % 8 == 0) ? (F.bid % 8) * (F.G / 8) + F.bid / 8 : F.bid;
    F.ctl = (gu32*)(args.ws + WS_CTL);
    const int lo = args.ph_lo, hi = args.ph_hi;
    const bool fused = (hi - lo) > 1;
    for (int u = F.tid; u < (LDS_BYTES - LDSCTL_OFF) / 4; u += NTHREADS) ((LAS unsigned*)(F.lds + LDSCTL_OFF))[u] = 0u;
    __syncthreads();
    XcdBarrier bar; bar.bar = (unsigned*)(F.ctl + CW_BAR); bar.x = 0; bar.st = nullptr;
    if (fused) bar = xcd_barrier_post((unsigned*)(F.ctl + CW_BAR), (volatile LAS unsigned*)(F.lds + L_XB));
    const bool split = fused && MK_SPLIT && (F.G % 16 == 0) && lo == 0 && hi > 16;
    const int NCV = split ? F.G / 2 : 0;
    const bool is_conv = split && F.bid < NCV;
    XcdBarrier bar2; bar2.bar = (unsigned*)(F.ctl + CW_BAR2); bar2.x = 0; bar2.st = nullptr;
    if (split && !is_conv) bar2 = xcd_barrier_post((unsigned*)(F.ctl + CW_BAR2), (volatile LAS unsigned*)(F.lds + L_XB2));
#ifndef MK_PROBE
#define MK_PROBE 0
#endif
#define IN(id) (lo <= (id) && (id) < hi)
#define PHASE_BEGIN ArgsP ap = (ArgsP)__builtin_amdgcn_kernarg_segment_ptr(); asm volatile("" : "+s"(ap)); GAS unsigned char* wsg_ = (GAS unsigned char*)ap->ws; asm volatile("" : "+s"(wsg_)); unsigned char* ws = (unsigned char*)wsg_; Frame Fp = F; { const int l_ = lane_id_now(); Fp.lane = l_; Fp.tid = F.wave * 64 + l_; } Fp.ctl = (gu32*)(ws + WS_CTL);
#define SEAM(id) do { if (fused && (id) != LAST_PHASE) { xcd_barrier(bar, F.wave == 0 && lane_id_now() == 0, (unsigned)F.G); if (MK_PROBE == 10) xcd_barrier(bar, F.wave == 0 && lane_id_now() == 0, (unsigned)F.G); } } while (0)
#define SEAMW(id, sync, last) do { if (!split) SEAM(id); else if (last) SEAM(id); else if ((sync) && !is_conv) xcd_barrier(bar2, F.wave == 0 && lane_id_now() == 0, (unsigned)(F.G - NCV)); } while (0)
#define WIN_FRAME do { if (split) { Fp.G = F.G - NCV; Fp.bid = F.bid - NCV; Fp.vcu = (Fp.G % 8 == 0) ? (Fp.bid % 8) * (Fp.G / 8) + Fp.bid / 8 : Fp.bid; } } while (0)
#define REPS(k) ((MK_PROBE) == (k) ? 2 : 1)

#ifndef SKIP_P0
    if (MK_FP8TEST && lo == 0 && F.bid == 0 && F.wave == 0) fp8_selftest(F.ctl, F.lane);
    if (IN(0)) { PHASE_BEGIN for (int rep = 0; rep < REPS(1); ++rep) p0_prologue(Fp, ap, ws, split ? 1 : 0); SEAM(0); }
#endif

    for (int s = 0; s < N_STEPS; ++s) {
        const int pb = 1 + 10 * s;
        const int layer = s == 0 ? 0 : (s == 1 ? 0 : (s <= 3 ? 1 : s - 2));
        const int kind = layer % 3;
        const bool rest = !(s == 0 || s == 2);
#ifndef SKIP_G1
        const bool inw = split && s <= 1;
        if (IN(pb) && inw && is_conv) {
            if (s == 0) { PHASE_BEGIN Fp.G = NCV; p0_prologue(Fp, ap, ws, 2); }
        } else
        if (IN(pb)) {
            PHASE_BEGIN
            if (inw) WIN_FRAME;
            pg8::Gemm g; pg8::EpiProj E; E.ssq_in = nullptr; E.ssq_out = nullptr; E.rope = (const pg8::f32x2*)(ws + WS_ROPE); E.rope_heads = 0u; E.oscale = 1.0f;
            if (s == 0) { g = pg8::Gemm{(const bf16*)(ws + WS_MEMB), (const bf16*)(ws + WS_WKV), NB * MEML, 2048, 1024, 1024}; E.O = (bf16*)(ws + WS_KVMEM); E.ldc = 2048; }
            else if (s == 3) { g = pg8::Gemm{(const bf16*)(ws + WS_PROJ), (const bf16*)(ws + WS_WUQ), T, 1280, 256, 1280}; E.O = (bf16*)(ws + WS_QQ); E.ldc = 1280; E.ssq_in = (const float*)(ws + WS_SSQ); E.rope_heads = 0xFFFFFu; }
            else { const int n = kind == 0 ? 2560 : (kind == 1 ? 1280 : 1536);
                g = pg8::Gemm{(const bf16*)(ws + WS_XB), (const bf16*)(ws + WS_WIN + (size_t)layer * 5 * MiB), T, n, 1024, 1024}; E.O = (bf16*)(ws + WS_PROJ); E.ldc = n;
                if (layer != 0) { g.A = (const bf16*)(ws + WS_XB8); g.K = 512; g.lda = 512; E.oscale = 1.0f / 64.0f; }
                if (kind == 1) { E.ssq_out = (float*)(ws + WS_SSQ); E.rope_heads = 0xF0u | (1u << 16); }
                if (kind == 2) E.rope_heads = 0xFFFFu; }
            pg8::StaticOrder S; S.init(g.M, g.N, Fp.G, (s == 0 && !inw) ? Fp.G - 1 - Fp.bid : Fp.bid); if (s <= 1) S.split = 0;
            if (!(s == 0 || s == 1 || s == 3)) { for (int rep = 0; rep < REPS(2); ++rep) pg8::gemm_phase<pg8::EpiProj, pg8::StaticOrder, true, true, true>(F.lds + RING_OFF, g, S, E, F.wave * 64 + lane_id_now()); }
            else { for (int rep = 0; rep < REPS(2); ++rep) pg8::gemm_phase<pg8::EpiProj, pg8::StaticOrder, true, true, false>(F.lds + RING_OFF, g, S, E, F.wave * 64 + lane_id_now()); }
        }
        if (IN(pb)) { if (inw) SEAMW(pb, s == 1, false); else if (!(s == 0 && fused)) SEAM(pb); }
#endif
        if (s == 3) {
#ifndef SKIP_PS
            if (IN(pb + 1)) { PHASE_BEGIN for (int rep = 0; rep < ((MK_PROBE == 3 || MK_PROBE == 31) ? 2 : 1); ++rep) score_phase(Fp, (const bf16*)(ws + WS_QQ), (const bf16*)(ws + WS_PROJ), (float*)(ws + WS_ACT)); SEAM(pb + 1); }
#endif
#ifndef SKIP_PT
            if (IN(pb + 2)) { PHASE_BEGIN for (int rep = 0; rep < ((MK_PROBE == 3 || MK_PROBE == 32) ? 2 : 1); ++rep) select_phase(Fp, (const float*)(ws + WS_ACT), (unsigned long long*)(ws + WS_MASK)); SEAM(pb + 2); }
#endif
        }
        if (!rest) continue;
#ifndef SKIP_MIX
        if (IN(pb + 3) && !(inw && is_conv)) { PHASE_BEGIN if (inw) WIN_FRAME; for (int rep = 0; rep < ((MK_PROBE == 4 || (MK_PROBE == 41 && kind == 1) || (MK_PROBE == 42 && kind == 2) || (MK_PROBE == 43 && kind == 0)) ? 2 : 1); ++rep) mixer_phase(Fp, ap, ws, layer, kind, s + 8 * rep); }
        if (IN(pb + 3)) { if (inw) SEAMW(pb + 3, true, false); else SEAM(pb + 3); }
#endif
#ifndef SKIP_G2
        if (IN(pb + 4) && !(inw && is_conv)) {
            PHASE_BEGIN
            if (inw) WIN_FRAME;
            pg8::Gemm g{(const bf16*)(ws + WS_CAT), (const bf16*)(ws + WS_WOUT + (size_t)layer * 2 * MiB), T, 1024, 512, 512};
            pg8::EpiProj E; E.O = (bf16*)(ws + WS_Y); E.ldc = 1024; E.ssq_in = nullptr; E.ssq_out = nullptr; E.rope = nullptr; E.rope_heads = 0u; E.oscale = 1.0f / 128.0f;
            pg8::StaticOrder S; S.init(T, 1024, Fp.G, Fp.bid);
            for (int rep = 0; rep < REPS(5); ++rep) pg8::gemm_phase<pg8::EpiProj, pg8::StaticOrder, true, true, true>(F.lds + RING_OFF, g, S, E, F.wave * 64 + lane_id_now());
        }
        if (IN(pb + 4)) { if (inw) SEAMW(pb + 4, true, false); else SEAM(pb + 4); }
#endif
#ifndef SKIP_LN1
        if (IN(pb + 5) && !(inw && is_conv)) {
            PHASE_BEGIN
            if (inw) WIN_FRAME;
            for (int rep = 0; rep < ((MK_PROBE == 6 || MK_PROBE == 61 || MK_PROBE == 62 || MK_PROBE == 63) ? 2 : 1); ++rep)
            ln1_phase(Fp, (const bf16*)(ws + WS_XB), (const bf16*)(ws + WS_Y), ap->in[12] + layer * D, ap->in[13] + layer * D, (bf16*)(ws + WS_QQ),
                      ap->in[14] + (size_t)layer * D * NEXP, ap->in[15] + layer * NEXP, (bf16*)(ws + (rep ? WS_ACT : WS_XP)), Fp.ctl + (rep ? CW_GDUMMY : CW_GCOUNT) + layer * NEXP,
                      (int*)(ws + (rep ? WS_SSQ : WS_ROWS)), (float*)(ws + (rep ? WS_MASK : WS_GATES)), (rep && MK_PROBE == 61) ? 2 : (rep && MK_PROBE == 62) ? 1 : (rep && MK_PROBE == 63) ? 0 : 3);
        }
        if (IN(pb + 5)) { if (inw) SEAMW(pb + 5, true, true); else SEAM(pb + 5); }
#endif
        if (IN(pb + 6) || IN(pb + 7)) {
            LAS int* pref = (LAS int*)(F.lds + L_PREF); LAS int* tiles = (LAS int*)(F.lds + L_TILES);
#ifndef SKIP_G3
            if (IN(pb + 6)) {
                PHASE_BEGIN
                if (Fp.wave == 0) {
                    const int l_ = Fp.lane; const int tl_ = l_ < 32 ? (int)((__hip_atomic_load(Fp.ctl + CW_GCOUNT + layer * NEXP + (l_ & 31), RLX_AGENT) + 255u) >> 8) : 0;
                    int v_ = tl_ * 8;
#pragma unroll
                    for (int d_ = 1; d_ < 32; d_ <<= 1) { const int t_ = __builtin_amdgcn_ds_bpermute(((l_ - d_) & 63) << 2, v_); if (l_ >= d_) v_ += t_; }
                    if (l_ < 32) { tiles[l_] = tl_; pref[l_] = v_ - tl_ * 8; } if (l_ == 31) pref[32] = v_; }
                __syncthreads();
                pg8::Gemm g{(const bf16*)(ws + WS_XP), (const bf16*)(ws + WS_WGU + (size_t)layer * 64 * MiB), NEXP * CAPROWS, NEXP * 2048, 512, 512};
                pg8::EpiSwiglu E{(bf16*)(ws + WS_ACT), ap->in[17] + (size_t)layer * NEXP * 2048};
                pg8::MoeOrder S{pref, tiles, 8, pref[32], F.G, F.vcu};
                for (int rep = 0; rep < REPS(7); ++rep) pg8::gemm_phase<pg8::EpiSwiglu, pg8::MoeOrder, true, true, true>(F.lds + RING_OFF, g, S, E, F.wave * 64 + lane_id_now());
                SEAM(pb + 6);
            }
#endif
#ifndef SKIP_G4
            if (IN(pb + 7)) {
                PHASE_BEGIN
                if (Fp.wave == 0) {
                    const int l_ = Fp.lane; const int tl_ = l_ < 32 ? (int)((__hip_atomic_load(Fp.ctl + CW_GCOUNT + layer * NEXP + (l_ & 31), RLX_AGENT) + 255u) >> 8) : 0;
                    int v_ = tl_ * 4;
#pragma unroll
                    for (int d_ = 1; d_ < 32; d_ <<= 1) { const int t_ = __builtin_amdgcn_ds_bpermute(((l_ - d_) & 63) << 2, v_); if (l_ >= d_) v_ += t_; }
                    if (l_ < 32) { tiles[l_] = tl_; pref[l_] = v_ - tl_ * 4; } if (l_ == 31) pref[32] = v_; }
                __syncthreads();
                pg8::Gemm g{(const bf16*)(ws + WS_ACT), (const bf16*)(ws + WS_WDN + (size_t)layer * 32 * MiB), NEXP * CAPROWS, NEXP * 1024, 512, 512};
                pg8::EpiDown E{(bf16*)(ws + WS_XP), ap->in[19] + (size_t)layer * NEXP * 1024};
                pg8::MoeOrder S{pref, tiles, 4, pref[32], F.G, F.vcu};
                for (int rep = 0; rep < REPS(8); ++rep) pg8::gemm_phase<pg8::EpiDown, pg8::MoeOrder, true, true, true>(F.lds + RING_OFF, g, S, E, F.wave * 64 + lane_id_now());
                SEAM(pb + 7);
            }
#endif
        }
#ifndef SKIP_LN2
        if (IN(pb + 8)) {
            PHASE_BEGIN
            for (int rep = 0; rep < REPS(9); ++rep)
            ln2_phase(Fp, (const bf16*)(ws + WS_QQ), (const bf16*)(ws + WS_XP), (const int*)(ws + WS_ROWS), (const float*)(ws + WS_GATES), ap->in[20] + layer * D, ap->in[21] + layer * D,
                      layer == DEPTH - 1 ? ap->out : (float*)nullptr, (bf16*)(ws + WS_XB), (layer + 1 < DEPTH) ? (unsigned char*)(ws + WS_XB8) : (unsigned char*)nullptr);
            SEAM(pb + 8);
        }
#endif
    }
    if (MK_FP8TEST && hi > LAST_PHASE) {
        const unsigned code = __hip_atomic_load(F.ctl + CW_ERR, RLX_AGENT);
        if (code) { const float v = code == 2u ? 100.f : 10.f;
            for (int row = F.bid * NWAVES + F.wave; row < T; row += F.G * NWAVES) { f32x4* o = (f32x4*)(args.out + (size_t)row * D) + F.lane;
#pragma unroll
                for (int j = 0; j < 4; ++j) o[64 * j] = (f32x4){v, v, v, v}; } }
    }
#undef IN
#undef SEAM
}

extern "C" void kernel_launch(void* const* d_in, const int* in_sizes, int n_in, void* d_out, int out_size, void* d_ws, size_t ws_size, hipStream_t stream) {
    static int grid = 0;
    if (grid == 0) {
        if (n_in != 22 || in_sizes[0] != T * D || out_size != T * D || ws_size < WS_END) { fprintf(stderr, "kernel_launch: unexpected shapes (n_in %d, in0 %d, out %d, ws %zu < %zu); nothing launched\n", n_in, n_in > 0 ? in_sizes[0] : -1, out_size, ws_size, (size_t)WS_END); grid = -1; return; }
        int dev = 0, cus = 0, per_cu = 0;
        if (hipGetDevice(&dev) != hipSuccess || hipDeviceGetAttribute(&cus, hipDeviceAttributeMultiprocessorCount, dev) != hipSuccess) { fprintf(stderr, "kernel_launch: device query failed\n"); grid = -1; return; }
        if (hipFuncSetAttribute((const void*)mk_fwd, hipFuncAttributeMaxDynamicSharedMemorySize, LDS_BYTES) != hipSuccess) { fprintf(stderr, "kernel_launch: hipFuncSetAttribute failed\n"); grid = -1; return; }
        if (hipOccupancyMaxActiveBlocksPerMultiprocessor(&per_cu, (const void*)mk_fwd, NTHREADS, LDS_BYTES) != hipSuccess || per_cu < 1) fprintf(stderr, "kernel_launch: note: occupancy query reports %d workgroups per CU\n", per_cu);
        (void)hipGetLastError();
        grid = cus;
    }
    if (grid < 0) return;
    if (hipMemsetAsync((char*)d_ws + WS_CTL, 0, CTL_ZERO_BYTES, stream) != hipSuccess) { fprintf(stderr, "kernel_launch: hipMemsetAsync failed\n"); return; }
    Args a{};
    for (int i = 0; i < 22; ++i) a.in[i] = (const float*)d_in[i];
    a.out = (float*)d_out; a.ws = (unsigned char*)d_ws;
    unsigned char* ws = (unsigned char*)d_ws;
    { int nj = 0, items = 0;
      auto add = [&](const float* src, int ldw, int K, int col0, int nvalid, int nblk, size_t dst_off, int row0, const float* scale, int f8 = 0, float mul = 1.0f) {
          Job& j = a.jobs[nj++]; j.src = src; j.dst = (bf16*)(ws + dst_off); j.scale = scale; j.ldw = ldw; j.K = K; j.col0 = col0; j.nvalid = nvalid; j.nblk = nblk; j.row0 = row0; j.item0 = items; j.f8 = f8; j.mul = mul; j.pad = 0;
          items += nblk * (K / 128); };
      const float* a_w_in = a.in[2]; const float* b_w_in = a.in[4]; const float* c_w_in = a.in[8];
      add(a_w_in, 2560, 1024, 0, 2560, 10, WS_WIN + 0 * 5 * MiB, 0, nullptr);
      add(a_w_in + (size_t)1024 * 2560, 2560, 1024, 0, 2560, 10, WS_WIN + 3 * 5 * MiB, 0, nullptr, 1, 64.0f);
      add(b_w_in, 1096, 1024, 0, 768, 3, WS_WIN + 1 * 5 * MiB, 0, nullptr, 1, 64.0f);
      add(b_w_in, 1096, 1024, 840, 256, 1, WS_WIN + 1 * 5 * MiB, 768, nullptr, 1, 64.0f);
      add(b_w_in, 1096, 1024, 768, 72, 1, WS_WIN + 1 * 5 * MiB, 1024, nullptr, 1, 64.0f);
      add(c_w_in, 1536, 1024, 0, 1536, 6, WS_WIN + 2 * 5 * MiB, 0, nullptr, 1, 64.0f);
      for (int l = 0; l < 4; ++l) add(a.in[10] + (size_t)l * 1024 * 1024, 1024, 1024, 0, 1024, 4, WS_WOUT + (size_t)l * 2 * MiB, 0, nullptr, 1, 128.0f);
      for (int l = 0; l < 4; ++l) add(a.in[11] + (size_t)l * 1024 * 512, 512, 1024, 0, 512, 2, WS_WKV, 512 * l, nullptr);
      add(a.in[6], 768, 256, 0, 768, 3, WS_WUQ, 0, a.in[5]);
      add(a.in[7], 512, 256, 0, 512, 2, WS_WUQ, 768, a.in[5]);
      a.njob_items = items; }
    a.pad = 0;
#if MK_MULTI
    for (int id = 0; id <= LAST_PHASE; ++id) {
        if (!phase_exists(id)) continue;
        a.ph_lo = id; a.ph_hi = id + 1;
        hipLaunchKernelGGL(mk_fwd, dim3(grid), dim3(NTHREADS), LDS_BYTES, stream, a);
    }
#else
    a.ph_lo = 0; a.ph_hi = LAST_PHASE + 1;
    hipLaunchKernelGGL(mk_fwd, dim3(grid), dim3(NTHREADS), LDS_BYTES, stream, a);
#endif
    const hipError_t le = hipPeekAtLastError();
    if (le != hipSuccess) fprintf(stderr, "kernel_launch: launch failed: %s (grid %d)\n", hipGetErrorName(le), grid);
}
```

```cpp
#include <hip/hip_runtime.h>
#include <cstdio>
#include <cstdint>
#include <cmath>

#ifndef MK_MULTI
#define MK_MULTI 0
#endif
#ifndef MK_SPLIT
#define MK_SPLIT 0
#endif
#ifndef MK_CHECK
#define MK_CHECK 0
#endif

namespace pg8 {
#define PG8_LAS __attribute__((address_space(3)))
typedef unsigned short bf16_t;
typedef short bf16x8 __attribute__((ext_vector_type(8)));
typedef float f32x4 __attribute__((ext_vector_type(4)));
typedef unsigned u32x4 __attribute__((ext_vector_type(4)));
typedef int i32x8 __attribute__((ext_vector_type(8)));
typedef short bf16x16 __attribute__((ext_vector_type(16)));
typedef unsigned u32x2 __attribute__((ext_vector_type(2)));
constexpr int BM = 256, BK = 64, HALF = 128, HTB = HALF * BK * 2  , STAGE_BYTES = 8 * HTB, NXCD = 8, WGM = 8;

__host__ __device__ __forceinline__ int lds_byte(int r, int c) { const int st = (r >> 4) * 2 + (c >> 5), rr = r & 15, cc = c & 31, ob = rr * 64 + cc * 2; return st * 1024 + (ob ^ (((ob >> 9) & 1) << 5)); }
__host__ __device__ __forceinline__ void stage_rc(int b, int& R, int& C) { const int st = b / 1024, sb = b % 1024, swz = sb ^ (((sb >> 9) & 1) << 5); R = (st >> 1) * 16 + swz / 64; C = (st & 1) * 32 + (swz % 64) / 2; }
__host__ __device__ __forceinline__ int perm32(int rho) { const int n = rho >> 4, i = rho & 15; return 8 * (i >> 2) + 4 * n + (i & 3); }

struct Unit { int pm, pn, hs; };
struct Gemm { const bf16_t* A; const bf16_t* Bt; int M, N, K, lda; };

struct StaticOrder {
    int nM, nN, nwg, G, c, split;
    __host__ __device__ void init(int M, int N, int G_, int c_) { nM = M / BM; nN = N / BM; nwg = nM * nN; G = G_; c = c_; split = 1; }
    __host__ __device__ bool next(int i, Unit& u) const {
        const int nfull = nwg / G, rem = nwg - nfull * G; int L = i * G + c; u.hs = 0;
        if (split && i == nfull && rem > 0 && 2 * rem <= G) { if (c >= 2 * rem) return false; L = nfull * G + (c >> 1); u.hs = 1 + (c & 1); }
        if (L >= nwg) return false;
        int wgid = L; { const int q = nwg / NXCD, r = nwg % NXCD, xcd = wgid % NXCD, off = wgid / NXCD; wgid = (xcd < r ? xcd * (q + 1) : r * (q + 1) + (xcd - r) * q) + off; }
        const int nig = WGM * nN, gid = wgid / nig, fm = gid * WGM, gsz = (nM - fm) < WGM ? (nM - fm) : WGM;
        u.pm = fm + ((wgid % nig) % gsz); u.pn = (wgid % nig) / gsz; return true;
    }
    __device__ __forceinline__ void a_ready(const Unit&) const {}
    __device__ __forceinline__ void done(const Unit&) const {}
};

typedef float f32x2 __attribute__((ext_vector_type(2)));
__device__ __forceinline__ float shx16(float v, int lane, int m) { return __int_as_float(__builtin_amdgcn_ds_bpermute((lane ^ m) << 2, __float_as_int(v))); }
typedef __bf16 bf16x2_t __attribute__((ext_vector_type(2)));
__device__ __forceinline__ unsigned pk4_fp8(float a, float b, float c, float d) { int w = __builtin_amdgcn_cvt_pk_fp8_f32(a, b, 0, false); w = __builtin_amdgcn_cvt_pk_fp8_f32(c, d, w, true); return (unsigned)w; }
__device__ __forceinline__ unsigned cvt_pk_bf16(float lo, float hi) { f32x2 v = {lo, hi}; bf16x2_t b = __builtin_convertvector(v, bf16x2_t); return __builtin_bit_cast(unsigned, b); }

struct EpiProj {
    static constexpr bool PERM = true, AFTER_DRAIN = false, BIAS_LDS = false; static constexpr int NSTORE = 16;
    bf16_t* O; int ldc; const float* ssq_in; float* ssq_out; const f32x2* rope; unsigned rope_heads; float oscale;
    __device__ __forceinline__ void operator()(const f32x4 (&acc)[2][2][4][2], const Unit& u, int wr, int wc, int fr, int fq) const {
        if (ssq_in != nullptr || rope_heads != 0u) run<true>(acc, u, wr, wc, fr, fq); else run<false>(acc, u, wr, wc, fr, fq);
    }
    template <bool LOADS>
    __device__ __forceinline__ void run(const f32x4 (&acc)[2][2][4][2], const Unit& u, int wr, int wc, int fr, int fq) const {
        const int row0 = u.pm * BM + (u.hs == 2 ? HALF : 0) + wr * 64 + fr, col0 = u.pn * BM + wc * 32 + 8 * fq;
        const bool do_ssq = (ssq_out != nullptr) && (u.pn == 0);
        const __amdgpu_buffer_rsrc_t ors = __builtin_amdgcn_make_buffer_rsrc((void*)O, 0, 0x7fffffff, 0x00020000);
        const bool any_rope = rope_heads != 0u;
        f32x4 sq_n = {0.f, 0.f, 0.f, 0.f}, cs_n[4];
#pragma unroll
        for (int q = 0; q < 4; ++q) cs_n[q] = (f32x4){0.f, 0.f, 0.f, 0.f};
        const float* sqp_ = ssq_in ? ssq_in : (const float*)rope;
#define EPI_ROWLOADS(ROW) do { if constexpr (LOADS) { sq_n = *(const f32x4*)(sqp_ + (size_t)(ROW) * 4); \
            const f32x4* cs_ = (const f32x4*)(rope + (size_t)((ROW) & 4095) * 8); cs_n[0] = cs_[0]; cs_n[1] = cs_[1]; cs_n[2] = cs_[2]; cs_n[3] = cs_[3]; } } while (0)
        EPI_ROWLOADS(row0);
#pragma unroll
        for (int ai = 0; ai < 2; ++ai) if (ai == 0 || u.hs == 0)
#pragma unroll
            for (int m = 0; m < 4; ++m) {
                const int row = row0 + ai * HALF + m * 16;
                const f32x4 s = sq_n, c01 = cs_n[0], c23 = cs_n[1], c45 = cs_n[2], c67 = cs_n[3];
                if (!(ai == 1 && m == 3)) { const int rown = row0 + (m == 3 ? HALF : ai * HALF + (m + 1) * 16); EPI_ROWLOADS(rown); }
                float rs = 1.f;
                if (ssq_in) rs = 1.0f / sqrtf(((s[0] + s[1]) + (s[2] + s[3])) * (1.f / 256.f) + 1e-5f);
                float ss = 0.f;
#pragma unroll
                for (int bj = 0; bj < 2; ++bj) {
                    f32x4 v0 = acc[ai][bj][m][0] * oscale, v1 = acc[ai][bj][m][1] * oscale;
                    if (do_ssq) ss += ((v0[0] * v0[0] + v0[1] * v0[1]) + (v0[2] * v0[2] + v0[3] * v0[3])) + ((v1[0] * v1[0] + v1[1] * v1[1]) + (v1[2] * v1[2] + v1[3] * v1[3]));
                    v0 = v0 * rs; v1 = v1 * rs;
                    const int head = (u.pn * BM + bj * HALF + wc * 32) >> 6;
                    if (((rope_heads >> head) & 1u) && !(wc & 1)) {
                        f32x4 o0, o1;
#pragma unroll
                        for (int j = 0; j < 4; ++j) { o0[j] = shx16(v0[j], fr + 16 * fq, 16); o1[j] = shx16(v1[j], fr + 16 * fq, 16); }
                        if (fq < 2) {
                            const float sg = fq == 0 ? -1.f : 1.f;
                            v0[0] = v0[0] * c01[0] + sg * o0[0] * c01[1]; v0[1] = v0[1] * c01[2] + sg * o0[1] * c01[3];
                            v0[2] = v0[2] * c23[0] + sg * o0[2] * c23[1]; v0[3] = v0[3] * c23[2] + sg * o0[3] * c23[3];
                            v1[0] = v1[0] * c45[0] + sg * o1[0] * c45[1]; v1[1] = v1[1] * c45[2] + sg * o1[1] * c45[3];
                            v1[2] = v1[2] * c67[0] + sg * o1[2] * c67[1]; v1[3] = v1[3] * c67[2] + sg * o1[3] * c67[3];
                        }
                    }
                    u32x4 w; w.x = cvt_pk_bf16(v0[0], v0[1]); w.y = cvt_pk_bf16(v0[2], v0[3]); w.z = cvt_pk_bf16(v1[0], v1[1]); w.w = cvt_pk_bf16(v1[2], v1[3]);
                    __builtin_amdgcn_raw_buffer_store_b128(w, ors, (row * ldc + col0 + bj * HALF) * 2, 0, 0);
                }
                if (do_ssq) { ss += shx16(ss, fr + 16 * fq, 16); ss += shx16(ss, fr + 16 * fq, 32); if (fq == 0) ssq_out[(size_t)row * 4 + wc] = ss; }
            }
#undef EPI_ROWLOADS
    }
};
struct EpiSwiglu {
    static constexpr bool PERM = true, AFTER_DRAIN = false, BIAS_LDS = true; static constexpr int NSTORE = 8;
    bf16_t* O; const float* bias;
    static constexpr float WSC = 1.0f / 64.0f;
    __device__ __forceinline__ void stage_bias(const Unit& u, PG8_LAS void* dst, int lane) const {
        const __amdgpu_buffer_rsrc_t brs = __builtin_amdgcn_make_buffer_rsrc((void*)bias, 0, 32 * 2048 * 4, 0x00020000);
        const int e = u.pn >> 3, t = u.pn & 7;
        __builtin_amdgcn_raw_ptr_buffer_load_lds(brs, dst, 16, (lane & 31) * 16 + (lane >> 5) * 4096, (e * 2048 + t * 128) * 4, 0, 0);
    }
    __device__ __forceinline__ void operator()(const f32x4 (&acc)[2][2][4][2], const Unit& u, int wr, int wc, int fr, int fq, const PG8_LAS float* bl) const {
        const int t = u.pn & 7;
        const int row0 = u.pm * BM + (u.hs == 2 ? HALF : 0) + wr * 64 + fr, jl = wc * 32 + 8 * fq, j0 = t * 128 + jl;
        const f32x4 bg0 = *(const PG8_LAS f32x4*)(bl + jl), bg1 = *(const PG8_LAS f32x4*)(bl + jl + 4), bu0 = *(const PG8_LAS f32x4*)(bl + 128 + jl), bu1 = *(const PG8_LAS f32x4*)(bl + 128 + jl + 4);
#pragma unroll
        for (int ai = 0; ai < 2; ++ai) if (ai == 0 || u.hs == 0)
#pragma unroll
            for (int m = 0; m < 4; ++m) {
                const int row = row0 + ai * HALF + m * 16;
                float r[8];
#pragma unroll
                for (int n = 0; n < 2; ++n) {
                    const f32x4 ag = acc[ai][0][m][n], au = acc[ai][1][m][n], bg_ = (n ? bg1 : bg0), bu_ = (n ? bu1 : bu0);
#pragma unroll
                    for (int jp = 0; jp < 4; jp += 2) {
                        const f32x2 wsc2 = {WSC, WSC}, one2 = {1.0f, 1.0f}, kk2 = {-1.702f * 1.4426950408889634f, -1.702f * 1.4426950408889634f};
                        f32x2 g2 = __builtin_elementwise_fma((f32x2){ag[jp], ag[jp + 1]}, wsc2, (f32x2){bg_[jp], bg_[jp + 1]});
                        f32x2 u2 = __builtin_elementwise_fma((f32x2){au[jp], au[jp + 1]}, wsc2, (f32x2){bu_[jp], bu_[jp + 1]});
                        g2[0] = fminf(g2[0], 7.0f); g2[1] = fminf(g2[1], 7.0f);
                        u2[0] = fminf(fmaxf(u2[0], -7.0f), 7.0f); u2[1] = fminf(fmaxf(u2[1], -7.0f), 7.0f);
                        const f32x2 t2 = g2 * kk2;
                        f32x2 d2 = {__builtin_amdgcn_exp2f(t2[0]), __builtin_amdgcn_exp2f(t2[1])}; d2 = d2 + one2;
                        const f32x2 s2 = {__builtin_amdgcn_rcpf(d2[0]), __builtin_amdgcn_rcpf(d2[1])};
                        const f32x2 r2 = ((u2 + one2) * g2) * s2;
                        r[n * 4 + jp] = r2[0]; r[n * 4 + jp + 1] = r2[1];
                    }
                }
                u32x2 w; w.x = pk4_fp8(r[0], r[1], r[2], r[3]); w.y = pk4_fp8(r[4], r[5], r[6], r[7]);
                *(u32x2*)((unsigned char*)O + (size_t)row * 1024 + j0) = w;
            }
    }
};
struct EpiDown {
    static constexpr bool PERM = true, AFTER_DRAIN = false, BIAS_LDS = true; static constexpr int NSTORE = 16;
    bf16_t* O; const float* bias;
    __device__ __forceinline__ void stage_bias(const Unit& u, PG8_LAS void* dst, int lane) const {
        const __amdgpu_buffer_rsrc_t brs = __builtin_amdgcn_make_buffer_rsrc((void*)bias, 0, 32 * 1024 * 4, 0x00020000);
        const int e = u.pn >> 2, t = u.pn & 3;
        __builtin_amdgcn_raw_ptr_buffer_load_lds(brs, dst, 16, lane * 16, (e * 1024 + t * 256) * 4, 0, 0);
    }
    __device__ __forceinline__ void operator()(const f32x4 (&acc)[2][2][4][2], const Unit& u, int wr, int wc, int fr, int fq, const PG8_LAS float* bl) const {
        const int t = u.pn & 3;
        const int row0 = u.pm * BM + (u.hs == 2 ? HALF : 0) + wr * 64 + fr, cl = wc * 32 + 8 * fq, col0 = t * BM + cl;
        f32x4 bv[2][2];
#pragma unroll
        for (int bj = 0; bj < 2; ++bj)
#pragma unroll
            for (int n = 0; n < 2; ++n) bv[bj][n] = *(const PG8_LAS f32x4*)(bl + cl + bj * HALF + 4 * n);
#pragma unroll
        for (int ai = 0; ai < 2; ++ai) if (ai == 0 || u.hs == 0)
#pragma unroll
            for (int m = 0; m < 4; ++m) { unsigned char* rowp = (unsigned char*)O + (size_t)(row0 + ai * HALF + m * 16) * 1024 + col0;
#pragma unroll
                for (int bj = 0; bj < 2; ++bj) { const f32x4 v0 = (acc[ai][bj][m][0] * (1.0f / 128.0f) + bv[bj][0]) * 16.0f, v1 = (acc[ai][bj][m][1] * (1.0f / 128.0f) + bv[bj][1]) * 16.0f;
                    u32x2 w; w.x = pk4_fp8(v0[0], v0[1], v0[2], v0[3]); w.y = pk4_fp8(v1[0], v1[1], v1[2], v1[3]);
                    *(u32x2*)(rowp + bj * HALF) = w; } }
    }
};
struct MoeOrder {
    const PG8_LAS int* pref; const PG8_LAS int* tiles; int ntn, total, G, vcu;
    __device__ __forceinline__ bool next(int i, Unit& u) const {
        const int nfull = total / G, rem = total - nfull * G; int L = i * G + vcu; u.hs = 0;
        if (i == nfull && rem > 0 && 2 * rem <= G) { if (vcu >= 2 * rem) return false; L = nfull * G + (vcu >> 1); u.hs = 1 + (vcu & 1); }
        if (L >= total) return false;
        int e = 0;
        for (int k = 1; k < 32; ++k) e += (pref[k] <= L) ? 1 : 0;
        const int r = L - pref[e], te = tiles[e];
        const int grp = te * 4, ntq = r / grp, r2 = r - ntq * grp, mt = r2 >> 2, ntl = r2 & 3;
        u.pm = __builtin_amdgcn_readfirstlane(e * 64 + mt); u.pn = __builtin_amdgcn_readfirstlane(e * ntn + ntq * 4 + ntl); return true;
    }
    __device__ __forceinline__ void a_ready(const Unit&) const {}
    __device__ __forceinline__ void done(const Unit&) const {}
};

template <class Epi, class Sched, bool ALIGN_EPI = false, bool SP2 = false, bool FP8 = false>
__device__ __forceinline__ void gemm_phase(PG8_LAS unsigned char* lds, const Gemm g, const Sched& S, const Epi& E, const int tid_in) {
    const int tid_ = tid_in;
    const int tid = tid_, wid = __builtin_amdgcn_readfirstlane(tid >> 6), lane = tid & 63, wr = wid >> 2, wc = wid & 3, fr = lane & 15, fq = lane >> 4;
    const int K = g.K, nt = K / BK;
    unsigned voffA[2], voffB[2];
#pragma unroll
    for (int i = 0; i < 2; ++i) { int R, C; stage_rc(tid * 16 + i * 8192, R, C); const int Rb = Epi::PERM ? ((R & ~31) + perm32(R & 31)) : R;
        voffA[i] = (unsigned)(R * g.lda + C) * 2u; voffB[i] = (unsigned)(Rb * K + C) * 2u; }
    const unsigned kstep = (unsigned)(BK * 2);
    const unsigned hstepA = (unsigned)HALF * g.lda * 2, hstepB = (unsigned)HALF * K * 2;
    const unsigned tstepA = 2 * hstepA, tstepB = 2 * hstepB;
    const unsigned ldsw = (unsigned)wid * 1024u;
    const int aoff = lds_byte(wr * 64 + fr, fq * 8), boff = lds_byte(wc * 32 + fr, fq * 8);
#define PG8_SA(b, h) (((b) * 2 + (h)) * HTB)
#define PG8_SB(b, h) ((4 + (b) * 2 + (h)) * HTB)
    const __amdgpu_buffer_rsrc_t rA = __builtin_amdgcn_make_buffer_rsrc((void*)g.A, 0, 0x7fffffff, 0x00020000), rB = __builtin_amdgcn_make_buffer_rsrc((void*)g.Bt, 0, 0x7fffffff, 0x00020000);
#define PG8_STAGE(bufoff, soff, voff, rs) do { _Pragma("unroll") for (int _i = 0; _i < 2; ++_i) \
        __builtin_amdgcn_raw_ptr_buffer_load_lds(rs, (PG8_LAS void*)(lds + (bufoff) + ldsw + _i * 8192), 16, (int)(voff)[_i], (int)(soff), 0, 0); } while (0)
#define PG8_LD2(P) __builtin_shufflevector(*(const PG8_LAS bf16x8*)(P), *(const PG8_LAS bf16x8*)((P) + 1024), 0, 1, 2, 3, 4, 5, 6, 7, 8, 9, 10, 11, 12, 13, 14, 15)
#define PG8_LDA(dst, b, h) do { _Pragma("unroll") for (int m = 0; m < 4; ++m) dst[m] = PG8_LD2(lds + PG8_SA(b, h) + aoff + m * 2048); } while (0)
#define PG8_LDB(dst, b, h) do { _Pragma("unroll") for (int n = 0; n < 2; ++n) dst[n] = PG8_LD2(lds + PG8_SB(b, h) + boff + n * 2048); } while (0)
#define PG8_LO(X) __builtin_shufflevector((X), (X), 0, 1, 2, 3, 4, 5, 6, 7)
#define PG8_HI(X) __builtin_shufflevector((X), (X), 8, 9, 10, 11, 12, 13, 14, 15)
#define PG8_MMA(ai, bj, At, Bt) do { __builtin_amdgcn_s_setprio(1); if constexpr (FP8) { _Pragma("unroll") for (int m = 0; m < 4; ++m) _Pragma("unroll") for (int n = 0; n < 2; ++n) \
        acc[ai][bj][m][n] = __builtin_amdgcn_mfma_scale_f32_16x16x128_f8f6f4(__builtin_bit_cast(i32x8, Bt[n]), __builtin_bit_cast(i32x8, At[m]), acc[ai][bj][m][n], 0, 0, 0, 0x7f7f7f7f, 0, 0x7f7f7f7f); \
        asm volatile("" : "+v"(acc[ai][bj][0][0]), "+v"(acc[ai][bj][0][1]), "+v"(acc[ai][bj][1][0]), "+v"(acc[ai][bj][1][1]), "+v"(acc[ai][bj][2][0]), "+v"(acc[ai][bj][2][1]), "+v"(acc[ai][bj][3][0]), "+v"(acc[ai][bj][3][1]));   } else { \
        _Pragma("unroll") for (int m = 0; m < 4; ++m) _Pragma("unroll") for (int n = 0; n < 2; ++n) { \
        acc[ai][bj][m][n] = __builtin_amdgcn_mfma_f32_16x16x32_bf16(PG8_LO(Bt[n]), PG8_LO(At[m]), acc[ai][bj][m][n], 0, 0, 0); \
        acc[ai][bj][m][n] = __builtin_amdgcn_mfma_f32_16x16x32_bf16(PG8_HI(Bt[n]), PG8_HI(At[m]), acc[ai][bj][m][n], 0, 0, 0); } } __builtin_amdgcn_s_setprio(0); } while (0)
#define PG8_WAIT_V(n) asm volatile("s_waitcnt vmcnt(" #n ")" ::: "memory")
#define PG8_WAIT_L(n) asm volatile("s_waitcnt lgkmcnt(" #n ")" ::: "memory")
#define PG8_WAIT_V8S do { if (t != 0 || pst == 0) PG8_WAIT_V(8); else if (pst == Epi::NSTORE) asm volatile("s_waitcnt vmcnt(%0)" :: "n"(8 + Epi::NSTORE) : "memory"); else asm volatile("s_waitcnt vmcnt(%0)" :: "n"(8 + Epi::NSTORE / 2) : "memory"); } while (0)
#define PG8_BAR __builtin_amdgcn_s_barrier()
#define PG8_SCHED __builtin_amdgcn_sched_barrier(0)
    Unit cur, nxt; int ui = 0, pst = 0;
    if (!S.next(0, cur)) return;
    f32x4 acc[2][2][4][2];
    float z0_ = 0.f; asm volatile("" : "+v"(z0_));
#pragma unroll
    for (int a = 0; a < 2; ++a)
#pragma unroll
        for (int b = 0; b < 2; ++b)
#pragma unroll
            for (int m = 0; m < 4; ++m)
#pragma unroll
                for (int n = 0; n < 2; ++n) acc[a][b][m][n] = (f32x4){z0_, z0_, z0_, z0_};
    bf16x16 At[4], B0[2], B1[2];
    unsigned cA = (unsigned)cur.pm * tstepA + (cur.hs == 2 ? hstepA : 0u), cB = (unsigned)cur.pn * tstepB;
    S.a_ready(cur);
    if constexpr (SP2) {
        PG8_STAGE(PG8_SB(0, 0), cB, voffB, rB); PG8_STAGE(PG8_SB(0, 1), cB + hstepB, voffB, rB); PG8_STAGE(PG8_SA(0, 0), cA, voffA, rA); PG8_STAGE(PG8_SA(0, 1), cA + hstepA, voffA, rA);
        if (wr == 1) PG8_BAR;
        PG8_WAIT_V(2); PG8_BAR;
        PG8_STAGE(PG8_SB(1, 0), cB + kstep, voffB, rB); PG8_STAGE(PG8_SA(1, 0), cA + kstep, voffA, rA); PG8_STAGE(PG8_SB(1, 1), cB + hstepB + kstep, voffB, rB);
        PG8_WAIT_V(6); PG8_BAR;
    } else {
        PG8_STAGE(PG8_SB(0, 0), cB, voffB, rB); PG8_STAGE(PG8_SA(0, 0), cA, voffA, rA); PG8_STAGE(PG8_SB(0, 1), cB + hstepB, voffB, rB); PG8_STAGE(PG8_SA(0, 1), cA + hstepA, voffA, rA);
        if (wr == 1) PG8_BAR;
        PG8_WAIT_V(4); PG8_BAR;
        PG8_STAGE(PG8_SB(1, 0), cB + kstep, voffB, rB); PG8_STAGE(PG8_SA(1, 0), cA + kstep, voffA, rA); PG8_STAGE(PG8_SB(1, 1), cB + hstepB + kstep, voffB, rB);
        PG8_WAIT_V(6); PG8_BAR;
    }
    for (;;) {
        const bool has_next = S.next(ui + 1, nxt);
        if constexpr (Epi::BIAS_LDS) { if (wid == 0) { int lb_; asm volatile("v_mbcnt_lo_u32_b32 %0, -1, 0\n\tv_mbcnt_hi_u32_b32 %0, -1, %0" : "=v"(lb_)); E.stage_bias(cur, (PG8_LAS void*)(lds + STAGE_BYTES + (ui & 1) * 1024), lb_); } }
        const unsigned nA = has_next ? (unsigned)nxt.pm * tstepA + (nxt.hs == 2 ? hstepA : 0u) : cA, nB = has_next ? (unsigned)nxt.pn * tstepB : cB;
        const bool chalf = cur.hs != 0;
        for (int t = 0; t < nt; t += 2) {
            const bool last = (t == nt - 2);
            const unsigned a1 = cA + (unsigned)(t + 1) * kstep;
            const unsigned a2 = last ? nA : cA + (unsigned)(t + 2) * kstep, b2 = last ? nB : cB + (unsigned)(t + 2) * kstep;
            const unsigned a3 = a2 + kstep, b3 = b2 + kstep;
            if (last && has_next) S.a_ready(nxt);
            if constexpr (SP2) {
            PG8_LDB(B0, 0, 0); PG8_LDB(B1, 0, 1); PG8_SCHED; PG8_LDA(At, 0, 0); PG8_STAGE(PG8_SA(1, 1), a1 + hstepA, voffA, rA);
            PG8_WAIT_V8S; PG8_WAIT_L(0); PG8_BAR; PG8_MMA(0, 0, At, B0); PG8_MMA(0, 1, At, B1); PG8_BAR; PG8_SCHED;
            PG8_LDA(At, 0, 1); PG8_STAGE(PG8_SB(0, 0), b2, voffB, rB); PG8_STAGE(PG8_SB(0, 1), b2 + hstepB, voffB, rB); PG8_STAGE(PG8_SA(0, 0), a2, voffA, rA);
            PG8_WAIT_V8S; PG8_WAIT_L(0); PG8_BAR; if (!chalf) { PG8_MMA(1, 0, At, B0); PG8_MMA(1, 1, At, B1); } PG8_BAR; PG8_SCHED;
            PG8_LDB(B0, 1, 0); PG8_LDB(B1, 1, 1); PG8_SCHED; PG8_LDA(At, 1, 0); PG8_STAGE(PG8_SA(0, 1), a2 + hstepA, voffA, rA);
            PG8_WAIT_V(8); PG8_WAIT_L(0); PG8_BAR; PG8_MMA(0, 0, At, B0); PG8_MMA(0, 1, At, B1); PG8_BAR; PG8_SCHED;
            PG8_LDA(At, 1, 1); PG8_STAGE(PG8_SB(1, 0), b3, voffB, rB); PG8_STAGE(PG8_SB(1, 1), b3 + hstepB, voffB, rB); PG8_STAGE(PG8_SA(1, 0), a3, voffA, rA);
            PG8_WAIT_V(8); PG8_WAIT_L(0); PG8_BAR; if (!chalf) { PG8_MMA(1, 0, At, B0); PG8_MMA(1, 1, At, B1); } PG8_BAR; PG8_SCHED;
            } else {
            PG8_LDB(B0, 0, 0); PG8_SCHED; PG8_LDA(At, 0, 0); PG8_STAGE(PG8_SA(1, 1), a1 + hstepA, voffA, rA);
            PG8_WAIT_L(8); PG8_BAR; PG8_WAIT_L(0); PG8_MMA(0, 0, At, B0); PG8_BAR; PG8_SCHED;
            PG8_LDB(B1, 0, 1); PG8_STAGE(PG8_SB(0, 0), b2, voffB, rB);
            PG8_BAR; PG8_WAIT_L(0); PG8_MMA(0, 1, At, B1); PG8_BAR;
            PG8_LDA(At, 0, 1); PG8_STAGE(PG8_SA(0, 0), a2, voffA, rA);
            PG8_BAR; PG8_WAIT_L(0); PG8_MMA(1, 0, At, B0); PG8_BAR; PG8_SCHED;
            PG8_STAGE(PG8_SB(0, 1), b2 + hstepB, voffB, rB);
            PG8_WAIT_V(6); PG8_BAR; PG8_MMA(1, 1, At, B1); PG8_BAR;
            PG8_LDB(B0, 1, 0); PG8_SCHED; PG8_LDA(At, 1, 0); PG8_STAGE(PG8_SA(0, 1), a2 + hstepA, voffA, rA);
            PG8_WAIT_L(8); PG8_BAR; PG8_WAIT_L(0); PG8_MMA(0, 0, At, B0); PG8_BAR; PG8_SCHED;
            PG8_LDB(B1, 1, 1); PG8_STAGE(PG8_SB(1, 0), b3, voffB, rB);
            PG8_BAR; PG8_WAIT_L(0); PG8_MMA(0, 1, At, B1); PG8_BAR;
            PG8_LDA(At, 1, 1); PG8_STAGE(PG8_SA(1, 0), a3, voffA, rA);
            PG8_BAR; PG8_WAIT_L(0); PG8_MMA(1, 0, At, B0); PG8_BAR; PG8_SCHED;
            PG8_STAGE(PG8_SB(1, 1), b3 + hstepB, voffB, rB);
            PG8_WAIT_V(6); PG8_BAR; PG8_MMA(1, 1, At, B1); PG8_BAR;
            }
        }
        if constexpr (ALIGN_EPI) { if (wr == 0) PG8_BAR; }
        if constexpr (!Epi::AFTER_DRAIN) { int l_; asm volatile("v_mbcnt_lo_u32_b32 %0, -1, 0\n\tv_mbcnt_hi_u32_b32 %0, -1, %0" : "=v"(l_)); if constexpr (Epi::BIAS_LDS) E(acc, cur, wr, wc, l_ & 15, l_ >> 4, (const PG8_LAS float*)(lds + STAGE_BYTES + (ui & 1) * 1024)); else E(acc, cur, wr, wc, l_ & 15, l_ >> 4); S.done(cur); }
        if (!has_next) break;
        asm volatile("" : "+v"(z0_));
#pragma unroll
        for (int a = 0; a < 2; ++a)
#pragma unroll
            for (int b = 0; b < 2; ++b)
#pragma unroll
                for (int m = 0; m < 4; ++m)
#pragma unroll
                    for (int n = 0; n < 2; ++n) acc[a][b][m][n] = (f32x4){z0_, z0_, z0_, z0_};
        pst = cur.hs ? Epi::NSTORE / 2 : Epi::NSTORE; cur = nxt; cA = nA; cB = nB; ++ui;
        if constexpr (ALIGN_EPI) { if (wr == 1) PG8_BAR; }
    }
    PG8_WAIT_V(0);
    if constexpr (!ALIGN_EPI) { if (wr == 0) PG8_BAR; }
    PG8_BAR;
    if constexpr (Epi::AFTER_DRAIN) { E.fused(acc, cur, wr, wc, fr, fq, lds, wid, lane); S.done(cur); }
#undef PG8_SA
#undef PG8_SB
#undef PG8_STAGE
#undef PG8_LDA
#undef PG8_LDB
#undef PG8_MMA
#undef PG8_LD2
#undef PG8_LO
#undef PG8_HI
#undef PG8_WAIT_V
#undef PG8_WAIT_L
#undef PG8_WAIT_V8S
#undef PG8_BAR
#undef PG8_SCHED
}
}

constexpr int NB = 4, SEQ = 4096, T = NB * SEQ, D = 1024, DEPTH = 4, NEXP = 32, DEXP = 1024, MEML = 256;
constexpr int CAPROWS = 16384;
constexpr float LN_EPS = 1e-5f, ALPHA = 1.681792830507429f;
constexpr float LOG2E = 1.4426950408889634f, C2 = 0.125f * 1.4426950408889634f;
constexpr float NEG_BIG = -1.0e30f;
constexpr float NEG_RAW = -0x1p100f;
constexpr int NWAVES = 8, NTHREADS = 512;

constexpr size_t MiB = 1u << 20;
constexpr size_t WS_CTL = 0, CTL_ZERO_BYTES = 65536;
constexpr size_t WS_ROPE = 1 * MiB;
constexpr size_t WS_WUQ = 2 * MiB;
constexpr size_t WS_MEMB = 3 * MiB;
constexpr size_t WS_KVMEM = 5 * MiB;
constexpr size_t WS_WKV = 9 * MiB;
constexpr size_t WS_WOUT = 13 * MiB;
constexpr size_t WS_WIN = 21 * MiB;
constexpr size_t WS_SSQ = 41 * MiB;
constexpr size_t WS_ROWS = 42 * MiB;
constexpr size_t WS_GATES = 43 * MiB;
constexpr size_t WS_MASK = 44 * MiB;
constexpr size_t WS_XB = 52 * MiB;
constexpr size_t WS_CAT = 84 * MiB;
constexpr size_t WS_Y = 116 * MiB;
constexpr size_t WS_QQ = 148 * MiB;
constexpr size_t WS_PROJ = 188 * MiB;
constexpr size_t WS_XB8 = 268 * MiB;
constexpr size_t WS_XA = 268 * MiB;
constexpr size_t WS_XM = 332 * MiB;
constexpr size_t WS_WGU = 400 * MiB;
constexpr size_t WS_WDN = 912 * MiB;
constexpr size_t WS_XP = 1168 * MiB;
constexpr size_t WS_ACT = 2192 * MiB;
constexpr size_t WS_END = 3216 * MiB;
constexpr int CW_TMO = 0, CW_ERR = 2;
constexpr int CW_BAR = 4096;
constexpr int CW_QHEAD = 8192;
constexpr int CW_GCOUNT = 9216;
constexpr int CW_BAR2 = 12288;
constexpr int CW_GDUMMY = 9472;
static_assert((CW_BAR2 + 3456) * 4 <= (int)CTL_ZERO_BYTES && (CW_GDUMMY + 128) * 4 <= (int)CTL_ZERO_BYTES, "CTL words inside the memset region");

constexpr int RING_OFF = 0, RING_BYTES = 131072;
constexpr int LDSCTL_OFF = 143360;
constexpr int L_XB = LDSCTL_OFF + 0;
constexpr int L_Q = LDSCTL_OFF + 16;
constexpr int L_XB2 = LDSCTL_OFF + 32;
constexpr int L_PREF = LDSCTL_OFF + 64;
constexpr int L_TILES = LDSCTL_OFF + 256;
constexpr int L_CNT = LDSCTL_OFF + 384;
constexpr int L_BASE = LDSCTL_OFF + 512;
constexpr int L_ROUTE = LDSCTL_OFF + 1024;
constexpr int LDS_BYTES = 147456;

#define GAS __attribute__((address_space(1)))
#define LAS __attribute__((address_space(3)))
typedef unsigned short bf16;
typedef unsigned u32x4 __attribute__((ext_vector_type(4)));
typedef unsigned u32x2 __attribute__((ext_vector_type(2)));
typedef float f32x4 __attribute__((ext_vector_type(4)));
typedef float f32x2 __attribute__((ext_vector_type(2)));
typedef float f32x16 __attribute__((ext_vector_type(16)));
typedef short bf16x8 __attribute__((ext_vector_type(8)));
typedef short s16x4 __attribute__((ext_vector_type(4)));
typedef short v4i16_t __attribute__((ext_vector_type(4)));
typedef GAS unsigned gu32;
#define RLX_AGENT __ATOMIC_RELAXED, __HIP_MEMORY_SCOPE_AGENT
__device__ __forceinline__ unsigned pk2(float lo, float hi) { return pg8::cvt_pk_bf16(lo, hi); }
__device__ __forceinline__ float bf2f(bf16 b) { return __uint_as_float((unsigned)b << 16); }
__device__ __forceinline__ float bflo(unsigned w) { return __uint_as_float(w << 16); }
__device__ __forceinline__ float bfhi(unsigned w) { return __uint_as_float(w & 0xffff0000u); }
__device__ __forceinline__ int crow(int r, int hi) { return (r & 3) + 8 * (r >> 2) + 4 * hi; }
__device__ __forceinline__ float swapmax(float m) { auto rr = __builtin_amdgcn_permlane32_swap(__float_as_uint(m), __float_as_uint(m), false, false); return fmaxf(__uint_as_float(rr[0]), __uint_as_float(rr[1])); }
__device__ __forceinline__ float swapsum(float m) { auto rr = __builtin_amdgcn_permlane32_swap(__float_as_uint(m), __float_as_uint(m), false, false); return __uint_as_float(rr[0]) + __uint_as_float(rr[1]); }
__device__ __forceinline__ int lane_id_now() { int l; asm volatile("v_mbcnt_lo_u32_b32 %0, -1, 0\n\tv_mbcnt_hi_u32_b32 %0, -1, %0" : "=v"(l)); return l; }
__device__ __forceinline__ float shx(float v, int m) { return __int_as_float(__builtin_amdgcn_ds_bpermute((lane_id_now() ^ m) << 2, __float_as_int(v))); }
__device__ __forceinline__ int shxi(int v, int m) { return __builtin_amdgcn_ds_bpermute((lane_id_now() ^ m) << 2, v); }
__device__ __forceinline__ int shli(int v, int src) { return __builtin_amdgcn_ds_bpermute(src << 2, v); }
__device__ __forceinline__ float wave_sum(float v) {
#define WS_DPP(CTRL) v += __int_as_float(__builtin_amdgcn_update_dpp(0, __float_as_int(v), (CTRL), 0xF, 0xF, false))
    WS_DPP(0xB1); WS_DPP(0x4E); WS_DPP(0x141); WS_DPP(0x140);
#undef WS_DPP
    const float r0 = __int_as_float(__builtin_amdgcn_readlane(__float_as_int(v), 0)), r1 = __int_as_float(__builtin_amdgcn_readlane(__float_as_int(v), 16));
    const float r2 = __int_as_float(__builtin_amdgcn_readlane(__float_as_int(v), 32)), r3 = __int_as_float(__builtin_amdgcn_readlane(__float_as_int(v), 48));
    return (r0 + r1) + (r2 + r3);
}

#define XB_TMO      128
#define XB_XCNT(j)  (256  + 64 * (j))
#define XB_XSUB(j)  (1280 + 64 * (j))
#define XB_XGEN(j)  (2304 + 64 * (j))
#define XB_TOP      3328
#define XB_TOPGEN   3392
#define XCD_BAR_WORDS 3456
#define XB_SPIN_CAP (1u << 18)

__device__ __forceinline__ unsigned xb_ld(unsigned* p)              { return __hip_atomic_load(p, __ATOMIC_RELAXED, __HIP_MEMORY_SCOPE_AGENT); }
__device__ __forceinline__ unsigned xb_add(unsigned* p, unsigned v) { return __hip_atomic_fetch_add(p, v, __ATOMIC_RELAXED, __HIP_MEMORY_SCOPE_AGENT); }
__device__ __forceinline__ unsigned xb_xcc_id() { return (unsigned)__builtin_amdgcn_s_getreg((3 << 11) | 20) & 0xFu; }
#define XB_SPIN(cond, bar) do { unsigned _sp = 0; while (cond) { __builtin_amdgcn_s_sleep(1); \
    if ((++_sp & 255u) == 0u) { if (xb_ld(&(bar)[XB_TMO])) break; if (_sp > XB_SPIN_CAP) { atomicAdd(&(bar)[XB_TMO], 1u); break; } } } } while (0)

struct XcdBarrier {
    unsigned* bar; unsigned x;
    volatile LAS unsigned* st;
};

__device__ __forceinline__ XcdBarrier xcd_barrier_post(unsigned* bar, volatile LAS unsigned* st) {
    XcdBarrier b; b.bar = bar; b.x = xb_xcc_id(); b.st = st;
    if (threadIdx.x == 0) (void)xb_add(&bar[XB_XCNT(b.x)], 1u);
    return b;
}
__device__ __forceinline__ void xcd_barrier_complete(unsigned* bar, unsigned x, unsigned& nloc, unsigned& nx, const unsigned G) {
    unsigned sum, cnt, mine, sp = 0u;
    for (;;) {
        sum = 0u; cnt = 0u; mine = 0u;
#pragma unroll
        for (unsigned j = 0; j < 16; ++j) { const unsigned c = xb_ld(&bar[XB_XCNT(j)]); sum += c; cnt += (c > 0u) ? 1u : 0u; mine = (j == x) ? c : mine; }
        if (sum == G) break;
        __builtin_amdgcn_s_sleep(1);
        if ((++sp & 255u) == 0u) { if (xb_ld(&bar[XB_TMO])) break; if (sp > XB_SPIN_CAP) { atomicAdd(&bar[XB_TMO], 1u); break; } }
    }
    nloc = mine > 0u ? mine : 1u; nx = cnt > 0u ? cnt : 1u;
}

__device__ __noinline__ void xcd_barrier_ni(unsigned* bar_, unsigned x_, unsigned st_off, bool leader_thread, unsigned G_) {
    XcdBarrier b; b.bar = bar_; b.x = x_; b.st = (volatile LAS unsigned*)(uintptr_t)st_off;
    asm volatile("s_waitcnt vmcnt(0)" ::: "memory");
    __syncthreads();
    if (leader_thread) {
        unsigned* bar = b.bar;
        __builtin_amdgcn_s_waitcnt(0);
        unsigned nloc = b.st[0], nx = b.st[1];
        if (nloc == 0u) { xcd_barrier_complete(bar, b.x, nloc, nx, G_); b.st[0] = nloc; b.st[1] = nx; }
        const unsigned old = xb_add(&bar[XB_XSUB(b.x)], 1u);
        const unsigned gen = old / nloc;
        if (old + 1u == (gen + 1u) * nloc) {
            __builtin_amdgcn_fence(__ATOMIC_RELEASE, "agent");
            asm volatile("s_waitcnt vmcnt(0)" ::: "memory");
            const unsigned og = xb_add(&bar[XB_TOP], 1u);
            const unsigned tg = og / nx;
            if (og + 1u == (tg + 1u) * nx) xb_add(&bar[XB_TOPGEN], 1u);
            else XB_SPIN(xb_ld(&bar[XB_TOPGEN]) == tg, bar);
            __builtin_amdgcn_fence(__ATOMIC_ACQUIRE, "agent");
            xb_add(&bar[XB_XGEN(b.x)], 1u);
            asm volatile("s_waitcnt vmcnt(0)" ::: "memory");
        } else {
            XB_SPIN(xb_ld(&bar[XB_XGEN(b.x)]) == gen, bar);
            __builtin_amdgcn_fence(__ATOMIC_ACQUIRE, "agent");
            asm volatile("s_waitcnt vmcnt(0)" ::: "memory");
        }
    }
    __syncthreads();
}
__device__ __forceinline__ void xcd_barrier(const XcdBarrier& b, bool leader_thread, unsigned G) { xcd_barrier_ni(b.bar, b.x, (unsigned)(uintptr_t)b.st, leader_thread, G); }

struct Frame {
    LAS unsigned char* lds;
    gu32* ctl;
    int tid, lane, wave, bid, G, vcu;
};
struct Job { const float* src; bf16* dst; const float* scale; int ldw, K, col0, nvalid, nblk, row0, item0, f8; float mul; int pad; };
constexpr int NJOBS = 16;
struct Args {
    const float* in[22]; float* out; unsigned char* ws; Job jobs[NJOBS];
    int njob_items, ph_lo, ph_hi, pad;
};
typedef const __attribute__((address_space(4))) Args* ArgsP;

struct TrItem { const float* src; const float* scale; bf16* dst; int ldw, k0, colbase, nvalid, perm, dstK, drow0, f8; float mul; };
__device__ __forceinline__ void tr_load(f32x4 (&v)[16], const TrItem& I, int lane, int wid) {
#pragma unroll
    for (int rr = 0; rr < 16; ++rr) {
        const int k = rr * 8 + wid, n = 4 * lane;
        const float* srow = I.src + (size_t)(I.k0 + k) * I.ldw + I.colbase;
        const int col = (I.perm && n >= 128) ? n + 896 : n;
        if (n + 3 < I.nvalid) v[rr] = __builtin_nontemporal_load((const f32x4*)(srow + col));
        else { f32x4 t; t[0] = (n < I.nvalid) ? srow[col] : 0.f; t[1] = (n + 1 < I.nvalid) ? srow[col + 1] : 0.f; t[2] = (n + 2 < I.nvalid) ? srow[col + 2] : 0.f; t[3] = 0.f; v[rr] = t; }
    }
}
__device__ __forceinline__ void tr_to_lds(const f32x4 (&v)[16], LAS float* scr, const TrItem& I, int lane, int wid) {
#pragma unroll
    for (int rr = 0; rr < 16; ++rr) {
        const int k = rr * 8 + wid;
        const float sc = I.scale ? I.scale[I.k0 + k] * I.mul : I.mul;
        *(LAS f32x4*)(scr + k * 256 + 4 * (lane ^ ((k >> 3) & 15))) = v[rr] * sc;
    }
}
__device__ __forceinline__ void tr_store(const LAS float* scr, const TrItem& I, int lane, int wid) {
#pragma unroll
    for (int q = 0; q < 8; ++q) {
        const int n = wid * 32 + q * 4 + (lane >> 4), a = lane & 15;
        const LAS float* s = scr + (8 * a) * 256 + 4 * ((n >> 2) ^ a) + (n & 3);
        if (I.f8) { u32x2 o; o.x = pg8::pk4_fp8(s[0], s[256], s[2 * 256], s[3 * 256]); o.y = pg8::pk4_fp8(s[4 * 256], s[5 * 256], s[6 * 256], s[7 * 256]);
            __builtin_nontemporal_store(o, (u32x2*)((unsigned char*)I.dst + (size_t)(I.drow0 + n) * I.dstK + I.k0 + 8 * a)); }
        else { u32x4 o; o.x = pk2(s[0], s[256]); o.y = pk2(s[2 * 256], s[3 * 256]); o.z = pk2(s[4 * 256], s[5 * 256]); o.w = pk2(s[6 * 256], s[7 * 256]);
            *(u32x4*)(I.dst + (size_t)(I.drow0 + n) * I.dstK + I.k0 + 8 * a) = o; }
    }
}
__device__ __forceinline__ void sincos_d(double x, float& c, float& s) {
    const double TWO_PI = 6.283185307179586476925, INV_2PI = 0.15915494309189533577;
    const double r = x - TWO_PI * rint(x * INV_2PI), r2 = r * r;
    double sn = 1.0, cs = 1.0;
#pragma unroll
    for (int k = 14; k >= 1; --k) { sn = 1.0 - sn * r2 / (double)((2 * k) * (2 * k + 1)); cs = 1.0 - cs * r2 / (double)((2 * k - 1) * (2 * k)); }
    s = (float)(sn * r); c = (float)cs;
}
constexpr int MOE_ITEMS = DEPTH * NEXP * 96, MOE_ITEMS_LAYER = NEXP * 96;
#ifndef MK_CVT_LAYERS_P0
#define MK_CVT_LAYERS_P0 4
#endif
__device__ __forceinline__ TrItem tr_decode(ArgsP A, unsigned char* ws, int it) {
    TrItem I;
    if (it < MOE_ITEMS) {
        const int le = it / 96, r = it % 96; I.scale = nullptr; I.nvalid = 256; I.dstK = 1024; I.f8 = 1;
        if (r < 64) { const int kb = r >> 3, nb = r & 7; I.src = A->in[16] + (size_t)le * (1024 * 2048); I.ldw = 2048; I.k0 = kb * 128; I.colbase = nb * 128; I.perm = 1;
            I.dst = (bf16*)(ws + WS_WGU + (size_t)le * (2048 * 1024)); I.drow0 = nb * 256; I.mul = 64.0f; }
        else { const int r2 = r - 64, kb = r2 >> 2, nb = r2 & 3; I.src = A->in[18] + (size_t)le * (1024 * 1024); I.ldw = 1024; I.k0 = kb * 128; I.colbase = nb * 256; I.perm = 0;
            I.dst = (bf16*)(ws + WS_WDN + (size_t)le * (1024 * 1024)); I.drow0 = nb * 256; I.mul = 128.0f; }
    } else {
        const int ji = it - MOE_ITEMS; int j = 0;
#pragma unroll
        for (int q = 1; q < NJOBS; ++q) j += (A->jobs[q].item0 <= ji) ? 1 : 0;
        const int K = A->jobs[j].K, r = ji - A->jobs[j].item0, nkb = K >> 7, kb = r % nkb, nb = r / nkb;
        int nv = A->jobs[j].nvalid - nb * 256; nv = nv < 0 ? 0 : (nv > 256 ? 256 : nv);
        I.src = A->jobs[j].src; I.scale = A->jobs[j].scale; I.dst = A->jobs[j].dst; I.ldw = A->jobs[j].ldw; I.k0 = kb * 128; I.colbase = A->jobs[j].col0 + nb * 256; I.nvalid = nv; I.perm = 0;
        I.dstK = K; I.drow0 = A->jobs[j].row0 + nb * 256; I.f8 = A->jobs[j].f8; I.mul = A->jobs[j].mul;
    }
    return I;
}
__device__ __forceinline__ void tr_run(Frame& F, ArgsP A, unsigned char* ws, int j0, int step, int j1, int split, int gap) {
    LAS float* scr = (LAS float*)(F.lds + RING_OFF);
#define TR_ITEM(jj) tr_decode(A, ws, (jj) < split ? (jj) : (jj) + gap)
    if (j0 < j1) {
        f32x4 vA[16], vB[16];
        TrItem ia = TR_ITEM(j0), ib = ia;
        tr_load(vA, ia, F.lane, F.wave);
        if (j0 + step < j1) { ib = TR_ITEM(j0 + step); tr_load(vB, ib, F.lane, F.wave); }
        for (int j = j0; j < j1; j += 2 * step) {
            tr_to_lds(vA, scr, ia, F.lane, F.wave);
            __syncthreads();
            const TrItem ca = ia;
            if (j + 2 * step < j1) { ia = TR_ITEM(j + 2 * step); tr_load(vA, ia, F.lane, F.wave); }
            tr_store(scr, ca, F.lane, F.wave);
            __syncthreads();
            if (j + step < j1) {
                tr_to_lds(vB, scr, ib, F.lane, F.wave);
                __syncthreads();
                const TrItem cb = ib;
                if (j + 3 * step < j1) { ib = TR_ITEM(j + 3 * step); tr_load(vB, ib, F.lane, F.wave); }
                tr_store(scr, cb, F.lane, F.wave);
                __syncthreads();
            }
        }
    }
#undef TR_ITEM
}
__device__ __forceinline__ void p0_prologue(Frame& F, ArgsP A, unsigned char* ws, const int part) {
    constexpr int NP0 = MK_CVT_LAYERS_P0 * MOE_ITEMS_LAYER;
    const int total = NP0 + A->njob_items;
    const int it_lo = (part == 1) ? NP0 : 0, it_hi = (part == 2) ? NP0 : total;
    tr_run(F, A, ws, it_lo + F.bid, F.G, it_hi, NP0, MOE_ITEMS - NP0);
    if (part == 2) return;
    const size_t gt = (size_t)F.bid * NTHREADS + F.tid, NT = (size_t)F.G * NTHREADS;
    { const float* x = A->in[0]; bf16* xb = (bf16*)(ws + WS_XB);
      for (size_t i = gt; i < (size_t)T * D / 8; i += 4 * NT) {
          f32x4 a[4], b[4];
#pragma unroll
          for (int k = 0; k < 4; ++k) if (i + k * NT < (size_t)T * D / 8) { a[k] = *(const f32x4*)(x + (i + k * NT) * 8); b[k] = *(const f32x4*)(x + (i + k * NT) * 8 + 4); }
#pragma unroll
          for (int k = 0; k < 4; ++k) if (i + k * NT < (size_t)T * D / 8) { u32x4 o; o.x = pk2(a[k][0], a[k][1]); o.y = pk2(a[k][2], a[k][3]); o.z = pk2(b[k][0], b[k][1]); o.w = pk2(b[k][2], b[k][3]); *(u32x4*)(xb + (i + k * NT) * 8) = o; } }
      const float* mm = A->in[1]; bf16* mb = (bf16*)(ws + WS_MEMB);
      for (size_t i = gt; i < (size_t)NB * MEML * D / 8; i += NT) { const f32x4 a = *(const f32x4*)(mm + i * 8), b = *(const f32x4*)(mm + i * 8 + 4);
          u32x4 o; o.x = pk2(a[0], a[1]); o.y = pk2(a[2], a[3]); o.z = pk2(b[0], b[1]); o.w = pk2(b[2], b[3]); *(u32x4*)(mb + i * 8) = o; } }
    { f32x2* rt = (f32x2*)(ws + WS_ROPE);
      for (size_t i = gt; i < (size_t)SEQ * 8; i += NT) { const int pos = (int)(i >> 3), k = (int)(i & 7);
          const double inv = k == 0 ? 1.0 : k == 1 ? 0.19392274474868576 : k == 2 ? 0.03760603093086393 : k == 3 ? 0.007292664737217109 : k == 4 ? 0.001414213562373095 : k == 5 ? 0.0002742481756762073 : k == 6 ? 5.318295896944988e-05 : 1.031338537721246e-05;
          float c, s; sincos_d((double)pos * inv, c, s); rt[i] = (f32x2){c, s}; } }
}

struct AttnP {
    const bf16* Q; const bf16* K; const bf16* V; bf16* O; const unsigned long long* mask;
    int ldq, ldk, ldv, ldo, qrow0, krow0, t_lo, t_hi, qpos0, mode, has_sink, o8; float sink2;
};
constexpr int AT_K0 = 0, AT_KSZ = 64 * 144, AT_V0 = 2 * AT_KSZ, AT_VSZ = 8192;
__device__ __forceinline__ s16x4 vtr(const LAS unsigned char* p) { return __builtin_bit_cast(s16x4, __builtin_amdgcn_ds_read_tr16_b64_v4i16((LAS v4i16_t*)p)); }
__device__ __forceinline__ void attn_unit(const Frame& F, const AttnP& P) {
    const int tid = F.tid, lane = F.lane, wid = F.wave, r32 = lane & 31, hi = lane >> 5;
    LAS unsigned char* lds = F.lds + RING_OFF;
    const int skey = tid >> 3, sc = tid & 7;
    const int kdst = skey * 144 + sc * 16;
    const int vdst = (sc >> 2) * 4096 + (skey >> 4) * 1024 + (skey & 15) * 64 + (sc & 3) * 16;
    const bf16* kg = P.K + (size_t)(P.krow0 + skey) * P.ldk + sc * 8;
    const bf16* vg = P.V + (size_t)(P.krow0 + skey) * P.ldv + sc * 8;
    const int qrow = P.qrow0 + wid * 32 + r32;
    bf16x8 qr[4];
#pragma unroll
    for (int d0 = 0; d0 < 4; ++d0) qr[d0] = *(const bf16x8*)(P.Q + (size_t)qrow * P.ldq + d0 * 16 + hi * 8);
    const int qmin = P.qpos0 + wid * 32, qmax = qmin + 31, qpos = qmin + r32;
    float m = P.has_sink ? P.sink2 : NEG_BIG;
    f32x16 o0 = {}, o1 = {}, lacc;
#pragma unroll
    for (int r = 0; r < 16; ++r) lacc[r] = P.has_sink ? 1.f : 0.f;
    const bf16x8 ones8 = (bf16x8){0x3f80, 0x3f80, 0x3f80, 0x3f80, 0x3f80, 0x3f80, 0x3f80, 0x3f80};
    const int vp0 = ((lane >> 4) & 1) * 32 + (lane & 3) * 8 + (4 * hi + ((lane & 15) >> 2)) * 64;
    u32x4 kreg = *(const u32x4*)(kg + (size_t)P.t_lo * 64 * P.ldk), vreg = *(const u32x4*)(vg + (size_t)P.t_lo * 64 * P.ldv);
    const unsigned long long* mrow = P.mode == 2 ? P.mask + (size_t)(wid * 32 + r32) * 64 : nullptr;
    unsigned long long mcur = 0ull, mnxt = P.mode == 2 ? mrow[P.t_lo] : 0ull;
    *(LAS u32x4*)(lds + AT_K0 + kdst) = kreg; *(LAS u32x4*)(lds + AT_V0 + vdst) = vreg;
    __syncthreads();
    for (int t = P.t_lo; t < P.t_hi; ++t) {
        const int cur = (t - P.t_lo) & 1;
        const bool more = (t + 1 < P.t_hi);
        mcur = mnxt;
        if (more) { kreg = *(const u32x4*)(kg + (size_t)(t + 1) * 64 * P.ldk); vreg = *(const u32x4*)(vg + (size_t)(t + 1) * 64 * P.ldv); if (P.mode == 2) mnxt = mrow[t + 1]; }
        bool active = true;
        if (P.mode == 1) active = (64 * t + 63 >= qmin - 127) && (64 * t <= qmax);
        if (P.mode == 2) active = (64 * t <= qmax);
        if (active) {
            const LAS unsigned char* Kb = lds + AT_K0 + cur * AT_KSZ; const LAS unsigned char* Vb = lds + AT_V0 + cur * AT_VSZ;
            f32x16 p0 = {}, p1 = {};
#pragma unroll
            for (int d0 = 0; d0 < 4; ++d0) {
                const bf16x8 a0 = *(const LAS bf16x8*)(Kb + r32 * 144 + (2 * d0 + hi) * 16);
                const bf16x8 a1 = *(const LAS bf16x8*)(Kb + (r32 + 32) * 144 + (2 * d0 + hi) * 16);
                p0 = __builtin_amdgcn_mfma_f32_32x32x16_bf16(a0, qr[d0], p0, 0, 0, 0);
                p1 = __builtin_amdgcn_mfma_f32_32x32x16_bf16(a1, qr[d0], p1, 0, 0, 0);
            }
            float mx = fmaxf(p0[0], p1[0]);
#pragma unroll
            for (int r = 1; r < 16; ++r) mx = fmaxf(fmaxf(mx, p0[r]), p1[r]);
            mx = swapmax(mx) * C2;
            const float mnew = fmaxf(m, mx), alpha = __builtin_amdgcn_exp2f(m - mnew);
            m = mnew;
#pragma unroll
            for (int r = 0; r < 16; r += 2) {
                f32x2 a_ = {p0[r], p0[r + 1]}, b_ = {p1[r], p1[r + 1]}; const f32x2 c2_ = {C2, C2}, nm_ = {-mnew, -mnew};
                a_ = __builtin_elementwise_fma(a_, c2_, nm_); b_ = __builtin_elementwise_fma(b_, c2_, nm_);
                p0[r] = __builtin_amdgcn_exp2f(a_[0]); p0[r + 1] = __builtin_amdgcn_exp2f(a_[1]); p1[r] = __builtin_amdgcn_exp2f(b_[0]); p1[r + 1] = __builtin_amdgcn_exp2f(b_[1]); }
            if (P.mode == 1) {
                const int rel = qpos - 64 * t - 4 * hi;
#pragma unroll
                for (int r = 0; r < 16; ++r) { const int c = (r & 3) + 8 * (r >> 2);
                    p0[r] = ((unsigned)(rel - c) < 128u) ? p0[r] : 0.f; p1[r] = ((unsigned)(rel - c - 32) < 128u) ? p1[r] : 0.f; }
            } else if (P.mode == 2) {
                const unsigned long long w = mcur >> (4 * hi);
                const int wl = (int)(unsigned)w, wh = (int)(unsigned)(w >> 32);
#pragma unroll
                for (int r = 0; r < 16; ++r) { const int c = (r & 3) + 8 * (r >> 2);
                    int d0_ = __builtin_amdgcn_sbfe(wl, c, 1), d1_ = __builtin_amdgcn_sbfe(wh, c, 1); asm("" : "+v"(d0_), "+v"(d1_));
                    p0[r] = __uint_as_float(__float_as_uint(p0[r]) & (unsigned)d0_); p1[r] = __uint_as_float(__float_as_uint(p1[r]) & (unsigned)d1_); }
            }
            if (__any(alpha != 1.0f)) {
#pragma unroll
                for (int r = 0; r < 16; ++r) { o0[r] *= alpha; o1[r] *= alpha; lacc[r] *= alpha; }
            }
            bf16x8 pf[4];
            { u32x4 w;
              w.x = pk2(p0[0], p0[1]); w.y = pk2(p0[2], p0[3]); w.z = pk2(p0[4], p0[5]); w.w = pk2(p0[6], p0[7]); pf[0] = __builtin_bit_cast(bf16x8, w);
              w.x = pk2(p0[8], p0[9]); w.y = pk2(p0[10], p0[11]); w.z = pk2(p0[12], p0[13]); w.w = pk2(p0[14], p0[15]); pf[1] = __builtin_bit_cast(bf16x8, w);
              w.x = pk2(p1[0], p1[1]); w.y = pk2(p1[2], p1[3]); w.z = pk2(p1[4], p1[5]); w.w = pk2(p1[6], p1[7]); pf[2] = __builtin_bit_cast(bf16x8, w);
              w.x = pk2(p1[8], p1[9]); w.y = pk2(p1[10], p1[11]); w.z = pk2(p1[12], p1[13]); w.w = pk2(p1[14], p1[15]); pf[3] = __builtin_bit_cast(bf16x8, w); }
#pragma unroll
            for (int ks = 0; ks < 4; ++ks) {
                const s16x4 a_lo = vtr(Vb + vp0 + ks * 1024), a_hi = vtr(Vb + vp0 + ks * 1024 + 512);
                const s16x4 b_lo = vtr(Vb + vp0 + 4096 + ks * 1024), b_hi = vtr(Vb + vp0 + 4096 + ks * 1024 + 512);
                const bf16x8 va = (bf16x8){a_lo[0], a_lo[1], a_lo[2], a_lo[3], a_hi[0], a_hi[1], a_hi[2], a_hi[3]};
                const bf16x8 vb = (bf16x8){b_lo[0], b_lo[1], b_lo[2], b_lo[3], b_hi[0], b_hi[1], b_hi[2], b_hi[3]};
                o0 = __builtin_amdgcn_mfma_f32_32x32x16_bf16(va, pf[ks], o0, 0, 0, 0);
                o1 = __builtin_amdgcn_mfma_f32_32x32x16_bf16(vb, pf[ks], o1, 0, 0, 0);
                lacc = __builtin_amdgcn_mfma_f32_32x32x16_bf16(ones8, pf[ks], lacc, 0, 0, 0);
            }
        }
        if (more) { *(LAS u32x4*)(lds + AT_K0 + (cur ^ 1) * AT_KSZ + kdst) = kreg; *(LAS u32x4*)(lds + AT_V0 + (cur ^ 1) * AT_VSZ + vdst) = vreg; }
        __syncthreads();
    }
    const float inv = 1.0f / lacc[0];
    if (P.o8) {
        unsigned char* orow8 = (unsigned char*)P.O + (size_t)qrow * P.ldo + 4 * hi;
#pragma unroll
        for (int g = 0; g < 4; ++g) {
            *(unsigned*)(orow8 + 8 * g) = pg8::pk4_fp8(o0[4 * g] * inv, o0[4 * g + 1] * inv, o0[4 * g + 2] * inv, o0[4 * g + 3] * inv);
            *(unsigned*)(orow8 + 32 + 8 * g) = pg8::pk4_fp8(o1[4 * g] * inv, o1[4 * g + 1] * inv, o1[4 * g + 2] * inv, o1[4 * g + 3] * inv);
        }
        return;
    }
    bf16* orow = P.O + (size_t)qrow * P.ldo + 4 * hi;
#pragma unroll
    for (int g = 0; g < 4; ++g) {
        u32x2 w0, w1;
        w0.x = pk2(o0[4 * g] * inv, o0[4 * g + 1] * inv); w0.y = pk2(o0[4 * g + 2] * inv, o0[4 * g + 3] * inv);
        w1.x = pk2(o1[4 * g] * inv, o1[4 * g + 1] * inv); w1.y = pk2(o1[4 * g + 2] * inv, o1[4 * g + 3] * inv);
        *(u32x2*)(orow + 8 * g) = w0; *(u32x2*)(orow + 32 + 8 * g) = w1;
    }
}

__device__ __forceinline__ void conv_item(const bf16* PROJ, const float* cw, bf16* CAT, int idx) {
    const int chunk = idx % 96, run = idx / 96, c0 = chunk * 8, t0 = run * 16;
    float w0[8], w1[8], w2[8];
#pragma unroll
    for (int j = 0; j < 8; ++j) { w0[j] = cw[c0 + j]; w1[j] = cw[768 + c0 + j]; w2[j] = cw[1536 + c0 + j]; }
    float z1[8], z2[8];
#pragma unroll
    for (int j = 0; j < 8; ++j) { z1[j] = 0.f; z2[j] = 0.f; }
    if ((t0 & (SEQ - 1)) != 0) {
#pragma unroll
        for (int back = 2; back >= 1; --back) {
            const bf16* row = PROJ + (size_t)(t0 - back) * 2560;
            const u32x4 uu = *(const u32x4*)(row + c0), cc = *(const u32x4*)(row + 1536 + c0);
            float z[8];
            z[0] = bflo(uu.x) * bflo(cc.x); z[1] = bfhi(uu.x) * bfhi(cc.x); z[2] = bflo(uu.y) * bflo(cc.y); z[3] = bfhi(uu.y) * bfhi(cc.y);
            z[4] = bflo(uu.z) * bflo(cc.z); z[5] = bfhi(uu.z) * bfhi(cc.z); z[6] = bflo(uu.w) * bflo(cc.w); z[7] = bfhi(uu.w) * bfhi(cc.w);
#pragma unroll
            for (int j = 0; j < 8; ++j) { if (back == 2) z2[j] = z[j]; else z1[j] = z[j]; }
        }
    }
    u32x4 in_[2][4][3];
#define CONV_LOADG(G, S) do { _Pragma("unroll") for (int k = 0; k < 4; ++k) { const bf16* row = PROJ + (size_t)(t0 + 4 * (G) + k) * 2560; \
        in_[S][k][0] = *(const u32x4*)(row + c0); in_[S][k][1] = *(const u32x4*)(row + 768 + c0); in_[S][k][2] = *(const u32x4*)(row + 1536 + c0); } } while (0)
    CONV_LOADG(0, 0);
#pragma unroll
    for (int g = 0; g < 4; ++g) {
        if (g < 3) CONV_LOADG(g + 1, (g + 1) & 1);
#pragma unroll
        for (int k = 0; k < 4; ++k) {
            const int i = 4 * g + k;
            const u32x4 uu = in_[g & 1][k][0], bb = in_[g & 1][k][1], cc = in_[g & 1][k][2];
            float z[8], b[8], r[8];
            z[0] = bflo(uu.x) * bflo(cc.x); z[1] = bfhi(uu.x) * bfhi(cc.x); z[2] = bflo(uu.y) * bflo(cc.y); z[3] = bfhi(uu.y) * bfhi(cc.y);
            z[4] = bflo(uu.z) * bflo(cc.z); z[5] = bfhi(uu.z) * bfhi(cc.z); z[6] = bflo(uu.w) * bflo(cc.w); z[7] = bfhi(uu.w) * bfhi(cc.w);
            b[0] = bflo(bb.x); b[1] = bfhi(bb.x); b[2] = bflo(bb.y); b[3] = bfhi(bb.y); b[4] = bflo(bb.z); b[5] = bfhi(bb.z); b[6] = bflo(bb.w); b[7] = bfhi(bb.w);
#pragma unroll
            for (int j = 0; j < 8; ++j) { r[j] = b[j] * ((w0[j] * z2[j] + w1[j] * z1[j]) + w2[j] * z[j]); z2[j] = z1[j]; z1[j] = z[j]; }
            u32x4 o; o.x = pk2(r[0], r[1]); o.y = pk2(r[2], r[3]); o.z = pk2(r[4], r[5]); o.w = pk2(r[6], r[7]);
            (void)o; u32x2 o8_; o8_.x = pg8::pk4_fp8(r[0], r[1], r[2], r[3]); o8_.y = pg8::pk4_fp8(r[4], r[5], r[6], r[7]); *(u32x2*)((unsigned char*)CAT + (size_t)(t0 + i) * 1024 + c0) = o8_;
        }
    }
#undef CONV_LOADG
}

__device__ __forceinline__ void mixer_phase(Frame& F, ArgsP A, unsigned char* ws, int layer, int kind, int qidx) {
    const bf16* PROJ = (const bf16*)(ws + WS_PROJ); bf16* CAT = (bf16*)(ws + WS_CAT); const bf16* KVM = (const bf16*)(ws + WS_KVMEM) + layer * 512;
    const int nproj = kind == 0 ? 2560 : (kind == 1 ? 1280 : 1536), qm_off = kind == 0 ? 2304 : (kind == 1 ? 768 : 1280);
    const int n_main = kind == 0 ? 0 : 768, n_mem = 256, n_conv = kind == 0 ? 192 : 0;
    constexpr int CVT_PER = 12, N_CVT = (DEPTH - MK_CVT_LAYERS_P0) * MOE_ITEMS_LAYER / CVT_PER;
    const int n_cvt = (kind == 1) ? N_CVT : 0;
    const int total = n_main + n_mem + n_conv + n_cvt;
    volatile LAS unsigned* qw = (volatile LAS unsigned*)(F.lds + L_Q);
    for (;;) {
        if (F.tid == 0) *qw = __hip_atomic_fetch_add(F.ctl + CW_QHEAD + 64 * qidx, 1u, RLX_AGENT);
        __syncthreads();
        int u = (int)*qw;
        __syncthreads();
        if (u >= total) break;
        if (n_cvt) {
            if (u < 3 * n_cvt) { if (u % 3 == 2) { const int c = u / 3; tr_run(F, A, ws, MK_CVT_LAYERS_P0 * MOE_ITEMS_LAYER + c * CVT_PER, 1, MK_CVT_LAYERS_P0 * MOE_ITEMS_LAYER + c * CVT_PER + CVT_PER, MOE_ITEMS, 0); continue; } u = (u / 3) * 2 + u % 3; }
            else u -= n_cvt;
        }
        if (u < n_main) {
            AttnP P;
            if (kind == 1) {
                const int qt = 15 - u / 48, rem = u % 48, b = rem / 12, h = rem % 12, g = h / 3;
                P.Q = (const bf16*)(ws + WS_QQ) + h * 64; P.ldq = 1280; P.K = PROJ + 256 + g * 64; P.ldk = 1280; P.V = PROJ + 512 + g * 64; P.ldv = 1280;
                P.O = (bf16*)((unsigned char*)CAT + h * 64); P.ldo = 1024; P.o8 = 1; P.qrow0 = b * SEQ + qt * 256; P.krow0 = b * SEQ; P.t_lo = 0; P.t_hi = qt * 4 + 4; P.qpos0 = qt * 256; P.mode = 2;
                P.mask = (const unsigned long long*)(ws + WS_MASK) + (size_t)P.qrow0 * 64; P.has_sink = 0; P.sink2 = 0.f;
            } else {
                const int b = u / 192, h = (u / 16) % 12, qt = u % 16, g = h / 3;
                P.Q = PROJ + h * 64; P.ldq = 1536; P.K = PROJ + 768 + g * 64; P.ldk = 1536; P.V = PROJ + 1024 + g * 64; P.ldv = 1536;
                P.O = (bf16*)((unsigned char*)CAT + h * 64); P.ldo = 1024; P.o8 = 1; P.qrow0 = b * SEQ + qt * 256; P.krow0 = b * SEQ; P.qpos0 = qt * 256;
                P.t_lo = qt == 0 ? 0 : (qt * 256 - 128) / 64; P.t_hi = qt * 4 + 4; P.mode = 1; P.mask = nullptr; P.has_sink = 1; P.sink2 = A->in[9][h] * LOG2E;
            }
            attn_unit(F, P);
        } else if (u < n_main + n_mem) {
            const int v = u - n_main, b = v / 64, h = (v / 16) % 4, qt = v % 16;
            AttnP P;
            P.Q = PROJ + qm_off + h * 64; P.ldq = nproj; P.K = KVM + h * 64; P.ldk = 2048; P.V = KVM + 256 + h * 64; P.ldv = 2048;
            P.o8 = 1; P.O = P.o8 ? (bf16*)((unsigned char*)CAT + 768 + h * 64) : CAT + 768 + h * 64; P.ldo = 1024; P.qrow0 = b * SEQ + qt * 256; P.krow0 = b * MEML; P.t_lo = 0; P.t_hi = 4; P.qpos0 = qt * 256; P.mode = 0; P.mask = nullptr; P.has_sink = 0; P.sink2 = 0.f;
            attn_unit(F, P);
        } else {
            const int v = u - n_main - n_mem;
            conv_item(PROJ, A->in[3] + (size_t)(layer == 0 ? 0 : 1) * 3 * 768, CAT, v * NTHREADS + F.tid);
        }
    }
}

__device__ __forceinline__ void score_phase(Frame& F, const bf16* QQ, const bf16* PROJ, float* SC) {
    const int lane = F.lane, r32 = lane & 31, hi = lane >> 5;
    LAS float* wtab = (LAS float*)(F.lds + RING_OFF + F.wave * 1024);
    constexpr float WSCALE = 0.04419417382415922f;
    constexpr int PER_B = 576;
    const __amdgpu_buffer_rsrc_t scrs = __builtin_amdgcn_make_buffer_rsrc((void*)SC, 0, T * SEQ * 4, 0x00020000);
    for (int wu = F.bid * NWAVES + F.wave; wu < NB * PER_B; wu += F.G * NWAVES) {
        const int b = wu / PER_B, idx = PER_B - 1 - wu % PER_B;
        int g = 0;
        for (int k = 1; k < 8; ++k) g += (8 * k * (k + 1) <= idx) ? 1 : 0;
        const int r = idx - 8 * g * (g + 1), qb = 16 * g + r / (g + 1), c = r % (g + 1);
        const int kb_lo = 16 * c, kb_hi = (16 * c + 16 < qb + 1) ? 16 * c + 16 : qb + 1;
        const int t0 = b * SEQ + 32 * qb;
#pragma unroll
        for (int k = 0; k < 4; ++k) { const int i4 = lane * 4 + k, h = i4 >> 5, hh = (i4 >> 4) & 1, reg = i4 & 15;
            wtab[i4] = bf2f(PROJ[(size_t)(t0 + crow(reg, hh)) * 1280 + 1088 + h]) * WSCALE; }
        bf16x8 qA[8][4];
#pragma unroll
        for (int h = 0; h < 8; ++h)
#pragma unroll
            for (int st = 0; st < 4; ++st) qA[h][st] = *(const bf16x8*)(QQ + (size_t)(t0 + r32) * 1280 + 768 + h * 64 + st * 16 + hi * 8);
        const bf16* kbase = PROJ + (size_t)(b * SEQ + r32) * 1280 + 1024 + hi * 8;
        bf16x8 kA[4], kBf[4];
#pragma unroll
        for (int st = 0; st < 4; ++st) kA[st] = *(const bf16x8*)(kbase + (size_t)(32 * kb_lo) * 1280 + st * 16);
#define PS_BLOCK(KF, KB) do { f32x16 acc = {}; \
            _Pragma("unroll") for (int h = 0; h < 8; ++h) { f32x16 dd = {}; \
                _Pragma("unroll") for (int st = 0; st < 4; ++st) dd = __builtin_amdgcn_mfma_f32_32x32x16_bf16(qA[h][st], KF[st], dd, 0, 0, 0); \
                const LAS f32x4* wp = (const LAS f32x4*)(wtab + (h * 2 + hi) * 16); const f32x4 w0 = wp[0], w1 = wp[1], w2 = wp[2], w3 = wp[3]; \
                _Pragma("unroll") for (int q = 0; q < 4; ++q) { acc[q] = fmaf(w0[q], fmaxf(dd[q], 0.f), acc[q]); acc[4 + q] = fmaf(w1[q], fmaxf(dd[4 + q], 0.f), acc[4 + q]); \
                    acc[8 + q] = fmaf(w2[q], fmaxf(dd[8 + q], 0.f), acc[8 + q]); acc[12 + q] = fmaf(w3[q], fmaxf(dd[12 + q], 0.f), acc[12 + q]); } \
                if (h & 1) __builtin_amdgcn_sched_barrier(0); } \
            _Pragma("unroll") for (int reg = 0; reg < 16; ++reg) __builtin_amdgcn_raw_buffer_store_b32(__float_as_uint(acc[reg]), scrs, (4 * hi * SEQ + r32) * 4, ((t0 + (reg & 3) + 8 * (reg >> 2)) * SEQ + 32 * (KB)) * 4, 0); } while (0)
        for (int kb = kb_lo; kb < kb_hi; kb += 2) {
            __builtin_amdgcn_sched_barrier(0);
            if (kb + 1 < kb_hi) {
#pragma unroll
                for (int st = 0; st < 4; ++st) kBf[st] = *(const bf16x8*)(kbase + (size_t)(32 * (kb + 1)) * 1280 + st * 16);
            }
            __builtin_amdgcn_sched_barrier(0);
            PS_BLOCK(kA, kb);
            __builtin_amdgcn_sched_barrier(0);
            if (kb + 1 < kb_hi) {
                if (kb + 2 < kb_hi) {
#pragma unroll
                    for (int st = 0; st < 4; ++st) kA[st] = *(const bf16x8*)(kbase + (size_t)(32 * (kb + 2)) * 1280 + st * 16);
                }
                __builtin_amdgcn_sched_barrier(0);
                PS_BLOCK(kBf, kb + 1);
            }
        }
#undef PS_BLOCK
    }
}
__device__ __forceinline__ void select_phase(Frame& F, const float* SC, unsigned long long* MASK) {
    const int qstride = F.G * NWAVES;
    unsigned raw[64];
#define SEL_LOAD(qq) do { const int pos_ = (qq) & (SEQ - 1); if ((qq) < T && pos_ >= 256) { int ln_ = lane_id_now(); const int ni_ = (pos_ >> 6) + 1; const float* row_ = SC + (size_t)(qq) * SEQ; \
        _Pragma("unroll") for (int gq = 0; gq < 4; ++gq) if (ni_ > 16 * gq) { _Pragma("unroll") for (int i = 16 * gq; i < 16 * gq + 16; ++i) { const int s_ = 64 * i + ln_; raw[i] = __float_as_uint(__builtin_nontemporal_load(row_ + (s_ <= pos_ ? s_ : pos_))); } } } } while (0)
    int q0_ = F.bid * NWAVES + F.wave;
    SEL_LOAD(q0_);
    for (int q = q0_; q < T; q += qstride) {
        int lane = F.lane; asm volatile("" : "+v"(lane));
        const int pos = q & (SEQ - 1);
        unsigned long long myword = 0ull;
        if (pos < 256) {
            const int lo = 64 * lane;
            myword = (lo > pos) ? 0ull : ((pos - lo >= 63) ? ~0ull : ((1ull << (pos - lo + 1)) - 1ull));
            SEL_LOAD(q + qstride);
        } else {
            const int ni = (pos >> 6) + 1;
            unsigned key[64];
#pragma unroll
            for (int i = 0; i < 64; ++i) key[i] = 0u;
#pragma unroll
            for (int gq = 0; gq < 4; ++gq) if (ni > 16 * gq) {
#pragma unroll
                for (int i = 16 * gq; i < 16 * gq + 16; ++i) { const int s = 64 * i + lane; unsigned bts = raw[i]; if (bts == 0x80000000u) bts = 0u;
                    const unsigned kk = (bts & 0x80000000u) ? ~bts : (bts | 0x80000000u); key[i] = (s <= pos) ? kk : 0u; } }
            SEL_LOAD(q + qstride);
            auto count_ge = [&](const unsigned Tp) -> int {
                int cA = 0, cB = 0, cC = 0, cD = 0;
#pragma unroll
                for (int gq = 0; gq < 4; ++gq) if (ni > 16 * gq) {
                    unsigned long long m0_, m1_, m2_, m3_;
                    asm("v_cmp_le_u32_e64 %4, %8, %9\n\tv_cmp_le_u32_e64 %5, %8, %10\n\tv_cmp_le_u32_e64 %6, %8, %11\n\tv_cmp_le_u32_e64 %7, %8, %12\n\tv_addc_co_u32_e64 %0, %4, 0, %0, %4\n\tv_addc_co_u32_e64 %1, %5, 0, %1, %5\n\tv_addc_co_u32_e64 %2, %6, 0, %2, %6\n\tv_addc_co_u32_e64 %3, %7, 0, %3, %7\n\tv_cmp_le_u32_e64 %4, %8, %13\n\tv_cmp_le_u32_e64 %5, %8, %14\n\tv_cmp_le_u32_e64 %6, %8, %15\n\tv_cmp_le_u32_e64 %7, %8, %16\n\tv_addc_co_u32_e64 %0, %4, 0, %0, %4\n\tv_addc_co_u32_e64 %1, %5, 0, %1, %5\n\tv_addc_co_u32_e64 %2, %6, 0, %2, %6\n\tv_addc_co_u32_e64 %3, %7, 0, %3, %7\n\tv_cmp_le_u32_e64 %4, %8, %17\n\tv_cmp_le_u32_e64 %5, %8, %18\n\tv_cmp_le_u32_e64 %6, %8, %19\n\tv_cmp_le_u32_e64 %7, %8, %20\n\tv_addc_co_u32_e64 %0, %4, 0, %0, %4\n\tv_addc_co_u32_e64 %1, %5, 0, %1, %5\n\tv_addc_co_u32_e64 %2, %6, 0, %2, %6\n\tv_addc_co_u32_e64 %3, %7, 0, %3, %7\n\tv_cmp_le_u32_e64 %4, %8, %21\n\tv_cmp_le_u32_e64 %5, %8, %22\n\tv_cmp_le_u32_e64 %6, %8, %23\n\tv_cmp_le_u32_e64 %7, %8, %24\n\tv_addc_co_u32_e64 %0, %4, 0, %0, %4\n\tv_addc_co_u32_e64 %1, %5, 0, %1, %5\n\tv_addc_co_u32_e64 %2, %6, 0, %2, %6\n\tv_addc_co_u32_e64 %3, %7, 0, %3, %7"
                        : "+v"(cA), "+v"(cB), "+v"(cC), "+v"(cD), "=&s"(m0_), "=&s"(m1_), "=&s"(m2_), "=&s"(m3_) : "s"(Tp), "v"(key[16 * gq + 0]), "v"(key[16 * gq + 1]), "v"(key[16 * gq + 2]), "v"(key[16 * gq + 3]), "v"(key[16 * gq + 4]), "v"(key[16 * gq + 5]), "v"(key[16 * gq + 6]), "v"(key[16 * gq + 7]), "v"(key[16 * gq + 8]), "v"(key[16 * gq + 9]), "v"(key[16 * gq + 10]), "v"(key[16 * gq + 11]), "v"(key[16 * gq + 12]), "v"(key[16 * gq + 13]), "v"(key[16 * gq + 14]), "v"(key[16 * gq + 15])); }
                const int cl = (cA + cB) + (cC + cD);
                int c = 0;
#pragma unroll
                for (int bb = 0; bb < 7; ++bb) c += __popcll(__ballot((cl >> bb) & 1)) << bb;
                return c; };
            unsigned kmx = 0u;
#pragma unroll
            for (int i = 0; i < 64; ++i) kmx = key[i] > kmx ? key[i] : kmx;
#pragma unroll
            for (int o = 1; o < 64; o <<= 1) { const unsigned ov = (unsigned)shxi((int)kmx, o); kmx = ov > kmx ? ov : kmx; }
            kmx = (unsigned)__builtin_amdgcn_readfirstlane((int)kmx);
            unsigned lo = 0u, hi = kmx + 1u; int clo = pos + 1, chi = 0;
            if (kmx > 0x82000000u) { const unsigned l2 = (kmx & 0xff800000u) - 0x02000000u; const int c2 = count_ge(l2); if (c2 >= 256) { lo = l2; clo = c2; } else { hi = l2; chi = c2; } }
            float flo = (float)clo - 255.5f, fhi = (float)chi - 255.5f; int side = 0;
            for (int it = 0; it < 96; ++it) {
                if (clo == 256 || hi - lo <= 1u) break;
                const unsigned span = hi - lo;
                unsigned mid;
                if (it % 3 == 2) mid = lo + (span >> 1);
                else { const float tt = flo / (flo - fhi); unsigned d = (unsigned)((float)span * tt); d = d < 1u ? 1u : (d > span - 1u ? span - 1u : d); mid = lo + d; }
                mid = (unsigned)__builtin_amdgcn_readfirstlane((int)mid);
                const int c = count_ge(mid);
                if (c >= 256) { lo = mid; clo = c; flo = (float)c - 255.5f; if (side == 1) fhi *= 0.5f; side = 1; }
                else { hi = mid; chi = c; fhi = (float)c - 255.5f; if (side == -1) flo *= 0.5f; side = -1; }
            }
            const unsigned Tk = lo; const int cT = clo;
            int need = 256, base = 0;
            if (cT != 256) {
                int cl = 0;
#pragma unroll
                for (int i = 0; i < 64; ++i) cl += (key[i] > Tk) ? 1 : 0;
                int cgt = 0;
#pragma unroll
                for (int bb = 0; bb < 7; ++bb) cgt += __popcll(__ballot((cl >> bb) & 1)) << bb;
                need = 256 - cgt;
            }
            int wlo = 0, whi = 0;
            if (cT == 256) {
#pragma unroll
                for (int i = 0; i < 64; ++i) { const unsigned long long wsel = __ballot(key[i] >= Tk);
                    asm("s_nop 4\n\tv_writelane_b32 %0, %2, %4\n\tv_writelane_b32 %1, %3, %4" : "+v"(wlo), "+v"(whi) : "s"((int)(unsigned)wsel), "s"((int)(unsigned)(wsel >> 32)), "n"(i)); }
            } else {
                const unsigned long long ltmask = (1ull << lane) - 1ull;
#pragma unroll
                for (int i = 0; i < 64; ++i) {
                    const unsigned long long eq = __ballot(key[i] == Tk); const int rank = base + __popcll(eq & ltmask);
                    const bool sel = (key[i] > Tk) || (key[i] == Tk && rank < need); base += __popcll(eq);
                    const unsigned long long wsel = __ballot(sel);
                    asm("s_nop 4\n\tv_writelane_b32 %0, %2, %4\n\tv_writelane_b32 %1, %3, %4" : "+v"(wlo), "+v"(whi) : "s"((int)(unsigned)wsel), "s"((int)(unsigned)(wsel >> 32)), "n"(i));
                }
            }
            myword = ((unsigned long long)(unsigned)whi << 32) | (unsigned long long)(unsigned)wlo;
        }
        MASK[(size_t)q * 64 + lane] = myword;
    }
}

#undef SEL_LOAD
__device__ __forceinline__ void ln1_phase(Frame& F, const bf16* xres, const bf16* Y, const float* g1, const float* b1, bf16* XMB, const float* rw, const float* rb,
                                          bf16* XP, gu32* gcount, int* ROWS, float* GATES, const int pmode = 3) {
    const int lane = F.lane, wid = F.wave, tid = F.tid;
    float ALPHA_ = ALPHA; asm volatile("" : "+v"(ALPHA_));
    LAS float* x32 = (LAS float*)(F.lds + RING_OFF);
    volatile LAS unsigned* cnt = (volatile LAS unsigned*)(F.lds + L_CNT); volatile LAS unsigned* base = (volatile LAS unsigned*)(F.lds + L_BASE);
    LAS int* route = (LAS int*)(F.lds + L_ROUTE);
    const int e = lane & 31, half = lane >> 5;
    const float rbe = rb[e];
    const __amdgpu_buffer_rsrc_t xrs_ = __builtin_amdgcn_make_buffer_rsrc((void*)xres, 0, T * D * 2, 0x00020000), yrs_ = __builtin_amdgcn_make_buffer_rsrc((void*)Y, 0, T * D * 2, 0x00020000);
    for (int chunk = F.bid; chunk < T / 64; chunk += F.G) {
        if (tid < 32) cnt[tid] = 0u;
        __syncthreads();
        u32x2 rxn[4][4], ryn[4][4];
#define LN1_LOAD(B) do { _Pragma("unroll") for (int rr = 0; rr < 4; ++rr) { const int ro_ = (chunk * 64 + wid * 8 + (B) * 4 + rr) * (D * 2);       \
            _Pragma("unroll") for (int j = 0; j < 4; ++j) { rxn[rr][j] = __builtin_bit_cast(u32x2, __builtin_amdgcn_raw_buffer_load_b64(xrs_, lane * 8, ro_ + 512 * j, 2)); ryn[rr][j] = __builtin_bit_cast(u32x2, __builtin_amdgcn_raw_buffer_load_b64(yrs_, lane * 8, ro_ + 512 * j, 2)); } } } while (0)
        LN1_LOAD(0);
#pragma unroll 1
        for (int batch = 0; batch < 2; ++batch) {
            const int lrow0 = wid * 8 + batch * 4, row0 = chunk * 64 + lrow0;
            u32x2 rx[4][4], ry[4][4];
#pragma unroll
            for (int rr = 0; rr < 4; ++rr)
#pragma unroll
                for (int j = 0; j < 4; ++j) { rx[rr][j] = rxn[rr][j]; ry[rr][j] = ryn[rr][j]; }
            if (batch == 0) LN1_LOAD(1);
            float xv[4][16], mean_[4], rstd_[4];
#pragma unroll
            for (int rr = 0; rr < 4; ++rr) { float s = 0.f;
#pragma unroll
                for (int j = 0; j < 4; ++j) { const u32x2 xx = rx[rr][j], yy = ry[rr][j];
                    xv[rr][4 * j] = ALPHA_ * bflo(xx.x) + bflo(yy.x); xv[rr][4 * j + 1] = ALPHA_ * bfhi(xx.x) + bfhi(yy.x); xv[rr][4 * j + 2] = ALPHA_ * bflo(xx.y) + bflo(yy.y); xv[rr][4 * j + 3] = ALPHA_ * bfhi(xx.y) + bfhi(yy.y);
                    s += (xv[rr][4 * j] + xv[rr][4 * j + 1]) + (xv[rr][4 * j + 2] + xv[rr][4 * j + 3]); }
                mean_[rr] = s; }
#pragma unroll
            for (int rr = 0; rr < 4; ++rr) mean_[rr] = wave_sum(mean_[rr]);
#pragma unroll
            for (int rr = 0; rr < 4; ++rr) { mean_[rr] *= (1.f / D); float s2 = 0.f;
#pragma unroll
                for (int k = 0; k < 16; ++k) { xv[rr][k] -= mean_[rr]; s2 += xv[rr][k] * xv[rr][k]; }
                rstd_[rr] = s2; }
            __builtin_amdgcn_sched_barrier(0);
            f32x4 gg_[4], bb_[4];
#pragma unroll
            for (int j = 0; j < 4; ++j) { gg_[j] = __builtin_bit_cast(f32x4, __builtin_amdgcn_raw_buffer_load_b128(__builtin_amdgcn_make_buffer_rsrc((void*)g1, 0, D * 4, 0x00020000), lane * 16, j * 1024, 0)); bb_[j] = __builtin_bit_cast(f32x4, __builtin_amdgcn_raw_buffer_load_b128(__builtin_amdgcn_make_buffer_rsrc((void*)b1, 0, D * 4, 0x00020000), lane * 16, j * 1024, 0)); }
            __builtin_amdgcn_sched_barrier(0);
#pragma unroll
            for (int rr = 0; rr < 4; ++rr) rstd_[rr] = wave_sum(rstd_[rr]);
#pragma unroll
            for (int rr = 0; rr < 4; ++rr) { const float rstd = 1.0f / sqrtf(rstd_[rr] * (1.f / D) + LN_EPS);
#pragma unroll
                for (int j = 0; j < 4; ++j) { const f32x4 gg = gg_[j], bb = bb_[j];
                    f32x4 o;
#pragma unroll
                    for (int k = 0; k < 4; ++k) o[k] = xv[rr][4 * j + k] * rstd * gg[k] + bb[k];
                    u32x2 pb; pb.x = pk2(o[0], o[1]); pb.y = pk2(o[2], o[3]);
                    *(u32x2*)(XMB + (size_t)(row0 + rr) * D + 4 * lane + 256 * j) = pb;
                    *(LAS f32x4*)(x32 + (wid * 4 + rr) * 1028 + 4 * lane + 256 * j) = o; } }
            float a0 = 0.f, a1 = 0.f, a2 = 0.f, a3 = 0.f;
            float wA[32], wB[32];
            const __amdgpu_buffer_rsrc_t wrs = __builtin_amdgcn_make_buffer_rsrc((void*)rw, 0, D * NEXP * 4, 0x00020000);
            const int wvo = ((wid * 128 + half * 4) * 32 + e) * 4;
            __builtin_amdgcn_sched_barrier(0);
            if (pmode & 1) {
#pragma unroll
                for (int i = 0; i < 8; ++i)
#pragma unroll
                    for (int t = 0; t < 4; ++t) wA[4 * i + t] = __uint_as_float(__builtin_amdgcn_raw_buffer_load_b32(wrs, wvo, (8 * i + t) * 128, 0));
            }
            __builtin_amdgcn_sched_barrier(0);
            __syncthreads();
            if (pmode & 1) {
                f32x16 pacc, pacc1;
#pragma unroll
                for (int r = 0; r < 16; ++r) { pacc[r] = 0.f; pacc1[r] = 0.f; }
                const LAS float* xa = x32 + (lane & 31) * 1028 + wid * 128 + half * 4;
                f32x4 xq[16];
#pragma unroll
                for (int i = 0; i < 8; ++i) xq[i] = *(const LAS f32x4*)(xa + 8 * i);
#pragma unroll
                for (int i = 0; i < 8; ++i)
#pragma unroll
                    for (int t = 0; t < 4; ++t) wB[4 * i + t] = __uint_as_float(__builtin_amdgcn_raw_buffer_load_b32(wrs, wvo, (64 + 8 * i + t) * 128, 0));
#pragma unroll
                for (int i = 0; i < 8; ++i) {
                    pacc = __builtin_amdgcn_mfma_f32_32x32x2f32(xq[i][0], wA[4 * i + 0], pacc, 0, 0, 0); pacc1 = __builtin_amdgcn_mfma_f32_32x32x2f32(xq[i][1], wA[4 * i + 1], pacc1, 0, 0, 0);
                    pacc = __builtin_amdgcn_mfma_f32_32x32x2f32(xq[i][2], wA[4 * i + 2], pacc, 0, 0, 0); pacc1 = __builtin_amdgcn_mfma_f32_32x32x2f32(xq[i][3], wA[4 * i + 3], pacc1, 0, 0, 0); }
                __builtin_amdgcn_sched_barrier(0);
#pragma unroll
                for (int i = 8; i < 16; ++i) xq[i] = *(const LAS f32x4*)(xa + 8 * i);
#pragma unroll
                for (int i = 0; i < 8; ++i) {
                    pacc = __builtin_amdgcn_mfma_f32_32x32x2f32(xq[8 + i][0], wB[4 * i + 0], pacc, 0, 0, 0); pacc1 = __builtin_amdgcn_mfma_f32_32x32x2f32(xq[8 + i][1], wB[4 * i + 1], pacc1, 0, 0, 0);
                    pacc = __builtin_amdgcn_mfma_f32_32x32x2f32(xq[8 + i][2], wB[4 * i + 2], pacc, 0, 0, 0); pacc1 = __builtin_amdgcn_mfma_f32_32x32x2f32(xq[8 + i][3], wB[4 * i + 3], pacc1, 0, 0, 0); }
#pragma unroll
                for (int r = 0; r < 16; ++r) pacc[r] += pacc1[r];
                __syncthreads();
                LAS float* pw = x32 + wid * 1024 + e;
#pragma unroll
                for (int r = 0; r < 16; ++r) pw[crow(r, half) * 32] = pacc[r];
                __syncthreads();
                const LAS float* pr = x32 + (half * 4) * 1024 + (wid * 4) * 32 + e;
#pragma unroll
                for (int q = 0; q < 4; ++q) { a0 += pr[q * 1024]; a1 += pr[q * 1024 + 32]; a2 += pr[q * 1024 + 64]; a3 += pr[q * 1024 + 96]; }
            } else { __syncthreads(); __syncthreads(); }
            __syncthreads();
            float lg[4]; lg[0] = a0 + shx(a0, 32) + rbe; lg[1] = a1 + shx(a1, 32) + rbe; lg[2] = a2 + shx(a2, 32) + rbe; lg[3] = a3 + shx(a3, 32) + rbe;
            float selv[4][4]; int seli[4][4];
#pragma unroll
            for (int rr = 0; rr < 4; ++rr) {
                float v = lg[rr];
#pragma unroll
                for (int k = 0; k < 4; ++k) {
                    float bv = v; int bi = e;
#pragma unroll
                    for (int msk = 1; msk < 32; msk <<= 1) { const float ov = shx(bv, msk); const int oi = shxi(bi, msk); if (ov > bv || (ov == bv && oi < bi)) { bv = ov; bi = oi; } }
                    selv[rr][k] = bv; seli[rr][k] = bi;
                    if (bi == e) v = -INFINITY;
                }
            }
            if (lane < 16) {
                const int rr = lane >> 2, k = lane & 3;
                float sv[4]; int si[4];
#pragma unroll
                for (int q = 0; q < 4; ++q) { sv[q] = rr == 0 ? selv[0][q] : rr == 1 ? selv[1][q] : rr == 2 ? selv[2][q] : selv[3][q]; si[q] = rr == 0 ? seli[0][q] : rr == 1 ? seli[1][q] : rr == 2 ? seli[2][q] : seli[3][q]; }
                const float ex1 = __expf(sv[1] - sv[0]), ex2 = __expf(sv[2] - sv[0]), ex3 = __expf(sv[3] - sv[0]);
                const float isum = 1.0f / (1.0f + ex1 + ex2 + ex3);
                const int me = k == 0 ? si[0] : k == 1 ? si[1] : k == 2 ? si[2] : si[3];
                const float mg = (k == 0 ? 1.0f : k == 1 ? ex1 : k == 2 ? ex2 : ex3) * isum;
                const int mr = (int)__hip_atomic_fetch_add((LAS unsigned*)(F.lds + L_CNT) + me, 1u, __ATOMIC_RELAXED, __HIP_MEMORY_SCOPE_WORKGROUP);
                LAS int* rt = route + ((lrow0 + rr) * 4 + k) * 3;
                rt[0] = me; rt[1] = mr; rt[2] = __float_as_int(mg);
            }
        }
        __syncthreads();
        if (wid == 0) { const int l_ = lane_id_now(); if (l_ < 32) base[l_] = __hip_atomic_fetch_add(gcount + l_, cnt[l_], RLX_AGENT); }
        __syncthreads();
#pragma unroll 1
        for (int batch = 0; batch < 2; ++batch) {
            const int lrow0 = wid * 8 + batch * 4, row0 = chunk * 64 + lrow0;
            u32x4 sa[4], sb[4];
#pragma unroll
            for (int rr = 0; rr < 4; ++rr) { const bf16* src = XMB + (size_t)(row0 + rr) * D; sa[rr] = *(const u32x4*)(src + lane * 16); sb[rr] = *(const u32x4*)(src + lane * 16 + 8); }
            int vrow = 0;
            if (lane < 16) { const int rr = lane >> 2, k = lane & 3; const LAS int* rt = route + ((lrow0 + rr) * 4 + k) * 3; const int me = rt[0];
                vrow = me * CAPROWS + (int)base[me] + rt[1]; ROWS[(size_t)(row0 + rr) * 4 + k] = vrow; GATES[(size_t)(row0 + rr) * 4 + k] = __int_as_float(rt[2]); }
            if (pmode & 2) {
#pragma unroll
                for (int rr = 0; rr < 4; ++rr) {
                    const u32x4 a = sa[rr], b = sb[rr];
                    u32x4 o; o.x = pg8::pk4_fp8(bflo(a.x), bfhi(a.x), bflo(a.y), bfhi(a.y)); o.y = pg8::pk4_fp8(bflo(a.z), bfhi(a.z), bflo(a.w), bfhi(a.w));
                    o.z = pg8::pk4_fp8(bflo(b.x), bfhi(b.x), bflo(b.y), bfhi(b.y)); o.w = pg8::pk4_fp8(bflo(b.z), bfhi(b.z), bflo(b.w), bfhi(b.w));
#pragma unroll
                    for (int k = 0; k < 4; ++k) { const int vr = shli(vrow, rr * 4 + k); unsigned char* dst = (unsigned char*)XP + (size_t)vr * D;
                        __builtin_nontemporal_store(o, (u32x4*)(dst + lane * 16)); }
                }
            }
        }
        __syncthreads();
    }
}
#undef LN1_LOAD
__device__ __forceinline__ void ln2_phase(Frame& F, const bf16* XMB, const bf16* YP, const int* ROWS, const float* GATES, const float* g2, const float* b2, float* out, bf16* XB, unsigned char* XB8) {
    const int lane = F.lane;
    float ALPHA_ = ALPHA; asm volatile("" : "+v"(ALPHA_));
    const int rstride = F.G * NWAVES, row_first = F.bid * NWAVES + F.wave;
    const unsigned char* yp8 = (const unsigned char*)YP;
    int ix0 = 0, ix1 = 0, ix2 = 0, ix3 = 0; f32x4 gtn = {0.f, 0.f, 0.f, 0.f};
    u32x2 xbn[4]; int qn[4][4]; f32x4 gtc = {0.f, 0.f, 0.f, 0.f};
#define LN2_IDX(R) do { if ((R) < T) { ix0 = ROWS[(size_t)(R) * 4]; ix1 = ROWS[(size_t)(R) * 4 + 1]; ix2 = ROWS[(size_t)(R) * 4 + 2]; ix3 = ROWS[(size_t)(R) * 4 + 3]; gtn = *(const f32x4*)(GATES + (size_t)(R) * 4); } } while (0)
#define LN2_DATA(R) do { if ((R) < T) { gtc = gtn; _Pragma("unroll") for (int j = 0; j < 4; ++j) { const int c = 4 * lane + 256 * j; xbn[j] = *(const u32x2*)(XMB + (size_t)(R) * D + c); \
        qn[j][0] = *(const int*)(yp8 + (size_t)ix0 * D + c); qn[j][1] = *(const int*)(yp8 + (size_t)ix1 * D + c); qn[j][2] = *(const int*)(yp8 + (size_t)ix2 * D + c); qn[j][3] = *(const int*)(yp8 + (size_t)ix3 * D + c); } } } while (0)
    f32x4 gg_[4], bb_[4];
#pragma unroll
    for (int j = 0; j < 4; ++j) { gg_[j] = *(const f32x4*)(g2 + 4 * lane + 256 * j); bb_[j] = *(const f32x4*)(b2 + 4 * lane + 256 * j); }
    LN2_IDX(row_first);
    LN2_DATA(row_first);
    LN2_IDX(row_first + rstride);
    for (int row = row_first; row < T; row += rstride) {
        u32x2 xbc[4]; int qc[4][4]; const f32x4 gt = gtc;
#pragma unroll
        for (int j = 0; j < 4; ++j) { xbc[j] = xbn[j]; qc[j][0] = qn[j][0]; qc[j][1] = qn[j][1]; qc[j][2] = qn[j][2]; qc[j][3] = qn[j][3]; }
        LN2_DATA(row + rstride);
        LN2_IDX(row + 2 * rstride);
        float v[16]; float s = 0.f;
#pragma unroll
        for (int j = 0; j < 4; ++j) {
            const u32x2 xb_ = xbc[j]; const f32x4 xx = {bflo(xb_.x), bfhi(xb_.x), bflo(xb_.y), bfhi(xb_.y)};
            const int q0 = qc[j][0], q1 = qc[j][1], q2 = qc[j][2], q3 = qc[j][3];
            const f32x2 a0 = __builtin_amdgcn_cvt_pk_f32_fp8(q0, false), b0 = __builtin_amdgcn_cvt_pk_f32_fp8(q0, true), a1 = __builtin_amdgcn_cvt_pk_f32_fp8(q1, false), b1 = __builtin_amdgcn_cvt_pk_f32_fp8(q1, true);
            const f32x2 a2 = __builtin_amdgcn_cvt_pk_f32_fp8(q2, false), b2_ = __builtin_amdgcn_cvt_pk_f32_fp8(q2, true), a3 = __builtin_amdgcn_cvt_pk_f32_fp8(q3, false), b3 = __builtin_amdgcn_cvt_pk_f32_fp8(q3, true);
            const float g0 = gt[0] * (1.0f / 16.0f), g1 = gt[1] * (1.0f / 16.0f), g2_ = gt[2] * (1.0f / 16.0f), g3 = gt[3] * (1.0f / 16.0f);
            v[4 * j]     = ALPHA_ * xx[0] + ((g0 * a0[0] + g1 * a1[0]) + (g2_ * a2[0] + g3 * a3[0]));
            v[4 * j + 1] = ALPHA_ * xx[1] + ((g0 * a0[1] + g1 * a1[1]) + (g2_ * a2[1] + g3 * a3[1]));
            v[4 * j + 2] = ALPHA_ * xx[2] + ((g0 * b0[0] + g1 * b1[0]) + (g2_ * b2_[0] + g3 * b3[0]));
            v[4 * j + 3] = ALPHA_ * xx[3] + ((g0 * b0[1] + g1 * b1[1]) + (g2_ * b2_[1] + g3 * b3[1]));
            s += (v[4 * j] + v[4 * j + 1]) + (v[4 * j + 2] + v[4 * j + 3]); }
        const float mean = wave_sum(s) * (1.f / D); float s2 = 0.f;
#pragma unroll
        for (int k = 0; k < 16; ++k) { v[k] -= mean; s2 += v[k] * v[k]; }
        const float rstd = 1.0f / sqrtf(wave_sum(s2) * (1.f / D) + LN_EPS);
#pragma unroll
        for (int j = 0; j < 4; ++j) { const int c = 4 * lane + 256 * j; const f32x4 gg = gg_[j], bb = bb_[j];
            f32x4 o;
#pragma unroll
            for (int k = 0; k < 4; ++k) o[k] = v[4 * j + k] * rstd * gg[k] + bb[k];
            if (out) *(f32x4*)(out + (size_t)row * D + c) = o;
            u32x2 pb; pb.x = pk2(o[0], o[1]); pb.y = pk2(o[2], o[3]); *(u32x2*)(XB + (size_t)row * D + c) = pb;
            if (XB8) *(unsigned*)(XB8 + (size_t)row * D + c) = pg8::pk4_fp8(o[0], o[1], o[2], o[3]); }
    }
}
#undef LN2_IDX
#undef LN2_DATA

#ifndef MK_FP8TEST
#define MK_FP8TEST 0
#endif
typedef int i32x8 __attribute__((ext_vector_type(8)));
__device__ __forceinline__ int t8_val(int which, int rc, int g, int j) { unsigned h = (unsigned)(which * 7919 + rc * 104729 + g * 1299709 + j * 15485863 + 12345); h ^= h >> 13; h *= 0x5bd1e995u; h ^= h >> 15; return (int)(h % 9u) - 4; }
__device__ __forceinline__ void fp8_selftest(gu32* ctl, int lane) {
    const int rc = lane & 15, g = lane >> 4;
    i32x8 a, b;
#pragma unroll
    for (int w = 0; w < 8; ++w) {
        int wa = __builtin_amdgcn_cvt_pk_fp8_f32((float)t8_val(0, rc, g, 4 * w), (float)t8_val(0, rc, g, 4 * w + 1), 0, false);
        wa = __builtin_amdgcn_cvt_pk_fp8_f32((float)t8_val(0, rc, g, 4 * w + 2), (float)t8_val(0, rc, g, 4 * w + 3), wa, true);
        int wb = __builtin_amdgcn_cvt_pk_fp8_f32((float)t8_val(1, rc, g, 4 * w), (float)t8_val(1, rc, g, 4 * w + 1), 0, false);
        wb = __builtin_amdgcn_cvt_pk_fp8_f32((float)t8_val(1, rc, g, 4 * w + 2), (float)t8_val(1, rc, g, 4 * w + 3), wb, true);
        a[w] = wa; b[w] = wb;
    }
    f32x4 c = {0.f, 0.f, 0.f, 0.f};
    c = __builtin_amdgcn_mfma_scale_f32_16x16x128_f8f6f4(a, b, c, 0, 0, 0, 0x7f7f7f7f, 0, 0x7f7f7f7f);
    int bad = 0, scaled = 0;
#pragma unroll
    for (int reg = 0; reg < 4; ++reg) {
        const int row = 4 * (lane >> 4) + reg, col = lane & 15; int e = 0;
        for (int gg = 0; gg < 4; ++gg) for (int j = 0; j < 32; ++j) e += t8_val(0, row, gg, j) * t8_val(1, col, gg, j);
        if (c[reg] != (float)e) { bad = 1; if (e != 0 && (c[reg] == (float)e * 0.5f || c[reg] == (float)e * 2.0f || c[reg] == (float)e * 0.25f || c[reg] == (float)e * 4.0f)) scaled = 1; }
    }
    const unsigned long long mb = __ballot(bad), ms = __ballot(bad && scaled);
    if (lane == 0 && mb) __hip_atomic_store(ctl + CW_ERR, (mb == ms) ? 2u : 1u, RLX_AGENT);
}

constexpr int N_STEPS = 6, LAST_PHASE = 1 + 10 * 5 + 8;
__host__ __device__ constexpr bool phase_exists(int id) {
    if (id == 0) return true;
    if (id < 1 || id > LAST_PHASE) return false;
    const int s = (id - 1) / 10, p = (id - 1) % 10;
    if (p == 0) return true;
    if (p == 9) return false;
    if (s == 0 || s == 2) return false;
    if (p == 1 || p == 2) return s == 3;
    return true;
}
__global__ void __launch_bounds__(NTHREADS, 2) mk_fwd(Args args) {
    extern __shared__ __attribute__((aligned(16))) unsigned char lds_raw[];
    Frame F;
    F.lds = (LAS unsigned char*)lds_raw;
    F.tid = threadIdx.x; F.lane = F.tid & 63; F.wave = __builtin_amdgcn_readfirstlane(F.tid >> 6);
    F.bid = blockIdx.x; F.G = gridDim.x; F.vcu = (F.G % 8 == 0) ? (F.bid % 8) * (F.G / 8) + F.bid / 8 : F.bid;
    F.ctl = (gu32*)(args.ws + WS_CTL);
    const int lo = args.ph_lo, hi = args.ph_hi;
    const bool fused = (hi - lo) > 1;
    for (int u = F.tid; u < (LDS_BYTES - LDSCTL_OFF) / 4; u += NTHREADS) ((LAS unsigned*)(F.lds + LDSCTL_OFF))[u] = 0u;
    __syncthreads();
    XcdBarrier bar; bar.bar = (unsigned*)(F.ctl + CW_BAR); bar.x = 0; bar.st = nullptr;
    if (fused) bar = xcd_barrier_post((unsigned*)(F.ctl + CW_BAR), (volatile LAS unsigned*)(F.lds + L_XB));
    const bool split = fused && MK_SPLIT && (F.G % 16 == 0) && lo == 0 && hi > 16;
    const int NCV = split ? F.G / 2 : 0;
    const bool is_conv = split && F.bid < NCV;
    XcdBarrier bar2; bar2.bar = (unsigned*)(F.ctl + CW_BAR2); bar2.x = 0; bar2.st = nullptr;
    if (split && !is_conv) bar2 = xcd_barrier_post((unsigned*)(F.ctl + CW_BAR2), (volatile LAS unsigned*)(F.lds + L_XB2));
#ifndef MK_PROBE
#define MK_PROBE 0
#endif
#define IN(id) (lo <= (id) && (id) < hi)
#define PHASE_BEGIN ArgsP ap = (ArgsP)__builtin_amdgcn_kernarg_segment_ptr(); asm volatile("" : "+s"(ap)); GAS unsigned char* wsg_ = (GAS unsigned char*)ap->ws; asm volatile("" : "+s"(wsg_)); unsigned char* ws = (unsigned char*)wsg_; Frame Fp = F; { const int l_ = lane_id_now(); Fp.lane = l_; Fp.tid = F.wave * 64 + l_; } Fp.ctl = (gu32*)(ws + WS_CTL);
#define SEAM(id) do { if (fused && (id) != LAST_PHASE) { xcd_barrier(bar, F.wave == 0 && lane_id_now() == 0, (unsigned)F.G); if (MK_PROBE == 10) xcd_barrier(bar, F.wave == 0 && lane_id_now() == 0, (unsigned)F.G); } } while (0)
#define SEAMW(id, sync, last) do { if (!split) SEAM(id); else if (last) SEAM(id); else if ((sync) && !is_conv) xcd_barrier(bar2, F.wave == 0 && lane_id_now() == 0, (unsigned)(F.G - NCV)); } while (0)
#define WIN_FRAME do { if (split) { Fp.G = F.G - NCV; Fp.bid = F.bid - NCV; Fp.vcu = (Fp.G % 8 == 0) ? (Fp.bid % 8) * (Fp.G / 8) + Fp.bid / 8 : Fp.bid; } } while (0)
#define REPS(k) ((MK_PROBE) == (k) ? 2 : 1)

#ifndef SKIP_P0
    if (MK_FP8TEST && lo == 0 && F.bid == 0 && F.wave == 0) fp8_selftest(F.ctl, F.lane);
    if (IN(0)) { PHASE_BEGIN for (int rep = 0; rep < REPS(1); ++rep) p0_prologue(Fp, ap, ws, split ? 1 : 0); SEAM(0); }
#endif

    for (int s = 0; s < N_STEPS; ++s) {
        const int pb = 1 + 10 * s;
        const int layer = s == 0 ? 0 : (s == 1 ? 0 : (s <= 3 ? 1 : s - 2));
        const int kind = layer % 3;
        const bool rest = !(s == 0 || s == 2);
#ifndef SKIP_G1
        const bool inw = split && s <= 1;
        if (IN(pb) && inw && is_conv) {
            if (s == 0) { PHASE_BEGIN Fp.G = NCV; p0_prologue(Fp, ap, ws, 2); }
        } else
        if (IN(pb)) {
            PHASE_BEGIN
            if (inw) WIN_FRAME;
            pg8::Gemm g; pg8::EpiProj E; E.ssq_in = nullptr; E.ssq_out = nullptr; E.rope = (const pg8::f32x2*)(ws + WS_ROPE); E.rope_heads = 0u; E.oscale = 1.0f;
            if (s == 0) { g = pg8::Gemm{(const bf16*)(ws + WS_MEMB), (const bf16*)(ws + WS_WKV), NB * MEML, 2048, 1024, 1024}; E.O = (bf16*)(ws + WS_KVMEM); E.ldc = 2048; }
            else if (s == 3) { g = pg8::Gemm{(const bf16*)(ws + WS_PROJ), (const bf16*)(ws + WS_WUQ), T, 1280, 256, 1280}; E.O = (bf16*)(ws + WS_QQ); E.ldc = 1280; E.ssq_in = (const float*)(ws + WS_SSQ); E.rope_heads = 0xFFFFFu; }
            else { const int n = kind == 0 ? 2560 : (kind == 1 ? 1280 : 1536);
                g = pg8::Gemm{(const bf16*)(ws + WS_XB), (const bf16*)(ws + WS_WIN + (size_t)layer * 5 * MiB), T, n, 1024, 1024}; E.O = (bf16*)(ws + WS_PROJ); E.ldc = n;
                if (layer != 0) { g.A = (const bf16*)(ws + WS_XB8); g.K = 512; g.lda = 512; E.oscale = 1.0f / 64.0f; }
                if (kind == 1) { E.ssq_out = (float*)(ws + WS_SSQ); E.rope_heads = 0xF0u | (1u << 16); }
                if (kind == 2) E.rope_heads = 0xFFFFu; }
            pg8::StaticOrder S; S.init(g.M, g.N, Fp.G, (s == 0 && !inw) ? Fp.G - 1 - Fp.bid : Fp.bid); if (s <= 1) S.split = 0;
            if (!(s == 0 || s == 1 || s == 3)) { for (int rep = 0; rep < REPS(2); ++rep) pg8::gemm_phase<pg8::EpiProj, pg8::StaticOrder, true, true, true>(F.lds + RING_OFF, g, S, E, F.wave * 64 + lane_id_now()); }
            else { for (int rep = 0; rep < REPS(2); ++rep) pg8::gemm_phase<pg8::EpiProj, pg8::StaticOrder, true, true, false>(F.lds + RING_OFF, g, S, E, F.wave * 64 + lane_id_now()); }
        }
        if (IN(pb)) { if (inw) SEAMW(pb, s == 1, false); else if (!(s == 0 && fused)) SEAM(pb); }
#endif
        if (s == 3) {
#ifndef SKIP_PS
            if (IN(pb + 1)) { PHASE_BEGIN for (int rep = 0; rep < ((MK_PROBE == 3 || MK_PROBE == 31) ? 2 : 1); ++rep) score_phase(Fp, (const bf16*)(ws + WS_QQ), (const bf16*)(ws + WS_PROJ), (float*)(ws + WS_ACT)); SEAM(pb + 1); }
#endif
#ifndef SKIP_PT
            if (IN(pb + 2)) { PHASE_BEGIN for (int rep = 0; rep < ((MK_PROBE == 3 || MK_PROBE == 32) ? 2 : 1); ++rep) select_phase(Fp, (const float*)(ws + WS_ACT), (unsigned long long*)(ws + WS_MASK)); SEAM(pb + 2); }
#endif
        }
        if (!rest) continue;
#ifndef SKIP_MIX
        if (IN(pb + 3) && !(inw && is_conv)) { PHASE_BEGIN if (inw) WIN_FRAME; for (int rep = 0; rep < ((MK_PROBE == 4 || (MK_PROBE == 41 && kind == 1) || (MK_PROBE == 42 && kind == 2) || (MK_PROBE == 43 && kind == 0)) ? 2 : 1); ++rep) mixer_phase(Fp, ap, ws, layer, kind, s + 8 * rep); }
        if (IN(pb + 3)) { if (inw) SEAMW(pb + 3, true, false); else SEAM(pb + 3); }
#endif
#ifndef SKIP_G2
        if (IN(pb + 4) && !(inw && is_conv)) {
            PHASE_BEGIN
            if (inw) WIN_FRAME;
            pg8::Gemm g{(const bf16*)(ws + WS_CAT), (const bf16*)(ws + WS_WOUT + (size_t)layer * 2 * MiB), T, 1024, 512, 512};
            pg8::EpiProj E; E.O = (bf16*)(ws + WS_Y); E.ldc = 1024; E.ssq_in = nullptr; E.ssq_out = nullptr; E.rope = nullptr; E.rope_heads = 0u; E.oscale = 1.0f / 128.0f;
            pg8::StaticOrder S; S.init(T, 1024, Fp.G, Fp.bid);
            for (int rep = 0; rep < REPS(5); ++rep) pg8::gemm_phase<pg8::EpiProj, pg8::StaticOrder, true, true, true>(F.lds + RING_OFF, g, S, E, F.wave * 64 + lane_id_now());
        }
        if (IN(pb + 4)) { if (inw) SEAMW(pb + 4, true, false); else SEAM(pb + 4); }
#endif
#ifndef SKIP_LN1
        if (IN(pb + 5) && !(inw && is_conv)) {
            PHASE_BEGIN
            if (inw) WIN_FRAME;
            for (int rep = 0; rep < ((MK_PROBE == 6 || MK_PROBE == 61 || MK_PROBE == 62 || MK_PROBE == 63) ? 2 : 1); ++rep)
            ln1_phase(Fp, (const bf16*)(ws + WS_XB), (const bf16*)(ws + WS_Y), ap->in[12] + layer * D, ap->in[13] + layer * D, (bf16*)(ws + WS_QQ),
                      ap->in[14] + (size_t)layer * D * NEXP, ap->in[15] + layer * NEXP, (bf16*)(ws + (rep ? WS_ACT : WS_XP)), Fp.ctl + (rep ? CW_GDUMMY : CW_GCOUNT) + layer * NEXP,
                      (int*)(ws + (rep ? WS_SSQ : WS_ROWS)), (float*)(ws + (rep ? WS_MASK : WS_GATES)), (rep && MK_PROBE == 61) ? 2 : (rep && MK_PROBE == 62) ? 1 : (rep && MK_PROBE == 63) ? 0 : 3);
        }
        if (IN(pb + 5)) { if (inw) SEAMW(pb + 5, true, true); else SEAM(pb + 5); }
#endif
        if (IN(pb + 6) || IN(pb + 7)) {
            LAS int* pref = (LAS int*)(F.lds + L_PREF); LAS int* tiles = (LAS int*)(F.lds + L_TILES);
#ifndef SKIP_G3
            if (IN(pb + 6)) {
                PHASE_BEGIN
                if (Fp.wave == 0) {
                    const int l_ = Fp.lane; const int tl_ = l_ < 32 ? (int)((__hip_atomic_load(Fp.ctl + CW_GCOUNT + layer * NEXP + (l_ & 31), RLX_AGENT) + 255u) >> 8) : 0;
                    int v_ = tl_ * 8;
#pragma unroll
                    for (int d_ = 1; d_ < 32; d_ <<= 1) { const int t_ = __builtin_amdgcn_ds_bpermute(((l_ - d_) & 63) << 2, v_); if (l_ >= d_) v_ += t_; }
                    if (l_ < 32) { tiles[l_] = tl_; pref[l_] = v_ - tl_ * 8; } if (l_ == 31) pref[32] = v_; }
                __syncthreads();
                pg8::Gemm g{(const bf16*)(ws + WS_XP), (const bf16*)(ws + WS_WGU + (size_t)layer * 64 * MiB), NEXP * CAPROWS, NEXP * 2048, 512, 512};
                pg8::EpiSwiglu E{(bf16*)(ws + WS_ACT), ap->in[17] + (size_t)layer * NEXP * 2048};
                pg8::MoeOrder S{pref, tiles, 8, pref[32], F.G, F.vcu};
                for (int rep = 0; rep < REPS(7); ++rep) pg8::gemm_phase<pg8::EpiSwiglu, pg8::MoeOrder, true, true, true>(F.lds + RING_OFF, g, S, E, F.wave * 64 + lane_id_now());
                SEAM(pb + 6);
            }
#endif
#ifndef SKIP_G4
            if (IN(pb + 7)) {
                PHASE_BEGIN
                if (Fp.wave == 0) {
                    const int l_ = Fp.lane; const int tl_ = l_ < 32 ? (int)((__hip_atomic_load(Fp.ctl + CW_GCOUNT + layer * NEXP + (l_ & 31), RLX_AGENT) + 255u) >> 8) : 0;
                    int v_ = tl_ * 4;
#pragma unroll
                    for (int d_ = 1; d_ < 32; d_ <<= 1) { const int t_ = __builtin_amdgcn_ds_bpermute(((l_ - d_) & 63) << 2, v_); if (l_ >= d_) v_ += t_; }
                    if (l_ < 32) { tiles[l_] = tl_; pref[l_] = v_ - tl_ * 4; } if (l_ == 31) pref[32] = v_; }
                __syncthreads();
                pg8::Gemm g{(const bf16*)(ws + WS_ACT), (const bf16*)(ws + WS_WDN + (size_t)layer * 32 * MiB), NEXP * CAPROWS, NEXP * 1024, 512, 512};
                pg8::EpiDown E{(bf16*)(ws + WS_XP), ap->in[19] + (size_t)layer * NEXP * 1024};
                pg8::MoeOrder S{pref, tiles, 4, pref[32], F.G, F.vcu};
                for (int rep = 0; rep < REPS(8); ++rep) pg8::gemm_phase<pg8::EpiDown, pg8::MoeOrder, true, true, true>(F.lds + RING_OFF, g, S, E, F.wave * 64 + lane_id_now());
                SEAM(pb + 7);
            }
#endif
        }
#ifndef SKIP_LN2
        if (IN(pb + 8)) {
            PHASE_BEGIN
            for (int rep = 0; rep < REPS(9); ++rep)
            ln2_phase(Fp, (const bf16*)(ws + WS_QQ), (const bf16*)(ws + WS_XP), (const int*)(ws + WS_ROWS), (const float*)(ws + WS_GATES), ap->in[20] + layer * D, ap->in[21] + layer * D,
                      layer == DEPTH - 1 ? ap->out : (float*)nullptr, (bf16*)(ws + WS_XB), (layer + 1 < DEPTH) ? (unsigned char*)(ws + WS_XB8) : (unsigned char*)nullptr);
            SEAM(pb + 8);
        }
#endif
    }
    if (MK_FP8TEST && hi > LAST_PHASE) {
        const unsigned code = __hip_atomic_load(F.ctl + CW_ERR, RLX_AGENT);
        if (code) { const float v = code == 2u ? 100.f : 10.f;
            for (int row = F.bid * NWAVES + F.wave; row < T; row += F.G * NWAVES) { f32x4* o = (f32x4*)(args.out + (size_t)row * D) + F.lane;
#pragma unroll
                for (int j = 0; j < 4; ++j) o[64 * j] = (f32x4){v, v, v, v}; } }
    }
#undef IN
#undef SEAM
}

extern "C" void kernel_launch(void* const* d_in, const int* in_sizes, int n_in, void* d_out, int out_size, void* d_ws, size_t ws_size, hipStream_t stream) {
    static int grid = 0;
    if (grid == 0) {
        if (n_in != 22 || in_sizes[0] != T * D || out_size != T * D || ws_size < WS_END) { fprintf(stderr, "kernel_launch: unexpected shapes (n_in %d, in0 %d, out %d, ws %zu < %zu); nothing launched\n", n_in, n_in > 0 ? in_sizes[0] : -1, out_size, ws_size, (size_t)WS_END); grid = -1; return; }
        int dev = 0, cus = 0, per_cu = 0;
        if (hipGetDevice(&dev) != hipSuccess || hipDeviceGetAttribute(&cus, hipDeviceAttributeMultiprocessorCount, dev) != hipSuccess) { fprintf(stderr, "kernel_launch: device query failed\n"); grid = -1; return; }
        if (hipFuncSetAttribute((const void*)mk_fwd, hipFuncAttributeMaxDynamicSharedMemorySize, LDS_BYTES) != hipSuccess) { fprintf(stderr, "kernel_launch: hipFuncSetAttribute failed\n"); grid = -1; return; }
        if (hipOccupancyMaxActiveBlocksPerMultiprocessor(&per_cu, (const void*)mk_fwd, NTHREADS, LDS_BYTES) != hipSuccess || per_cu < 1) fprintf(stderr, "kernel_launch: note: occupancy query reports %d workgroups per CU\n", per_cu);
        (void)hipGetLastError();
        grid = cus;
    }
    if (grid < 0) return;
    if (hipMemsetAsync((char*)d_ws + WS_CTL, 0, CTL_ZERO_BYTES, stream) != hipSuccess) { fprintf(stderr, "kernel_launch: hipMemsetAsync failed\n"); return; }
    Args a{};
    for (int i = 0; i < 22; ++i) a.in[i] = (const float*)d_in[i];
    a.out = (float*)d_out; a.ws = (unsigned char*)d_ws;
    unsigned char* ws = (unsigned char*)d_ws;
    { int nj = 0, items = 0;
      auto add = [&](const float* src, int ldw, int K, int col0, int nvalid, int nblk, size_t dst_off, int row0, const float* scale, int f8 = 0, float mul = 1.0f) {
          Job& j = a.jobs[nj++]; j.src = src; j.dst = (bf16*)(ws + dst_off); j.scale = scale; j.ldw = ldw; j.K = K; j.col0 = col0; j.nvalid = nvalid; j.nblk = nblk; j.row0 = row0; j.item0 = items; j.f8 = f8; j.mul = mul; j.pad = 0;
          items += nblk * (K / 128); };
      const float* a_w_in = a.in[2]; const float* b_w_in = a.in[4]; const float* c_w_in = a.in[8];
      add(a_w_in, 2560, 1024, 0, 2560, 10, WS_WIN + 0 * 5 * MiB, 0, nullptr);
      add(a_w_in + (size_t)1024 * 2560, 2560, 1024, 0, 2560, 10, WS_WIN + 3 * 5 * MiB, 0, nullptr, 1, 64.0f);
      add(b_w_in, 1096, 1024, 0, 768, 3, WS_WIN + 1 * 5 * MiB, 0, nullptr, 1, 64.0f);
      add(b_w_in, 1096, 1024, 840, 256, 1, WS_WIN + 1 * 5 * MiB, 768, nullptr, 1, 64.0f);
      add(b_w_in, 1096, 1024, 768, 72, 1, WS_WIN + 1 * 5 * MiB, 1024, nullptr, 1, 64.0f);
      add(c_w_in, 1536, 1024, 0, 1536, 6, WS_WIN + 2 * 5 * MiB, 0, nullptr, 1, 64.0f);
      for (int l = 0; l < 4; ++l) add(a.in[10] + (size_t)l * 1024 * 1024, 1024, 1024, 0, 1024, 4, WS_WOUT + (size_t)l * 2 * MiB, 0, nullptr, 1, 128.0f);
      for (int l = 0; l < 4; ++l) add(a.in[11] + (size_t)l * 1024 * 512, 512, 1024, 0, 512, 2, WS_WKV, 512 * l, nullptr);
      add(a.in[6], 768, 256, 0, 768, 3, WS_WUQ, 0, a.in[5]);
      add(a.in[7], 512, 256, 0, 512, 2, WS_WUQ, 768, a.in[5]);
      a.njob_items = items; }
    a.pad = 0;
#if MK_MULTI
    for (int id = 0; id <= LAST_PHASE; ++id) {
        if (!phase_exists(id)) continue;
        a.ph_lo = id; a.ph_hi = id + 1;
        hipLaunchKernelGGL(mk_fwd, dim3(grid), dim3(NTHREADS), LDS_BYTES, stream, a);
    }
#else
    a.ph_lo = 0; a.ph_hi = LAST_PHASE + 1;
    hipLaunchKernelGGL(mk_fwd, dim3(grid), dim3(NTHREADS), LDS_BYTES, stream, a);
#endif
    const hipError_t le = hipPeekAtLastError();
    if (le != hipSuccess) fprintf(stderr, "kernel_launch: launch failed: %s (grid %d)\n", hipGetErrorName(le), grid);
}
```

```cpp
#include <hip/hip_runtime.h>
#include <cstdio>
#include <cstdint>
#include <cmath>

#ifndef MK_MULTI
#define MK_MULTI 0
#endif
#ifndef MK_SPLIT
#define MK_SPLIT 0
#endif
#ifndef MK_CHECK
#define MK_CHECK 0
#endif

namespace pg8 {
#define PG8_LAS __attribute__((address_space(3)))
typedef unsigned short bf16_t;
typedef short bf16x8 __attribute__((ext_vector_type(8)));
typedef float f32x4 __attribute__((ext_vector_type(4)));
typedef unsigned u32x4 __attribute__((ext_vector_type(4)));
typedef int i32x8 __attribute__((ext_vector_type(8)));
typedef short bf16x16 __attribute__((ext_vector_type(16)));
typedef unsigned u32x2 __attribute__((ext_vector_type(2)));
constexpr int BM = 256, BK = 64, HALF = 128, HTB = HALF * BK * 2  , STAGE_BYTES = 8 * HTB, NXCD = 8, WGM = 8;

__host__ __device__ __forceinline__ int lds_byte(int r, int c) { const int st = (r >> 4) * 2 + (c >> 5), rr = r & 15, cc = c & 31, ob = rr * 64 + cc * 2; return st * 1024 + (ob ^ (((ob >> 9) & 1) << 5)); }
__host__ __device__ __forceinline__ void stage_rc(int b, int& R, int& C) { const int st = b / 1024, sb = b % 1024, swz = sb ^ (((sb >> 9) & 1) << 5); R = (st >> 1) * 16 + swz / 64; C = (st & 1) * 32 + (swz % 64) / 2; }
__host__ __device__ __forceinline__ int perm32(int rho) { const int n = rho >> 4, i = rho & 15; return 8 * (i >> 2) + 4 * n + (i & 3); }

struct Unit { int pm, pn, hs; };
struct Gemm { const bf16_t* A; const bf16_t* Bt; int M, N, K, lda; };

struct StaticOrder {
    int nM, nN, nwg, G, c, split;
    __host__ __device__ void init(int M, int N, int G_, int c_) { nM = M / BM; nN = N / BM; nwg = nM * nN; G = G_; c = c_; split = 1; }
    __host__ __device__ bool next(int i, Unit& u) const {
        const int nfull = nwg / G, rem = nwg - nfull * G; int L = i * G + c; u.hs = 0;
        if (split && i == nfull && rem > 0 && 2 * rem <= G) { if (c >= 2 * rem) return false; L = nfull * G + (c >> 1); u.hs = 1 + (c & 1); }
        if (L >= nwg) return false;
        int wgid = L; { const int q = nwg / NXCD, r = nwg % NXCD, xcd = wgid % NXCD, off = wgid / NXCD; wgid = (xcd < r ? xcd * (q + 1) : r * (q + 1) + (xcd - r) * q) + off; }
        const int nig = WGM * nN, gid = wgid / nig, fm = gid * WGM, gsz = (nM - fm) < WGM ? (nM - fm) : WGM;
        u.pm = fm + ((wgid % nig) % gsz); u.pn = (wgid % nig) / gsz; return true;
    }
    __device__ __forceinline__ void a_ready(const Unit&) const {}
    __device__ __forceinline__ void done(const Unit&) const {}
};

typedef float f32x2 __attribute__((ext_vector_type(2)));
__device__ __forceinline__ float shx16(float v, int lane, int m) { return __int_as_float(__builtin_amdgcn_ds_bpermute((lane ^ m) << 2, __float_as_int(v))); }
typedef __bf16 bf16x2_t __attribute__((ext_vector_type(2)));
__device__ __forceinline__ unsigned pk4_fp8(float a, float b, float c, float d) { int w = __builtin_amdgcn_cvt_pk_fp8_f32(a, b, 0, false); w = __builtin_amdgcn_cvt_pk_fp8_f32(c, d, w, true); return (unsigned)w; }
__device__ __forceinline__ unsigned cvt_pk_bf16(float lo, float hi) { f32x2 v = {lo, hi}; bf16x2_t b = __builtin_convertvector(v, bf16x2_t); return __builtin_bit_cast(unsigned, b); }

struct EpiProj {
    static constexpr bool PERM = true, AFTER_DRAIN = false, BIAS_LDS = false; static constexpr int NSTORE = 16;
    bf16_t* O; int ldc; const float* ssq_in; float* ssq_out; const f32x2* rope; unsigned rope_heads; float oscale;
    __device__ __forceinline__ void operator()(const f32x4 (&acc)[2][2][4][2], const Unit& u, int wr, int wc, int fr, int fq) const {
        if (ssq_in != nullptr || rope_heads != 0u) run<true>(acc, u, wr, wc, fr, fq); else run<false>(acc, u, wr, wc, fr, fq);
    }
    template <bool LOADS>
    __device__ __forceinline__ void run(const f32x4 (&acc)[2][2][4][2], const Unit& u, int wr, int wc, int fr, int fq) const {
        const int row0 = u.pm * BM + (u.hs == 2 ? HALF : 0) + wr * 64 + fr, col0 = u.pn * BM + wc * 32 + 8 * fq;
        const bool do_ssq = (ssq_out != nullptr) && (u.pn == 0);
        const __amdgpu_buffer_rsrc_t ors = __builtin_amdgcn_make_buffer_rsrc((void*)O, 0, 0x7fffffff, 0x00020000);
        const bool any_rope = rope_heads != 0u;
        f32x4 sq_n = {0.f, 0.f, 0.f, 0.f}, cs_n[4];
#pragma unroll
        for (int q = 0; q < 4; ++q) cs_n[q] = (f32x4){0.f, 0.f, 0.f, 0.f};
        const float* sqp_ = ssq_in ? ssq_in : (const float*)rope;
#define EPI_ROWLOADS(ROW) do { if constexpr (LOADS) { sq_n = *(const f32x4*)(sqp_ + (size_t)(ROW) * 4); \
            const f32x4* cs_ = (const f32x4*)(rope + (size_t)((ROW) & 4095) * 8); cs_n[0] = cs_[0]; cs_n[1] = cs_[1]; cs_n[2] = cs_[2]; cs_n[3] = cs_[3]; } } while (0)
        EPI_ROWLOADS(row0);
#pragma unroll
        for (int ai = 0; ai < 2; ++ai) if (ai == 0 || u.hs == 0)
#pragma unroll
            for (int m = 0; m < 4; ++m) {
                const int row = row0 + ai * HALF + m * 16;
                const f32x4 s = sq_n, c01 = cs_n[0], c23 = cs_n[1], c45 = cs_n[2], c67 = cs_n[3];
                if (!(ai == 1 && m == 3)) { const int rown = row0 + (m == 3 ? HALF : ai * HALF + (m + 1) * 16); EPI_ROWLOADS(rown); }
                float rs = 1.f;
                if (ssq_in) rs = 1.0f / sqrtf(((s[0] + s[1]) + (s[2] + s[3])) * (1.f / 256.f) + 1e-5f);
                float ss = 0.f;
#pragma unroll
                for (int bj = 0; bj < 2; ++bj) {
                    f32x4 v0 = acc[ai][bj][m][0] * oscale, v1 = acc[ai][bj][m][1] * oscale;
                    if (do_ssq) ss += ((v0[0] * v0[0] + v0[1] * v0[1]) + (v0[2] * v0[2] + v0[3] * v0[3])) + ((v1[0] * v1[0] + v1[1] * v1[1]) + (v1[2] * v1[2] + v1[3] * v1[3]));
                    v0 = v0 * rs; v1 = v1 * rs;
                    const int head = (u.pn * BM + bj * HALF + wc * 32) >> 6;
                    if (((rope_heads >> head) & 1u) && !(wc & 1)) {
                        f32x4 o0, o1;
#pragma unroll
                        for (int j = 0; j < 4; ++j) { o0[j] = shx16(v0[j], fr + 16 * fq, 16); o1[j] = shx16(v1[j], fr + 16 * fq, 16); }
                        if (fq < 2) {
                            const float sg = fq == 0 ? -1.f : 1.f;
                            v0[0] = v0[0] * c01[0] + sg * o0[0] * c01[1]; v0[1] = v0[1] * c01[2] + sg * o0[1] * c01[3];
                            v0[2] = v0[2] * c23[0] + sg * o0[2] * c23[1]; v0[3] = v0[3] * c23[2] + sg * o0[3] * c23[3];
                            v1[0] = v1[0] * c45[0] + sg * o1[0] * c45[1]; v1[1] = v1[1] * c45[2] + sg * o1[1] * c45[3];
                            v1[2] = v1[2] * c67[0] + sg * o1[2] * c67[1]; v1[3] = v1[3] * c67[2] + sg * o1[3] * c67[3];
                        }
                    }
                    u32x4 w; w.x = cvt_pk_bf16(v0[0], v0[1]); w.y = cvt_pk_bf16(v0[2], v0[3]); w.z = cvt_pk_bf16(v1[0], v1[1]); w.w = cvt_pk_bf16(v1[2], v1[3]);
                    __builtin_amdgcn_raw_buffer_store_b128(w, ors, (row * ldc + col0 + bj * HALF) * 2, 0, 0);
                }
                if (do_ssq) { ss += shx16(ss, fr + 16 * fq, 16); ss += shx16(ss, fr + 16 * fq, 32); if (fq == 0) ssq_out[(size_t)row * 4 + wc] = ss; }
            }
#undef EPI_ROWLOADS
    }
};
struct EpiSwiglu {
    static constexpr bool PERM = true, AFTER_DRAIN = false, BIAS_LDS = true; static constexpr int NSTORE = 8;
    bf16_t* O; const float* bias;
    static constexpr float WSC = 1.0f / 64.0f;
    __device__ __forceinline__ void stage_bias(const Unit& u, PG8_LAS void* dst, int lane) const {
        const __amdgpu_buffer_rsrc_t brs = __builtin_amdgcn_make_buffer_rsrc((void*)bias, 0, 32 * 2048 * 4, 0x00020000);
        const int e = u.pn >> 3, t = u.pn & 7;
        __builtin_amdgcn_raw_ptr_buffer_load_lds(brs, dst, 16, (lane & 31) * 16 + (lane >> 5) * 4096, (e * 2048 + t * 128) * 4, 0, 0);
    }
    __device__ __forceinline__ void operator()(const f32x4 (&acc)[2][2][4][2], const Unit& u, int wr, int wc, int fr, int fq, const PG8_LAS float* bl) const {
        const int t = u.pn & 7;
        const int row0 = u.pm * BM + (u.hs == 2 ? HALF : 0) + wr * 64 + fr, jl = wc * 32 + 8 * fq, j0 = t * 128 + jl;
        const f32x4 bg0 = *(const PG8_LAS f32x4*)(bl + jl), bg1 = *(const PG8_LAS f32x4*)(bl + jl + 4), bu0 = *(const PG8_LAS f32x4*)(bl + 128 + jl), bu1 = *(const PG8_LAS f32x4*)(bl + 128 + jl + 4);
#pragma unroll
        for (int ai = 0; ai < 2; ++ai) if (ai == 0 || u.hs == 0)
#pragma unroll
            for (int m = 0; m < 4; ++m) {
                const int row = row0 + ai * HALF + m * 16;
                float r[8];
#pragma unroll
                for (int n = 0; n < 2; ++n) {
                    const f32x4 ag = acc[ai][0][m][n], au = acc[ai][1][m][n], bg_ = (n ? bg1 : bg0), bu_ = (n ? bu1 : bu0);
#pragma unroll
                    for (int jp = 0; jp < 4; jp += 2) {
                        const f32x2 wsc2 = {WSC, WSC}, one2 = {1.0f, 1.0f}, kk2 = {-1.702f * 1.4426950408889634f, -1.702f * 1.4426950408889634f};
                        f32x2 g2 = __builtin_elementwise_fma((f32x2){ag[jp], ag[jp + 1]}, wsc2, (f32x2){bg_[jp], bg_[jp + 1]});
                        f32x2 u2 = __builtin_elementwise_fma((f32x2){au[jp], au[jp + 1]}, wsc2, (f32x2){bu_[jp], bu_[jp + 1]});
                        g2[0] = fminf(g2[0], 7.0f); g2[1] = fminf(g2[1], 7.0f);
                        u2[0] = fminf(fmaxf(u2[0], -7.0f), 7.0f); u2[1] = fminf(fmaxf(u2[1], -7.0f), 7.0f);
                        const f32x2 t2 = g2 * kk2;
                        f32x2 d2 = {__builtin_amdgcn_exp2f(t2[0]), __builtin_amdgcn_exp2f(t2[1])}; d2 = d2 + one2;
                        const f32x2 s2 = {__builtin_amdgcn_rcpf(d2[0]), __builtin_amdgcn_rcpf(d2[1])};
                        const f32x2 r2 = ((u2 + one2) * g2) * s2;
                        r[n * 4 + jp] = r2[0]; r[n * 4 + jp + 1] = r2[1];
                    }
                }
                u32x2 w; w.x = pk4_fp8(r[0], r[1], r[2], r[3]); w.y = pk4_fp8(r[4], r[5], r[6], r[7]);
                *(u32x2*)((unsigned char*)O + (size_t)row * 1024 + j0) = w;
            }
    }
};
struct EpiDown {
    static constexpr bool PERM = true, AFTER_DRAIN = false, BIAS_LDS = true; static constexpr int NSTORE = 16;
    bf16_t* O; const float* bias;
    __device__ __forceinline__ void stage_bias(const Unit& u, PG8_LAS void* dst, int lane) const {
        const __amdgpu_buffer_rsrc_t brs = __builtin_amdgcn_make_buffer_rsrc((void*)bias, 0, 32 * 1024 * 4, 0x00020000);
        const int e = u.pn >> 2, t = u.pn & 3;
        __builtin_amdgcn_raw_ptr_buffer_load_lds(brs, dst, 16, lane * 16, (e * 1024 + t * 256) * 4, 0, 0);
    }
    __device__ __forceinline__ void operator()(const f32x4 (&acc)[2][2][4][2], const Unit& u, int wr, int wc, int fr, int fq, const PG8_LAS float* bl) const {
        const int t = u.pn & 3;
        const int row0 = u.pm * BM + (u.hs == 2 ? HALF : 0) + wr * 64 + fr, cl = wc * 32 + 8 * fq, col0 = t * BM + cl;
        f32x4 bv[2][2];
#pragma unroll
        for (int bj = 0; bj < 2; ++bj)
#pragma unroll
            for (int n = 0; n < 2; ++n) bv[bj][n] = *(const PG8_LAS f32x4*)(bl + cl + bj * HALF + 4 * n) * 16.0f;
#pragma unroll
        for (int ai = 0; ai < 2; ++ai) if (ai == 0 || u.hs == 0)
#pragma unroll
            for (int m = 0; m < 4; ++m) { unsigned char* rowp = (unsigned char*)O + (size_t)(row0 + ai * HALF + m * 16) * 1024 + col0;
#pragma unroll
                for (int bj = 0; bj < 2; ++bj) { const f32x4 v0 = acc[ai][bj][m][0] * (16.0f / 128.0f) + bv[bj][0], v1 = acc[ai][bj][m][1] * (16.0f / 128.0f) + bv[bj][1];
                    u32x2 w; w.x = pk4_fp8(v0[0], v0[1], v0[2], v0[3]); w.y = pk4_fp8(v1[0], v1[1], v1[2], v1[3]);
                    *(u32x2*)(rowp + bj * HALF) = w; } }
    }
};
struct MoeOrder {
    const PG8_LAS int* pref; const PG8_LAS int* tiles; int ntn, total, G, vcu;
    __device__ __forceinline__ bool next(int i, Unit& u) const {
        const int nfull = total / G, rem = total - nfull * G; int L = i * G + vcu; u.hs = 0;
        if (i == nfull && rem > 0 && 2 * rem <= G) { if (vcu >= 2 * rem) return false; L = nfull * G + (vcu >> 1); u.hs = 1 + (vcu & 1); }
        if (L >= total) return false;
        int e = 0;
        for (int k = 1; k < 32; ++k) e += (pref[k] <= L) ? 1 : 0;
        const int r = L - pref[e], te = tiles[e];
        const int grp = te * 4, ntq = r / grp, r2 = r - ntq * grp, mt = r2 >> 2, ntl = r2 & 3;
        u.pm = __builtin_amdgcn_readfirstlane(e * 64 + mt); u.pn = __builtin_amdgcn_readfirstlane(e * ntn + ntq * 4 + ntl); return true;
    }
    __device__ __forceinline__ void a_ready(const Unit&) const {}
    __device__ __forceinline__ void done(const Unit&) const {}
};

template <class Epi, class Sched, bool ALIGN_EPI = false, bool SP2 = false, bool FP8 = false>
__device__ __forceinline__ void gemm_phase(PG8_LAS unsigned char* lds, const Gemm g, const Sched& S, const Epi& E, const int tid_in) {
    const int tid_ = tid_in;
    const int tid = tid_, wid = __builtin_amdgcn_readfirstlane(tid >> 6), lane = tid & 63, wr = wid >> 2, wc = wid & 3, fr = lane & 15, fq = lane >> 4;
    const int K = g.K, nt = K / BK;
    unsigned voffA[2], voffB[2];
#pragma unroll
    for (int i = 0; i < 2; ++i) { int R, C; stage_rc(tid * 16 + i * 8192, R, C); const int Rb = Epi::PERM ? ((R & ~31) + perm32(R & 31)) : R;
        voffA[i] = (unsigned)(R * g.lda + C) * 2u; voffB[i] = (unsigned)(Rb * K + C) * 2u; }
    const unsigned kstep = (unsigned)(BK * 2);
    const unsigned hstepA = (unsigned)HALF * g.lda * 2, hstepB = (unsigned)HALF * K * 2;
    const unsigned tstepA = 2 * hstepA, tstepB = 2 * hstepB;
    const unsigned ldsw = (unsigned)wid * 1024u;
    const int aoff = lds_byte(wr * 64 + fr, fq * 8), boff = lds_byte(wc * 32 + fr, fq * 8);
#define PG8_SA(b, h) (((b) * 2 + (h)) * HTB)
#define PG8_SB(b, h) ((4 + (b) * 2 + (h)) * HTB)
    const __amdgpu_buffer_rsrc_t rA = __builtin_amdgcn_make_buffer_rsrc((void*)g.A, 0, 0x7fffffff, 0x00020000), rB = __builtin_amdgcn_make_buffer_rsrc((void*)g.Bt, 0, 0x7fffffff, 0x00020000);
#define PG8_STAGE(bufoff, soff, voff, rs) do { _Pragma("unroll") for (int _i = 0; _i < 2; ++_i) \
        __builtin_amdgcn_raw_ptr_buffer_load_lds(rs, (PG8_LAS void*)(lds + (bufoff) + ldsw + _i * 8192), 16, (int)(voff)[_i], (int)(soff), 0, 0); } while (0)
#define PG8_LD2(P) __builtin_shufflevector(*(const PG8_LAS bf16x8*)(P), *(const PG8_LAS bf16x8*)((P) + 1024), 0, 1, 2, 3, 4, 5, 6, 7, 8, 9, 10, 11, 12, 13, 14, 15)
#define PG8_LDA(dst, b, h) do { _Pragma("unroll") for (int m = 0; m < 4; ++m) dst[m] = PG8_LD2(lds + PG8_SA(b, h) + aoff + m * 2048); } while (0)
#define PG8_LDB(dst, b, h) do { _Pragma("unroll") for (int n = 0; n < 2; ++n) dst[n] = PG8_LD2(lds + PG8_SB(b, h) + boff + n * 2048); } while (0)
#define PG8_LO(X) __builtin_shufflevector((X), (X), 0, 1, 2, 3, 4, 5, 6, 7)
#define PG8_HI(X) __builtin_shufflevector((X), (X), 8, 9, 10, 11, 12, 13, 14, 15)
#define PG8_MMA(ai, bj, At, Bt) do { __builtin_amdgcn_s_setprio(1); if constexpr (FP8) { _Pragma("unroll") for (int m = 0; m < 4; ++m) _Pragma("unroll") for (int n = 0; n < 2; ++n) \
        acc[ai][bj][m][n] = __builtin_amdgcn_mfma_scale_f32_16x16x128_f8f6f4(__builtin_bit_cast(i32x8, Bt[n]), __builtin_bit_cast(i32x8, At[m]), acc[ai][bj][m][n], 0, 0, 0, 0x7f7f7f7f, 0, 0x7f7f7f7f); \
        asm volatile("" : "+v"(acc[ai][bj][0][0]), "+v"(acc[ai][bj][0][1]), "+v"(acc[ai][bj][1][0]), "+v"(acc[ai][bj][1][1]), "+v"(acc[ai][bj][2][0]), "+v"(acc[ai][bj][2][1]), "+v"(acc[ai][bj][3][0]), "+v"(acc[ai][bj][3][1]));   } else { \
        _Pragma("unroll") for (int m = 0; m < 4; ++m) _Pragma("unroll") for (int n = 0; n < 2; ++n) { \
        acc[ai][bj][m][n] = __builtin_amdgcn_mfma_f32_16x16x32_bf16(PG8_LO(Bt[n]), PG8_LO(At[m]), acc[ai][bj][m][n], 0, 0, 0); \
        acc[ai][bj][m][n] = __builtin_amdgcn_mfma_f32_16x16x32_bf16(PG8_HI(Bt[n]), PG8_HI(At[m]), acc[ai][bj][m][n], 0, 0, 0); } } __builtin_amdgcn_s_setprio(0); } while (0)
#define PG8_WAIT_V(n) asm volatile("s_waitcnt vmcnt(" #n ")" ::: "memory")
#define PG8_WAIT_L(n) asm volatile("s_waitcnt lgkmcnt(" #n ")" ::: "memory")
#define PG8_WAIT_V8S do { if (t != 0 || pst == 0) PG8_WAIT_V(8); else if (pst == Epi::NSTORE) asm volatile("s_waitcnt vmcnt(%0)" :: "n"(8 + Epi::NSTORE) : "memory"); else asm volatile("s_waitcnt vmcnt(%0)" :: "n"(8 + Epi::NSTORE / 2) : "memory"); } while (0)
#define PG8_BAR __builtin_amdgcn_s_barrier()
#define PG8_SCHED __builtin_amdgcn_sched_barrier(0)
    Unit cur, nxt; int ui = 0, pst = 0;
    if (!S.next(0, cur)) return;
    f32x4 acc[2][2][4][2];
    float z0_ = 0.f; asm volatile("" : "+v"(z0_));
#pragma unroll
    for (int a = 0; a < 2; ++a)
#pragma unroll
        for (int b = 0; b < 2; ++b)
#pragma unroll
            for (int m = 0; m < 4; ++m)
#pragma unroll
                for (int n = 0; n < 2; ++n) acc[a][b][m][n] = (f32x4){z0_, z0_, z0_, z0_};
    bf16x16 At[4], B0[2], B1[2];
    unsigned cA = (unsigned)cur.pm * tstepA + (cur.hs == 2 ? hstepA : 0u), cB = (unsigned)cur.pn * tstepB;
    S.a_ready(cur);
    if constexpr (SP2) {
        PG8_STAGE(PG8_SB(0, 0), cB, voffB, rB); PG8_STAGE(PG8_SB(0, 1), cB + hstepB, voffB, rB); PG8_STAGE(PG8_SA(0, 0), cA, voffA, rA); PG8_STAGE(PG8_SA(0, 1), cA + hstepA, voffA, rA);
        if (wr == 1) PG8_BAR;
        PG8_WAIT_V(2); PG8_BAR;
        PG8_STAGE(PG8_SB(1, 0), cB + kstep, voffB, rB); PG8_STAGE(PG8_SA(1, 0), cA + kstep, voffA, rA); PG8_STAGE(PG8_SB(1, 1), cB + hstepB + kstep, voffB, rB);
        PG8_WAIT_V(6); PG8_BAR;
    } else {
        PG8_STAGE(PG8_SB(0, 0), cB, voffB, rB); PG8_STAGE(PG8_SA(0, 0), cA, voffA, rA); PG8_STAGE(PG8_SB(0, 1), cB + hstepB, voffB, rB); PG8_STAGE(PG8_SA(0, 1), cA + hstepA, voffA, rA);
        if (wr == 1) PG8_BAR;
        PG8_WAIT_V(4); PG8_BAR;
        PG8_STAGE(PG8_SB(1, 0), cB + kstep, voffB, rB); PG8_STAGE(PG8_SA(1, 0), cA + kstep, voffA, rA); PG8_STAGE(PG8_SB(1, 1), cB + hstepB + kstep, voffB, rB);
        PG8_WAIT_V(6); PG8_BAR;
    }
    for (;;) {
        const bool has_next = S.next(ui + 1, nxt);
        if constexpr (Epi::BIAS_LDS) { if (wid == 0) { int lb_; asm volatile("v_mbcnt_lo_u32_b32 %0, -1, 0\n\tv_mbcnt_hi_u32_b32 %0, -1, %0" : "=v"(lb_)); E.stage_bias(cur, (PG8_LAS void*)(lds + STAGE_BYTES + (ui & 1) * 1024), lb_); } }
        const unsigned nA = has_next ? (unsigned)nxt.pm * tstepA + (nxt.hs == 2 ? hstepA : 0u) : cA, nB = has_next ? (unsigned)nxt.pn * tstepB : cB;
        const bool chalf = cur.hs != 0;
        for (int t = 0; t < nt; t += 2) {
            const bool last = (t == nt - 2);
            const unsigned a1 = cA + (unsigned)(t + 1) * kstep;
            const unsigned a2 = last ? nA : cA + (unsigned)(t + 2) * kstep, b2 = last ? nB : cB + (unsigned)(t + 2) * kstep;
            const unsigned a3 = a2 + kstep, b3 = b2 + kstep;
            if (last && has_next) S.a_ready(nxt);
            if constexpr (SP2) {
            PG8_LDB(B0, 0, 0); PG8_LDB(B1, 0, 1); PG8_SCHED; PG8_LDA(At, 0, 0); PG8_STAGE(PG8_SA(1, 1), a1 + hstepA, voffA, rA);
            PG8_WAIT_V8S; PG8_WAIT_L(0); PG8_BAR; PG8_MMA(0, 0, At, B0); PG8_MMA(0, 1, At, B1); PG8_BAR; PG8_SCHED;
            PG8_LDA(At, 0, 1); PG8_STAGE(PG8_SB(0, 0), b2, voffB, rB); PG8_STAGE(PG8_SB(0, 1), b2 + hstepB, voffB, rB); PG8_STAGE(PG8_SA(0, 0), a2, voffA, rA);
            PG8_WAIT_V8S; PG8_WAIT_L(0); PG8_BAR; if (!chalf) { PG8_MMA(1, 0, At, B0); PG8_MMA(1, 1, At, B1); } PG8_BAR; PG8_SCHED;
            PG8_LDB(B0, 1, 0); PG8_LDB(B1, 1, 1); PG8_SCHED; PG8_LDA(At, 1, 0); PG8_STAGE(PG8_SA(0, 1), a2 + hstepA, voffA, rA);
            PG8_WAIT_V(8); PG8_WAIT_L(0); PG8_BAR; PG8_MMA(0, 0, At, B0); PG8_MMA(0, 1, At, B1); PG8_BAR; PG8_SCHED;
            PG8_LDA(At, 1, 1); PG8_STAGE(PG8_SB(1, 0), b3, voffB, rB); PG8_STAGE(PG8_SB(1, 1), b3 + hstepB, voffB, rB); PG8_STAGE(PG8_SA(1, 0), a3, voffA, rA);
            PG8_WAIT_V(8); PG8_WAIT_L(0); PG8_BAR; if (!chalf) { PG8_MMA(1, 0, At, B0); PG8_MMA(1, 1, At, B1); } PG8_BAR; PG8_SCHED;
            } else {
            PG8_LDB(B0, 0, 0); PG8_SCHED; PG8_LDA(At, 0, 0); PG8_STAGE(PG8_SA(1, 1), a1 + hstepA, voffA, rA);
            PG8_WAIT_L(8); PG8_BAR; PG8_WAIT_L(0); PG8_MMA(0, 0, At, B0); PG8_BAR; PG8_SCHED;
            PG8_LDB(B1, 0, 1); PG8_STAGE(PG8_SB(0, 0), b2, voffB, rB);
            PG8_BAR; PG8_WAIT_L(0); PG8_MMA(0, 1, At, B1); PG8_BAR;
            PG8_LDA(At, 0, 1); PG8_STAGE(PG8_SA(0, 0), a2, voffA, rA);
            PG8_BAR; PG8_WAIT_L(0); PG8_MMA(1, 0, At, B0); PG8_BAR; PG8_SCHED;
            PG8_STAGE(PG8_SB(0, 1), b2 + hstepB, voffB, rB);
            PG8_WAIT_V(6); PG8_BAR; PG8_MMA(1, 1, At, B1); PG8_BAR;
            PG8_LDB(B0, 1, 0); PG8_SCHED; PG8_LDA(At, 1, 0); PG8_STAGE(PG8_SA(0, 1), a2 + hstepA, voffA, rA);
            PG8_WAIT_L(8); PG8_BAR; PG8_WAIT_L(0); PG8_MMA(0, 0, At, B0); PG8_BAR; PG8_SCHED;
            PG8_LDB(B1, 1, 1); PG8_STAGE(PG8_SB(1, 0), b3, voffB, rB);
            PG8_BAR; PG8_WAIT_L(0); PG8_MMA(0, 1, At, B1); PG8_BAR;
            PG8_LDA(At, 1, 1); PG8_STAGE(PG8_SA(1, 0), a3, voffA, rA);
            PG8_BAR; PG8_WAIT_L(0); PG8_MMA(1, 0, At, B0); PG8_BAR; PG8_SCHED;
            PG8_STAGE(PG8_SB(1, 1), b3 + hstepB, voffB, rB);
            PG8_WAIT_V(6); PG8_BAR; PG8_MMA(1, 1, At, B1); PG8_BAR;
            }
        }
        if constexpr (ALIGN_EPI) { if (wr == 0) PG8_BAR; }
        if constexpr (!Epi::AFTER_DRAIN) { int l_; asm volatile("v_mbcnt_lo_u32_b32 %0, -1, 0\n\tv_mbcnt_hi_u32_b32 %0, -1, %0" : "=v"(l_)); if constexpr (Epi::BIAS_LDS) E(acc, cur, wr, wc, l_ & 15, l_ >> 4, (const PG8_LAS float*)(lds + STAGE_BYTES + (ui & 1) * 1024)); else E(acc, cur, wr, wc, l_ & 15, l_ >> 4); S.done(cur); }
        if (!has_next) break;
        asm volatile("" : "+v"(z0_));
#pragma unroll
        for (int a = 0; a < 2; ++a)
#pragma unroll
            for (int b = 0; b < 2; ++b)
#pragma unroll
                for (int m = 0; m < 4; ++m)
#pragma unroll
                    for (int n = 0; n < 2; ++n) acc[a][b][m][n] = (f32x4){z0_, z0_, z0_, z0_};
        pst = cur.hs ? Epi::NSTORE / 2 : Epi::NSTORE; cur = nxt; cA = nA; cB = nB; ++ui;
        if constexpr (ALIGN_EPI) { if (wr == 1) PG8_BAR; }
    }
    PG8_WAIT_V(0);
    if constexpr (!ALIGN_EPI) { if (wr == 0) PG8_BAR; }
    PG8_BAR;
    if constexpr (Epi::AFTER_DRAIN) { E.fused(acc, cur, wr, wc, fr, fq, lds, wid, lane); S.done(cur); }
#undef PG8_SA
#undef PG8_SB
#undef PG8_STAGE
#undef PG8_LDA
#undef PG8_LDB
#undef PG8_MMA
#undef PG8_LD2
#undef PG8_LO
#undef PG8_HI
#undef PG8_WAIT_V
#undef PG8_WAIT_L
#undef PG8_WAIT_V8S
#undef PG8_BAR
#undef PG8_SCHED
}
}

constexpr int NB = 4, SEQ = 4096, T = NB * SEQ, D = 1024, DEPTH = 4, NEXP = 32, DEXP = 1024, MEML = 256;
constexpr int CAPROWS = 16384;
constexpr float LN_EPS = 1e-5f, ALPHA = 1.681792830507429f;
constexpr float LOG2E = 1.4426950408889634f, C2 = 0.125f * 1.4426950408889634f;
constexpr float NEG_BIG = -1.0e30f;
constexpr float NEG_RAW = -0x1p100f;
constexpr int NWAVES = 8, NTHREADS = 512;

constexpr size_t MiB = 1u << 20;
constexpr size_t WS_CTL = 0, CTL_ZERO_BYTES = 65536;
constexpr size_t WS_ROPE = 1 * MiB;
constexpr size_t WS_WUQ = 2 * MiB;
constexpr size_t WS_MEMB = 3 * MiB;
constexpr size_t WS_KVMEM = 5 * MiB;
constexpr size_t WS_WKV = 9 * MiB;
constexpr size_t WS_WOUT = 13 * MiB;
constexpr size_t WS_WIN = 21 * MiB;
constexpr size_t WS_SSQ = 41 * MiB;
constexpr size_t WS_ROWS = 42 * MiB;
constexpr size_t WS_GATES = 43 * MiB;
constexpr size_t WS_MASK = 44 * MiB;
constexpr size_t WS_XB = 52 * MiB;
constexpr size_t WS_CAT = 84 * MiB;
constexpr size_t WS_Y = 116 * MiB;
constexpr size_t WS_QQ = 148 * MiB;
constexpr size_t WS_PROJ = 188 * MiB;
constexpr size_t WS_XB8 = 268 * MiB;
constexpr size_t WS_XA = 268 * MiB;
constexpr size_t WS_XM = 332 * MiB;
constexpr size_t WS_WGU = 400 * MiB;
constexpr size_t WS_WDN = 912 * MiB;
constexpr size_t WS_XP = 1168 * MiB;
constexpr size_t WS_ACT = 2192 * MiB;
constexpr size_t WS_END = 3216 * MiB;
constexpr int CW_TMO = 0, CW_ERR = 2;
constexpr int CW_BAR = 4096;
constexpr int CW_QHEAD = 8192;
constexpr int CW_GCOUNT = 9216;
constexpr int CW_BAR2 = 12288;
constexpr int CW_GDUMMY = 9472;
static_assert((CW_BAR2 + 3456) * 4 <= (int)CTL_ZERO_BYTES && (CW_GDUMMY + 128) * 4 <= (int)CTL_ZERO_BYTES, "CTL words inside the memset region");

constexpr int RING_OFF = 0, RING_BYTES = 131072;
constexpr int LDSCTL_OFF = 143360;
constexpr int L_XB = LDSCTL_OFF + 0;
constexpr int L_Q = LDSCTL_OFF + 16;
constexpr int L_XB2 = LDSCTL_OFF + 32;
constexpr int L_PREF = LDSCTL_OFF + 64;
constexpr int L_TILES = LDSCTL_OFF + 256;
constexpr int L_CNT = LDSCTL_OFF + 384;
constexpr int L_BASE = LDSCTL_OFF + 512;
constexpr int L_ROUTE = LDSCTL_OFF + 1024;
constexpr int LDS_BYTES = 147456;

#define GAS __attribute__((address_space(1)))
#define LAS __attribute__((address_space(3)))
typedef unsigned short bf16;
typedef unsigned u32x4 __attribute__((ext_vector_type(4)));
typedef unsigned u32x2 __attribute__((ext_vector_type(2)));
typedef float f32x4 __attribute__((ext_vector_type(4)));
typedef float f32x2 __attribute__((ext_vector_type(2)));
typedef float f32x16 __attribute__((ext_vector_type(16)));
typedef short bf16x8 __attribute__((ext_vector_type(8)));
typedef short s16x4 __attribute__((ext_vector_type(4)));
typedef short v4i16_t __attribute__((ext_vector_type(4)));
typedef GAS unsigned gu32;
#define RLX_AGENT __ATOMIC_RELAXED, __HIP_MEMORY_SCOPE_AGENT
__device__ __forceinline__ unsigned pk2(float lo, float hi) { return pg8::cvt_pk_bf16(lo, hi); }
__device__ __forceinline__ float bf2f(bf16 b) { return __uint_as_float((unsigned)b << 16); }
__device__ __forceinline__ float bflo(unsigned w) { return __uint_as_float(w << 16); }
__device__ __forceinline__ float bfhi(unsigned w) { return __uint_as_float(w & 0xffff0000u); }
__device__ __forceinline__ int crow(int r, int hi) { return (r & 3) + 8 * (r >> 2) + 4 * hi; }
__device__ __forceinline__ float swapmax(float m) { auto rr = __builtin_amdgcn_permlane32_swap(__float_as_uint(m), __float_as_uint(m), false, false); return fmaxf(__uint_as_float(rr[0]), __uint_as_float(rr[1])); }
__device__ __forceinline__ float swapsum(float m) { auto rr = __builtin_amdgcn_permlane32_swap(__float_as_uint(m), __float_as_uint(m), false, false); return __uint_as_float(rr[0]) + __uint_as_float(rr[1]); }
__device__ __forceinline__ int lane_id_now() { int l; asm volatile("v_mbcnt_lo_u32_b32 %0, -1, 0\n\tv_mbcnt_hi_u32_b32 %0, -1, %0" : "=v"(l)); return l; }
__device__ __forceinline__ float shx(float v, int m) { return __int_as_float(__builtin_amdgcn_ds_bpermute((lane_id_now() ^ m) << 2, __float_as_int(v))); }
__device__ __forceinline__ int shxi(int v, int m) { return __builtin_amdgcn_ds_bpermute((lane_id_now() ^ m) << 2, v); }
__device__ __forceinline__ int shli(int v, int src) { return __builtin_amdgcn_ds_bpermute(src << 2, v); }
__device__ __forceinline__ float wave_sum(float v) {
#define WS_DPP(CTRL) v += __int_as_float(__builtin_amdgcn_update_dpp(0, __float_as_int(v), (CTRL), 0xF, 0xF, false))
    WS_DPP(0xB1); WS_DPP(0x4E); WS_DPP(0x141); WS_DPP(0x140);
#undef WS_DPP
    const float r0 = __int_as_float(__builtin_amdgcn_readlane(__float_as_int(v), 0)), r1 = __int_as_float(__builtin_amdgcn_readlane(__float_as_int(v), 16));
    const float r2 = __int_as_float(__builtin_amdgcn_readlane(__float_as_int(v), 32)), r3 = __int_as_float(__builtin_amdgcn_readlane(__float_as_int(v), 48));
    return (r0 + r1) + (r2 + r3);
}

#define XB_TMO      128
#define XB_XCNT(j)  (256  + 64 * (j))
#define XB_XSUB(j)  (1280 + 64 * (j))
#define XB_XGEN(j)  (2304 + 64 * (j))
#define XB_TOP      3328
#define XB_TOPGEN   3392
#define XCD_BAR_WORDS 3456
#define XB_SPIN_CAP (1u << 18)

__device__ __forceinline__ unsigned xb_ld(unsigned* p)              { return __hip_atomic_load(p, __ATOMIC_RELAXED, __HIP_MEMORY_SCOPE_AGENT); }
__device__ __forceinline__ unsigned xb_add(unsigned* p, unsigned v) { return __hip_atomic_fetch_add(p, v, __ATOMIC_RELAXED, __HIP_MEMORY_SCOPE_AGENT); }
__device__ __forceinline__ unsigned xb_xcc_id() { return (unsigned)__builtin_amdgcn_s_getreg((3 << 11) | 20) & 0xFu; }
#define XB_SPIN(cond, bar) do { unsigned _sp = 0; while (cond) { __builtin_amdgcn_s_sleep(1); \
    if ((++_sp & 255u) == 0u) { if (xb_ld(&(bar)[XB_TMO])) break; if (_sp > XB_SPIN_CAP) { atomicAdd(&(bar)[XB_TMO], 1u); break; } } } } while (0)

struct XcdBarrier {
    unsigned* bar; unsigned x;
    volatile LAS unsigned* st;
};

__device__ __forceinline__ XcdBarrier xcd_barrier_post(unsigned* bar, volatile LAS unsigned* st) {
    XcdBarrier b; b.bar = bar; b.x = xb_xcc_id(); b.st = st;
    if (threadIdx.x == 0) (void)xb_add(&bar[XB_XCNT(b.x)], 1u);
    return b;
}
__device__ __forceinline__ void xcd_barrier_complete(unsigned* bar, unsigned x, unsigned& nloc, unsigned& nx, const unsigned G) {
    unsigned sum, cnt, mine, sp = 0u;
    for (;;) {
        sum = 0u; cnt = 0u; mine = 0u;
#pragma unroll
        for (unsigned j = 0; j < 16; ++j) { const unsigned c = xb_ld(&bar[XB_XCNT(j)]); sum += c; cnt += (c > 0u) ? 1u : 0u; mine = (j == x) ? c : mine; }
        if (sum == G) break;
        __builtin_amdgcn_s_sleep(1);
        if ((++sp & 255u) == 0u) { if (xb_ld(&bar[XB_TMO])) break; if (sp > XB_SPIN_CAP) { atomicAdd(&bar[XB_TMO], 1u); break; } }
    }
    nloc = mine > 0u ? mine : 1u; nx = cnt > 0u ? cnt : 1u;
}

__device__ __noinline__ void xcd_barrier_ni(unsigned* bar_, unsigned x_, unsigned st_off, bool leader_thread, unsigned G_) {
    XcdBarrier b; b.bar = bar_; b.x = x_; b.st = (volatile LAS unsigned*)(uintptr_t)st_off;
    asm volatile("s_waitcnt vmcnt(0)" ::: "memory");
    __syncthreads();
    if (leader_thread) {
        unsigned* bar = b.bar;
        __builtin_amdgcn_s_waitcnt(0);
        unsigned nloc = b.st[0], nx = b.st[1];
        if (nloc == 0u) { xcd_barrier_complete(bar, b.x, nloc, nx, G_); b.st[0] = nloc; b.st[1] = nx; }
        const unsigned old = xb_add(&bar[XB_XSUB(b.x)], 1u);
        const unsigned gen = old / nloc;
        if (old + 1u == (gen + 1u) * nloc) {
            __builtin_amdgcn_fence(__ATOMIC_RELEASE, "agent");
            asm volatile("s_waitcnt vmcnt(0)" ::: "memory");
            const unsigned og = xb_add(&bar[XB_TOP], 1u);
            const unsigned tg = og / nx;
            if (og + 1u == (tg + 1u) * nx) xb_add(&bar[XB_TOPGEN], 1u);
            else XB_SPIN(xb_ld(&bar[XB_TOPGEN]) == tg, bar);
            __builtin_amdgcn_fence(__ATOMIC_ACQUIRE, "agent");
            xb_add(&bar[XB_XGEN(b.x)], 1u);
            asm volatile("s_waitcnt vmcnt(0)" ::: "memory");
        } else {
            XB_SPIN(xb_ld(&bar[XB_XGEN(b.x)]) == gen, bar);
            __builtin_amdgcn_fence(__ATOMIC_ACQUIRE, "agent");
            asm volatile("s_waitcnt vmcnt(0)" ::: "memory");
        }
    }
    __syncthreads();
}
__device__ __forceinline__ void xcd_barrier(const XcdBarrier& b, bool leader_thread, unsigned G) { xcd_barrier_ni(b.bar, b.x, (unsigned)(uintptr_t)b.st, leader_thread, G); }

struct Frame {
    LAS unsigned char* lds;
    gu32* ctl;
    int tid, lane, wave, bid, G, vcu;
};
struct Job { const float* src; bf16* dst; const float* scale; int ldw, K, col0, nvalid, nblk, row0, item0, f8; float mul; int pad; };
constexpr int NJOBS = 16;
struct Args {
    const float* in[22]; float* out; unsigned char* ws; Job jobs[NJOBS];
    int njob_items, ph_lo, ph_hi, pad;
};
typedef const __attribute__((address_space(4))) Args* ArgsP;

struct TrItem { const float* src; const float* scale; bf16* dst; int ldw, k0, colbase, nvalid, perm, dstK, drow0, f8; float mul; };
__device__ __forceinline__ void tr_load(f32x4 (&v)[16], const TrItem& I, int lane, int wid) {
#pragma unroll
    for (int rr = 0; rr < 16; ++rr) {
        const int k = rr * 8 + wid, n = 4 * lane;
        const float* srow = I.src + (size_t)(I.k0 + k) * I.ldw + I.colbase;
        const int col = (I.perm && n >= 128) ? n + 896 : n;
        if (n + 3 < I.nvalid) v[rr] = __builtin_nontemporal_load((const f32x4*)(srow + col));
        else { f32x4 t; t[0] = (n < I.nvalid) ? srow[col] : 0.f; t[1] = (n + 1 < I.nvalid) ? srow[col + 1] : 0.f; t[2] = (n + 2 < I.nvalid) ? srow[col + 2] : 0.f; t[3] = 0.f; v[rr] = t; }
    }
}
__device__ __forceinline__ void tr_to_lds(const f32x4 (&v)[16], LAS float* scr, const TrItem& I, int lane, int wid) {
#pragma unroll
    for (int rr = 0; rr < 16; ++rr) {
        const int k = rr * 8 + wid;
        const float sc = I.scale ? I.scale[I.k0 + k] * I.mul : I.mul;
        *(LAS f32x4*)(scr + k * 256 + 4 * (lane ^ ((k >> 3) & 15))) = v[rr] * sc;
    }
}
__device__ __forceinline__ void tr_store(const LAS float* scr, const TrItem& I, int lane, int wid) {
#pragma unroll
    for (int q = 0; q < 8; ++q) {
        const int n = wid * 32 + q * 4 + (lane >> 4), a = lane & 15;
        const LAS float* s = scr + (8 * a) * 256 + 4 * ((n >> 2) ^ a) + (n & 3);
        if (I.f8) { u32x2 o; o.x = pg8::pk4_fp8(s[0], s[256], s[2 * 256], s[3 * 256]); o.y = pg8::pk4_fp8(s[4 * 256], s[5 * 256], s[6 * 256], s[7 * 256]);
            __builtin_nontemporal_store(o, (u32x2*)((unsigned char*)I.dst + (size_t)(I.drow0 + n) * I.dstK + I.k0 + 8 * a)); }
        else { u32x4 o; o.x = pk2(s[0], s[256]); o.y = pk2(s[2 * 256], s[3 * 256]); o.z = pk2(s[4 * 256], s[5 * 256]); o.w = pk2(s[6 * 256], s[7 * 256]);
            *(u32x4*)(I.dst + (size_t)(I.drow0 + n) * I.dstK + I.k0 + 8 * a) = o; }
    }
}
__device__ __forceinline__ void sincos_d(double x, float& c, float& s) {
    const double TWO_PI = 6.283185307179586476925, INV_2PI = 0.15915494309189533577;
    const double r = x - TWO_PI * rint(x * INV_2PI), r2 = r * r;
    double sn = 1.0, cs = 1.0;
#pragma unroll
    for (int k = 14; k >= 1; --k) { sn = 1.0 - sn * r2 / (double)((2 * k) * (2 * k + 1)); cs = 1.0 - cs * r2 / (double)((2 * k - 1) * (2 * k)); }
    s = (float)(sn * r); c = (float)cs;
}
constexpr int MOE_ITEMS = DEPTH * NEXP * 96, MOE_ITEMS_LAYER = NEXP * 96;
#ifndef MK_CVT_LAYERS_P0
#define MK_CVT_LAYERS_P0 4
#endif
__device__ __forceinline__ TrItem tr_decode(ArgsP A, unsigned char* ws, int it) {
    TrItem I;
    if (it < MOE_ITEMS) {
        const int le = it / 96, r = it % 96; I.scale = nullptr; I.nvalid = 256; I.dstK = 1024; I.f8 = 1;
        if (r < 64) { const int kb = r >> 3, nb = r & 7; I.src = A->in[16] + (size_t)le * (1024 * 2048); I.ldw = 2048; I.k0 = kb * 128; I.colbase = nb * 128; I.perm = 1;
            I.dst = (bf16*)(ws + WS_WGU + (size_t)le * (2048 * 1024)); I.drow0 = nb * 256; I.mul = 64.0f; }
        else { const int r2 = r - 64, kb = r2 >> 2, nb = r2 & 3; I.src = A->in[18] + (size_t)le * (1024 * 1024); I.ldw = 1024; I.k0 = kb * 128; I.colbase = nb * 256; I.perm = 0;
            I.dst = (bf16*)(ws + WS_WDN + (size_t)le * (1024 * 1024)); I.drow0 = nb * 256; I.mul = 128.0f; }
    } else {
        const int ji = it - MOE_ITEMS; int j = 0;
#pragma unroll
        for (int q = 1; q < NJOBS; ++q) j += (A->jobs[q].item0 <= ji) ? 1 : 0;
        const int K = A->jobs[j].K, r = ji - A->jobs[j].item0, nkb = K >> 7, kb = r % nkb, nb = r / nkb;
        int nv = A->jobs[j].nvalid - nb * 256; nv = nv < 0 ? 0 : (nv > 256 ? 256 : nv);
        I.src = A->jobs[j].src; I.scale = A->jobs[j].scale; I.dst = A->jobs[j].dst; I.ldw = A->jobs[j].ldw; I.k0 = kb * 128; I.colbase = A->jobs[j].col0 + nb * 256; I.nvalid = nv; I.perm = 0;
        I.dstK = K; I.drow0 = A->jobs[j].row0 + nb * 256; I.f8 = A->jobs[j].f8; I.mul = A->jobs[j].mul;
    }
    return I;
}
__device__ __forceinline__ void tr_run(Frame& F, ArgsP A, unsigned char* ws, int j0, int step, int j1, int split, int gap) {
    LAS float* scr = (LAS float*)(F.lds + RING_OFF);
#define TR_ITEM(jj) tr_decode(A, ws, (jj) < split ? (jj) : (jj) + gap)
    if (j0 < j1) {
        f32x4 vA[16], vB[16];
        TrItem ia = TR_ITEM(j0), ib = ia;
        tr_load(vA, ia, F.lane, F.wave);
        if (j0 + step < j1) { ib = TR_ITEM(j0 + step); tr_load(vB, ib, F.lane, F.wave); }
        for (int j = j0; j < j1; j += 2 * step) {
            tr_to_lds(vA, scr, ia, F.lane, F.wave);
            __syncthreads();
            const TrItem ca = ia;
            if (j + 2 * step < j1) { ia = TR_ITEM(j + 2 * step); tr_load(vA, ia, F.lane, F.wave); }
            tr_store(scr, ca, F.lane, F.wave);
            __syncthreads();
            if (j + step < j1) {
                tr_to_lds(vB, scr, ib, F.lane, F.wave);
                __syncthreads();
                const TrItem cb = ib;
                if (j + 3 * step < j1) { ib = TR_ITEM(j + 3 * step); tr_load(vB, ib, F.lane, F.wave); }
                tr_store(scr, cb, F.lane, F.wave);
                __syncthreads();
            }
        }
    }
#undef TR_ITEM
}
__device__ __forceinline__ void p0_prologue(Frame& F, ArgsP A, unsigned char* ws, const int part) {
    constexpr int NP0 = MK_CVT_LAYERS_P0 * MOE_ITEMS_LAYER;
    const int total = NP0 + A->njob_items;
    const int it_lo = (part == 1) ? NP0 : 0, it_hi = (part == 2) ? NP0 : total;
    tr_run(F, A, ws, it_lo + F.bid, F.G, it_hi, NP0, MOE_ITEMS - NP0);
    if (part == 2) return;
    const size_t gt = (size_t)F.bid * NTHREADS + F.tid, NT = (size_t)F.G * NTHREADS;
    { const float* x = A->in[0]; bf16* xb = (bf16*)(ws + WS_XB);
      for (size_t i = gt; i < (size_t)T * D / 8; i += 4 * NT) {
          f32x4 a[4], b[4];
#pragma unroll
          for (int k = 0; k < 4; ++k) if (i + k * NT < (size_t)T * D / 8) { a[k] = *(const f32x4*)(x + (i + k * NT) * 8); b[k] = *(const f32x4*)(x + (i + k * NT) * 8 + 4); }
#pragma unroll
          for (int k = 0; k < 4; ++k) if (i + k * NT < (size_t)T * D / 8) { u32x4 o; o.x = pk2(a[k][0], a[k][1]); o.y = pk2(a[k][2], a[k][3]); o.z = pk2(b[k][0], b[k][1]); o.w = pk2(b[k][2], b[k][3]); *(u32x4*)(xb + (i + k * NT) * 8) = o; } }
      const float* mm = A->in[1]; bf16* mb = (bf16*)(ws + WS_MEMB);
      for (size_t i = gt; i < (size_t)NB * MEML * D / 8; i += NT) { const f32x4 a = *(const f32x4*)(mm + i * 8), b = *(const f32x4*)(mm + i * 8 + 4);
          u32x4 o; o.x = pk2(a[0], a[1]); o.y = pk2(a[2], a[3]); o.z = pk2(b[0], b[1]); o.w = pk2(b[2], b[3]); *(u32x4*)(mb + i * 8) = o; } }
    { f32x2* rt = (f32x2*)(ws + WS_ROPE);
      for (size_t i = gt; i < (size_t)SEQ * 8; i += NT) { const int pos = (int)(i >> 3), k = (int)(i & 7);
          const double inv = k == 0 ? 1.0 : k == 1 ? 0.19392274474868576 : k == 2 ? 0.03760603093086393 : k == 3 ? 0.007292664737217109 : k == 4 ? 0.001414213562373095 : k == 5 ? 0.0002742481756762073 : k == 6 ? 5.318295896944988e-05 : 1.031338537721246e-05;
          float c, s; sincos_d((double)pos * inv, c, s); rt[i] = (f32x2){c, s}; } }
}

struct AttnP {
    const bf16* Q; const bf16* K; const bf16* V; bf16* O; const unsigned long long* mask;
    int ldq, ldk, ldv, ldo, qrow0, krow0, t_lo, t_hi, qpos0, mode, has_sink, o8; float sink2;
};
constexpr int AT_K0 = 0, AT_KSZ = 64 * 144, AT_V0 = 2 * AT_KSZ, AT_VSZ = 8192;
__device__ __forceinline__ s16x4 vtr(const LAS unsigned char* p) { return __builtin_bit_cast(s16x4, __builtin_amdgcn_ds_read_tr16_b64_v4i16((LAS v4i16_t*)p)); }
__device__ __forceinline__ void attn_unit(const Frame& F, const AttnP& P) {
    const int tid = F.tid, lane = F.lane, wid = F.wave, r32 = lane & 31, hi = lane >> 5;
    LAS unsigned char* lds = F.lds + RING_OFF;
    const int skey = tid >> 3, sc = tid & 7;
    const int kdst = skey * 144 + sc * 16;
    const int vdst = (sc >> 2) * 4096 + (skey >> 4) * 1024 + (skey & 15) * 64 + (sc & 3) * 16;
    const bf16* kg = P.K + (size_t)(P.krow0 + skey) * P.ldk + sc * 8;
    const bf16* vg = P.V + (size_t)(P.krow0 + skey) * P.ldv + sc * 8;
    const int qrow = P.qrow0 + wid * 32 + r32;
    bf16x8 qr[4];
#pragma unroll
    for (int d0 = 0; d0 < 4; ++d0) qr[d0] = *(const bf16x8*)(P.Q + (size_t)qrow * P.ldq + d0 * 16 + hi * 8);
    const int qmin = P.qpos0 + wid * 32, qmax = qmin + 31, qpos = qmin + r32;
    float m = P.has_sink ? P.sink2 : NEG_BIG;
    f32x16 o0 = {}, o1 = {}, lacc;
#pragma unroll
    for (int r = 0; r < 16; ++r) lacc[r] = P.has_sink ? 1.f : 0.f;
    const bf16x8 ones8 = (bf16x8){0x3f80, 0x3f80, 0x3f80, 0x3f80, 0x3f80, 0x3f80, 0x3f80, 0x3f80};
    const int vp0 = ((lane >> 4) & 1) * 32 + (lane & 3) * 8 + (4 * hi + ((lane & 15) >> 2)) * 64;
    u32x4 kreg = *(const u32x4*)(kg + (size_t)P.t_lo * 64 * P.ldk), vreg = *(const u32x4*)(vg + (size_t)P.t_lo * 64 * P.ldv);
    const unsigned long long* mrow = P.mode == 2 ? P.mask + (size_t)(wid * 32 + r32) * 64 : nullptr;
    unsigned long long mcur = 0ull, mnxt = P.mode == 2 ? mrow[P.t_lo] : 0ull;
    *(LAS u32x4*)(lds + AT_K0 + kdst) = kreg; *(LAS u32x4*)(lds + AT_V0 + vdst) = vreg;
    __syncthreads();
    for (int t = P.t_lo; t < P.t_hi; ++t) {
        const int cur = (t - P.t_lo) & 1;
        const bool more = (t + 1 < P.t_hi);
        mcur = mnxt;
        if (more) { kreg = *(const u32x4*)(kg + (size_t)(t + 1) * 64 * P.ldk); vreg = *(const u32x4*)(vg + (size_t)(t + 1) * 64 * P.ldv); if (P.mode == 2) mnxt = mrow[t + 1]; }
        bool active = true;
        if (P.mode == 1) active = (64 * t + 63 >= qmin - 127) && (64 * t <= qmax);
        if (P.mode == 2) active = (64 * t <= qmax);
        if (active) {
            const LAS unsigned char* Kb = lds + AT_K0 + cur * AT_KSZ; const LAS unsigned char* Vb = lds + AT_V0 + cur * AT_VSZ;
            f32x16 p0 = {}, p1 = {};
#pragma unroll
            for (int d0 = 0; d0 < 4; ++d0) {
                const bf16x8 a0 = *(const LAS bf16x8*)(Kb + r32 * 144 + (2 * d0 + hi) * 16);
                const bf16x8 a1 = *(const LAS bf16x8*)(Kb + (r32 + 32) * 144 + (2 * d0 + hi) * 16);
                p0 = __builtin_amdgcn_mfma_f32_32x32x16_bf16(a0, qr[d0], p0, 0, 0, 0);
                p1 = __builtin_amdgcn_mfma_f32_32x32x16_bf16(a1, qr[d0], p1, 0, 0, 0);
            }
            float mx = fmaxf(p0[0], p1[0]);
#pragma unroll
            for (int r = 1; r < 16; ++r) mx = fmaxf(fmaxf(mx, p0[r]), p1[r]);
            mx = swapmax(mx) * C2;
            const float mnew = fmaxf(m, mx), alpha = __builtin_amdgcn_exp2f(m - mnew);
            m = mnew;
#pragma unroll
            for (int r = 0; r < 16; r += 2) {
                f32x2 a_ = {p0[r], p0[r + 1]}, b_ = {p1[r], p1[r + 1]}; const f32x2 c2_ = {C2, C2}, nm_ = {-mnew, -mnew};
                a_ = __builtin_elementwise_fma(a_, c2_, nm_); b_ = __builtin_elementwise_fma(b_, c2_, nm_);
                p0[r] = __builtin_amdgcn_exp2f(a_[0]); p0[r + 1] = __builtin_amdgcn_exp2f(a_[1]); p1[r] = __builtin_amdgcn_exp2f(b_[0]); p1[r + 1] = __builtin_amdgcn_exp2f(b_[1]); }
            if (P.mode == 1) {
                const int rel = qpos - 64 * t - 4 * hi;
#pragma unroll
                for (int r = 0; r < 16; ++r) { const int c = (r & 3) + 8 * (r >> 2);
                    p0[r] = ((unsigned)(rel - c) < 128u) ? p0[r] : 0.f; p1[r] = ((unsigned)(rel - c - 32) < 128u) ? p1[r] : 0.f; }
            } else if (P.mode == 2) {
                const unsigned long long w = mcur >> (4 * hi);
                const int wl = (int)(unsigned)w, wh = (int)(unsigned)(w >> 32);
#pragma unroll
                for (int r = 0; r < 16; ++r) { const int c = (r & 3) + 8 * (r >> 2);
                    int d0_ = __builtin_amdgcn_sbfe(wl, c, 1), d1_ = __builtin_amdgcn_sbfe(wh, c, 1); asm("" : "+v"(d0_), "+v"(d1_));
                    p0[r] = __uint_as_float(__float_as_uint(p0[r]) & (unsigned)d0_); p1[r] = __uint_as_float(__float_as_uint(p1[r]) & (unsigned)d1_); }
            }
            if (__any(alpha != 1.0f)) {
#pragma unroll
                for (int r = 0; r < 16; ++r) { o0[r] *= alpha; o1[r] *= alpha; lacc[r] *= alpha; }
            }
            bf16x8 pf[4];
            { u32x4 w;
              w.x = pk2(p0[0], p0[1]); w.y = pk2(p0[2], p0[3]); w.z = pk2(p0[4], p0[5]); w.w = pk2(p0[6], p0[7]); pf[0] = __builtin_bit_cast(bf16x8, w);
              w.x = pk2(p0[8], p0[9]); w.y = pk2(p0[10], p0[11]); w.z = pk2(p0[12], p0[13]); w.w = pk2(p0[14], p0[15]); pf[1] = __builtin_bit_cast(bf16x8, w);
              w.x = pk2(p1[0], p1[1]); w.y = pk2(p1[2], p1[3]); w.z = pk2(p1[4], p1[5]); w.w = pk2(p1[6], p1[7]); pf[2] = __builtin_bit_cast(bf16x8, w);
              w.x = pk2(p1[8], p1[9]); w.y = pk2(p1[10], p1[11]); w.z = pk2(p1[12], p1[13]); w.w = pk2(p1[14], p1[15]); pf[3] = __builtin_bit_cast(bf16x8, w); }
#pragma unroll
            for (int ks = 0; ks < 4; ++ks) {
                const s16x4 a_lo = vtr(Vb + vp0 + ks * 1024), a_hi = vtr(Vb + vp0 + ks * 1024 + 512);
                const s16x4 b_lo = vtr(Vb + vp0 + 4096 + ks * 1024), b_hi = vtr(Vb + vp0 + 4096 + ks * 1024 + 512);
                const bf16x8 va = (bf16x8){a_lo[0], a_lo[1], a_lo[2], a_lo[3], a_hi[0], a_hi[1], a_hi[2], a_hi[3]};
                const bf16x8 vb = (bf16x8){b_lo[0], b_lo[1], b_lo[2], b_lo[3], b_hi[0], b_hi[1], b_hi[2], b_hi[3]};
                o0 = __builtin_amdgcn_mfma_f32_32x32x16_bf16(va, pf[ks], o0, 0, 0, 0);
                o1 = __builtin_amdgcn_mfma_f32_32x32x16_bf16(vb, pf[ks], o1, 0, 0, 0);
                lacc = __builtin_amdgcn_mfma_f32_32x32x16_bf16(ones8, pf[ks], lacc, 0, 0, 0);
            }
        }
        if (more) { *(LAS u32x4*)(lds + AT_K0 + (cur ^ 1) * AT_KSZ + kdst) = kreg; *(LAS u32x4*)(lds + AT_V0 + (cur ^ 1) * AT_VSZ + vdst) = vreg; }
        __syncthreads();
    }
    const float inv = 1.0f / lacc[0];
    if (P.o8) {
        unsigned char* orow8 = (unsigned char*)P.O + (size_t)qrow * P.ldo + 4 * hi;
#pragma unroll
        for (int g = 0; g < 4; ++g) {
            *(unsigned*)(orow8 + 8 * g) = pg8::pk4_fp8(o0[4 * g] * inv, o0[4 * g + 1] * inv, o0[4 * g + 2] * inv, o0[4 * g + 3] * inv);
            *(unsigned*)(orow8 + 32 + 8 * g) = pg8::pk4_fp8(o1[4 * g] * inv, o1[4 * g + 1] * inv, o1[4 * g + 2] * inv, o1[4 * g + 3] * inv);
        }
        return;
    }
    bf16* orow = P.O + (size_t)qrow * P.ldo + 4 * hi;
#pragma unroll
    for (int g = 0; g < 4; ++g) {
        u32x2 w0, w1;
        w0.x = pk2(o0[4 * g] * inv, o0[4 * g + 1] * inv); w0.y = pk2(o0[4 * g + 2] * inv, o0[4 * g + 3] * inv);
        w1.x = pk2(o1[4 * g] * inv, o1[4 * g + 1] * inv); w1.y = pk2(o1[4 * g + 2] * inv, o1[4 * g + 3] * inv);
        *(u32x2*)(orow + 8 * g) = w0; *(u32x2*)(orow + 32 + 8 * g) = w1;
    }
}

__device__ __forceinline__ void conv_item(const bf16* PROJ, const float* cw, bf16* CAT, int idx) {
    const int chunk = idx % 96, run = idx / 96, c0 = chunk * 8, t0 = run * 16;
    float w0[8], w1[8], w2[8];
#pragma unroll
    for (int j = 0; j < 8; ++j) { w0[j] = cw[c0 + j]; w1[j] = cw[768 + c0 + j]; w2[j] = cw[1536 + c0 + j]; }
    float z1[8], z2[8];
#pragma unroll
    for (int j = 0; j < 8; ++j) { z1[j] = 0.f; z2[j] = 0.f; }
    if ((t0 & (SEQ - 1)) != 0) {
#pragma unroll
        for (int back = 2; back >= 1; --back) {
            const bf16* row = PROJ + (size_t)(t0 - back) * 2560;
            const u32x4 uu = *(const u32x4*)(row + c0), cc = *(const u32x4*)(row + 1536 + c0);
            float z[8];
            z[0] = bflo(uu.x) * bflo(cc.x); z[1] = bfhi(uu.x) * bfhi(cc.x); z[2] = bflo(uu.y) * bflo(cc.y); z[3] = bfhi(uu.y) * bfhi(cc.y);
            z[4] = bflo(uu.z) * bflo(cc.z); z[5] = bfhi(uu.z) * bfhi(cc.z); z[6] = bflo(uu.w) * bflo(cc.w); z[7] = bfhi(uu.w) * bfhi(cc.w);
#pragma unroll
            for (int j = 0; j < 8; ++j) { if (back == 2) z2[j] = z[j]; else z1[j] = z[j]; }
        }
    }
    u32x4 in_[2][4][3];
#define CONV_LOADG(G, S) do { _Pragma("unroll") for (int k = 0; k < 4; ++k) { const bf16* row = PROJ + (size_t)(t0 + 4 * (G) + k) * 2560; \
        in_[S][k][0] = *(const u32x4*)(row + c0); in_[S][k][1] = *(const u32x4*)(row + 768 + c0); in_[S][k][2] = *(const u32x4*)(row + 1536 + c0); } } while (0)
    CONV_LOADG(0, 0);
#pragma unroll
    for (int g = 0; g < 4; ++g) {
        if (g < 3) CONV_LOADG(g + 1, (g + 1) & 1);
#pragma unroll
        for (int k = 0; k < 4; ++k) {
            const int i = 4 * g + k;
            const u32x4 uu = in_[g & 1][k][0], bb = in_[g & 1][k][1], cc = in_[g & 1][k][2];
            float z[8], b[8], r[8];
            z[0] = bflo(uu.x) * bflo(cc.x); z[1] = bfhi(uu.x) * bfhi(cc.x); z[2] = bflo(uu.y) * bflo(cc.y); z[3] = bfhi(uu.y) * bfhi(cc.y);
            z[4] = bflo(uu.z) * bflo(cc.z); z[5] = bfhi(uu.z) * bfhi(cc.z); z[6] = bflo(uu.w) * bflo(cc.w); z[7] = bfhi(uu.w) * bfhi(cc.w);
            b[0] = bflo(bb.x); b[1] = bfhi(bb.x); b[2] = bflo(bb.y); b[3] = bfhi(bb.y); b[4] = bflo(bb.z); b[5] = bfhi(bb.z); b[6] = bflo(bb.w); b[7] = bfhi(bb.w);
#pragma unroll
            for (int j = 0; j < 8; ++j) { r[j] = b[j] * ((w0[j] * z2[j] + w1[j] * z1[j]) + w2[j] * z[j]); z2[j] = z1[j]; z1[j] = z[j]; }
            u32x4 o; o.x = pk2(r[0], r[1]); o.y = pk2(r[2], r[3]); o.z = pk2(r[4], r[5]); o.w = pk2(r[6], r[7]);
            (void)o; u32x2 o8_; o8_.x = pg8::pk4_fp8(r[0], r[1], r[2], r[3]); o8_.y = pg8::pk4_fp8(r[4], r[5], r[6], r[7]); *(u32x2*)((unsigned char*)CAT + (size_t)(t0 + i) * 1024 + c0) = o8_;
        }
    }
#undef CONV_LOADG
}

__device__ __forceinline__ void mixer_phase(Frame& F, ArgsP A, unsigned char* ws, int layer, int kind, int qidx) {
    const bf16* PROJ = (const bf16*)(ws + WS_PROJ); bf16* CAT = (bf16*)(ws + WS_CAT); const bf16* KVM = (const bf16*)(ws + WS_KVMEM) + layer * 512;
    const int nproj = kind == 0 ? 2560 : (kind == 1 ? 1280 : 1536), qm_off = kind == 0 ? 2304 : (kind == 1 ? 768 : 1280);
    const int n_main = kind == 0 ? 0 : 768, n_mem = 256, n_conv = kind == 0 ? 192 : 0;
    constexpr int CVT_PER = 12, N_CVT = (DEPTH - MK_CVT_LAYERS_P0) * MOE_ITEMS_LAYER / CVT_PER;
    const int n_cvt = (kind == 1) ? N_CVT : 0;
    const int total = n_main + n_mem + n_conv + n_cvt;
    volatile LAS unsigned* qw = (volatile LAS unsigned*)(F.lds + L_Q);
    for (;;) {
        if (F.tid == 0) *qw = __hip_atomic_fetch_add(F.ctl + CW_QHEAD + 64 * qidx, 1u, RLX_AGENT);
        __syncthreads();
        int u = (int)*qw;
        __syncthreads();
        if (u >= total) break;
        if (n_cvt) {
            if (u < 3 * n_cvt) { if (u % 3 == 2) { const int c = u / 3; tr_run(F, A, ws, MK_CVT_LAYERS_P0 * MOE_ITEMS_LAYER + c * CVT_PER, 1, MK_CVT_LAYERS_P0 * MOE_ITEMS_LAYER + c * CVT_PER + CVT_PER, MOE_ITEMS, 0); continue; } u = (u / 3) * 2 + u % 3; }
            else u -= n_cvt;
        }
        if (u < n_main) {
            AttnP P;
            if (kind == 1) {
                const int qt = 15 - u / 48, rem = u % 48, b = rem / 12, h = rem % 12, g = h / 3;
                P.Q = (const bf16*)(ws + WS_QQ) + h * 64; P.ldq = 1280; P.K = PROJ + 256 + g * 64; P.ldk = 1280; P.V = PROJ + 512 + g * 64; P.ldv = 1280;
                P.O = (bf16*)((unsigned char*)CAT + h * 64); P.ldo = 1024; P.o8 = 1; P.qrow0 = b * SEQ + qt * 256; P.krow0 = b * SEQ; P.t_lo = 0; P.t_hi = qt * 4 + 4; P.qpos0 = qt * 256; P.mode = 2;
                P.mask = (const unsigned long long*)(ws + WS_MASK) + (size_t)P.qrow0 * 64; P.has_sink = 0; P.sink2 = 0.f;
            } else {
                const int b = u / 192, h = (u / 16) % 12, qt = u % 16, g = h / 3;
                P.Q = PROJ + h * 64; P.ldq = 1536; P.K = PROJ + 768 + g * 64; P.ldk = 1536; P.V = PROJ + 1024 + g * 64; P.ldv = 1536;
                P.O = (bf16*)((unsigned char*)CAT + h * 64); P.ldo = 1024; P.o8 = 1; P.qrow0 = b * SEQ + qt * 256; P.krow0 = b * SEQ; P.qpos0 = qt * 256;
                P.t_lo = qt == 0 ? 0 : (qt * 256 - 128) / 64; P.t_hi = qt * 4 + 4; P.mode = 1; P.mask = nullptr; P.has_sink = 1; P.sink2 = A->in[9][h] * LOG2E;
            }
            attn_unit(F, P);
        } else if (u < n_main + n_mem) {
            const int v = u - n_main, b = v / 64, h = (v / 16) % 4, qt = v % 16;
            AttnP P;
            P.Q = PROJ + qm_off + h * 64; P.ldq = nproj; P.K = KVM + h * 64; P.ldk = 2048; P.V = KVM + 256 + h * 64; P.ldv = 2048;
            P.o8 = 1; P.O = P.o8 ? (bf16*)((unsigned char*)CAT + 768 + h * 64) : CAT + 768 + h * 64; P.ldo = 1024; P.qrow0 = b * SEQ + qt * 256; P.krow0 = b * MEML; P.t_lo = 0; P.t_hi = 4; P.qpos0 = qt * 256; P.mode = 0; P.mask = nullptr; P.has_sink = 0; P.sink2 = 0.f;
            attn_unit(F, P);
        } else {
            const int v = u - n_main - n_mem;
            conv_item(PROJ, A->in[3] + (size_t)(layer == 0 ? 0 : 1) * 3 * 768, CAT, v * NTHREADS + F.tid);
        }
    }
}

__device__ __forceinline__ void score_phase(Frame& F, const bf16* QQ, const bf16* PROJ, float* SC) {
    const int lane = F.lane, r32 = lane & 31, hi = lane >> 5;
    LAS float* wtab = (LAS float*)(F.lds + RING_OFF + F.wave * 1024);
    constexpr float WSCALE = 0.04419417382415922f;
    constexpr int PER_B = 576;
    const __amdgpu_buffer_rsrc_t scrs = __builtin_amdgcn_make_buffer_rsrc((void*)SC, 0, T * SEQ * 4, 0x00020000);
    for (int wu = F.bid * NWAVES + F.wave; wu < NB * PER_B; wu += F.G * NWAVES) {
        const int b = wu / PER_B, idx = PER_B - 1 - wu % PER_B;
        int g = 0;
        for (int k = 1; k < 8; ++k) g += (8 * k * (k + 1) <= idx) ? 1 : 0;
        const int r = idx - 8 * g * (g + 1), qb = 16 * g + r / (g + 1), c = r % (g + 1);
        const int kb_lo = 16 * c, kb_hi = (16 * c + 16 < qb + 1) ? 16 * c + 16 : qb + 1;
        const int t0 = b * SEQ + 32 * qb;
#pragma unroll
        for (int k = 0; k < 4; ++k) { const int i4 = lane * 4 + k, h = i4 >> 5, hh = (i4 >> 4) & 1, reg = i4 & 15;
            wtab[i4] = bf2f(PROJ[(size_t)(t0 + crow(reg, hh)) * 1280 + 1088 + h]) * WSCALE; }
        bf16x8 qA[8][4];
#pragma unroll
        for (int h = 0; h < 8; ++h)
#pragma unroll
            for (int st = 0; st < 4; ++st) qA[h][st] = *(const bf16x8*)(QQ + (size_t)(t0 + r32) * 1280 + 768 + h * 64 + st * 16 + hi * 8);
        const bf16* kbase = PROJ + (size_t)(b * SEQ + r32) * 1280 + 1024 + hi * 8;
        bf16x8 kA[4], kBf[4];
#pragma unroll
        for (int st = 0; st < 4; ++st) kA[st] = *(const bf16x8*)(kbase + (size_t)(32 * kb_lo) * 1280 + st * 16);
#define PS_BLOCK(KF, KB) do { f32x16 acc = {}; \
            _Pragma("unroll") for (int h = 0; h < 8; ++h) { f32x16 dd = {}; \
                _Pragma("unroll") for (int st = 0; st < 4; ++st) dd = __builtin_amdgcn_mfma_f32_32x32x16_bf16(qA[h][st], KF[st], dd, 0, 0, 0); \
                const LAS f32x4* wp = (const LAS f32x4*)(wtab + (h * 2 + hi) * 16); const f32x4 w0 = wp[0], w1 = wp[1], w2 = wp[2], w3 = wp[3]; \
                _Pragma("unroll") for (int q = 0; q < 4; ++q) { acc[q] = fmaf(w0[q], fmaxf(dd[q], 0.f), acc[q]); acc[4 + q] = fmaf(w1[q], fmaxf(dd[4 + q], 0.f), acc[4 + q]); \
                    acc[8 + q] = fmaf(w2[q], fmaxf(dd[8 + q], 0.f), acc[8 + q]); acc[12 + q] = fmaf(w3[q], fmaxf(dd[12 + q], 0.f), acc[12 + q]); } \
                if (h & 1) __builtin_amdgcn_sched_barrier(0); } \
            _Pragma("unroll") for (int reg = 0; reg < 16; ++reg) __builtin_amdgcn_raw_buffer_store_b32(__float_as_uint(acc[reg]), scrs, (4 * hi * SEQ + r32) * 4, ((t0 + (reg & 3) + 8 * (reg >> 2)) * SEQ + 32 * (KB)) * 4, 0); } while (0)
        for (int kb = kb_lo; kb < kb_hi; kb += 2) {
            __builtin_amdgcn_sched_barrier(0);
            if (kb + 1 < kb_hi) {
#pragma unroll
                for (int st = 0; st < 4; ++st) kBf[st] = *(const bf16x8*)(kbase + (size_t)(32 * (kb + 1)) * 1280 + st * 16);
            }
            __builtin_amdgcn_sched_barrier(0);
            PS_BLOCK(kA, kb);
            __builtin_amdgcn_sched_barrier(0);
            if (kb + 1 < kb_hi) {
                if (kb + 2 < kb_hi) {
#pragma unroll
                    for (int st = 0; st < 4; ++st) kA[st] = *(const bf16x8*)(kbase + (size_t)(32 * (kb + 2)) * 1280 + st * 16);
                }
                __builtin_amdgcn_sched_barrier(0);
                PS_BLOCK(kBf, kb + 1);
            }
        }
#undef PS_BLOCK
    }
}
__device__ __forceinline__ void select_phase(Frame& F, const float* SC, unsigned long long* MASK) {
    const int qstride = F.G * NWAVES;
    unsigned raw[64];
#define SEL_LOAD(qq) do { const int pos_ = (qq) & (SEQ - 1); if ((qq) < T && pos_ >= 256) { int ln_ = lane_id_now(); const int ni_ = (pos_ >> 6) + 1; const float* row_ = SC + (size_t)(qq) * SEQ; \
        _Pragma("unroll") for (int gq = 0; gq < 4; ++gq) if (ni_ > 16 * gq) { _Pragma("unroll") for (int i = 16 * gq; i < 16 * gq + 16; ++i) { const int s_ = 64 * i + ln_; raw[i] = __float_as_uint(__builtin_nontemporal_load(row_ + (s_ <= pos_ ? s_ : pos_))); } } } } while (0)
    int q0_ = F.bid * NWAVES + F.wave;
    SEL_LOAD(q0_);
    for (int q = q0_; q < T; q += qstride) {
        int lane = F.lane; asm volatile("" : "+v"(lane));
        const int pos = q & (SEQ - 1);
        unsigned long long myword = 0ull;
        if (pos < 256) {
            const int lo = 64 * lane;
            myword = (lo > pos) ? 0ull : ((pos - lo >= 63) ? ~0ull : ((1ull << (pos - lo + 1)) - 1ull));
            SEL_LOAD(q + qstride);
        } else {
            const int ni = (pos >> 6) + 1;
            unsigned key[64];
#pragma unroll
            for (int i = 0; i < 64; ++i) key[i] = 0u;
#pragma unroll
            for (int gq = 0; gq < 4; ++gq) if (ni > 16 * gq) {
#pragma unroll
                for (int i = 16 * gq; i < 16 * gq + 16; ++i) { const int s = 64 * i + lane; unsigned bts = raw[i]; if (bts == 0x80000000u) bts = 0u;
                    const unsigned kk = (bts & 0x80000000u) ? ~bts : (bts | 0x80000000u); key[i] = (s <= pos) ? kk : 0u; } }
            SEL_LOAD(q + qstride);
            auto count_ge = [&](const unsigned Tp) -> int {
                int cA = 0, cB = 0, cC = 0, cD = 0;
#pragma unroll
                for (int gq = 0; gq < 4; ++gq) if (ni > 16 * gq) {
                    unsigned long long m0_, m1_, m2_, m3_;
                    asm("v_cmp_le_u32_e64 %4, %8, %9\n\tv_cmp_le_u32_e64 %5, %8, %10\n\tv_cmp_le_u32_e64 %6, %8, %11\n\tv_cmp_le_u32_e64 %7, %8, %12\n\tv_addc_co_u32_e64 %0, %4, 0, %0, %4\n\tv_addc_co_u32_e64 %1, %5, 0, %1, %5\n\tv_addc_co_u32_e64 %2, %6, 0, %2, %6\n\tv_addc_co_u32_e64 %3, %7, 0, %3, %7\n\tv_cmp_le_u32_e64 %4, %8, %13\n\tv_cmp_le_u32_e64 %5, %8, %14\n\tv_cmp_le_u32_e64 %6, %8, %15\n\tv_cmp_le_u32_e64 %7, %8, %16\n\tv_addc_co_u32_e64 %0, %4, 0, %0, %4\n\tv_addc_co_u32_e64 %1, %5, 0, %1, %5\n\tv_addc_co_u32_e64 %2, %6, 0, %2, %6\n\tv_addc_co_u32_e64 %3, %7, 0, %3, %7\n\tv_cmp_le_u32_e64 %4, %8, %17\n\tv_cmp_le_u32_e64 %5, %8, %18\n\tv_cmp_le_u32_e64 %6, %8, %19\n\tv_cmp_le_u32_e64 %7, %8, %20\n\tv_addc_co_u32_e64 %0, %4, 0, %0, %4\n\tv_addc_co_u32_e64 %1, %5, 0, %1, %5\n\tv_addc_co_u32_e64 %2, %6, 0, %2, %6\n\tv_addc_co_u32_e64 %3, %7, 0, %3, %7\n\tv_cmp_le_u32_e64 %4, %8, %21\n\tv_cmp_le_u32_e64 %5, %8, %22\n\tv_cmp_le_u32_e64 %6, %8, %23\n\tv_cmp_le_u32_e64 %7, %8, %24\n\tv_addc_co_u32_e64 %0, %4, 0, %0, %4\n\tv_addc_co_u32_e64 %1, %5, 0, %1, %5\n\tv_addc_co_u32_e64 %2, %6, 0, %2, %6\n\tv_addc_co_u32_e64 %3, %7, 0, %3, %7"
                        : "+v"(cA), "+v"(cB), "+v"(cC), "+v"(cD), "=&s"(m0_), "=&s"(m1_), "=&s"(m2_), "=&s"(m3_) : "s"(Tp), "v"(key[16 * gq + 0]), "v"(key[16 * gq + 1]), "v"(key[16 * gq + 2]), "v"(key[16 * gq + 3]), "v"(key[16 * gq + 4]), "v"(key[16 * gq + 5]), "v"(key[16 * gq + 6]), "v"(key[16 * gq + 7]), "v"(key[16 * gq + 8]), "v"(key[16 * gq + 9]), "v"(key[16 * gq + 10]), "v"(key[16 * gq + 11]), "v"(key[16 * gq + 12]), "v"(key[16 * gq + 13]), "v"(key[16 * gq + 14]), "v"(key[16 * gq + 15])); }
                const int cl = (cA + cB) + (cC + cD);
                int c = 0;
#pragma unroll
                for (int bb = 0; bb < 7; ++bb) c += __popcll(__ballot((cl >> bb) & 1)) << bb;
                return c; };
            unsigned kmx = 0u;
#pragma unroll
            for (int i = 0; i < 64; ++i) kmx = key[i] > kmx ? key[i] : kmx;
#pragma unroll
            for (int o = 1; o < 64; o <<= 1) { const unsigned ov = (unsigned)shxi((int)kmx, o); kmx = ov > kmx ? ov : kmx; }
            kmx = (unsigned)__builtin_amdgcn_readfirstlane((int)kmx);
            unsigned lo = 0u, hi = kmx + 1u; int clo = pos + 1, chi = 0;
            if (kmx > 0x82000000u) { const unsigned l2 = (kmx & 0xff800000u) - 0x02000000u; const int c2 = count_ge(l2); if (c2 >= 256) { lo = l2; clo = c2; } else { hi = l2; chi = c2; } }
            float flo = (float)clo - 255.5f, fhi = (float)chi - 255.5f; int side = 0;
            for (int it = 0; it < 96; ++it) {
                if (clo == 256 || hi - lo <= 1u) break;
                const unsigned span = hi - lo;
                unsigned mid;
                if (it % 3 == 2) mid = lo + (span >> 1);
                else { const float tt = flo / (flo - fhi); unsigned d = (unsigned)((float)span * tt); d = d < 1u ? 1u : (d > span - 1u ? span - 1u : d); mid = lo + d; }
                mid = (unsigned)__builtin_amdgcn_readfirstlane((int)mid);
                const int c = count_ge(mid);
                if (c >= 256) { lo = mid; clo = c; flo = (float)c - 255.5f; if (side == 1) fhi *= 0.5f; side = 1; }
                else { hi = mid; chi = c; fhi = (float)c - 255.5f; if (side == -1) flo *= 0.5f; side = -1; }
            }
            const unsigned Tk = lo; const int cT = clo;
            int need = 256, base = 0;
            if (cT != 256) {
                int cl = 0;
#pragma unroll
                for (int i = 0; i < 64; ++i) cl += (key[i] > Tk) ? 1 : 0;
                int cgt = 0;
#pragma unroll
                for (int bb = 0; bb < 7; ++bb) cgt += __popcll(__ballot((cl >> bb) & 1)) << bb;
                need = 256 - cgt;
            }
            int wlo = 0, whi = 0;
            if (cT == 256) {
#pragma unroll
                for (int i = 0; i < 64; ++i) { const unsigned long long wsel = __ballot(key[i] >= Tk);
                    asm("s_nop 4\n\tv_writelane_b32 %0, %2, %4\n\tv_writelane_b32 %1, %3, %4" : "+v"(wlo), "+v"(whi) : "s"((int)(unsigned)wsel), "s"((int)(unsigned)(wsel >> 32)), "n"(i)); }
            } else {
                const unsigned long long ltmask = (1ull << lane) - 1ull;
#pragma unroll
                for (int i = 0; i < 64; ++i) {
                    const unsigned long long eq = __ballot(key[i] == Tk); const int rank = base + __popcll(eq & ltmask);
                    const bool sel = (key[i] > Tk) || (key[i] == Tk && rank < need); base += __popcll(eq);
                    const unsigned long long wsel = __ballot(sel);
                    asm("s_nop 4\n\tv_writelane_b32 %0, %2, %4\n\tv_writelane_b32 %1, %3, %4" : "+v"(wlo), "+v"(whi) : "s"((int)(unsigned)wsel), "s"((int)(unsigned)(wsel >> 32)), "n"(i));
                }
            }
            myword = ((unsigned long long)(unsigned)whi << 32) | (unsigned long long)(unsigned)wlo;
        }
        MASK[(size_t)q * 64 + lane] = myword;
    }
}

#undef SEL_LOAD
__device__ __forceinline__ void ln1_phase(Frame& F, const bf16* xres, const bf16* Y, const float* g1, const float* b1, bf16* XMB, const float* rw, const float* rb,
                                          bf16* XP, gu32* gcount, int* ROWS, float* GATES, const int pmode = 3) {
    const int lane = F.lane, wid = F.wave, tid = F.tid;
    float ALPHA_ = ALPHA; asm volatile("" : "+v"(ALPHA_));
    LAS float* x32 = (LAS float*)(F.lds + RING_OFF);
    volatile LAS unsigned* cnt = (volatile LAS unsigned*)(F.lds + L_CNT); volatile LAS unsigned* base = (volatile LAS unsigned*)(F.lds + L_BASE);
    LAS int* route = (LAS int*)(F.lds + L_ROUTE);
    const int e = lane & 31, half = lane >> 5;
    const float rbe = rb[e];
    const __amdgpu_buffer_rsrc_t xrs_ = __builtin_amdgcn_make_buffer_rsrc((void*)xres, 0, T * D * 2, 0x00020000), yrs_ = __builtin_amdgcn_make_buffer_rsrc((void*)Y, 0, T * D * 2, 0x00020000);
    for (int chunk = F.bid; chunk < T / 64; chunk += F.G) {
        if (tid < 32) cnt[tid] = 0u;
        __syncthreads();
        u32x2 rxn[4][4], ryn[4][4];
#define LN1_LOAD(B) do { _Pragma("unroll") for (int rr = 0; rr < 4; ++rr) { const int ro_ = (chunk * 64 + wid * 8 + (B) * 4 + rr) * (D * 2);       \
            _Pragma("unroll") for (int j = 0; j < 4; ++j) { rxn[rr][j] = __builtin_bit_cast(u32x2, __builtin_amdgcn_raw_buffer_load_b64(xrs_, lane * 8, ro_ + 512 * j, 2)); ryn[rr][j] = __builtin_bit_cast(u32x2, __builtin_amdgcn_raw_buffer_load_b64(yrs_, lane * 8, ro_ + 512 * j, 2)); } } } while (0)
        LN1_LOAD(0);
#pragma unroll 1
        for (int batch = 0; batch < 2; ++batch) {
            const int lrow0 = wid * 8 + batch * 4, row0 = chunk * 64 + lrow0;
            u32x2 rx[4][4], ry[4][4];
#pragma unroll
            for (int rr = 0; rr < 4; ++rr)
#pragma unroll
                for (int j = 0; j < 4; ++j) { rx[rr][j] = rxn[rr][j]; ry[rr][j] = ryn[rr][j]; }
            if (batch == 0) LN1_LOAD(1);
            float xv[4][16], mean_[4], rstd_[4];
#pragma unroll
            for (int rr = 0; rr < 4; ++rr) { float s = 0.f;
#pragma unroll
                for (int j = 0; j < 4; ++j) { const u32x2 xx = rx[rr][j], yy = ry[rr][j];
                    xv[rr][4 * j] = ALPHA_ * bflo(xx.x) + bflo(yy.x); xv[rr][4 * j + 1] = ALPHA_ * bfhi(xx.x) + bfhi(yy.x); xv[rr][4 * j + 2] = ALPHA_ * bflo(xx.y) + bflo(yy.y); xv[rr][4 * j + 3] = ALPHA_ * bfhi(xx.y) + bfhi(yy.y);
                    s += (xv[rr][4 * j] + xv[rr][4 * j + 1]) + (xv[rr][4 * j + 2] + xv[rr][4 * j + 3]); }
                mean_[rr] = s; }
#pragma unroll
            for (int rr = 0; rr < 4; ++rr) mean_[rr] = wave_sum(mean_[rr]);
#pragma unroll
            for (int rr = 0; rr < 4; ++rr) { mean_[rr] *= (1.f / D); float s2 = 0.f;
#pragma unroll
                for (int k = 0; k < 16; ++k) { xv[rr][k] -= mean_[rr]; s2 += xv[rr][k] * xv[rr][k]; }
                rstd_[rr] = s2; }
            __builtin_amdgcn_sched_barrier(0);
            f32x4 gg_[4], bb_[4];
#pragma unroll
            for (int j = 0; j < 4; ++j) { gg_[j] = __builtin_bit_cast(f32x4, __builtin_amdgcn_raw_buffer_load_b128(__builtin_amdgcn_make_buffer_rsrc((void*)g1, 0, D * 4, 0x00020000), lane * 16, j * 1024, 0)); bb_[j] = __builtin_bit_cast(f32x4, __builtin_amdgcn_raw_buffer_load_b128(__builtin_amdgcn_make_buffer_rsrc((void*)b1, 0, D * 4, 0x00020000), lane * 16, j * 1024, 0)); }
            __builtin_amdgcn_sched_barrier(0);
#pragma unroll
            for (int rr = 0; rr < 4; ++rr) rstd_[rr] = wave_sum(rstd_[rr]);
#pragma unroll
            for (int rr = 0; rr < 4; ++rr) { const float rstd = 1.0f / sqrtf(rstd_[rr] * (1.f / D) + LN_EPS);
#pragma unroll
                for (int j = 0; j < 4; ++j) { const f32x4 gg = gg_[j], bb = bb_[j];
                    f32x4 o;
#pragma unroll
                    for (int k = 0; k < 4; ++k) o[k] = xv[rr][4 * j + k] * rstd * gg[k] + bb[k];
                    u32x2 pb; pb.x = pk2(o[0], o[1]); pb.y = pk2(o[2], o[3]);
                    *(u32x2*)(XMB + (size_t)(row0 + rr) * D + 4 * lane + 256 * j) = pb;
                    *(LAS f32x4*)(x32 + (wid * 4 + rr) * 1028 + 4 * lane + 256 * j) = o; } }
            float a0 = 0.f, a1 = 0.f, a2 = 0.f, a3 = 0.f;
            float wA[32], wB[32];
            const __amdgpu_buffer_rsrc_t wrs = __builtin_amdgcn_make_buffer_rsrc((void*)rw, 0, D * NEXP * 4, 0x00020000);
            const int wvo = ((wid * 128 + half * 4) * 32 + e) * 4;
            __builtin_amdgcn_sched_barrier(0);
            if (pmode & 1) {
#pragma unroll
                for (int i = 0; i < 8; ++i)
#pragma unroll
                    for (int t = 0; t < 4; ++t) wA[4 * i + t] = __uint_as_float(__builtin_amdgcn_raw_buffer_load_b32(wrs, wvo, (8 * i + t) * 128, 0));
            }
            __builtin_amdgcn_sched_barrier(0);
            __syncthreads();
            if (pmode & 1) {
                f32x16 pacc, pacc1;
#pragma unroll
                for (int r = 0; r < 16; ++r) { pacc[r] = 0.f; pacc1[r] = 0.f; }
                const LAS float* xa = x32 + (lane & 31) * 1028 + wid * 128 + half * 4;
                f32x4 xq[16];
#pragma unroll
                for (int i = 0; i < 8; ++i) xq[i] = *(const LAS f32x4*)(xa + 8 * i);
#pragma unroll
                for (int i = 0; i < 8; ++i)
#pragma unroll
                    for (int t = 0; t < 4; ++t) wB[4 * i + t] = __uint_as_float(__builtin_amdgcn_raw_buffer_load_b32(wrs, wvo, (64 + 8 * i + t) * 128, 0));
#pragma unroll
                for (int i = 0; i < 8; ++i) {
                    pacc = __builtin_amdgcn_mfma_f32_32x32x2f32(xq[i][0], wA[4 * i + 0], pacc, 0, 0, 0); pacc1 = __builtin_amdgcn_mfma_f32_32x32x2f32(xq[i][1], wA[4 * i + 1], pacc1, 0, 0, 0);
                    pacc = __builtin_amdgcn_mfma_f32_32x32x2f32(xq[i][2], wA[4 * i + 2], pacc, 0, 0, 0); pacc1 = __builtin_amdgcn_mfma_f32_32x32x2f32(xq[i][3], wA[4 * i + 3], pacc1, 0, 0, 0); }
                __builtin_amdgcn_sched_barrier(0);
#pragma unroll
                for (int i = 8; i < 16; ++i) xq[i] = *(const LAS f32x4*)(xa + 8 * i);
#pragma unroll
                for (int i = 0; i < 8; ++i) {
                    pacc = __builtin_amdgcn_mfma_f32_32x32x2f32(xq[8 + i][0], wB[4 * i + 0], pacc, 0, 0, 0); pacc1 = __builtin_amdgcn_mfma_f32_32x32x2f32(xq[8 + i][1], wB[4 * i + 1], pacc1, 0, 0, 0);
                    pacc = __builtin_amdgcn_mfma_f32_32x32x2f32(xq[8 + i][2], wB[4 * i + 2], pacc, 0, 0, 0); pacc1 = __builtin_amdgcn_mfma_f32_32x32x2f32(xq[8 + i][3], wB[4 * i + 3], pacc1, 0, 0, 0); }
#pragma unroll
                for (int r = 0; r < 16; ++r) pacc[r] += pacc1[r];
                __syncthreads();
                LAS float* pw = x32 + wid * 1024 + e;
#pragma unroll
                for (int r = 0; r < 16; ++r) pw[crow(r, half) * 32] = pacc[r];
                __syncthreads();
                const LAS float* pr = x32 + (half * 4) * 1024 + (wid * 4) * 32 + e;
#pragma unroll
                for (int q = 0; q < 4; ++q) { a0 += pr[q * 1024]; a1 += pr[q * 1024 + 32]; a2 += pr[q * 1024 + 64]; a3 += pr[q * 1024 + 96]; }
            } else { __syncthreads(); __syncthreads(); }
            __syncthreads();
            float lg[4]; lg[0] = a0 + shx(a0, 32) + rbe; lg[1] = a1 + shx(a1, 32) + rbe; lg[2] = a2 + shx(a2, 32) + rbe; lg[3] = a3 + shx(a3, 32) + rbe;
            float selv[4][4]; int seli[4][4];
#pragma unroll
            for (int rr = 0; rr < 4; ++rr) {
                float v = lg[rr];
#pragma unroll
                for (int k = 0; k < 4; ++k) {
                    float bv = v; int bi = e;
#pragma unroll
                    for (int msk = 1; msk < 32; msk <<= 1) { const float ov = shx(bv, msk); const int oi = shxi(bi, msk); if (ov > bv || (ov == bv && oi < bi)) { bv = ov; bi = oi; } }
                    selv[rr][k] = bv; seli[rr][k] = bi;
                    if (bi == e) v = -INFINITY;
                }
            }
            if (lane < 16) {
                const int rr = lane >> 2, k = lane & 3;
                float sv[4]; int si[4];
#pragma unroll
                for (int q = 0; q < 4; ++q) { sv[q] = rr == 0 ? selv[0][q] : rr == 1 ? selv[1][q] : rr == 2 ? selv[2][q] : selv[3][q]; si[q] = rr == 0 ? seli[0][q] : rr == 1 ? seli[1][q] : rr == 2 ? seli[2][q] : seli[3][q]; }
                const float ex1 = __expf(sv[1] - sv[0]), ex2 = __expf(sv[2] - sv[0]), ex3 = __expf(sv[3] - sv[0]);
                const float isum = 1.0f / (1.0f + ex1 + ex2 + ex3);
                const int me = k == 0 ? si[0] : k == 1 ? si[1] : k == 2 ? si[2] : si[3];
                const float mg = (k == 0 ? 1.0f : k == 1 ? ex1 : k == 2 ? ex2 : ex3) * isum;
                const int mr = (int)__hip_atomic_fetch_add((LAS unsigned*)(F.lds + L_CNT) + me, 1u, __ATOMIC_RELAXED, __HIP_MEMORY_SCOPE_WORKGROUP);
                LAS int* rt = route + ((lrow0 + rr) * 4 + k) * 3;
                rt[0] = me; rt[1] = mr; rt[2] = __float_as_int(mg);
            }
        }
        __syncthreads();
        if (wid == 0) { const int l_ = lane_id_now(); if (l_ < 32) base[l_] = __hip_atomic_fetch_add(gcount + l_, cnt[l_], RLX_AGENT); }
        __syncthreads();
#pragma unroll 1
        for (int batch = 0; batch < 2; ++batch) {
            const int lrow0 = wid * 8 + batch * 4, row0 = chunk * 64 + lrow0;
            u32x4 sa[4], sb[4];
#pragma unroll
            for (int rr = 0; rr < 4; ++rr) { const bf16* src = XMB + (size_t)(row0 + rr) * D; sa[rr] = *(const u32x4*)(src + lane * 16); sb[rr] = *(const u32x4*)(src + lane * 16 + 8); }
            int vrow = 0;
            if (lane < 16) { const int rr = lane >> 2, k = lane & 3; const LAS int* rt = route + ((lrow0 + rr) * 4 + k) * 3; const int me = rt[0];
                vrow = me * CAPROWS + (int)base[me] + rt[1]; ROWS[(size_t)(row0 + rr) * 4 + k] = vrow; GATES[(size_t)(row0 + rr) * 4 + k] = __int_as_float(rt[2]); }
            if (pmode & 2) {
#pragma unroll
                for (int rr = 0; rr < 4; ++rr) {
                    const u32x4 a = sa[rr], b = sb[rr];
                    u32x4 o; o.x = pg8::pk4_fp8(bflo(a.x), bfhi(a.x), bflo(a.y), bfhi(a.y)); o.y = pg8::pk4_fp8(bflo(a.z), bfhi(a.z), bflo(a.w), bfhi(a.w));
                    o.z = pg8::pk4_fp8(bflo(b.x), bfhi(b.x), bflo(b.y), bfhi(b.y)); o.w = pg8::pk4_fp8(bflo(b.z), bfhi(b.z), bflo(b.w), bfhi(b.w));
#pragma unroll
                    for (int k = 0; k < 4; ++k) { const int vr = shli(vrow, rr * 4 + k); unsigned char* dst = (unsigned char*)XP + (size_t)vr * D;
                        __builtin_nontemporal_store(o, (u32x4*)(dst + lane * 16)); }
                }
            }
        }
        __syncthreads();
    }
}
#undef LN1_LOAD
__device__ __forceinline__ void ln2_phase(Frame& F, const bf16* XMB, const bf16* YP, const int* ROWS, const float* GATES, const float* g2, const float* b2, float* out, bf16* XB, unsigned char* XB8) {
    const int lane = F.lane;
    float ALPHA_ = ALPHA; asm volatile("" : "+v"(ALPHA_));
    const int rstride = F.G * NWAVES, row_first = F.bid * NWAVES + F.wave;
    const unsigned char* yp8 = (const unsigned char*)YP;
    int ix0 = 0, ix1 = 0, ix2 = 0, ix3 = 0; f32x4 gtn = {0.f, 0.f, 0.f, 0.f};
    u32x2 xbn[4]; int qn[4][4]; f32x4 gtc = {0.f, 0.f, 0.f, 0.f};
#define LN2_IDX(R) do { if ((R) < T) { ix0 = ROWS[(size_t)(R) * 4]; ix1 = ROWS[(size_t)(R) * 4 + 1]; ix2 = ROWS[(size_t)(R) * 4 + 2]; ix3 = ROWS[(size_t)(R) * 4 + 3]; gtn = *(const f32x4*)(GATES + (size_t)(R) * 4); } } while (0)
#define LN2_DATA(R) do { if ((R) < T) { gtc = gtn; _Pragma("unroll") for (int j = 0; j < 4; ++j) { const int c = 4 * lane + 256 * j; xbn[j] = *(const u32x2*)(XMB + (size_t)(R) * D + c); \
        qn[j][0] = *(const int*)(yp8 + (size_t)ix0 * D + c); qn[j][1] = *(const int*)(yp8 + (size_t)ix1 * D + c); qn[j][2] = *(const int*)(yp8 + (size_t)ix2 * D + c); qn[j][3] = *(const int*)(yp8 + (size_t)ix3 * D + c); } } } while (0)
    f32x4 gg_[4], bb_[4];
#pragma unroll
    for (int j = 0; j < 4; ++j) { gg_[j] = *(const f32x4*)(g2 + 4 * lane + 256 * j); bb_[j] = *(const f32x4*)(b2 + 4 * lane + 256 * j); }
    LN2_IDX(row_first);
    LN2_DATA(row_first);
    LN2_IDX(row_first + rstride);
    for (int row = row_first; row < T; row += rstride) {
        u32x2 xbc[4]; int qc[4][4]; const f32x4 gt = gtc;
#pragma unroll
        for (int j = 0; j < 4; ++j) { xbc[j] = xbn[j]; qc[j][0] = qn[j][0]; qc[j][1] = qn[j][1]; qc[j][2] = qn[j][2]; qc[j][3] = qn[j][3]; }
        LN2_DATA(row + rstride);
        LN2_IDX(row + 2 * rstride);
        float v[16]; float s = 0.f;
#pragma unroll
        for (int j = 0; j < 4; ++j) {
            const u32x2 xb_ = xbc[j]; const f32x4 xx = {bflo(xb_.x), bfhi(xb_.x), bflo(xb_.y), bfhi(xb_.y)};
            const int q0 = qc[j][0], q1 = qc[j][1], q2 = qc[j][2], q3 = qc[j][3];
            const f32x2 a0 = __builtin_amdgcn_cvt_pk_f32_fp8(q0, false), b0 = __builtin_amdgcn_cvt_pk_f32_fp8(q0, true), a1 = __builtin_amdgcn_cvt_pk_f32_fp8(q1, false), b1 = __builtin_amdgcn_cvt_pk_f32_fp8(q1, true);
            const f32x2 a2 = __builtin_amdgcn_cvt_pk_f32_fp8(q2, false), b2_ = __builtin_amdgcn_cvt_pk_f32_fp8(q2, true), a3 = __builtin_amdgcn_cvt_pk_f32_fp8(q3, false), b3 = __builtin_amdgcn_cvt_pk_f32_fp8(q3, true);
            const float g0 = gt[0] * (1.0f / 16.0f), g1 = gt[1] * (1.0f / 16.0f), g2_ = gt[2] * (1.0f / 16.0f), g3 = gt[3] * (1.0f / 16.0f);
            v[4 * j]     = ALPHA_ * xx[0] + ((g0 * a0[0] + g1 * a1[0]) + (g2_ * a2[0] + g3 * a3[0]));
            v[4 * j + 1] = ALPHA_ * xx[1] + ((g0 * a0[1] + g1 * a1[1]) + (g2_ * a2[1] + g3 * a3[1]));
            v[4 * j + 2] = ALPHA_ * xx[2] + ((g0 * b0[0] + g1 * b1[0]) + (g2_ * b2_[0] + g3 * b3[0]));
            v[4 * j + 3] = ALPHA_ * xx[3] + ((g0 * b0[1] + g1 * b1[1]) + (g2_ * b2_[1] + g3 * b3[1]));
            s += (v[4 * j] + v[4 * j + 1]) + (v[4 * j + 2] + v[4 * j + 3]); }
        const float mean = wave_sum(s) * (1.f / D); float s2 = 0.f;
#pragma unroll
        for (int k = 0; k < 16; ++k) { v[k] -= mean; s2 += v[k] * v[k]; }
        const float rstd = 1.0f / sqrtf(wave_sum(s2) * (1.f / D) + LN_EPS);
#pragma unroll
        for (int j = 0; j < 4; ++j) { const int c = 4 * lane + 256 * j; const f32x4 gg = gg_[j], bb = bb_[j];
            f32x4 o;
#pragma unroll
            for (int k = 0; k < 4; ++k) o[k] = v[4 * j + k] * rstd * gg[k] + bb[k];
            if (out) *(f32x4*)(out + (size_t)row * D + c) = o;
            u32x2 pb; pb.x = pk2(o[0], o[1]); pb.y = pk2(o[2], o[3]); *(u32x2*)(XB + (size_t)row * D + c) = pb;
            if (XB8) *(unsigned*)(XB8 + (size_t)row * D + c) = pg8::pk4_fp8(o[0], o[1], o[2], o[3]); }
    }
}
#undef LN2_IDX
#undef LN2_DATA

#ifndef MK_FP8TEST
#define MK_FP8TEST 0
#endif
typedef int i32x8 __attribute__((ext_vector_type(8)));
__device__ __forceinline__ int t8_val(int which, int rc, int g, int j) { unsigned h = (unsigned)(which * 7919 + rc * 104729 + g * 1299709 + j * 15485863 + 12345); h ^= h >> 13; h *= 0x5bd1e995u; h ^= h >> 15; return (int)(h % 9u) - 4; }
__device__ __forceinline__ void fp8_selftest(gu32* ctl, int lane) {
    const int rc = lane & 15, g = lane >> 4;
    i32x8 a, b;
#pragma unroll
    for (int w = 0; w < 8; ++w) {
        int wa = __builtin_amdgcn_cvt_pk_fp8_f32((float)t8_val(0, rc, g, 4 * w), (float)t8_val(0, rc, g, 4 * w + 1), 0, false);
        wa = __builtin_amdgcn_cvt_pk_fp8_f32((float)t8_val(0, rc, g, 4 * w + 2), (float)t8_val(0, rc, g, 4 * w + 3), wa, true);
        int wb = __builtin_amdgcn_cvt_pk_fp8_f32((float)t8_val(1, rc, g, 4 * w), (float)t8_val(1, rc, g, 4 * w + 1), 0, false);
        wb = __builtin_amdgcn_cvt_pk_fp8_f32((float)t8_val(1, rc, g, 4 * w + 2), (float)t8_val(1, rc, g, 4 * w + 3), wb, true);
        a[w] = wa; b[w] = wb;
    }
    f32x4 c = {0.f, 0.f, 0.f, 0.f};
    c = __builtin_amdgcn_mfma_scale_f32_16x16x128_f8f6f4(a, b, c, 0, 0, 0, 0x7f7f7f7f, 0, 0x7f7f7f7f);
    int bad = 0, scaled = 0;
#pragma unroll
    for (int reg = 0; reg < 4; ++reg) {
        const int row = 4 * (lane >> 4) + reg, col = lane & 15; int e = 0;
        for (int gg = 0; gg < 4; ++gg) for (int j = 0; j < 32; ++j) e += t8_val(0, row, gg, j) * t8_val(1, col, gg, j);
        if (c[reg] != (float)e) { bad = 1; if (e != 0 && (c[reg] == (float)e * 0.5f || c[reg] == (float)e * 2.0f || c[reg] == (float)e * 0.25f || c[reg] == (float)e * 4.0f)) scaled = 1; }
    }
    const unsigned long long mb = __ballot(bad), ms = __ballot(bad && scaled);
    if (lane == 0 && mb) __hip_atomic_store(ctl + CW_ERR, (mb == ms) ? 2u : 1u, RLX_AGENT);
}

constexpr int N_STEPS = 6, LAST_PHASE = 1 + 10 * 5 + 8;
__host__ __device__ constexpr bool phase_exists(int id) {
    if (id == 0) return true;
    if (id < 1 || id > LAST_PHASE) return false;
    const int s = (id - 1) / 10, p = (id - 1) % 10;
    if (p == 0) return true;
    if (p == 9) return false;
    if (s == 0 || s == 2) return false;
    if (p == 1 || p == 2) return s == 3;
    return true;
}
__global__ void __launch_bounds__(NTHREADS, 2) mk_fwd(Args args) {
    extern __shared__ __attribute__((aligned(16))) unsigned char lds_raw[];
    Frame F;
    F.lds = (LAS unsigned char*)lds_raw;
    F.tid = threadIdx.x; F.lane = F.tid & 63; F.wave = __builtin_amdgcn_readfirstlane(F.tid >> 6);
    F.bid = blockIdx.x; F.G = gridDim.x; F.vcu = (F.G % 8 == 0) ? (F.bid % 8) * (F.G / 8) + F.bid / 8 : F.bid;
    F.ctl = (gu32*)(args.ws + WS_CTL);
    const int lo = args.ph_lo, hi = args.ph_hi;
    const bool fused = (hi - lo) > 1;
    for (int u = F.tid; u < (LDS_BYTES - LDSCTL_OFF) / 4; u += NTHREADS) ((LAS unsigned*)(F.lds + LDSCTL_OFF))[u] = 0u;
    __syncthreads();
    XcdBarrier bar; bar.bar = (unsigned*)(F.ctl + CW_BAR); bar.x = 0; bar.st = nullptr;
    if (fused) bar = xcd_barrier_post((unsigned*)(F.ctl + CW_BAR), (volatile LAS unsigned*)(F.lds + L_XB));
    const bool split = fused && MK_SPLIT && (F.G % 16 == 0) && lo == 0 && hi > 16;
    const int NCV = split ? F.G / 2 : 0;
    const bool is_conv = split && F.bid < NCV;
    XcdBarrier bar2; bar2.bar = (unsigned*)(F.ctl + CW_BAR2); bar2.x = 0; bar2.st = nullptr;
    if (split && !is_conv) bar2 = xcd_barrier_post((unsigned*)(F.ctl + CW_BAR2), (volatile LAS unsigned*)(F.lds + L_XB2));
#ifndef MK_PROBE
#define MK_PROBE 0
#endif
#define IN(id) (lo <= (id) && (id) < hi)
#define PHASE_BEGIN ArgsP ap = (ArgsP)__builtin_amdgcn_kernarg_segment_ptr(); asm volatile("" : "+s"(ap)); GAS unsigned char* wsg_ = (GAS unsigned char*)ap->ws; asm volatile("" : "+s"(wsg_)); unsigned char* ws = (unsigned char*)wsg_; Frame Fp = F; { const int l_ = lane_id_now(); Fp.lane = l_; Fp.tid = F.wave * 64 + l_; } Fp.ctl = (gu32*)(ws + WS_CTL);
#define SEAM(id) do { if (fused && (id) != LAST_PHASE) { xcd_barrier(bar, F.wave == 0 && lane_id_now() == 0, (unsigned)F.G); if (MK_PROBE == 10) xcd_barrier(bar, F.wave == 0 && lane_id_now() == 0, (unsigned)F.G); } } while (0)
#define SEAMW(id, sync, last) do { if (!split) SEAM(id); else if (last) SEAM(id); else if ((sync) && !is_conv) xcd_barrier(bar2, F.wave == 0 && lane_id_now() == 0, (unsigned)(F.G - NCV)); } while (0)
#define WIN_FRAME do { if (split) { Fp.G = F.G - NCV; Fp.bid = F.bid - NCV; Fp.vcu = (Fp.G % 8 == 0) ? (Fp.bid % 8) * (Fp.G / 8) + Fp.bid / 8 : Fp.bid; } } while (0)
#define REPS(k) ((MK_PROBE) == (k) ? 2 : 1)

#ifndef SKIP_P0
    if (MK_FP8TEST && lo == 0 && F.bid == 0 && F.wave == 0) fp8_selftest(F.ctl, F.lane);
    if (IN(0)) { PHASE_BEGIN for (int rep = 0; rep < REPS(1); ++rep) p0_prologue(Fp, ap, ws, split ? 1 : 0); SEAM(0); }
#endif

    for (int s = 0; s < N_STEPS; ++s) {
        const int pb = 1 + 10 * s;
        const int layer = s == 0 ? 0 : (s == 1 ? 0 : (s <= 3 ? 1 : s - 2));
        const int kind = layer % 3;
        const bool rest = !(s == 0 || s == 2);
#ifndef SKIP_G1
        const bool inw = split && s <= 1;
        if (IN(pb) && inw && is_conv) {
            if (s == 0) { PHASE_BEGIN Fp.G = NCV; p0_prologue(Fp, ap, ws, 2); }
        } else
        if (IN(pb)) {
            PHASE_BEGIN
            if (inw) WIN_FRAME;
            pg8::Gemm g; pg8::EpiProj E; E.ssq_in = nullptr; E.ssq_out = nullptr; E.rope = (const pg8::f32x2*)(ws + WS_ROPE); E.rope_heads = 0u; E.oscale = 1.0f;
            if (s == 0) { g = pg8::Gemm{(const bf16*)(ws + WS_MEMB), (const bf16*)(ws + WS_WKV), NB * MEML, 2048, 1024, 1024}; E.O = (bf16*)(ws + WS_KVMEM); E.ldc = 2048; }
            else if (s == 3) { g = pg8::Gemm{(const bf16*)(ws + WS_PROJ), (const bf16*)(ws + WS_WUQ), T, 1280, 256, 1280}; E.O = (bf16*)(ws + WS_QQ); E.ldc = 1280; E.ssq_in = (const float*)(ws + WS_SSQ); E.rope_heads = 0xFFFFFu; }
            else { const int n = kind == 0 ? 2560 : (kind == 1 ? 1280 : 1536);
                g = pg8::Gemm{(const bf16*)(ws + WS_XB), (const bf16*)(ws + WS_WIN + (size_t)layer * 5 * MiB), T, n, 1024, 1024}; E.O = (bf16*)(ws + WS_PROJ); E.ldc = n;
                if (layer != 0) { g.A = (const bf16*)(ws + WS_XB8); g.K = 512; g.lda = 512; E.oscale = 1.0f / 64.0f; }
                if (kind == 1) { E.ssq_out = (float*)(ws + WS_SSQ); E.rope_heads = 0xF0u | (1u << 16); }
                if (kind == 2) E.rope_heads = 0xFFFFu; }
            pg8::StaticOrder S; S.init(g.M, g.N, Fp.G, (s == 0 && !inw) ? Fp.G - 1 - Fp.bid : Fp.bid); if (s <= 1) S.split = 0;
            if (!(s == 0 || s == 1 || s == 3)) { for (int rep = 0; rep < REPS(2); ++rep) pg8::gemm_phase<pg8::EpiProj, pg8::StaticOrder, true, true, true>(F.lds + RING_OFF, g, S, E, F.wave * 64 + lane_id_now()); }
            else { for (int rep = 0; rep < REPS(2); ++rep) pg8::gemm_phase<pg8::EpiProj, pg8::StaticOrder, true, true, false>(F.lds + RING_OFF, g, S, E, F.wave * 64 + lane_id_now()); }
        }
        if (IN(pb)) { if (inw) SEAMW(pb, s == 1, false); else if (!(s == 0 && fused)) SEAM(pb); }
#endif
        if (s == 3) {
#ifndef SKIP_PS
            if (IN(pb + 1)) { PHASE_BEGIN for (int rep = 0; rep < ((MK_PROBE == 3 || MK_PROBE == 31) ? 2 : 1); ++rep) score_phase(Fp, (const bf16*)(ws + WS_QQ), (const bf16*)(ws + WS_PROJ), (float*)(ws + WS_ACT)); SEAM(pb + 1); }
#endif
#ifndef SKIP_PT
            if (IN(pb + 2)) { PHASE_BEGIN for (int rep = 0; rep < ((MK_PROBE == 3 || MK_PROBE == 32) ? 2 : 1); ++rep) select_phase(Fp, (const float*)(ws + WS_ACT), (unsigned long long*)(ws + WS_MASK)); SEAM(pb + 2); }
#endif
        }
        if (!rest) continue;
#ifndef SKIP_MIX
        if (IN(pb + 3) && !(inw && is_conv)) { PHASE_BEGIN if (inw) WIN_FRAME; for (int rep = 0; rep < ((MK_PROBE == 4 || (MK_PROBE == 41 && kind == 1) || (MK_PROBE == 42 && kind == 2) || (MK_PROBE == 43 && kind == 0)) ? 2 : 1); ++rep) mixer_phase(Fp, ap, ws, layer, kind, s + 8 * rep); }
        if (IN(pb + 3)) { if (inw) SEAMW(pb + 3, true, false); else SEAM(pb + 3); }
#endif
#ifndef SKIP_G2
        if (IN(pb + 4) && !(inw && is_conv)) {
            PHASE_BEGIN
            if (inw) WIN_FRAME;
            pg8::Gemm g{(const bf16*)(ws + WS_CAT), (const bf16*)(ws + WS_WOUT + (size_t)layer * 2 * MiB), T, 1024, 512, 512};
            pg8::EpiProj E; E.O = (bf16*)(ws + WS_Y); E.ldc = 1024; E.ssq_in = nullptr; E.ssq_out = nullptr; E.rope = nullptr; E.rope_heads = 0u; E.oscale = 1.0f / 128.0f;
            pg8::StaticOrder S; S.init(T, 1024, Fp.G, Fp.bid);
            for (int rep = 0; rep < REPS(5); ++rep) pg8::gemm_phase<pg8::EpiProj, pg8::StaticOrder, true, true, true>(F.lds + RING_OFF, g, S, E, F.wave * 64 + lane_id_now());
        }
        if (IN(pb + 4)) { if (inw) SEAMW(pb + 4, true, false); else SEAM(pb + 4); }
#endif
#ifndef SKIP_LN1
        if (IN(pb + 5) && !(inw && is_conv)) {
            PHASE_BEGIN
            if (inw) WIN_FRAME;
            for (int rep = 0; rep < ((MK_PROBE == 6 || MK_PROBE == 61 || MK_PROBE == 62 || MK_PROBE == 63) ? 2 : 1); ++rep)
            ln1_phase(Fp, (const bf16*)(ws + WS_XB), (const bf16*)(ws + WS_Y), ap->in[12] + layer * D, ap->in[13] + layer * D, (bf16*)(ws + WS_QQ),
                      ap->in[14] + (size_t)layer * D * NEXP, ap->in[15] + layer * NEXP, (bf16*)(ws + (rep ? WS_ACT : WS_XP)), Fp.ctl + (rep ? CW_GDUMMY : CW_GCOUNT) + layer * NEXP,
                      (int*)(ws + (rep ? WS_SSQ : WS_ROWS)), (float*)(ws + (rep ? WS_MASK : WS_GATES)), (rep && MK_PROBE == 61) ? 2 : (rep && MK_PROBE == 62) ? 1 : (rep && MK_PROBE == 63) ? 0 : 3);
        }
        if (IN(pb + 5)) { if (inw) SEAMW(pb + 5, true, true); else SEAM(pb + 5); }
#endif
        if (IN(pb + 6) || IN(pb + 7)) {
            LAS int* pref = (LAS int*)(F.lds + L_PREF); LAS int* tiles = (LAS int*)(F.lds + L_TILES);
#ifndef SKIP_G3
            if (IN(pb + 6)) {
                PHASE_BEGIN
                if (Fp.wave == 0) {
                    const int l_ = Fp.lane; const int tl_ = l_ < 32 ? (int)((__hip_atomic_load(Fp.ctl + CW_GCOUNT + layer * NEXP + (l_ & 31), RLX_AGENT) + 255u) >> 8) : 0;
                    int v_ = tl_ * 8;
#pragma unroll
                    for (int d_ = 1; d_ < 32; d_ <<= 1) { const int t_ = __builtin_amdgcn_ds_bpermute(((l_ - d_) & 63) << 2, v_); if (l_ >= d_) v_ += t_; }
                    if (l_ < 32) { tiles[l_] = tl_; pref[l_] = v_ - tl_ * 8; } if (l_ == 31) pref[32] = v_; }
                __syncthreads();
                pg8::Gemm g{(const bf16*)(ws + WS_XP), (const bf16*)(ws + WS_WGU + (size_t)layer * 64 * MiB), NEXP * CAPROWS, NEXP * 2048, 512, 512};
                pg8::EpiSwiglu E{(bf16*)(ws + WS_ACT), ap->in[17] + (size_t)layer * NEXP * 2048};
                pg8::MoeOrder S{pref, tiles, 8, pref[32], F.G, F.vcu};
                for (int rep = 0; rep < REPS(7); ++rep) pg8::gemm_phase<pg8::EpiSwiglu, pg8::MoeOrder, true, true, true>(F.lds + RING_OFF, g, S, E, F.wave * 64 + lane_id_now());
                SEAM(pb + 6);
            }
#endif
#ifndef SKIP_G4
            if (IN(pb + 7)) {
                PHASE_BEGIN
                if (Fp.wave == 0) {
                    const int l_ = Fp.lane; const int tl_ = l_ < 32 ? (int)((__hip_atomic_load(Fp.ctl + CW_GCOUNT + layer * NEXP + (l_ & 31), RLX_AGENT) + 255u) >> 8) : 0;
                    int v_ = tl_ * 4;
#pragma unroll
                    for (int d_ = 1; d_ < 32; d_ <<= 1) { const int t_ = __builtin_amdgcn_ds_bpermute(((l_ - d_) & 63) << 2, v_); if (l_ >= d_) v_ += t_; }
                    if (l_ < 32) { tiles[l_] = tl_; pref[l_] = v_ - tl_ * 4; } if (l_ == 31) pref[32] = v_; }
                __syncthreads();
                pg8::Gemm g{(const bf16*)(ws + WS_ACT), (const bf16*)(ws + WS_WDN + (size_t)layer * 32 * MiB), NEXP * CAPROWS, NEXP * 1024, 512, 512};
                pg8::EpiDown E{(bf16*)(ws + WS_XP), ap->in[19] + (size_t)layer * NEXP * 1024};
                pg8::MoeOrder S{pref, tiles, 4, pref[32], F.G, F.vcu};
                for (int rep = 0; rep < REPS(8); ++rep) pg8::gemm_phase<pg8::EpiDown, pg8::MoeOrder, true, true, true>(F.lds + RING_OFF, g, S, E, F.wave * 64 + lane_id_now());
                SEAM(pb + 7);
            }
#endif
        }
#ifndef SKIP_LN2
        if (IN(pb + 8)) {
            PHASE_BEGIN
            for (int rep = 0; rep < REPS(9); ++rep)
            ln2_phase(Fp, (const bf16*)(ws + WS_QQ), (const bf16*)(ws + WS_XP), (const int*)(ws + WS_ROWS), (const float*)(ws + WS_GATES), ap->in[20] + layer * D, ap->in[21] + layer * D,
                      layer == DEPTH - 1 ? ap->out : (float*)nullptr, (bf16*)(ws + WS_XB), (layer + 1 < DEPTH) ? (unsigned char*)(ws + WS_XB8) : (unsigned char*)nullptr);
            SEAM(pb + 8);
        }
#endif
    }
    if (MK_FP8TEST && hi > LAST_PHASE) {
        const unsigned code = __hip_atomic_load(F.ctl + CW_ERR, RLX_AGENT);
        if (code) { const float v = code == 2u ? 100.f : 10.f;
            for (int row = F.bid * NWAVES + F.wave; row < T; row += F.G * NWAVES) { f32x4* o = (f32x4*)(args.out + (size_t)row * D) + F.lane;
#pragma unroll
                for (int j = 0; j < 4; ++j) o[64 * j] = (f32x4){v, v, v, v}; } }
    }
#undef IN
#undef SEAM
}

extern "C" void kernel_launch(void* const* d_in, const int* in_sizes, int n_in, void* d_out, int out_size, void* d_ws, size_t ws_size, hipStream_t stream) {
    static int grid = 0;
    if (grid == 0) {
        if (n_in != 22 || in_sizes[0] != T * D || out_size != T * D || ws_size < WS_END) { fprintf(stderr, "kernel_launch: unexpected shapes (n_in %d, in0 %d, out %d, ws %zu < %zu); nothing launched\n", n_in, n_in > 0 ? in_sizes[0] : -1, out_size, ws_size, (size_t)WS_END); grid = -1; return; }
        int dev = 0, cus = 0, per_cu = 0;
        if (hipGetDevice(&dev) != hipSuccess || hipDeviceGetAttribute(&cus, hipDeviceAttributeMultiprocessorCount, dev) != hipSuccess) { fprintf(stderr, "kernel_launch: device query failed\n"); grid = -1; return; }
        if (hipFuncSetAttribute((const void*)mk_fwd, hipFuncAttributeMaxDynamicSharedMemorySize, LDS_BYTES) != hipSuccess) { fprintf(stderr, "kernel_launch: hipFuncSetAttribute failed\n"); grid = -1; return; }
        if (hipOccupancyMaxActiveBlocksPerMultiprocessor(&per_cu, (const void*)mk_fwd, NTHREADS, LDS_BYTES) != hipSuccess || per_cu < 1) fprintf(stderr, "kernel_launch: note: occupancy query reports %d workgroups per CU\n", per_cu);
        (void)hipGetLastError();
        grid = cus;
    }
    if (grid < 0) return;
    if (hipMemsetAsync((char*)d_ws + WS_CTL, 0, CTL_ZERO_BYTES, stream) != hipSuccess) { fprintf(stderr, "kernel_launch: hipMemsetAsync failed\n"); return; }
    Args a{};
    for (int i = 0; i < 22; ++i) a.in[i] = (const float*)d_in[i];
    a.out = (float*)d_out; a.ws = (unsigned char*)d_ws;
    unsigned char* ws = (unsigned char*)d_ws;
    { int nj = 0, items = 0;
      auto add = [&](const float* src, int ldw, int K, int col0, int nvalid, int nblk, size_t dst_off, int row0, const float* scale, int f8 = 0, float mul = 1.0f) {
          Job& j = a.jobs[nj++]; j.src = src; j.dst = (bf16*)(ws + dst_off); j.scale = scale; j.ldw = ldw; j.K = K; j.col0 = col0; j.nvalid = nvalid; j.nblk = nblk; j.row0 = row0; j.item0 = items; j.f8 = f8; j.mul = mul; j.pad = 0;
          items += nblk * (K / 128); };
      const float* a_w_in = a.in[2]; const float* b_w_in = a.in[4]; const float* c_w_in = a.in[8];
      add(a_w_in, 2560, 1024, 0, 2560, 10, WS_WIN + 0 * 5 * MiB, 0, nullptr);
      add(a_w_in + (size_t)1024 * 2560, 2560, 1024, 0, 2560, 10, WS_WIN + 3 * 5 * MiB, 0, nullptr, 1, 64.0f);
      add(b_w_in, 1096, 1024, 0, 768, 3, WS_WIN + 1 * 5 * MiB, 0, nullptr, 1, 64.0f);
      add(b_w_in, 1096, 1024, 840, 256, 1, WS_WIN + 1 * 5 * MiB, 768, nullptr, 1, 64.0f);
      add(b_w_in, 1096, 1024, 768, 72, 1, WS_WIN + 1 * 5 * MiB, 1024, nullptr, 1, 64.0f);
      add(c_w_in, 1536, 1024, 0, 1536, 6, WS_WIN + 2 * 5 * MiB, 0, nullptr, 1, 64.0f);
      for (int l = 0; l < 4; ++l) add(a.in[10] + (size_t)l * 1024 * 1024, 1024, 1024, 0, 1024, 4, WS_WOUT + (size_t)l * 2 * MiB, 0, nullptr, 1, 128.0f);
      for (int l = 0; l < 4; ++l) add(a.in[11] + (size_t)l * 1024 * 512, 512, 1024, 0, 512, 2, WS_WKV, 512 * l, nullptr);
      add(a.in[6], 768, 256, 0, 768, 3, WS_WUQ, 0, a.in[5]);
      add(a.in[7], 512, 256, 0, 512, 2, WS_WUQ, 768, a.in[5]);
      a.njob_items = items; }
    a.pad = 0;
#if MK_MULTI
    for (int id = 0; id <= LAST_PHASE; ++id) {
        if (!phase_exists(id)) continue;
        a.ph_lo = id; a.ph_hi = id + 1;
        hipLaunchKernelGGL(mk_fwd, dim3(grid), dim3(NTHREADS), LDS_BYTES, stream, a);
    }
#else
    a.ph_lo = 0; a.ph_hi = LAST_PHASE + 1;
    hipLaunchKernelGGL(mk_fwd, dim3(grid), dim3(NTHREADS), LDS_BYTES, stream, a);
#endif
    const hipError_t le = hipPeekAtLastError();
    if (le != hipSuccess) fprintf(stderr, "kernel_launch: launch failed: %s (grid %d)\n", hipGetErrorName(le), grid);
}
```
